# Optimizing an MI355X kernel written in HIP

```python
import math
import jax
import jax.numpy as jnp
from jax import lax
import numpy as np

D_MODEL = 1024
BATCH = 2
SEQ = 16384
DEPTH = 2
DEC_BATCH = 1
DEC_SEQ = 16384
PAST_LEN = 128

GRID_W = 64
Q_BLOCK = 128
NORM_EPS = 1e-6
ROPE_THETA = 10000.0
NEG_BIG = -1e30
A_HEADS = 8
A_NOPE = 64
A_ROPE = 32
A_V = 64
A_Q_LORA = 384
A_KV_LORA = 256
B_PAIRS = ((128, 1), (512, 4), (2048, 16))
B_GROUPS = 3
B_HEADS = 8
B_HD = 64
C_HEADS = 8
C_KV_HEADS = 2
C_HD = 64
NUM_BUCKETS = 32
MAX_DISTANCE = 2048
D_FF = 4 * D_MODEL
N_BRANCH = 3
A_WIDTH = A_HEADS * A_V
B_WIDTH = B_HEADS * B_HD
C_WIDTH = C_HEADS * C_HD
IN_SPLIT = (A_Q_LORA, A_KV_LORA, A_ROPE, 3 * B_GROUPS * B_HEADS * B_HD, C_HEADS * C_HD, C_KV_HEADS * C_HD, C_KV_HEADS * C_HD, N_BRANCH * D_MODEL)
IN_COLS = A_Q_LORA + A_KV_LORA + A_ROPE + 3 * B_GROUPS * B_HEADS * B_HD + C_HEADS * C_HD + 2 * C_KV_HEADS * C_HD + N_BRANCH * D_MODEL

kernel_name = "hybrid_mla_dilated_axialgqa_encoder"


def rms_norm(x, g):
    xf = x.astype(jnp.float32)
    y = xf * lax.rsqrt(jnp.mean(xf * xf, axis=-1, keepdims=True) + NORM_EPS)
    return (y * g.astype(jnp.float32)).astype(x.dtype)


def split_columns(z):
    parts = []
    start = 0
    for width in IN_SPLIT:
        parts.append(z[..., start:start + width])
        start += width
    return parts


def apply_rope(x, pos):
    half = x.shape[-1] // 2
    freqs = ROPE_THETA ** (-jnp.arange(half, dtype=jnp.float32) / half)
    ang = pos.astype(jnp.float32)[:, None] * freqs[None, :]
    cos = jnp.cos(ang)[None, :, None, :]
    sin = jnp.sin(ang)[None, :, None, :]
    xf = x.astype(jnp.float32)
    x1, x2 = xf[..., :half], xf[..., half:]
    return jnp.concatenate([x1 * cos - x2 * sin, x1 * sin + x2 * cos], axis=-1).astype(x.dtype)


def t5_bucket(rel):
    half = NUM_BUCKETS // 2
    max_exact = half // 2
    ret = jnp.where(rel > 0, half, 0)
    n = jnp.abs(rel)
    nf = jnp.maximum(n, 1).astype(jnp.float32)
    large = max_exact + (jnp.log(nf / max_exact) / math.log(MAX_DISTANCE / max_exact) * (half - max_exact)).astype(jnp.int32)
    large = jnp.minimum(large, half - 1)
    return ret + jnp.where(n < max_exact, n, large)


def blocked_attention(q, k, v):
    bsz, seq, hq, dq = q.shape
    hk = k.shape[2]
    dv = v.shape[-1]
    rep = hq // hk
    scale = dq ** -0.5
    qb = q.reshape(bsz, seq // Q_BLOCK, Q_BLOCK, hk, rep, dq).swapaxes(0, 1)

    def one_block(q_blk):
        s = jnp.einsum('bqgrd,bkgd->bgrqk', q_blk, k).astype(jnp.float32) * scale
        p = jax.nn.softmax(s, axis=-1)
        return jnp.einsum('bgrqk,bkgd->bqgrd', p.astype(v.dtype), v)

    o = lax.map(one_block, qb)
    return o.swapaxes(0, 1).reshape(bsz, seq, hq, dv)


def dilated_group_attention(q, k, v, bias_hj, dilation, n_side):
    bsz, seq, nh, hd = q.shape
    scale = hd ** -0.5
    offs = dilation * jnp.arange(-n_side, n_side + 1, dtype=jnp.int32)
    nblk = seq // Q_BLOCK
    qb = q.reshape(bsz, nblk, Q_BLOCK, nh, hd).swapaxes(0, 1)

    def one_block(args):
        q_blk, blk = args
        t = blk * Q_BLOCK + jnp.arange(Q_BLOCK, dtype=jnp.int32)
        idx = t[:, None] + offs[None, :]
        valid = (idx >= 0) & (idx < seq)
        idx_c = jnp.clip(idx, 0, seq - 1)
        k_g = k[:, idx_c]
        v_g = v[:, idx_c]
        s = jnp.einsum('bqhd,bqjhd->bhqj', q_blk, k_g).astype(jnp.float32) * scale + bias_hj[None, :, None, :]
        s = jnp.where(valid[None, None], s, NEG_BIG)
        lse = jax.nn.logsumexp(s, axis=-1)
        p = jnp.exp(s - lse[..., None])
        o = jnp.einsum('bhqj,bqjhd->bqhd', p.astype(v.dtype), v_g)
        return o, lse.transpose(0, 2, 1)

    o, lse = lax.map(one_block, (qb, jnp.arange(nblk, dtype=jnp.int32)))
    o = o.swapaxes(0, 1).reshape(bsz, seq, nh, hd)
    lse = lse.swapaxes(0, 1).reshape(bsz, seq, nh)
    return o, lse


def encoder_layer(x, norm_mix, w_in, a_q_norm, a_kv_norm, a_w_uq, a_w_ukv, c_q_norm, c_k_norm,
                  w_br_a, w_br_b, w_br_c, w_out, norm_ffn, w_up, w_down, t5_table):
    bsz, seq, _ = x.shape
    rows = seq // GRID_W
    pos = jnp.arange(seq, dtype=jnp.int32)
    row_idx = jnp.repeat(jnp.arange(rows, dtype=jnp.int32), GRID_W)
    col_idx = jnp.tile(jnp.arange(GRID_W, dtype=jnp.int32), rows)

    h = rms_norm(x, norm_mix)
    z = h @ w_in
    cq, ckv, kr, qkv_b, q_c, k_c, v_c, gate_logits = split_columns(z)

    cq = rms_norm(cq, a_q_norm)
    q_a = (cq @ a_w_uq).reshape(bsz, seq, A_HEADS, A_NOPE + A_ROPE)
    q_a = jnp.concatenate([q_a[..., :A_NOPE], apply_rope(q_a[..., A_NOPE:], pos)], axis=-1)
    ckv = rms_norm(ckv, a_kv_norm)
    kv_a = (ckv @ a_w_ukv).reshape(bsz, seq, A_HEADS, A_NOPE + A_V)
    k_rope = jnp.broadcast_to(apply_rope(kr[:, :, None, :], pos), (bsz, seq, A_HEADS, A_ROPE))
    k_a = jnp.concatenate([kv_a[..., :A_NOPE], k_rope], axis=-1)
    o_a = blocked_attention(q_a, k_a, kv_a[..., A_NOPE:]).reshape(bsz, seq, A_WIDTH)

    qkv_b = qkv_b.reshape(bsz, seq, 3, B_GROUPS, B_HEADS, B_HD)
    outs, lses = [], []
    for g, (window, dilation) in enumerate(B_PAIRS):
        n_side = window // (2 * dilation)
        offs = dilation * jnp.arange(-n_side, n_side + 1, dtype=jnp.int32)
        bias_hj = t5_table[t5_bucket(offs)][:, g * B_HEADS:(g + 1) * B_HEADS].T.astype(jnp.float32)
        o_g, lse_g = dilated_group_attention(qkv_b[:, :, 0, g], qkv_b[:, :, 1, g], qkv_b[:, :, 2, g], bias_hj, dilation, n_side)
        outs.append(o_g)
        lses.append(lse_g)
    wts = jax.nn.softmax(jnp.stack(lses, axis=0), axis=0)
    o_b = jnp.einsum('gbsh,gbshd->bshd', wts.astype(x.dtype), jnp.stack(outs, axis=0)).reshape(bsz, seq, B_WIDTH)

    q_c = rms_norm(q_c.reshape(bsz, seq, C_HEADS, C_HD), c_q_norm)
    k_c = rms_norm(k_c.reshape(bsz, seq, C_KV_HEADS, C_HD), c_k_norm)
    v_c = v_c.reshape(bsz, seq, C_KV_HEADS, C_HD)
    half = C_HD // 2
    q_c = jnp.concatenate([apply_rope(q_c[..., :half], row_idx), apply_rope(q_c[..., half:], col_idx)], axis=-1)
    k_c = jnp.concatenate([apply_rope(k_c[..., :half], row_idx), apply_rope(k_c[..., half:], col_idx)], axis=-1)
    o_c = blocked_attention(q_c, k_c, v_c).reshape(bsz, seq, C_WIDTH)

    gates = jax.nn.sigmoid(gate_logits.reshape(bsz, seq, N_BRANCH, D_MODEL))
    mix = gates[:, :, 0] * (o_a @ w_br_a) + gates[:, :, 1] * (o_b @ w_br_b) + gates[:, :, 2] * (o_c @ w_br_c)
    x = x + mix @ w_out

    h2 = rms_norm(x, norm_ffn)
    x = x + jnp.square(jax.nn.relu(h2 @ w_up)) @ w_down
    return x


def trunk(x, norm_mix, w_in, a_q_norm, a_kv_norm, a_w_uq, a_w_ukv, c_q_norm, c_k_norm,
          w_br_a, w_br_b, w_br_c, w_out, norm_ffn, w_up, w_down, t5_table, final_norm):
    for l in range(DEPTH):
        x = encoder_layer(x, norm_mix[l], w_in[l], a_q_norm[l], a_kv_norm[l], a_w_uq[l], a_w_ukv[l],
                          c_q_norm[l], c_k_norm[l], w_br_a[l], w_br_b[l], w_br_c[l], w_out[l],
                          norm_ffn[l], w_up[l], w_down[l], t5_table)
    return rms_norm(x, final_norm)


def setup_inputs(seed: int = 0) -> dict:
    key = jax.random.key(seed)
    ks = jax.random.split(key, 20)
    f32 = jnp.float32

    def dense(k, fan_in, fan_out):
        return jax.random.normal(k, (DEPTH, fan_in, fan_out), f32) * fan_in ** -0.5

    def gain(k, shape):
        return 1.0 + 0.01 * jax.random.normal(k, shape, f32)

    return {
        "x_prompt": jax.random.normal(ks[0], (BATCH, SEQ, D_MODEL), f32),
        "x_sample": jax.random.normal(ks[1], (DEC_BATCH, DEC_SEQ, D_MODEL), f32),
        "norm_mix": gain(ks[2], (DEPTH, D_MODEL)),
        "w_in": dense(ks[3], D_MODEL, IN_COLS),
        "a_q_norm": gain(ks[4], (DEPTH, A_Q_LORA)),
        "a_kv_norm": gain(ks[5], (DEPTH, A_KV_LORA)),
        "a_w_uq": dense(ks[6], A_Q_LORA, A_HEADS * (A_NOPE + A_ROPE)),
        "a_w_ukv": dense(ks[7], A_KV_LORA, A_HEADS * (A_NOPE + A_V)),
        "c_q_norm": gain(ks[8], (DEPTH, C_HD)),
        "c_k_norm": gain(ks[9], (DEPTH, C_HD)),
        "w_br_a": dense(ks[10], A_WIDTH, D_MODEL),
        "w_br_b": dense(ks[11], B_WIDTH, D_MODEL),
        "w_br_c": dense(ks[12], C_WIDTH, D_MODEL),
        "w_out": dense(ks[13], D_MODEL, D_MODEL),
        "norm_ffn": gain(ks[14], (DEPTH, D_MODEL)),
        "w_up": dense(ks[15], D_MODEL, D_FF),
        "w_down": dense(ks[16], D_FF, D_MODEL),
        "t5_table": 0.1 * jax.random.normal(ks[17], (NUM_BUCKETS, B_GROUPS * B_HEADS), f32),
        "final_norm": gain(ks[18], (D_MODEL,)),
    }


def reference(x_prompt, x_sample, norm_mix, w_in, a_q_norm, a_kv_norm, a_w_uq, a_w_ukv, c_q_norm, c_k_norm,
              w_br_a, w_br_b, w_br_c, w_out, norm_ffn, w_up, w_down, t5_table, final_norm):
    y_prompt = trunk(x_prompt, norm_mix, w_in, a_q_norm, a_kv_norm, a_w_uq, a_w_ukv, c_q_norm, c_k_norm,
                     w_br_a, w_br_b, w_br_c, w_out, norm_ffn, w_up, w_down, t5_table, final_norm)
    y_sample = trunk(x_sample, norm_mix, w_in, a_q_norm, a_kv_norm, a_w_uq, a_w_ukv, c_q_norm, c_k_norm,
                     w_br_a, w_br_b, w_br_c, w_out, norm_ffn, w_up, w_down, t5_table, final_norm)
    return (y_prompt, y_sample)
```

```cpp
#include <hip/hip_runtime.h>
#include <hip/hip_cooperative_groups.h>
#include <stdint.h>
#include <cstdio>
namespace cg = cooperative_groups;

typedef unsigned short bf16_t;
typedef short bf16x8 __attribute__((ext_vector_type(8)));
typedef short s16x4 __attribute__((ext_vector_type(4)));
typedef float f32x16 __attribute__((ext_vector_type(16)));
typedef float f32x4 __attribute__((ext_vector_type(4)));
typedef float f32x2 __attribute__((ext_vector_type(2)));
typedef unsigned u32x4 __attribute__((ext_vector_type(4)));
typedef unsigned u32x2 __attribute__((ext_vector_type(2)));
typedef __bf16 bf16x2_t __attribute__((ext_vector_type(2)));

#define DI __device__ __forceinline__
#define MFMA(a, b, c) __builtin_amdgcn_mfma_f32_32x32x16_bf16((a), (b), (c), 0, 0, 0)

DI unsigned pk2(float lo, float hi) { f32x2 v = {lo, hi}; bf16x2_t b = __builtin_convertvector(v, bf16x2_t); return __builtin_bit_cast(unsigned, b); }
DI bf16_t f2bf(float x) { return (bf16_t)(pk2(x, 0.f) & 0xffffu); }
DI float bflo(unsigned u) { return __uint_as_float(u << 16); }
DI float bfhi(unsigned u) { return __uint_as_float(u & 0xffff0000u); }
DI float bf2f(bf16_t b) { return __uint_as_float(((unsigned)b) << 16); }
DI int crow(int i, int h) { return (i & 3) + 8 * (i >> 2) + 4 * h; }
DI float fexp2(float x) { return __builtin_amdgcn_exp2f(x); }
DI int otid() { int t = threadIdx.x; asm volatile("" : "+v"(t)); return t; }
DI int wave_of(int tid) { return __builtin_amdgcn_readfirstlane(tid >> 6); }

constexpr int S = 16384, DM = 1024, ZP = 7680, DFF = 4096;
constexpr int ZC_CQ = 0, ZC_CKV = 384, ZC_KR = 640, ZC_QKVB = 768, ZC_QC = 3840, ZC_KC = 4352, ZC_GATE = 4608;
constexpr int GC_VB = 3840, GC_VC = 6016;
constexpr float LOG2E = 1.4426950408889634f, LN2 = 0.6931471805599453f;

constexpr size_t WT_IN = 0;
constexpr size_t WT_UQ = WT_IN + (size_t)9216 * 1024 * 2;
constexpr size_t WT_UKV = WT_UQ + (size_t)768 * 384 * 2;
constexpr size_t WT_BRA = WT_UKV + (size_t)1024 * 256 * 2;
constexpr size_t WT_BRB = WT_BRA + (size_t)1024 * 512 * 2;
constexpr size_t WT_BRC = WT_BRB + (size_t)1024 * 512 * 2;
constexpr size_t WT_OUT = WT_BRC + (size_t)1024 * 512 * 2;
constexpr size_t WT_UP = WT_OUT + (size_t)1024 * 3072 * 2;
constexpr size_t WT_DOWN = WT_UP + (size_t)4096 * 1024 * 2;
constexpr size_t OFF_CS = WT_DOWN + (size_t)1024 * 4096 * 2;
constexpr size_t OFF_BT = OFF_CS + (size_t)16384 * 16 * 8;
constexpr size_t OFF_Z = OFF_BT + 32768;
constexpr size_t OFF_H = OFF_Z + (size_t)S * ZP * 2;
constexpr size_t OFF_QA = OFF_H + (size_t)S * 1024 * 2;
constexpr size_t OFF_KA = OFF_QA + (size_t)S * 768 * 2;
constexpr size_t OFF_VAT = OFF_KA + (size_t)S * 512 * 2;
constexpr size_t OFF_VCT = OFF_VAT + (size_t)S * 512 * 2;
constexpr size_t OFF_OA = OFF_VCT + (size_t)S * 128 * 2;
constexpr size_t OFF_OB = OFF_OA + (size_t)S * 512 * 2;
constexpr size_t OFF_OC = OFF_OB + (size_t)S * 512 * 2;
constexpr size_t OFF_LSE = OFF_OC + (size_t)S * 512 * 2;
constexpr size_t OFF_SSQ = OFF_LSE + (size_t)3 * S * 8 * 4;
constexpr size_t OFF_VBT = OFF_SSQ + (size_t)3 * S * 4;
constexpr size_t OFF_BAR = OFF_VBT + (size_t)1536 * S * 2;
constexpr size_t WS_END = OFF_BAR + 16384;

constexpr int LDS_BYTES = 131072 + 1024;

struct Params {
  const float* x_prompt; const float* x_sample;
  const float* norm_mix; const float* w_in; const float* a_q_norm; const float* a_kv_norm; const float* a_w_uq; const float* a_w_ukv;
  const float* c_q_norm; const float* c_k_norm; const float* w_br_a; const float* w_br_b; const float* w_br_c; const float* w_out;
  const float* norm_ffn; const float* w_up; const float* w_down; const float* t5_table; const float* final_norm;
  float* out; char* ws;
};

DI void sincos_d(double x, float& c, float& s) {
  const double k = rint(x * 0.6366197723675814);
  double t = fma(-k, 1.5707963267948966, x); t = fma(-k, 6.123233995736766e-17, t);
  const double t2 = t * t;
  double sn = 1.0 - t2 / 210.0; sn = 1.0 - t2 / 156.0 * sn; sn = 1.0 - t2 / 110.0 * sn; sn = 1.0 - t2 / 72.0 * sn; sn = 1.0 - t2 / 42.0 * sn; sn = 1.0 - t2 / 20.0 * sn; sn = 1.0 - t2 / 6.0 * sn; sn *= t;
  double cs = 1.0 - t2 / 240.0; cs = 1.0 - t2 / 182.0 * cs; cs = 1.0 - t2 / 132.0 * cs; cs = 1.0 - t2 / 90.0 * cs; cs = 1.0 - t2 / 56.0 * cs; cs = 1.0 - t2 / 30.0 * cs; cs = 1.0 - t2 / 12.0 * cs; cs = 1.0 - t2 / 2.0 * cs;
  const int q = ((int)k) & 3;
  double so = (q == 0) ? sn : (q == 1) ? cs : (q == 2) ? -sn : -cs;
  double co = (q == 0) ? cs : (q == 1) ? -sn : (q == 2) ? -cs : sn;
  c = (float)co; s = (float)so;
}

DI void build_tables(const Params& p) {
  f32x2* CS = (f32x2*)(p.ws + OFF_CS);
  const int gsz = gridDim.x * 512, gid = blockIdx.x * 512 + otid();
  for (int e = gid; e < 16384 * 16; e += gsz) {
    const int pos = e >> 4, i = e & 15;
    double f = 1.0; for (int j = 0; j < i; ++j) f *= 0.5623413251903491;
    const float ff = (float)f; const float ang = (float)pos * ff;
    float c, s; sincos_d((double)ang, c, s);
    CS[e] = (f32x2){c, s};
  }
  float* BT = (float*)(p.ws + OFF_BT);
  for (int e = gid; e < 3 * 8 * 256; e += gsz) {
    const int gh = e >> 8, g = gh >> 3, hd = gh & 7, j = (e & 255) - 32;
    float v = 0.f;
    if (j >= 0 && j <= 128) {
      const int rel = (j - 64) << (2 * g);
      const int n = rel < 0 ? -rel : rel;
      int b = rel > 0 ? 16 : 0;
      if (n < 8) b += n; else { int lg = 31 - __clz(n); int vv = 5 + lg; b += (vv < 15 ? vv : 15); }
      v = p.t5_table[b * 24 + g * 8 + hd] * LOG2E;
    }
    BT[e] = v;
  }
}

DI void cvt_tile(const float* __restrict__ W, int ldw, int ldk, int koff, bf16_t* __restrict__ Wt, int k0, int n0, int mode, const float* __restrict__ rscale, float* tile) {
  const int tid = otid();
#pragma unroll
  for (int i = 0; i < 8; ++i) {
    const int kl = (tid >> 6) + 8 * i, nl = tid & 63, nn = n0 + nl;
    int src = nn;
    if (mode == 1) src = nn < 672 ? nn : (nn < 768 ? -1 : nn - 96);
    float v = 0.f;
    if (src >= 0) v = W[(size_t)(k0 + kl) * ldw + src];
    if (rscale) v *= rscale[k0 + kl];
    tile[kl * 65 + nl] = v;
  }
  __syncthreads();
#pragma unroll
  for (int i = 0; i < 8; ++i) {
    const int nl = (tid >> 6) + 8 * i, kl = tid & 63;
    Wt[(size_t)(n0 + nl) * ldk + koff + k0 + kl] = f2bf(tile[kl * 65 + nl]);
  }
  __syncthreads();
}

DI void convert_weights(const Params& p, int layer, char* smem) {
  float* tile = (float*)smem;
  int base = 0;
  for (int mtx = 0; mtx < 9; ++mtx) {
    const float* W; int K, Nsrc, Ndst, mode = 0, ldk = 0, koff = 0; const float* rs = nullptr; size_t off;
    switch (mtx) {
      case 0: W = p.w_in + (size_t)layer * 1024 * 9120; K = 1024; Nsrc = 9120; Ndst = 9216; mode = 1; off = WT_IN; break;
      case 1: W = p.a_w_uq + (size_t)layer * 384 * 768; K = 384; Nsrc = 768; Ndst = 768; rs = p.a_q_norm + layer * 384; off = WT_UQ; break;
      case 2: W = p.a_w_ukv + (size_t)layer * 256 * 1024; K = 256; Nsrc = 1024; Ndst = 1024; rs = p.a_kv_norm + layer * 256; off = WT_UKV; break;
      case 3: W = p.w_br_a + (size_t)layer * 512 * 1024; K = 512; Nsrc = 1024; Ndst = 1024; off = WT_BRA; break;
      case 4: W = p.w_br_b + (size_t)layer * 512 * 1024; K = 512; Nsrc = 1024; Ndst = 1024; off = WT_BRB; break;
      case 5: W = p.w_br_c + (size_t)layer * 512 * 1024; K = 512; Nsrc = 1024; Ndst = 1024; off = WT_BRC; break;
      case 6: W = p.w_out + (size_t)layer * 1024 * 1024; K = 1024; Nsrc = 1024; Ndst = 1024; off = WT_OUT; break;
      case 7: W = p.w_up + (size_t)layer * 1024 * 4096; K = 1024; Nsrc = 4096; Ndst = 4096; rs = p.norm_ffn + layer * DM; off = WT_UP; break;
      case 8: default: W = p.w_down + (size_t)layer * 4096 * 1024; K = 4096; Nsrc = 1024; Ndst = 1024; off = WT_DOWN; break;
    }
    if (ldk == 0) ldk = K;
    const int nk = K / 64, nn = Ndst / 64, cnt = nk * nn;
    bf16_t* Wt = (bf16_t*)(p.ws + off);
    int first = (int)blockIdx.x - (base % (int)gridDim.x); if (first < 0) first += gridDim.x;
    for (int it = first; it < cnt; it += gridDim.x) {
      const int kt = it % nk, nt = it / nk;
      cvt_tile(W, Nsrc, ldk, koff, Wt, kt * 64, nt * 64, mode, rs, tile);
    }
    base += cnt;
  }
}

DI void phase_norm(const float* __restrict__ x, const float* __restrict__ g, bf16_t* __restrict__ H, int rows) {
  const int tid = otid(), lane = tid & 63, wid = tid >> 6;
  for (int row = blockIdx.x * 8 + wid; row < rows; row += gridDim.x * 8) {
    const float* xr = x + (size_t)row * DM;
    f32x4 v[4]; float ss = 0.f;
#pragma unroll
    for (int i = 0; i < 4; ++i) { v[i] = *(const f32x4*)(xr + i * 256 + lane * 4); ss += v[i][0] * v[i][0] + v[i][1] * v[i][1] + v[i][2] * v[i][2] + v[i][3] * v[i][3]; }
#pragma unroll
    for (int o = 32; o >= 1; o >>= 1) ss += __shfl_xor(ss, o);
    const float rstd = rsqrtf(ss * (1.0f / DM) + 1e-6f);
#pragma unroll
    for (int i = 0; i < 4; ++i) {
      const f32x4 gg = *(const f32x4*)(g + i * 256 + lane * 4);
      u32x2 w; w.x = pk2(v[i][0] * rstd * gg[0], v[i][1] * rstd * gg[1]); w.y = pk2(v[i][2] * rstd * gg[2], v[i][3] * rstd * gg[3]);
      *(u32x2*)(H + (size_t)row * DM + i * 256 + lane * 4) = w;
    }
  }
}

DI void phase_final_norm(float* __restrict__ x, const float* __restrict__ g, int rows) {
  const int tid = otid(), lane = tid & 63, wid = tid >> 6;
  for (int row = blockIdx.x * 8 + wid; row < rows; row += gridDim.x * 8) {
    float* xr = x + (size_t)row * DM;
    f32x4 v[4]; float ss = 0.f;
#pragma unroll
    for (int i = 0; i < 4; ++i) { v[i] = *(const f32x4*)(xr + i * 256 + lane * 4); ss += v[i][0] * v[i][0] + v[i][1] * v[i][1] + v[i][2] * v[i][2] + v[i][3] * v[i][3]; }
#pragma unroll
    for (int o = 32; o >= 1; o >>= 1) ss += __shfl_xor(ss, o);
    const float rstd = rsqrtf(ss * (1.0f / DM) + 1e-6f);
#pragma unroll
    for (int i = 0; i < 4; ++i) {
      const f32x4 gg = *(const f32x4*)(g + i * 256 + lane * 4);
      f32x4 o = {v[i][0] * rstd * gg[0], v[i][1] * rstd * gg[1], v[i][2] * rstd * gg[2], v[i][3] * rstd * gg[3]};
      *(f32x4*)(xr + i * 256 + lane * 4) = o;
    }
  }
}


namespace pg8 {
#define PG8_LAS __attribute__((address_space(3)))
typedef unsigned short bf16_t;
typedef short bf16x8 __attribute__((ext_vector_type(8)));
typedef float f32x4 __attribute__((ext_vector_type(4)));
typedef unsigned u32x4 __attribute__((ext_vector_type(4)));
constexpr int BM = 256, BK = 64, HALF = 128, HTB = HALF * BK * 2  , STAGE_BYTES = 8 * HTB, NXCD = 8, WGM = 8;

__host__ __device__ __forceinline__ int lds_byte(int r, int c) { const int st = (r >> 4) * 2 + (c >> 5), rr = r & 15, cc = c & 31, ob = rr * 64 + cc * 2; return st * 1024 + (ob ^ (((ob >> 9) & 1) << 5)); }
__host__ __device__ __forceinline__ void stage_rc(int b, int& R, int& C) { const int st = b / 1024, sb = b % 1024, swz = sb ^ (((sb >> 9) & 1) << 5); R = (st >> 1) * 16 + swz / 64; C = (st & 1) * 32 + (swz % 64) / 2; }
__host__ __device__ __forceinline__ int perm32(int rho) { const int n = rho >> 4, i = rho & 15; return 8 * (i >> 2) + 4 * n + (i & 3); }

struct Unit { int pm, pn; };
struct Gemm { const bf16_t* A; const bf16_t* Bt; int M, N, K, lda, ldb; };

struct StaticOrder {
    int nM, nN, nwg, G, c;
    __host__ __device__ void init(int M, int N, int G_, int c_) { nM = M / BM; nN = N / BM; nwg = nM * nN; G = G_; c = c_; }
    __host__ __device__ bool next(int i, Unit& u) const {
        const long L = (long)i * G + c; if (L >= nwg) return false;
        map((int)L, u); return true; }
    __host__ __device__ void map(int L, Unit& u) const {
        int wgid = L; { const int q = nwg / NXCD, r = nwg % NXCD, xcd = wgid % NXCD, off = wgid / NXCD; wgid = (xcd < r ? xcd * (q + 1) : r * (q + 1) + (xcd - r) * q) + off; }
        const int nig = WGM * nN, gid = wgid / nig, fm = gid * WGM, gsz = (nM - fm) < WGM ? (nM - fm) : WGM;
        u.pm = fm + ((wgid % nig) % gsz); u.pn = (wgid % nig) / gsz;
    }
    __device__ __forceinline__ void a_ready(const Unit&) const {}
    __device__ __forceinline__ void done(const Unit&) const {}
};
template <class Epi, class Sched, bool ALIGN_EPI = false, bool SP2 = false>
__device__ __forceinline__ void gemm_phase(PG8_LAS unsigned char* lds, const Gemm g, const Sched& S, const Epi& E) {
    int tid_ = threadIdx.x; asm volatile("" : "+v"(tid_)); const int tid = tid_, wid = __builtin_amdgcn_readfirstlane(tid >> 6), lane = tid & 63, wr = wid >> 2, wc = wid & 3, fr = lane & 15, fq = lane >> 4;
    const int K = g.K, nt = K / BK;
    unsigned voffA[2], voffB[2];
#pragma unroll
    for (int i = 0; i < 2; ++i) { int R, C; stage_rc(tid * 16 + i * 8192, R, C); const int Rb = Epi::PERM ? ((R & ~31) + perm32(R & 31)) : R;
        voffA[i] = (unsigned)(R * g.lda + C) * 2u; voffB[i] = (unsigned)(Rb * g.ldb + C) * 2u; }
    const size_t kstep = (size_t)(BK * 2);
    const size_t hA = (size_t)HALF * g.lda * 2, hB = (size_t)HALF * g.ldb * 2;
    const size_t tA = 2 * hA, tB = 2 * hB;
    const unsigned ldsw = (unsigned)wid * 1024u;
    const int aoff = lds_byte(wr * 64 + fr, fq * 8), boff = lds_byte(wc * 32 + fr, fq * 8);
#define PG8_SA(b, h) (((b) * 2 + (h)) * HTB)
#define PG8_SB(b, h) ((4 + (b) * 2 + (h)) * HTB)
#define PG8_STAGE(bufoff, gbase, voff) do { _Pragma("unroll") for (int _i = 0; _i < 2; ++_i) \
        __builtin_amdgcn_global_load_lds((const unsigned*)((const char*)(gbase) + (voff)[_i]), (PG8_LAS unsigned*)(lds + (bufoff) + ldsw + _i * 8192), 16, 0, 0); } while (0)
#define PG8_LDA(dst, b, h) do { _Pragma("unroll") for (int m = 0; m < 4; ++m) _Pragma("unroll") for (int k = 0; k < 2; ++k) dst[m][k] = *(const PG8_LAS bf16x8*)(lds + PG8_SA(b, h) + aoff + m * 2048 + k * 1024); } while (0)
#define PG8_LDB(dst, b, h) do { _Pragma("unroll") for (int n = 0; n < 2; ++n) _Pragma("unroll") for (int k = 0; k < 2; ++k) dst[n][k] = *(const PG8_LAS bf16x8*)(lds + PG8_SB(b, h) + boff + n * 2048 + k * 1024); } while (0)
#define PG8_MMA(ai, bj, At, Bt) do { __builtin_amdgcn_s_setprio(1); _Pragma("unroll") for (int m = 0; m < 4; ++m) _Pragma("unroll") for (int n = 0; n < 2; ++n) _Pragma("unroll") for (int k = 0; k < 2; ++k) \
        acc[ai][bj][m][n] = __builtin_amdgcn_mfma_f32_16x16x32_bf16(Bt[n][k], At[m][k], acc[ai][bj][m][n], 0, 0, 0); __builtin_amdgcn_s_setprio(0); } while (0)
#define PG8_WAIT_V(n) asm volatile("s_waitcnt vmcnt(" #n ")" ::: "memory")
#define PG8_WAIT_L(n) asm volatile("s_waitcnt lgkmcnt(" #n ")" ::: "memory")
#define PG8_BAR __builtin_amdgcn_s_barrier()
#define PG8_SCHED __builtin_amdgcn_sched_barrier(0)
    Unit cur, nxt; int ui = 0;
    if (!S.next(0, cur)) return;
    f32x4 acc[2][2][4][2];
#pragma unroll
    for (int a = 0; a < 2; ++a)
#pragma unroll
        for (int b = 0; b < 2; ++b)
#pragma unroll
            for (int m = 0; m < 4; ++m)
#pragma unroll
                for (int n = 0; n < 2; ++n) acc[a][b][m][n] = (f32x4){0.f, 0.f, 0.f, 0.f};
    bf16x8 At[4][2], B0[2][2], B1[2][2];
    const char* cA = (const char*)g.A + (size_t)cur.pm * tA; const char* cB = (const char*)g.Bt + (size_t)cur.pn * tB;
    S.a_ready(cur);
    if constexpr (SP2) {
        PG8_STAGE(PG8_SB(0, 0), cB, voffB); PG8_STAGE(PG8_SB(0, 1), cB + hB, voffB); PG8_STAGE(PG8_SA(0, 0), cA, voffA); PG8_STAGE(PG8_SA(0, 1), cA + hA, voffA);
        if (wr == 1) PG8_BAR;
        PG8_WAIT_V(2); PG8_BAR;
        PG8_STAGE(PG8_SB(1, 0), cB + kstep, voffB); PG8_STAGE(PG8_SA(1, 0), cA + kstep, voffA); PG8_STAGE(PG8_SB(1, 1), cB + hB + kstep, voffB);
        PG8_WAIT_V(6); PG8_BAR;
    } else {
        PG8_STAGE(PG8_SB(0, 0), cB, voffB); PG8_STAGE(PG8_SA(0, 0), cA, voffA); PG8_STAGE(PG8_SB(0, 1), cB + hB, voffB); PG8_STAGE(PG8_SA(0, 1), cA + hA, voffA);
        if (wr == 1) PG8_BAR;
        PG8_WAIT_V(4); PG8_BAR;
        PG8_STAGE(PG8_SB(1, 0), cB + kstep, voffB); PG8_STAGE(PG8_SA(1, 0), cA + kstep, voffA); PG8_STAGE(PG8_SB(1, 1), cB + hB + kstep, voffB);
        PG8_WAIT_V(6); PG8_BAR;
    }
    for (;;) {
        const bool has_next = S.next(ui + 1, nxt);
        const char* nA = has_next ? (const char*)g.A + (size_t)nxt.pm * tA : cA; const char* nB = has_next ? (const char*)g.Bt + (size_t)nxt.pn * tB : cB;
_Pragma("unroll 1")
        for (int t = 0; t < nt; t += 2) {
            const bool last = (t == nt - 2);
            const char* a1 = cA + (size_t)(t + 1) * kstep;
            const char* a2 = last ? nA : cA + (size_t)(t + 2) * kstep; const char* b2 = last ? nB : cB + (size_t)(t + 2) * kstep;
            const char* a3 = a2 + kstep; const char* b3 = b2 + kstep;
            if (last && has_next) S.a_ready(nxt);
            if constexpr (SP2) {
            PG8_LDB(B0, 0, 0); PG8_LDB(B1, 0, 1); PG8_SCHED; PG8_LDA(At, 0, 0); PG8_STAGE(PG8_SA(1, 1), a1 + hA, voffA);
            PG8_WAIT_V(8); PG8_WAIT_L(0); PG8_BAR; PG8_MMA(0, 0, At, B0); PG8_MMA(0, 1, At, B1); PG8_BAR; PG8_SCHED;
            PG8_LDA(At, 0, 1); PG8_STAGE(PG8_SB(0, 0), b2, voffB); PG8_STAGE(PG8_SB(0, 1), b2 + hB, voffB); PG8_STAGE(PG8_SA(0, 0), a2, voffA);
            PG8_WAIT_V(8); PG8_WAIT_L(0); PG8_BAR; PG8_MMA(1, 0, At, B0); PG8_MMA(1, 1, At, B1); PG8_BAR; PG8_SCHED;
            PG8_LDB(B0, 1, 0); PG8_LDB(B1, 1, 1); PG8_SCHED; PG8_LDA(At, 1, 0); PG8_STAGE(PG8_SA(0, 1), a2 + hA, voffA);
            PG8_WAIT_V(8); PG8_WAIT_L(0); PG8_BAR; PG8_MMA(0, 0, At, B0); PG8_MMA(0, 1, At, B1); PG8_BAR; PG8_SCHED;
            PG8_LDA(At, 1, 1); PG8_STAGE(PG8_SB(1, 0), b3, voffB); PG8_STAGE(PG8_SB(1, 1), b3 + hB, voffB); PG8_STAGE(PG8_SA(1, 0), a3, voffA);
            PG8_WAIT_V(8); PG8_WAIT_L(0); PG8_BAR; PG8_MMA(1, 0, At, B0); PG8_MMA(1, 1, At, B1); PG8_BAR; PG8_SCHED;
            } else {
            PG8_LDB(B0, 0, 0); PG8_SCHED; PG8_LDA(At, 0, 0); PG8_STAGE(PG8_SA(1, 1), a1 + hA, voffA);
            PG8_WAIT_L(8); PG8_BAR; PG8_WAIT_L(0); PG8_MMA(0, 0, At, B0); PG8_BAR; PG8_SCHED;
            PG8_LDB(B1, 0, 1); PG8_STAGE(PG8_SB(0, 0), b2, voffB);
            PG8_BAR; PG8_WAIT_L(0); PG8_MMA(0, 1, At, B1); PG8_BAR;
            PG8_LDA(At, 0, 1); PG8_STAGE(PG8_SA(0, 0), a2, voffA);
            PG8_BAR; PG8_WAIT_L(0); PG8_MMA(1, 0, At, B0); PG8_BAR; PG8_SCHED;
            PG8_STAGE(PG8_SB(0, 1), b2 + hB, voffB);
            PG8_WAIT_V(6); PG8_BAR; PG8_MMA(1, 1, At, B1); PG8_BAR;
            PG8_LDB(B0, 1, 0); PG8_SCHED; PG8_LDA(At, 1, 0); PG8_STAGE(PG8_SA(0, 1), a2 + hA, voffA);
            PG8_WAIT_L(8); PG8_BAR; PG8_WAIT_L(0); PG8_MMA(0, 0, At, B0); PG8_BAR; PG8_SCHED;
            PG8_LDB(B1, 1, 1); PG8_STAGE(PG8_SB(1, 0), b3, voffB);
            PG8_BAR; PG8_WAIT_L(0); PG8_MMA(0, 1, At, B1); PG8_BAR;
            PG8_LDA(At, 1, 1); PG8_STAGE(PG8_SA(1, 0), a3, voffA);
            PG8_BAR; PG8_WAIT_L(0); PG8_MMA(1, 0, At, B0); PG8_BAR; PG8_SCHED;
            PG8_STAGE(PG8_SB(1, 1), b3 + hB, voffB);
            PG8_WAIT_V(6); PG8_BAR; PG8_MMA(1, 1, At, B1); PG8_BAR;
            }
        }
        if constexpr (ALIGN_EPI) { if (wr == 0) PG8_BAR; }
        if constexpr (!Epi::AFTER_DRAIN) { E(acc, cur, wr, wc, fr, fq); S.done(cur); }
        if (!has_next) break;
#pragma unroll
        for (int a = 0; a < 2; ++a)
#pragma unroll
            for (int b = 0; b < 2; ++b)
#pragma unroll
                for (int m = 0; m < 4; ++m)
#pragma unroll
                    for (int n = 0; n < 2; ++n) acc[a][b][m][n] = (f32x4){0.f, 0.f, 0.f, 0.f};
        cur = nxt; cA = nA; cB = nB; ++ui;
        if constexpr (ALIGN_EPI) { if (wr == 1) PG8_BAR; }
    }
    PG8_WAIT_V(0);
    if constexpr (!ALIGN_EPI) { if (wr == 0) PG8_BAR; }
    PG8_BAR;
    if constexpr (Epi::AFTER_DRAIN) { E.fused(acc, cur, wr, wc, fr, fq, lds, wid, lane); S.done(cur); }
#undef PG8_SA
#undef PG8_SB
#undef PG8_STAGE
#undef PG8_LDA
#undef PG8_LDB
#undef PG8_MMA
#undef PG8_WAIT_V
#undef PG8_WAIT_L
#undef PG8_BAR
#undef PG8_SCHED
}
}

DI void rope_pair8(float (&x1)[8], float (&x2)[8], const f32x2* cs) {
#pragma unroll
  for (int j = 0; j < 8; ++j) { const f32x2 c = cs[j]; const float a = x1[j], b = x2[j]; x1[j] = a * c.x - b * c.y; x2[j] = a * c.y + b * c.x; }
}
typedef pg8::Unit Unit;
#define ACC_T const f32x4 (&acc)[2][2][4][2]
#define EROW(u, ai, m) ((u).pm * 256 + (ai) * 128 + wr * 64 + (m) * 16 + fr)
DI u32x4 pack_f8(const f32x4 a, const f32x4 b) { u32x4 w; w.x = pk2(a[0], a[1]); w.y = pk2(a[2], a[3]); w.z = pk2(b[0], b[1]); w.w = pk2(b[2], b[3]); return w; }

struct EpiInproj {
  static constexpr bool PERM = true, AFTER_DRAIN = false;
  bf16_t* Z; bf16_t* VCT; bf16_t* VBT; float* ssq_q; float* ssq_kv;
  DI void operator()(ACC_T, const Unit& u, int wr, int wc, int fr, int fq) const {
#pragma unroll
    for (int bj = 0; bj < 2; ++bj) {
      const int tt = 2 * u.pn + bj, cb = tt * 128 + wc * 32 + 8 * fq;
      int sh = 0; if (tt >= 6 && tt < 42) sh = 2 * (((tt - 6) >> 2) % 3);
      const int msk = (1 << sh) - 1;
      if (tt >= 38 && tt < 42) {
        bf16_t* vt = VBT + (size_t)(cb - GC_VB) * S + fr * (S >> 4) + u.pm * 16 + wr * 4;
#pragma unroll
        for (int ai = 0; ai < 2; ++ai)
#pragma unroll
          for (int n = 0; n < 2; ++n) {
            __builtin_amdgcn_sched_barrier(0);
#pragma unroll
            for (int e = 0; e < 4; ++e) {
              u32x2 w; w.x = pk2(acc[ai][bj][0][n][e], acc[ai][bj][1][n][e]); w.y = pk2(acc[ai][bj][2][n][e], acc[ai][bj][3][n][e]);
              *(u32x2*)(vt + (size_t)(4 * n + e) * S + ai * 8) = w;
            }
          }
      } else if (tt == 47 || (tt >= 30 && tt < 38)) {
        bf16_t* vt = (tt == 47) ? VCT + (size_t)(cb - GC_VC) * S : VBT + (size_t)(cb - GC_VB) * S;
#pragma unroll
        for (int ai = 0; ai < 2; ++ai)
#pragma unroll
          for (int m = 0; m < 4; ++m) {
            __builtin_amdgcn_sched_barrier(0);
            const int row = EROW(u, ai, m), prow = (row & msk) * (S >> sh) + (row >> sh);
            bf16_t* vp = vt + prow;
#pragma unroll
            for (int n = 0; n < 2; ++n)
#pragma unroll
              for (int e = 0; e < 4; ++e) vp[(size_t)(4 * n + e) * S] = f2bf(acc[ai][bj][m][n][e]);
          }
      } else {
        const int zc = cb < GC_VB ? cb : cb - 1536;
        float* ssq = (tt < 3) ? ssq_q : ((tt < 5) ? ssq_kv : nullptr);
#pragma unroll
        for (int ai = 0; ai < 2; ++ai)
#pragma unroll
          for (int m = 0; m < 4; ++m) {
            const int row = EROW(u, ai, m), prow = (row & msk) * (S >> sh) + (row >> sh);
            const f32x4 v0 = acc[ai][bj][m][0], v1 = acc[ai][bj][m][1];
            *(u32x4*)(Z + (size_t)prow * ZP + zc) = pack_f8(v0, v1);
            if (ssq) {
              float s = v0[0] * v0[0] + v0[1] * v0[1] + v0[2] * v0[2] + v0[3] * v0[3] + v1[0] * v1[0] + v1[1] * v1[1] + v1[2] * v1[2] + v1[3] * v1[3];
              s += __shfl_xor(s, 16); s += __shfl_xor(s, 32);
              if (fq == 0) __hip_atomic_fetch_add(ssq + row, s, __ATOMIC_RELAXED, __HIP_MEMORY_SCOPE_AGENT);
            }
          }
      }
    }
  }
};
struct EpiUpQ {
  static constexpr bool PERM = true, AFTER_DRAIN = false;
  bf16_t* QA; const float* ssq;
  DI void operator()(ACC_T, const Unit& u, int wr, int wc, int fr, int fq) const {
#pragma unroll
    for (int ai = 0; ai < 2; ++ai)
#pragma unroll
      for (int m = 0; m < 4; ++m) {
        const int row = EROW(u, ai, m); const float rs = rsqrtf(ssq[row] * (1.0f / 384.0f) + 1e-6f);
#pragma unroll
        for (int bj = 0; bj < 2; ++bj) {
          const int cb = u.pn * 256 + bj * 128 + wc * 32 + 8 * fq;
          *(u32x4*)(QA + (size_t)row * 768 + cb) = pack_f8(acc[ai][bj][m][0] * rs, acc[ai][bj][m][1] * rs);
        }
      }
  }
};
struct EpiUpKV {
  static constexpr bool PERM = true, AFTER_DRAIN = false;
  bf16_t* KA; bf16_t* VAT; const float* ssq;
  DI void operator()(ACC_T, const Unit& u, int wr, int wc, int fr, int fq) const {
#pragma unroll
    for (int ai = 0; ai < 2; ++ai)
#pragma unroll
      for (int m = 0; m < 4; ++m) {
        __builtin_amdgcn_sched_barrier(0);
        const int row = EROW(u, ai, m); const float rs = rsqrtf(ssq[row] * (1.0f / 256.0f) + 1e-6f);
#pragma unroll
        for (int bj = 0; bj < 2; ++bj) {
          const int head = 2 * u.pn + bj, w0 = wc * 32 + 8 * fq;
          if (wc < 2) {
            *(u32x4*)(KA + (size_t)row * 512 + head * 64 + w0) = pack_f8(acc[ai][bj][m][0] * rs, acc[ai][bj][m][1] * rs);
          } else {
            bf16_t* vp = VAT + (size_t)(head * 64 + w0 - 64) * S + row;
#pragma unroll
            for (int n = 0; n < 2; ++n)
#pragma unroll
              for (int e = 0; e < 4; ++e) vp[(size_t)(4 * n + e) * S] = f2bf(acc[ai][bj][m][n][e] * rs);
          }
        }
      }
  }
};
struct EpiMerge {
  static constexpr bool PERM = true, AFTER_DRAIN = false;
  const bf16_t* Z; bf16_t* MIX;
  DI void operator()(ACC_T, const Unit& u, int wr, int wc, int fr, int fq) const {
    const int b = u.pm >> 6, pm = u.pm & 63, pn = u.pn & 3;
#pragma unroll
    for (int ai = 0; ai < 2; ++ai)
#pragma unroll
      for (int m = 0; m < 4; ++m) {
        const int row = pm * 256 + ai * 128 + wr * 64 + m * 16 + fr;
#pragma unroll
        for (int bj = 0; bj < 2; ++bj) {
          const int col = pn * 256 + bj * 128 + wc * 32 + 8 * fq;
          const u32x4 g = *(const u32x4*)(Z + (size_t)row * ZP + ZC_GATE + b * 1024 + col);
          f32x4 v0 = acc[ai][bj][m][0], v1 = acc[ai][bj][m][1];
#pragma unroll
          for (int q = 0; q < 2; ++q) {
            v0[2 * q] *= 1.0f / (1.0f + __expf(-bflo(g[q]))); v0[2 * q + 1] *= 1.0f / (1.0f + __expf(-bfhi(g[q])));
            v1[2 * q] *= 1.0f / (1.0f + __expf(-bflo(g[2 + q]))); v1[2 * q + 1] *= 1.0f / (1.0f + __expf(-bfhi(g[2 + q])));
          }
          bf16_t* mp = MIX + (size_t)row * DM + col;
          if (b > 0) { const u32x4 o = *(const u32x4*)mp;
#pragma unroll
            for (int q = 0; q < 2; ++q) { v0[2 * q] += bflo(o[q]); v0[2 * q + 1] += bfhi(o[q]); v1[2 * q] += bflo(o[2 + q]); v1[2 * q + 1] += bfhi(o[2 + q]); } }
          *(u32x4*)mp = pack_f8(v0, v1);
        }
      }
  }
};
template <bool NORM_OUT> struct EpiResid {
  static constexpr bool PERM = false, AFTER_DRAIN = false;
  const float* xs; float* xd; bf16_t* xb; float* ssq;
  DI void operator()(ACC_T, const Unit& u, int wr, int wc, int fr, int fq) const {
#pragma unroll
    for (int ai = 0; ai < 2; ++ai)
#pragma unroll
      for (int m = 0; m < 4; ++m) {
        const int row = EROW(u, ai, m);
        const size_t ro = (size_t)row * DM + u.pn * 256 + wc * 32 + 4 * fq;
        float ss = 0.f;
#pragma unroll
        for (int bj = 0; bj < 2; ++bj)
#pragma unroll
          for (int n = 0; n < 2; ++n) {
            const size_t o = ro + bj * 128 + n * 16; const f32x4 x = *(const f32x4*)(xs + o) + acc[ai][bj][m][n]; *(f32x4*)(xd + o) = x;
            if (NORM_OUT) { u32x2 w; w.x = pk2(x[0], x[1]); w.y = pk2(x[2], x[3]); *(u32x2*)(xb + o) = w; ss += x[0] * x[0] + x[1] * x[1] + x[2] * x[2] + x[3] * x[3]; }
          }
        if (NORM_OUT) { ss += __shfl_xor(ss, 16); ss += __shfl_xor(ss, 32); if (fq == 0) __hip_atomic_fetch_add(ssq + row, ss, __ATOMIC_RELAXED, __HIP_MEMORY_SCOPE_AGENT); }
      }
  }
};
struct EpiRelu2 {
  static constexpr bool PERM = true, AFTER_DRAIN = false;
  bf16_t* HID; const float* ssq;
  DI void operator()(ACC_T, const Unit& u, int wr, int wc, int fr, int fq) const {
#pragma unroll
    for (int ai = 0; ai < 2; ++ai)
#pragma unroll
      for (int m = 0; m < 4; ++m) {
        const int row = EROW(u, ai, m); const float rs = rsqrtf(ssq[row] * (1.0f / DM) + 1e-6f);
#pragma unroll
        for (int bj = 0; bj < 2; ++bj) {
          f32x4 v0 = acc[ai][bj][m][0], v1 = acc[ai][bj][m][1];
#pragma unroll
          for (int e = 0; e < 4; ++e) { const float a = fmaxf(v0[e], 0.f) * rs, c = fmaxf(v1[e], 0.f) * rs; v0[e] = a * a; v1[e] = c * c; }
          *(u32x4*)(HID + (size_t)row * DFF + u.pn * 256 + bj * 128 + wc * 32 + 8 * fq) = pack_f8(v0, v1);
        }
      }
  }
};
struct DiagOrder {
  pg8::StaticOrder so; int G, c;
  DI void init(int G_, int c_) { so.init(S, 1024, G_, c_); G = G_; c = c_; }
  DI bool next(int i, Unit& u) const { const int tile = (i / 3) * G + c, b = i % 3; if (tile >= 256) return false; so.map(tile, u); u.pm += 64 * b; u.pn += 4 * b; return true; }
  DI void a_ready(const Unit&) const {}
  DI void done(const Unit&) const {}
};
#define GEMM_LDS ((PG8_LAS unsigned char*)smem)

DI void phase_kpost(const Params& p, int layer) {
  bf16_t* Z = (bf16_t*)(p.ws + OFF_Z);
  const f32x2* CS = (const f32x2*)(p.ws + OFF_CS);
  for (int it = (int)gridDim.x - 1 - (int)blockIdx.x; it < 96; it += gridDim.x) {
      const int tid = otid();
      const int idx = it * 512 + tid;
      const int unit = idx / S, tkn = idx % S;
      if (unit < 2) {
        bf16_t* kp = Z + (size_t)tkn * ZP + ZC_KC + unit * 64;
        float x[8][8]; float ss = 0.f;
#pragma unroll
        for (int c = 0; c < 8; ++c) { const u32x4 v = *(const u32x4*)(kp + c * 8);
#pragma unroll
          for (int q = 0; q < 4; ++q) { x[c][2 * q] = bflo(v[q]); x[c][2 * q + 1] = bfhi(v[q]); ss += x[c][2 * q] * x[c][2 * q] + x[c][2 * q + 1] * x[c][2 * q + 1]; } }
        const float rs = rsqrtf(ss * (1.0f / 64.0f) + 1e-6f);
        const float* gk = p.c_k_norm + layer * 64;
#pragma unroll
        for (int c = 0; c < 8; ++c)
#pragma unroll
          for (int q = 0; q < 8; ++q) x[c][q] *= rs * gk[c * 8 + q];
        const f32x2* cr = CS + (size_t)(tkn >> 6) * 16; const f32x2* cc = CS + (size_t)(tkn & 63) * 16;
        rope_pair8(x[0], x[2], cr); rope_pair8(x[1], x[3], cr + 8);
        rope_pair8(x[4], x[6], cc); rope_pair8(x[5], x[7], cc + 8);
#pragma unroll
        for (int c = 0; c < 8; ++c) { u32x4 w; w.x = pk2(x[c][0], x[c][1]); w.y = pk2(x[c][2], x[c][3]); w.z = pk2(x[c][4], x[c][5]); w.w = pk2(x[c][6], x[c][7]); *(u32x4*)(kp + c * 8) = w; }
      } else {
        bf16_t* kp = Z + (size_t)tkn * ZP + ZC_KR;
        float x[4][8];
#pragma unroll
        for (int c = 0; c < 4; ++c) { const u32x4 v = *(const u32x4*)(kp + c * 8);
#pragma unroll
          for (int q = 0; q < 4; ++q) { x[c][2 * q] = bflo(v[q]); x[c][2 * q + 1] = bfhi(v[q]); } }
        const f32x2* cp = CS + (size_t)tkn * 16;
        rope_pair8(x[0], x[2], cp); rope_pair8(x[1], x[3], cp + 8);
#pragma unroll
        for (int c = 0; c < 4; ++c) { u32x4 w; w.x = pk2(x[c][0], x[c][1]); w.y = pk2(x[c][2], x[c][3]); w.z = pk2(x[c][4], x[c][5]); w.w = pk2(x[c][6], x[c][7]); *(u32x4*)(kp + c * 8) = w; }
      }
  }
}

DI bf16x8 pack8(float a0, float a1, float a2, float a3, float a4, float a5, float a6, float a7) {
  u32x4 w; w.x = pk2(a0, a1); w.y = pk2(a2, a3); w.z = pk2(a4, a5); w.w = pk2(a6, a7); return __builtin_bit_cast(bf16x8, w);
}
DI void unpack8(const u32x4 v, float (&x)[8]) {
#pragma unroll
  for (int q = 0; q < 4; ++q) { x[2 * q] = bflo(v[q]); x[2 * q + 1] = bfhi(v[q]); }
}

constexpr int ATT_STAGE = 20480;

template <int TYPE>
DI void attn_dense_unit(const Params& p, int layer, int head, int qb, char* lds) {
  constexpr int NQK = TYPE == 0 ? 6 : 4;
  const int tid = otid(), lane = tid & 63, wid = wave_of(tid), r = lane & 31, h = lane >> 5;
  const bf16_t* Z = (const bf16_t*)(p.ws + OFF_Z);
  const f32x2* CS = (const f32x2*)(p.ws + OFF_CS);
  const bf16_t* Kn; int ldk; const bf16_t* VT; bf16_t* O;
  if (TYPE == 0) { Kn = (const bf16_t*)(p.ws + OFF_KA) + head * 64; ldk = 512; VT = (const bf16_t*)(p.ws + OFF_VAT) + (size_t)head * 64 * S; O = (bf16_t*)(p.ws + OFF_OA); }
  else { const int kvh = head >> 2; Kn = Z + ZC_KC + kvh * 64; ldk = ZP; VT = (const bf16_t*)(p.ws + OFF_VCT) + (size_t)kvh * 64 * S; O = (bf16_t*)(p.ws + OFF_OC); }
  const int q = qb * 256 + wid * 32 + r;
  bf16x8 qf[NQK];
  if (TYPE == 0) {
    const bf16_t* qp = (const bf16_t*)(p.ws + OFF_QA) + (size_t)q * 768 + head * 96 + 8 * h;
    float x[6][8];
#pragma unroll
    for (int d0 = 0; d0 < 6; ++d0) unpack8(*(const u32x4*)(qp + d0 * 16), x[d0]);
    rope_pair8(x[4], x[5], CS + (size_t)q * 16 + 8 * h);
    const float sc = 0.10206207261596577f * LOG2E;
#pragma unroll
    for (int d0 = 0; d0 < 6; ++d0) qf[d0] = pack8(x[d0][0] * sc, x[d0][1] * sc, x[d0][2] * sc, x[d0][3] * sc, x[d0][4] * sc, x[d0][5] * sc, x[d0][6] * sc, x[d0][7] * sc);
  } else {
    const bf16_t* qp = Z + (size_t)q * ZP + ZC_QC + head * 64 + 8 * h;
    float x[4][8]; float ss = 0.f;
#pragma unroll
    for (int d0 = 0; d0 < 4; ++d0) { unpack8(*(const u32x4*)(qp + d0 * 16), x[d0]);
#pragma unroll
      for (int j = 0; j < 8; ++j) ss += x[d0][j] * x[d0][j]; }
    ss += __shfl_xor(ss, 32);
    const float rs = rsqrtf(ss * (1.0f / 64.0f) + 1e-6f);
    const float* gq = p.c_q_norm + layer * 64;
#pragma unroll
    for (int d0 = 0; d0 < 4; ++d0)
#pragma unroll
      for (int j = 0; j < 8; ++j) x[d0][j] *= rs * gq[d0 * 16 + 8 * h + j];
    rope_pair8(x[0], x[1], CS + (size_t)(q >> 6) * 16 + 8 * h);
    rope_pair8(x[2], x[3], CS + (size_t)(q & 63) * 16 + 8 * h);
    const float sc = 0.125f * LOG2E;
#pragma unroll
    for (int d0 = 0; d0 < 4; ++d0) qf[d0] = pack8(x[d0][0] * sc, x[d0][1] * sc, x[d0][2] * sc, x[d0][3] * sc, x[d0][4] * sc, x[d0][5] * sc, x[d0][6] * sc, x[d0][7] * sc);
  }
  typedef __attribute__((address_space(3))) unsigned lds_u32;
  const int srow = tid >> 3, sch = (tid & 7) ^ ((srow >> 1) & 7);
  const bf16_t* gk = Kn + (size_t)srow * ldk + sch * 8;
  const bf16_t* gv = VT + (size_t)srow * S + sch * 8;
  const int rrow = tid >> 2, rch = (tid & 3) ^ ((rrow >> 2) & 3);
  const bf16_t* gr = Z + ZC_KR + (size_t)rrow * ZP + rch * 8;
  char* wbase = lds + wid * 1024;
#define DMA(t, soff) do { \
    __builtin_amdgcn_global_load_lds((const unsigned*)(gk + (size_t)(t) * 64 * ldk), (lds_u32*)(wbase + (soff)), 16, 0, 0); \
    __builtin_amdgcn_global_load_lds((const unsigned*)(gv + (size_t)(t) * 64), (lds_u32*)(wbase + (soff) + 8192), 16, 0, 0); \
    if (TYPE == 0 && wid < 4) __builtin_amdgcn_global_load_lds((const unsigned*)(gr + (size_t)(t) * 64 * ZP), (lds_u32*)(wbase + (soff) + 16384), 16, 0, 0); } while (0)
#define DMA_WAIT(keep) do { if (keep) { if (TYPE == 0 && wid < 4) asm volatile("s_waitcnt vmcnt(3)" ::: "memory"); else asm volatile("s_waitcnt vmcnt(2)" ::: "memory"); } \
    else asm volatile("s_waitcnt vmcnt(0)" ::: "memory"); } while (0)
#define BAR() do { asm volatile("s_waitcnt lgkmcnt(0)" ::: "memory"); __builtin_amdgcn_s_barrier(); asm volatile("" ::: "memory"); } while (0)
  constexpr int NONES = (TYPE == 0) ? 0 : 2;
  float m_run = 0.f, lsum = 0.f; f32x16 o0, o1, negm, la;
#pragma unroll
  for (int i = 0; i < 16; ++i) { o0[i] = 0.f; o1[i] = 0.f; negm[i] = 0.f; la[i] = 0.f; }
  const bf16x8 ones = {0x3F80, 0x3F80, 0x3F80, 0x3F80, 0x3F80, 0x3F80, 0x3F80, 0x3F80};
  const int rK = (r & ~12) | ((r & 4) << 1) | ((r & 8) >> 1);
  const int ksw = (rK >> 1) & 7, rsw = (rK >> 2) & 3, vsw = (r >> 1) & 7;
  int koff[4], roff[2], voff[4];
#pragma unroll
  for (int d0 = 0; d0 < 4; ++d0) { koff[d0] = rK * 128 + (((2 * d0 + h) ^ ksw) << 4); voff[d0] = 8192 + r * 128 + (((2 * d0 + h) ^ vsw) << 4); }
#pragma unroll
  for (int d0 = 0; d0 < 2; ++d0) roff[d0] = 16384 + rK * 64 + (((2 * d0 + h) ^ rsw) << 4);
  constexpr int NT = S / 64;
  constexpr float THR = 8.0f;
#define SB() __builtin_amdgcn_sched_barrier(0)
#define QKR(d0, K0, K1, SOFF) do { if ((d0) < 4) { K0 = *(const bf16x8*)(lds + (SOFF) + koff[(d0) & 3]); K1 = *(const bf16x8*)(lds + (SOFF) + 32 * 128 + koff[(d0) & 3]); } \
    else if ((d0) < NQK) { K0 = *(const bf16x8*)(lds + (SOFF) + roff[(d0) & 1]); K1 = *(const bf16x8*)(lds + (SOFF) + 32 * 64 + roff[(d0) & 1]); } } while (0)
#define QKM(N0, N1, d0, K0, K1) do { if ((d0) == 0) { N0 = MFMA(K0, qf[0], negm); N1 = MFMA(K1, qf[0], negm); } \
    else if ((d0) < NQK) { N0 = MFMA(K0, qf[(d0) < NQK ? (d0) : 0], N0); N1 = MFMA(K1, qf[(d0) < NQK ? (d0) : 0], N1); } } while (0)
#define EX4(CC, B, SI) do { _Pragma("unroll") for (int i_ = 0; i_ < 4; ++i_) { CC[(B) + i_] = fexp2(CC[(B) + i_]); if ((SI) >= NONES) lsum += CC[(B) + i_]; } } while (0)
#define PK8(PF, CC, B) do { PF = pack8(CC[(B)], CC[(B) + 1], CC[(B) + 2], CC[(B) + 3], CC[(B) + 4], CC[(B) + 5], CC[(B) + 6], CC[(B) + 7]); } while (0)
#define VR(s_, V0, V1, SOFF) do { V0 = *(const bf16x8*)(lds + (SOFF) + voff[s_]); V1 = *(const bf16x8*)(lds + (SOFF) + 32 * 128 + voff[s_]); } while (0)
#define PVM(s_, V0, V1) do { o0 = MFMA(V0, pf[s_], o0); o1 = MFMA(V1, pf[s_], o1); if ((s_) < NONES) la = MFMA(ones, pf[s_], la); } while (0)
#define MAXG(NN, B) do { ma_ = fmaxf(fmaxf(ma_, NN[(B)]), NN[(B) + 1]); mb_ = fmaxf(fmaxf(mb_, NN[(B) + 2]), NN[(B) + 3]); \
    ma_ = fmaxf(fmaxf(ma_, NN[(B) + 4]), NN[(B) + 5]); mb_ = fmaxf(fmaxf(mb_, NN[(B) + 6]), NN[(B) + 7]); } while (0)
#define ROWMAX(P0, P1, MX) do { float a_ = fmaxf(fmaxf(P0[0], P0[1]), P1[0]), c_ = fmaxf(fmaxf(P0[2], P0[3]), P1[1]); a_ = fmaxf(fmaxf(a_, P1[2]), P1[3]); \
    _Pragma("unroll") for (int i_ = 4; i_ < 16; i_ += 4) { a_ = fmaxf(fmaxf(a_, P0[i_]), P0[i_ + 1]); c_ = fmaxf(fmaxf(c_, P0[i_ + 2]), P0[i_ + 3]); a_ = fmaxf(fmaxf(a_, P1[i_]), P1[i_ + 1]); c_ = fmaxf(fmaxf(c_, P1[i_ + 2]), P1[i_ + 3]); } \
    a_ = fmaxf(a_, c_); MX = fmaxf(a_, __shfl_xor(a_, 32)); } while (0)
#define RESCALE(P0, P1, DELTA) do { const float dl_ = (DELTA); m_run += dl_; const float al_ = fexp2(-dl_); lsum *= al_; \
    _Pragma("unroll") for (int i_ = 0; i_ < 16; ++i_) { P0[i_] -= dl_; P1[i_] -= dl_; o0[i_] *= al_; o1[i_] *= al_; if (NONES > 0) la[i_] *= al_; negm[i_] = -m_run; } } while (0)
#define STEP(C0, C1, N0, N1, T, HAS_NEXT, HAS_LOAD, S0, S1, S3) do { \
    if (HAS_LOAD) DMA((T) + 3, S3); \
    bf16x8 pf[4]; bf16x8 ka0, ka1, kb0, kb1, va0, va1, vb0, vb1; \
    if (HAS_NEXT) QKR(0, ka0, ka1, S1); \
    SB(); if (HAS_NEXT) { QKR(1, kb0, kb1, S1); QKM(N0, N1, 0, ka0, ka1); } EX4(C0, 0, 0); \
    SB(); if (HAS_NEXT) { QKR(2, ka0, ka1, S1); QKM(N0, N1, 1, kb0, kb1); } EX4(C0, 4, 0); PK8(pf[0], C0, 0); \
    SB(); if (HAS_NEXT) { QKR(3, kb0, kb1, S1); QKM(N0, N1, 2, ka0, ka1); } EX4(C0, 8, 1); \
    SB(); if (HAS_NEXT) { QKR(4, ka0, ka1, S1); QKM(N0, N1, 3, kb0, kb1); } EX4(C0, 12, 1); PK8(pf[1], C0, 8); if (NQK == 4) VR(0, va0, va1, S0); \
    if (NQK > 4) { \
      SB(); if (HAS_NEXT) { QKR(5, kb0, kb1, S1); QKM(N0, N1, 4, ka0, ka1); } EX4(C1, 0, 2); \
      SB(); if (HAS_NEXT) QKM(N0, N1, 5, kb0, kb1); EX4(C1, 4, 2); PK8(pf[2], C1, 0); VR(0, va0, va1, S0); } \
    float ma_ = -1e30f, mb_ = -1e30f; \
    if (NQK == 4) { \
      SB(); VR(1, vb0, vb1, S0); PVM(0, va0, va1); EX4(C1, 0, 2); EX4(C1, 4, 2); PK8(pf[2], C1, 0); \
      SB(); VR(2, va0, va1, S0); PVM(1, vb0, vb1); EX4(C1, 8, 3); EX4(C1, 12, 3); PK8(pf[3], C1, 8); \
    } else { \
      SB(); VR(1, vb0, vb1, S0); PVM(0, va0, va1); EX4(C1, 8, 3); \
      SB(); VR(2, va0, va1, S0); PVM(1, vb0, vb1); EX4(C1, 12, 3); PK8(pf[3], C1, 8); } \
    SB(); VR(3, vb0, vb1, S0); PVM(2, va0, va1); if (HAS_NEXT) { MAXG(N0, 0); MAXG(N0, 8); } \
    SB(); PVM(3, vb0, vb1); if (HAS_NEXT) { MAXG(N1, 0); MAXG(N1, 8); } \
    SB(); \
    float mx_ = fmaxf(ma_, mb_); { const auto rr_ = __builtin_amdgcn_permlane32_swap(__float_as_uint(mx_), __float_as_uint(mx_), false, false); mx_ = fmaxf(__uint_as_float(rr_[0]), __uint_as_float(rr_[1])); } \
    DMA_WAIT(HAS_LOAD); BAR(); \
    if (HAS_NEXT) { if (__any(mx_ > THR)) RESCALE(N0, N1, fmaxf(mx_, 0.f)); } } while (0)
  constexpr int R0 = 0, R1 = ATT_STAGE, R2 = 2 * ATT_STAGE, R3 = 3 * ATT_STAGE;
  f32x16 sA0, sA1, sB0, sB1;
  DMA(0, R0); DMA(1, R1); DMA(2, R2); DMA_WAIT(true); BAR();
  { bf16x8 ka0, ka1;
#pragma unroll
    for (int d0 = 0; d0 < NQK; ++d0) { QKR(d0, ka0, ka1, R0); QKM(sA0, sA1, d0, ka0, ka1); } }
  { float mx0; ROWMAX(sA0, sA1, mx0); m_run = mx0;
#pragma unroll
    for (int i = 0; i < 16; ++i) { sA0[i] -= mx0; sA1[i] -= mx0; negm[i] = -mx0; } }
  for (int t = 0; t < NT - 4; t += 4) {
    STEP(sA0, sA1, sB0, sB1, t, true, true, R0, R1, R3);
    STEP(sB0, sB1, sA0, sA1, t + 1, true, true, R1, R2, R0);
    STEP(sA0, sA1, sB0, sB1, t + 2, true, true, R2, R3, R1);
    STEP(sB0, sB1, sA0, sA1, t + 3, true, true, R3, R0, R2);
  }
  STEP(sA0, sA1, sB0, sB1, NT - 4, true, true, R0, R1, R3);
  STEP(sB0, sB1, sA0, sA1, NT - 3, true, false, R1, R2, R0);
  STEP(sA0, sA1, sB0, sB1, NT - 2, true, false, R2, R3, R1);
  STEP(sB0, sB1, sA0, sA1, NT - 1, false, false, R3, R0, R2);
  const float l = (NONES > 0 ? la[0] : 0.f) + lsum + __shfl_xor(lsum, 32);
#undef DMA
#undef DMA_WAIT
#undef BAR
#undef SB
#undef QKR
#undef QKM
#undef EX4
#undef PK8
#undef VR
#undef PVM
#undef MAXG
#undef ROWMAX
#undef RESCALE
#undef STEP
  const float inv = 1.0f / l;
  bf16_t* op = O + (size_t)q * 512 + head * 64 + 4 * h;
#pragma unroll
  for (int g = 0; g < 4; ++g) {
    u32x2 w; w.x = pk2(o0[4 * g] * inv, o0[4 * g + 1] * inv); w.y = pk2(o0[4 * g + 2] * inv, o0[4 * g + 3] * inv);
    *(u32x2*)(op + 8 * g) = w;
    u32x2 w1; w1.x = pk2(o1[4 * g] * inv, o1[4 * g + 1] * inv); w1.y = pk2(o1[4 * g + 2] * inv, o1[4 * g + 3] * inv);
    *(u32x2*)(op + 32 + 8 * g) = w1;
  }
}

constexpr int BLV = 49152;
DI void b_issue_k(const Params& p, int x, char* lds, int tid, int wid) {
  typedef __attribute__((address_space(3))) unsigned lds_u32;
  const int g = x >> 9, head = (x >> 6) & 7, blk256 = x & 63;
  const int sh = 2 * g, Ls = S >> sh, P0 = blk256 * 256, sub = P0 / Ls, i0 = P0 & (Ls - 1), sub0 = sub * Ls;
  const bf16_t* Zk = (const bf16_t*)(p.ws + OFF_Z) + ZC_QKVB + ((1 * 3 + g) * 8 + head) * 64;
#pragma unroll
  for (int i = 0; i < 6; ++i) {
    const int sl = i * 512 + tid, row = sl >> 3, c = (sl & 7) ^ ((row >> 1) & 7); int key = i0 - 64 + row; key = key < 0 ? 0 : (key > Ls - 1 ? Ls - 1 : key);
    __builtin_amdgcn_global_load_lds((const unsigned*)(Zk + (size_t)(sub0 + key) * ZP + c * 8), (lds_u32*)(lds + (i * 512 + wid * 64) * 16), 16, 0, 0);
  }
}
DI void b_issue_v(const Params& p, int x, char* lds, int tid, int wid) {
  typedef __attribute__((address_space(3))) unsigned lds_u32;
  const int g = x >> 9, head = (x >> 6) & 7, blk256 = x & 63;
  const int sh = 2 * g, Ls = S >> sh, P0 = blk256 * 256, sub = P0 / Ls, i0 = P0 & (Ls - 1), sub0 = sub * Ls;
  const bf16_t* VTg = (const bf16_t*)(p.ws + OFF_VBT) + (size_t)((g * 8 + head) * 64) * S + sub0;
#pragma unroll
  for (int i = 0; i < 6; ++i) {
    const int sl = i * 512 + tid, d = sl / 48, c = (sl - d * 48) ^ (d & 15); int k0 = i0 - 64 + 8 * c; k0 = k0 < 0 ? 0 : (k0 > Ls - 8 ? Ls - 8 : k0);
    __builtin_amdgcn_global_load_lds((const unsigned*)(VTg + (size_t)d * S + k0), (lds_u32*)(lds + BLV + (i * 512 + wid * 64) * 16), 16, 0, 0);
  }
}
DI void attn_b_item(const Params& p, int x, int xnext, char* lds) {
  const int tid = otid(), lane = tid & 63, wid = wave_of(tid), r = lane & 31, h = lane >> 5;
  const int g = x >> 9, head = (x >> 6) & 7, blk256 = x & 63;
  const bf16_t* Z = (const bf16_t*)(p.ws + OFF_Z);
  const int sh = 2 * g, Ls = S >> sh, P0 = blk256 * 256, sub = P0 / Ls, i0 = P0 & (Ls - 1);
  const bf16_t* Zq = Z + ZC_QKVB + ((0 * 3 + g) * 8 + head) * 64;
  constexpr int LV = BLV;
  const int i0w = i0 + 32 * wid;
  const float* BT = (const float*)(p.ws + OFF_BT) + (g * 8 + head) * 256 + 32 - r + 8 * h;
  const int rK = (r & ~12) | ((r & 4) << 1) | ((r & 8) >> 1);
  bf16x8 qf[4];
  {
    const bf16_t* qp = Zq + (size_t)(P0 + 32 * wid + r) * ZP + 8 * h; const float scq = 0.125f * LOG2E;
#pragma unroll
    for (int d0 = 0; d0 < 4; ++d0) { float x8[8]; unpack8(*(const u32x4*)(qp + d0 * 16), x8); qf[d0] = pack8(x8[0] * scq, x8[1] * scq, x8[2] * scq, x8[3] * scq, x8[4] * scq, x8[5] * scq, x8[6] * scq, x8[7] * scq); }
  }
  float bvs[5][16];
#pragma unroll
  for (int c = 0; c < 5; ++c)
#pragma unroll
    for (int i = 0; i < 16; ++i) bvs[c][i] = BT[32 * c + (i & 3) + 4 * ((i >> 2) & 1) + 16 * (i >> 3)];
  asm volatile("s_waitcnt vmcnt(0)" ::: "memory"); __builtin_amdgcn_s_barrier(); asm volatile("" ::: "memory");
#pragma unroll
  for (int c = 0; c < 5; ++c)
#pragma unroll
    for (int i = 0; i < 16; ++i) asm volatile("" : "+v"(bvs[c][i]));
  f32x16 sc[5];
  const int ksw = (rK >> 1) & 7;
#pragma unroll
  for (int c = 0; c < 5; ++c) {
#pragma unroll
    for (int i = 0; i < 16; ++i) sc[c][i] = 0.f;
    const char* kp = lds + (32 * wid + 32 * c + rK) * 128;
#pragma unroll
    for (int d0 = 0; d0 < 4; ++d0) { const bf16x8 kf = *(const bf16x8*)(kp + (((2 * d0 + h) ^ ksw) << 4)); sc[c] = MFMA(kf, qf[d0], sc[c]); }
  }
  asm volatile("s_waitcnt lgkmcnt(0)" ::: "memory"); __builtin_amdgcn_s_barrier(); asm volatile("" ::: "memory");
  if (xnext >= 0) b_issue_k(p, xnext, lds, tid, wid);
  float mx = -1e30f;
#pragma unroll
  for (int c = 0; c < 5; ++c)
#pragma unroll
    for (int i = 0; i < 16; ++i) {
      const int prow = (i & 3) + 4 * ((i >> 2) & 1) + 8 * h + 16 * (i >> 3);
      const int rel = 32 * c - 64 + prow - r, key = i0w + r + rel;
      const bool valid = ((unsigned)(rel + 64) <= 128u) & ((unsigned)key < (unsigned)Ls);
      const float v = valid ? sc[c][i] + bvs[c][i] : -1e30f;
      sc[c][i] = v; mx = fmaxf(mx, v);
    }
  mx = fmaxf(mx, __shfl_xor(mx, 32));
  float l = 0.f;
#pragma unroll
  for (int c = 0; c < 5; ++c)
#pragma unroll
    for (int i = 0; i < 16; ++i) { const float e = fexp2(sc[c][i] - mx); sc[c][i] = e; l += e; }
  l += __shfl_xor(l, 32);
  f32x16 o0, o1;
#pragma unroll
  for (int i = 0; i < 16; ++i) { o0[i] = 0.f; o1[i] = 0.f; }
  const char* vp = lds + LV + r * 768; const int vsw = r & 15;
#pragma unroll
  for (int c = 0; c < 5; ++c)
#pragma unroll
    for (int s = 0; s < 2; ++s) {
      const bf16x8 pf = pack8(sc[c][8 * s], sc[c][8 * s + 1], sc[c][8 * s + 2], sc[c][8 * s + 3], sc[c][8 * s + 4], sc[c][8 * s + 5], sc[c][8 * s + 6], sc[c][8 * s + 7]);
      const int ch = ((4 * wid + 4 * c + 2 * s + h) ^ vsw) << 4;
      const bf16x8 v0 = *(const bf16x8*)(vp + ch), v1 = *(const bf16x8*)(vp + 32 * 768 + ch);
      o0 = MFMA(v0, pf, o0); o1 = MFMA(v1, pf, o1);
    }
  asm volatile("s_waitcnt lgkmcnt(0)" ::: "memory"); __builtin_amdgcn_s_barrier(); asm volatile("" ::: "memory");
  if (xnext >= 0) b_issue_v(p, xnext, lds, tid, wid);
  const float inv = 1.0f / l;
  const int tkn = ((i0w + r) << sh) + sub;
  bf16_t* OG = (g < 2) ? (bf16_t*)(p.ws + OFF_H) + (size_t)g * S * 512 : (bf16_t*)(p.ws + OFF_OB);
  bf16_t* op = OG + (size_t)tkn * 512 + head * 64 + 4 * h;
#pragma unroll
  for (int gg = 0; gg < 4; ++gg) {
    u32x2 w; w.x = pk2(o0[4 * gg] * inv, o0[4 * gg + 1] * inv); w.y = pk2(o0[4 * gg + 2] * inv, o0[4 * gg + 3] * inv);
    *(u32x2*)(op + 8 * gg) = w;
    u32x2 w1; w1.x = pk2(o1[4 * gg] * inv, o1[4 * gg + 1] * inv); w1.y = pk2(o1[4 * gg + 2] * inv, o1[4 * gg + 3] * inv);
    *(u32x2*)(op + 32 + 8 * gg) = w1;
  }
  if (h == 0) { float* LSE = (float*)(p.ws + OFF_LSE); LSE[((size_t)g * S + tkn) * 8 + head] = (mx + __builtin_amdgcn_logf(l)) * LN2; }
}

DI void phase_attn(const Params& p, int layer, char* smem) {
  const int n_dense = 1024, n_b = 1536, total = n_dense + n_b;
  int it = blockIdx.x;
  for (; it < n_dense; it += gridDim.x) {
    if (it < 512) { attn_dense_unit<0>(p, layer, it & 7, it >> 3, smem); }
    else { const int v = it - 512; attn_dense_unit<1>(p, layer, v & 7, v >> 3, smem); }
  }
  if (it < total) {
    const int tid = otid(), wid = wave_of(tid);
    b_issue_k(p, it - n_dense, smem, tid, wid); b_issue_v(p, it - n_dense, smem, tid, wid);
    for (; it < total; it += gridDim.x) {
      const int nx = it + (int)gridDim.x;
      attn_b_item(p, it - n_dense, nx < total ? nx - n_dense : -1, smem);
    }
  }
}

DI void phase_combine(const Params& p) {
  const bf16_t* G0 = (const bf16_t*)(p.ws + OFF_H); const bf16_t* G1 = G0 + (size_t)S * 512; bf16_t* OB = (bf16_t*)(p.ws + OFF_OB);
  const float* LSE = (const float*)(p.ws + OFF_LSE);
  for (int e = blockIdx.x * 512 + otid(); e < S * 64; e += gridDim.x * 512) {
    const int tkn = e >> 6, c = e & 63, head = c >> 3;
    const float l0 = LSE[((size_t)0 * S + tkn) * 8 + head], l1 = LSE[((size_t)1 * S + tkn) * 8 + head], l2 = LSE[((size_t)2 * S + tkn) * 8 + head];
    const float mm = fmaxf(l0, fmaxf(l1, l2));
    float w0 = __expf(l0 - mm), w1 = __expf(l1 - mm), w2 = __expf(l2 - mm);
    const float iw = 1.0f / (w0 + w1 + w2); w0 *= iw; w1 *= iw; w2 *= iw;
    const size_t off = (size_t)tkn * 512 + c * 8;
    const u32x4 a = *(const u32x4*)(G0 + off), b = *(const u32x4*)(G1 + off), d = *(const u32x4*)(OB + off);
    u32x4 o;
#pragma unroll
    for (int q = 0; q < 4; ++q) o[q] = pk2(w0 * bflo(a[q]) + w1 * bflo(b[q]) + w2 * bflo(d[q]), w0 * bfhi(a[q]) + w1 * bfhi(b[q]) + w2 * bfhi(d[q]));
    *(u32x4*)(OB + off) = o;
  }
}

#define XB_TMO      128
#define XB_XCNT(j)  (256  + 64 * (j))
#define XB_XSUB(j)  (1280 + 64 * (j))
#define XB_XGEN(j)  (2304 + 64 * (j))
#define XB_TOP      3328
#define XB_TOPGEN   3392
#define XCD_BAR_WORDS 3456
#define XB_SPIN_CAP (1u << 18)
#ifndef LAS
#define LAS __attribute__((address_space(3)))
#endif

__device__ __forceinline__ unsigned xb_ld(unsigned* p)              { return __hip_atomic_load(p, __ATOMIC_RELAXED, __HIP_MEMORY_SCOPE_AGENT); }
__device__ __forceinline__ unsigned xb_add(unsigned* p, unsigned v) { return __hip_atomic_fetch_add(p, v, __ATOMIC_RELAXED, __HIP_MEMORY_SCOPE_AGENT); }
__device__ __forceinline__ unsigned xb_xcc_id() { return (unsigned)__builtin_amdgcn_s_getreg((3 << 11) | 20) & 0xFu; }
#define XB_SPIN(cond, bar) do { unsigned _sp = 0; while (cond) { __builtin_amdgcn_s_sleep(1); \
    if ((++_sp & 255u) == 0u) { if (xb_ld(&(bar)[XB_TMO])) break; if (_sp > XB_SPIN_CAP) { atomicAdd(&(bar)[XB_TMO], 1u); break; } } } } while (0)

struct XcdBarrier {
    unsigned* bar; unsigned x;
    volatile LAS unsigned* st;
};

__device__ __forceinline__ XcdBarrier xcd_barrier_post(unsigned* bar, volatile LAS unsigned* st) {
    XcdBarrier b; b.bar = bar; b.x = xb_xcc_id(); b.st = st;
    if (threadIdx.x == 0) (void)xb_add(&bar[XB_XCNT(b.x)], 1u);
    return b;
}
__device__ __forceinline__ void xcd_barrier_complete(unsigned* bar, unsigned x, unsigned& nloc, unsigned& nx) {
    const unsigned G = gridDim.x * gridDim.y * gridDim.z;
    unsigned sum, cnt, mine, sp = 0u;
    for (;;) {
        sum = 0u; cnt = 0u; mine = 0u;
#pragma unroll
        for (unsigned j = 0; j < 16; ++j) { const unsigned c = xb_ld(&bar[XB_XCNT(j)]); sum += c; cnt += (c > 0u) ? 1u : 0u; mine = (j == x) ? c : mine; }
        if (sum == G) break;
        __builtin_amdgcn_s_sleep(1);
        if ((++sp & 255u) == 0u) { if (xb_ld(&bar[XB_TMO])) break; if (sp > XB_SPIN_CAP) { atomicAdd(&bar[XB_TMO], 1u); break; } }
    }
    nloc = mine > 0u ? mine : 1u; nx = cnt > 0u ? cnt : 1u;
}

__device__ __forceinline__ void xcd_barrier(const XcdBarrier& b) {
    asm volatile("s_waitcnt vmcnt(0)" ::: "memory");
    __syncthreads();
    if (threadIdx.x == 0) {
        unsigned* bar = b.bar;
        __builtin_amdgcn_s_waitcnt(0);
        unsigned nloc = b.st[0], nx = b.st[1];
        if (nloc == 0u) { xcd_barrier_complete(bar, b.x, nloc, nx); b.st[0] = nloc; b.st[1] = nx; }
        const unsigned old = xb_add(&bar[XB_XSUB(b.x)], 1u);
        const unsigned gen = old / nloc;
        if (old + 1u == (gen + 1u) * nloc) {
            __builtin_amdgcn_fence(__ATOMIC_RELEASE, "agent");
            asm volatile("s_waitcnt vmcnt(0)" ::: "memory");
            const unsigned og = xb_add(&bar[XB_TOP], 1u);
            const unsigned tg = og / nx;
            if (og + 1u == (tg + 1u) * nx) xb_add(&bar[XB_TOPGEN], 1u);
            else XB_SPIN(xb_ld(&bar[XB_TOPGEN]) == tg, bar);
            __builtin_amdgcn_fence(__ATOMIC_ACQUIRE, "agent");
            xb_add(&bar[XB_XGEN(b.x)], 1u);
            asm volatile("s_waitcnt vmcnt(0)" ::: "memory");
        } else {
            XB_SPIN(xb_ld(&bar[XB_XGEN(b.x)]) == gen, bar);
            __builtin_amdgcn_fence(__ATOMIC_ACQUIRE, "agent");
            asm volatile("s_waitcnt vmcnt(0)" ::: "memory");
        }
    }
    __syncthreads();
}

__global__ void __launch_bounds__(512) hybrid_encoder_mega(Params p) {
  extern __shared__ __attribute__((aligned(16))) char smem[];
  cg::grid_group grid = cg::this_grid();
  const int G = gridDim.x, bx = blockIdx.x;
  bf16_t* Z = (bf16_t*)(p.ws + OFF_Z); bf16_t* H = (bf16_t*)(p.ws + OFF_H);
  float* ssq_q = (float*)(p.ws + OFF_SSQ); float* ssq_kv = ssq_q + S; float* ssq_x = ssq_q + 2 * S;
  bf16_t* XB = (bf16_t*)(p.ws + OFF_OA);
  volatile LAS unsigned* xst = (volatile LAS unsigned*)(smem + 131072);
  if (threadIdx.x == 0) { xst[0] = 0u; xst[1] = 0u; xst[2] = 0u; xst[3] = 0u; }
  __syncthreads();
  const XcdBarrier xb = xcd_barrier_post((unsigned*)(p.ws + OFF_BAR), xst);
  bool first_sync = true;
#define GSYNC() do { if (first_sync) { grid.sync(); first_sync = false; } else xcd_barrier(xb); } while (0)
  build_tables(p);
  for (int layer = 0; layer < 2; ++layer) {
    convert_weights(p, layer, smem);
    for (int seq = 0; seq < 3; ++seq) {
      const float* xin = (layer == 0) ? (seq < 2 ? p.x_prompt + (size_t)seq * S * DM : p.x_sample) : p.out + (size_t)seq * S * DM;
      float* xo = p.out + (size_t)seq * S * DM;
      phase_norm(xin, p.norm_mix + layer * DM, H, S);
      { const int tz = otid();
_Pragma("nounroll")
        for (int b = bx; b < 96; b += G) ssq_q[b * 512 + tz] = 0.f; }
      GSYNC();
      { pg8::Gemm g{H, (const bf16_t*)(p.ws + WT_IN), S, 9216, DM, DM, DM}; pg8::StaticOrder so; so.init(S, 9216, G, bx);
        EpiInproj E{Z, (bf16_t*)(p.ws + OFF_VCT), (bf16_t*)(p.ws + OFF_VBT), ssq_q, ssq_kv};
        pg8::gemm_phase<EpiInproj, pg8::StaticOrder, true, true>(GEMM_LDS, g, so, E); }
      GSYNC();
      { pg8::Gemm g{Z + ZC_CQ, (const bf16_t*)(p.ws + WT_UQ), S, 768, 384, ZP, 384}; pg8::StaticOrder so; so.init(S, 768, G, bx);
        EpiUpQ E{(bf16_t*)(p.ws + OFF_QA), ssq_q};
        pg8::gemm_phase<EpiUpQ, pg8::StaticOrder, true, true>(GEMM_LDS, g, so, E); }
      { pg8::Gemm g{Z + ZC_CKV, (const bf16_t*)(p.ws + WT_UKV), S, 1024, 256, ZP, 256}; pg8::StaticOrder so; so.init(S, 1024, G, bx);
        EpiUpKV E{(bf16_t*)(p.ws + OFF_KA), (bf16_t*)(p.ws + OFF_VAT), ssq_kv};
        pg8::gemm_phase<EpiUpKV, pg8::StaticOrder, true, true>(GEMM_LDS, g, so, E); }
      phase_kpost(p, layer);
      GSYNC();
      phase_attn(p, layer, smem);
      GSYNC();
      phase_combine(p);
      GSYNC();
      { pg8::Gemm g{(const bf16_t*)(p.ws + OFF_OA), (const bf16_t*)(p.ws + WT_BRA), 3 * S, 3072, 512, 512, 512}; DiagOrder so; so.init(G, bx);
        EpiMerge E{Z, H};
        pg8::gemm_phase<EpiMerge, DiagOrder, true, true>(GEMM_LDS, g, so, E); }
      GSYNC();
      { pg8::Gemm g{H, (const bf16_t*)(p.ws + WT_OUT), S, 1024, DM, DM, DM}; pg8::StaticOrder so; so.init(S, 1024, G, bx);
        EpiResid<true> E{xin, xo, XB, ssq_x};
        pg8::gemm_phase<EpiResid<true>, pg8::StaticOrder, true, true>(GEMM_LDS, g, so, E); }
      GSYNC();
      { pg8::Gemm g{XB, (const bf16_t*)(p.ws + WT_UP), S, DFF, DM, DM, DM}; pg8::StaticOrder so; so.init(S, DFF, G, bx);
        EpiRelu2 E{Z, ssq_x};
        pg8::gemm_phase<EpiRelu2, pg8::StaticOrder, true, true>(GEMM_LDS, g, so, E); }
      GSYNC();
      { pg8::Gemm g{Z, (const bf16_t*)(p.ws + WT_DOWN), S, 1024, DFF, DFF, DFF}; pg8::StaticOrder so; so.init(S, 1024, G, bx);
        EpiResid<false> E{xo, xo, nullptr, nullptr};
        pg8::gemm_phase<EpiResid<false>, pg8::StaticOrder, true, true>(GEMM_LDS, g, so, E); }
      GSYNC();
    }
  }
  phase_final_norm(p.out, p.final_norm, 3 * S);
}

extern "C" void kernel_launch(void* const* d_in, const int* in_sizes, int n_in, void* d_out, int out_size, void* d_ws, size_t ws_size, hipStream_t stream) {
  static int grid_blocks = 0;
  if (!grid_blocks) {
    if (ws_size < WS_END) { fprintf(stderr, "kernel_launch: workspace too small: %zu < %zu\n", ws_size, (size_t)WS_END); return; }
    if (hipFuncSetAttribute((const void*)hybrid_encoder_mega, hipFuncAttributeMaxDynamicSharedMemorySize, LDS_BYTES) != hipSuccess) { fprintf(stderr, "hipFuncSetAttribute failed\n"); return; }
    int dev = 0, cus = 0, per_cu = 0;
    hipGetDevice(&dev);
    hipDeviceGetAttribute(&cus, hipDeviceAttributeMultiprocessorCount, dev);
    hipOccupancyMaxActiveBlocksPerMultiprocessor(&per_cu, hybrid_encoder_mega, 512, LDS_BYTES);
    if (per_cu < 1) { fprintf(stderr, "occupancy query returned %d\n", per_cu); return; }
    grid_blocks = cus;
  }
  Params p{};
  p.x_prompt = (const float*)d_in[0]; p.x_sample = (const float*)d_in[1];
  p.norm_mix = (const float*)d_in[2]; p.w_in = (const float*)d_in[3]; p.a_q_norm = (const float*)d_in[4]; p.a_kv_norm = (const float*)d_in[5];
  p.a_w_uq = (const float*)d_in[6]; p.a_w_ukv = (const float*)d_in[7]; p.c_q_norm = (const float*)d_in[8]; p.c_k_norm = (const float*)d_in[9];
  p.w_br_a = (const float*)d_in[10]; p.w_br_b = (const float*)d_in[11]; p.w_br_c = (const float*)d_in[12]; p.w_out = (const float*)d_in[13];
  p.norm_ffn = (const float*)d_in[14]; p.w_up = (const float*)d_in[15]; p.w_down = (const float*)d_in[16]; p.t5_table = (const float*)d_in[17];
  p.final_norm = (const float*)d_in[18];
  p.out = (float*)d_out; p.ws = (char*)d_ws;
  (void)hipMemsetAsync((char*)d_ws + OFF_BAR, 0, 16384, stream);
  void* args[] = {&p};
  hipError_t e = hipLaunchCooperativeKernel((const void*)hybrid_encoder_mega, dim3(grid_blocks), dim3(512), args, LDS_BYTES, stream);
  if (e != hipSuccess) fprintf(stderr, "cooperative launch failed: %s (grid %d)\n", hipGetErrorString(e), grid_blocks);
}
```

```cpp
#include <hip/hip_runtime.h>
#include <hip/hip_cooperative_groups.h>
#include <stdint.h>
#include <cstdio>
namespace cg = cooperative_groups;

typedef unsigned short bf16_t;
typedef short bf16x8 __attribute__((ext_vector_type(8)));
typedef short s16x4 __attribute__((ext_vector_type(4)));
typedef float f32x16 __attribute__((ext_vector_type(16)));
typedef float f32x4 __attribute__((ext_vector_type(4)));
typedef float f32x2 __attribute__((ext_vector_type(2)));
typedef unsigned u32x4 __attribute__((ext_vector_type(4)));
typedef unsigned u32x2 __attribute__((ext_vector_type(2)));
typedef __bf16 bf16x2_t __attribute__((ext_vector_type(2)));

#define DI __device__ __forceinline__
#define MFMA(a, b, c) __builtin_amdgcn_mfma_f32_32x32x16_bf16((a), (b), (c), 0, 0, 0)

DI unsigned pk2(float lo, float hi) { f32x2 v = {lo, hi}; bf16x2_t b = __builtin_convertvector(v, bf16x2_t); return __builtin_bit_cast(unsigned, b); }
DI bf16_t f2bf(float x) { return (bf16_t)(pk2(x, 0.f) & 0xffffu); }
DI float bflo(unsigned u) { return __uint_as_float(u << 16); }
DI float bfhi(unsigned u) { return __uint_as_float(u & 0xffff0000u); }
DI float bf2f(bf16_t b) { return __uint_as_float(((unsigned)b) << 16); }
DI int crow(int i, int h) { return (i & 3) + 8 * (i >> 2) + 4 * h; }
DI float fexp2(float x) { return __builtin_amdgcn_exp2f(x); }
DI int otid() { int t = threadIdx.x; asm volatile("" : "+v"(t)); return t; }
DI int wave_of(int tid) { return __builtin_amdgcn_readfirstlane(tid >> 6); }

constexpr int S = 16384, DM = 1024, ZP = 7680, DFF = 4096;
constexpr int ZC_CQ = 0, ZC_CKV = 384, ZC_KR = 640, ZC_QKVB = 768, ZC_QC = 3840, ZC_KC = 4352, ZC_GATE = 4608;
constexpr int GC_VB = 3840, GC_VC = 6016;
constexpr float LOG2E = 1.4426950408889634f, LN2 = 0.6931471805599453f;

constexpr size_t WT_IN = 0;
constexpr size_t WT_UQ = WT_IN + (size_t)9216 * 1024 * 2;
constexpr size_t WT_UKV = WT_UQ + (size_t)768 * 384 * 2;
constexpr size_t WT_BRA = WT_UKV + (size_t)1024 * 256 * 2;
constexpr size_t WT_BRB = WT_BRA + (size_t)1024 * 512 * 2;
constexpr size_t WT_BRC = WT_BRB + (size_t)1024 * 512 * 2;
constexpr size_t WT_OUT = WT_BRC + (size_t)1024 * 512 * 2;
constexpr size_t WT_UP = WT_OUT + (size_t)1024 * 3072 * 2;
constexpr size_t WT_DOWN = WT_UP + (size_t)4096 * 1024 * 2;
constexpr size_t OFF_CS = WT_DOWN + (size_t)1024 * 4096 * 2;
constexpr size_t OFF_BT = OFF_CS + (size_t)16384 * 16 * 8;
constexpr size_t OFF_Z = OFF_BT + 32768;
constexpr size_t OFF_H = OFF_Z + (size_t)S * ZP * 2;
constexpr size_t OFF_QA = OFF_H + (size_t)S * 1024 * 2;
constexpr size_t OFF_KA = OFF_QA + (size_t)S * 768 * 2;
constexpr size_t OFF_VAT = OFF_KA + (size_t)S * 512 * 2;
constexpr size_t OFF_VCT = OFF_VAT + (size_t)S * 512 * 2;
constexpr size_t OFF_OA = OFF_VCT + (size_t)S * 128 * 2;
constexpr size_t OFF_OB = OFF_OA + (size_t)S * 512 * 2;
constexpr size_t OFF_OC = OFF_OB + (size_t)S * 512 * 2;
constexpr size_t OFF_LSE = OFF_OC + (size_t)S * 512 * 2;
constexpr size_t OFF_SSQ = OFF_LSE + (size_t)3 * S * 8 * 4;
constexpr size_t OFF_VBT = OFF_SSQ + (size_t)3 * S * 4;
constexpr size_t OFF_BAR = OFF_VBT + (size_t)1536 * S * 2;
constexpr size_t WS_END = OFF_BAR + 16384;

constexpr int LDS_BYTES = 131072 + 1024;

struct Params {
  const float* x_prompt; const float* x_sample;
  const float* norm_mix; const float* w_in; const float* a_q_norm; const float* a_kv_norm; const float* a_w_uq; const float* a_w_ukv;
  const float* c_q_norm; const float* c_k_norm; const float* w_br_a; const float* w_br_b; const float* w_br_c; const float* w_out;
  const float* norm_ffn; const float* w_up; const float* w_down; const float* t5_table; const float* final_norm;
  float* out; char* ws;
};

DI void sincos_d(double x, float& c, float& s) {
  const double k = rint(x * 0.6366197723675814);
  double t = fma(-k, 1.5707963267948966, x); t = fma(-k, 6.123233995736766e-17, t);
  const double t2 = t * t;
  double sn = 1.0 - t2 / 210.0; sn = 1.0 - t2 / 156.0 * sn; sn = 1.0 - t2 / 110.0 * sn; sn = 1.0 - t2 / 72.0 * sn; sn = 1.0 - t2 / 42.0 * sn; sn = 1.0 - t2 / 20.0 * sn; sn = 1.0 - t2 / 6.0 * sn; sn *= t;
  double cs = 1.0 - t2 / 240.0; cs = 1.0 - t2 / 182.0 * cs; cs = 1.0 - t2 / 132.0 * cs; cs = 1.0 - t2 / 90.0 * cs; cs = 1.0 - t2 / 56.0 * cs; cs = 1.0 - t2 / 30.0 * cs; cs = 1.0 - t2 / 12.0 * cs; cs = 1.0 - t2 / 2.0 * cs;
  const int q = ((int)k) & 3;
  double so = (q == 0) ? sn : (q == 1) ? cs : (q == 2) ? -sn : -cs;
  double co = (q == 0) ? cs : (q == 1) ? -sn : (q == 2) ? -cs : sn;
  c = (float)co; s = (float)so;
}

DI void build_tables(const Params& p) {
  f32x2* CS = (f32x2*)(p.ws + OFF_CS);
  const int gsz = gridDim.x * 512, gid = blockIdx.x * 512 + otid();
  for (int e = gid; e < 16384 * 16; e += gsz) {
    const int pos = e >> 4, i = e & 15;
    double f = 1.0; for (int j = 0; j < i; ++j) f *= 0.5623413251903491;
    const float ff = (float)f; const float ang = (float)pos * ff;
    float c, s; sincos_d((double)ang, c, s);
    CS[e] = (f32x2){c, s};
  }
  float* BT = (float*)(p.ws + OFF_BT);
  for (int e = gid; e < 3 * 8 * 256; e += gsz) {
    const int gh = e >> 8, g = gh >> 3, hd = gh & 7, j = (e & 255) - 32;
    float v = 0.f;
    if (j >= 0 && j <= 128) {
      const int rel = (j - 64) << (2 * g);
      const int n = rel < 0 ? -rel : rel;
      int b = rel > 0 ? 16 : 0;
      if (n < 8) b += n; else { int lg = 31 - __clz(n); int vv = 5 + lg; b += (vv < 15 ? vv : 15); }
      v = p.t5_table[b * 24 + g * 8 + hd] * LOG2E;
    }
    BT[e] = v;
  }
}

DI void cvt_tile(const float* __restrict__ W, int ldw, int ldk, int koff, bf16_t* __restrict__ Wt, int k0, int n0, int mode, const float* __restrict__ rscale, float* tile) {
  const int tid = otid();
#pragma unroll
  for (int i = 0; i < 8; ++i) {
    const int kl = (tid >> 6) + 8 * i, nl = tid & 63, nn = n0 + nl;
    int src = nn;
    if (mode == 1) src = nn < 672 ? nn : (nn < 768 ? -1 : nn - 96);
    float v = 0.f;
    if (src >= 0) v = W[(size_t)(k0 + kl) * ldw + src];
    if (rscale) v *= rscale[k0 + kl];
    tile[kl * 65 + nl] = v;
  }
  __syncthreads();
#pragma unroll
  for (int i = 0; i < 8; ++i) {
    const int nl = (tid >> 6) + 8 * i, kl = tid & 63;
    Wt[(size_t)(n0 + nl) * ldk + koff + k0 + kl] = f2bf(tile[kl * 65 + nl]);
  }
  __syncthreads();
}

DI void convert_weights(const Params& p, int layer, char* smem) {
  float* tile = (float*)smem;
  int base = 0;
  for (int mtx = 0; mtx < 9; ++mtx) {
    const float* W; int K, Nsrc, Ndst, mode = 0, ldk = 0, koff = 0; const float* rs = nullptr; size_t off;
    switch (mtx) {
      case 0: W = p.w_in + (size_t)layer * 1024 * 9120; K = 1024; Nsrc = 9120; Ndst = 9216; mode = 1; off = WT_IN; break;
      case 1: W = p.a_w_uq + (size_t)layer * 384 * 768; K = 384; Nsrc = 768; Ndst = 768; rs = p.a_q_norm + layer * 384; off = WT_UQ; break;
      case 2: W = p.a_w_ukv + (size_t)layer * 256 * 1024; K = 256; Nsrc = 1024; Ndst = 1024; rs = p.a_kv_norm + layer * 256; off = WT_UKV; break;
      case 3: W = p.w_br_a + (size_t)layer * 512 * 1024; K = 512; Nsrc = 1024; Ndst = 1024; off = WT_BRA; break;
      case 4: W = p.w_br_b + (size_t)layer * 512 * 1024; K = 512; Nsrc = 1024; Ndst = 1024; off = WT_BRB; break;
      case 5: W = p.w_br_c + (size_t)layer * 512 * 1024; K = 512; Nsrc = 1024; Ndst = 1024; off = WT_BRC; break;
      case 6: W = p.w_out + (size_t)layer * 1024 * 1024; K = 1024; Nsrc = 1024; Ndst = 1024; off = WT_OUT; break;
      case 7: W = p.w_up + (size_t)layer * 1024 * 4096; K = 1024; Nsrc = 4096; Ndst = 4096; rs = p.norm_ffn + layer * DM; off = WT_UP; break;
      case 8: default: W = p.w_down + (size_t)layer * 4096 * 1024; K = 4096; Nsrc = 1024; Ndst = 1024; off = WT_DOWN; break;
    }
    if (ldk == 0) ldk = K;
    const int nk = K / 64, nn = Ndst / 64, cnt = nk * nn;
    bf16_t* Wt = (bf16_t*)(p.ws + off);
    int first = (int)blockIdx.x - (base % (int)gridDim.x); if (first < 0) first += gridDim.x;
    for (int it = first; it < cnt; it += gridDim.x) {
      const int kt = it % nk, nt = it / nk;
      cvt_tile(W, Nsrc, ldk, koff, Wt, kt * 64, nt * 64, mode, rs, tile);
    }
    base += cnt;
  }
}

DI void phase_norm(const float* __restrict__ x, const float* __restrict__ g, bf16_t* __restrict__ H, int rows) {
  const int tid = otid(), lane = tid & 63, wid = tid >> 6;
  for (int row = blockIdx.x * 8 + wid; row < rows; row += gridDim.x * 8) {
    const float* xr = x + (size_t)row * DM;
    f32x4 v[4]; float ss = 0.f;
#pragma unroll
    for (int i = 0; i < 4; ++i) { v[i] = *(const f32x4*)(xr + i * 256 + lane * 4); ss += v[i][0] * v[i][0] + v[i][1] * v[i][1] + v[i][2] * v[i][2] + v[i][3] * v[i][3]; }
#pragma unroll
    for (int o = 32; o >= 1; o >>= 1) ss += __shfl_xor(ss, o);
    const float rstd = rsqrtf(ss * (1.0f / DM) + 1e-6f);
#pragma unroll
    for (int i = 0; i < 4; ++i) {
      const f32x4 gg = *(const f32x4*)(g + i * 256 + lane * 4);
      u32x2 w; w.x = pk2(v[i][0] * rstd * gg[0], v[i][1] * rstd * gg[1]); w.y = pk2(v[i][2] * rstd * gg[2], v[i][3] * rstd * gg[3]);
      *(u32x2*)(H + (size_t)row * DM + i * 256 + lane * 4) = w;
    }
  }
}

DI void phase_final_norm(float* __restrict__ x, const float* __restrict__ g, int rows) {
  const int tid = otid(), lane = tid & 63, wid = tid >> 6;
  for (int row = blockIdx.x * 8 + wid; row < rows; row += gridDim.x * 8) {
    float* xr = x + (size_t)row * DM;
    f32x4 v[4]; float ss = 0.f;
#pragma unroll
    for (int i = 0; i < 4; ++i) { v[i] = *(const f32x4*)(xr + i * 256 + lane * 4); ss += v[i][0] * v[i][0] + v[i][1] * v[i][1] + v[i][2] * v[i][2] + v[i][3] * v[i][3]; }
#pragma unroll
    for (int o = 32; o >= 1; o >>= 1) ss += __shfl_xor(ss, o);
    const float rstd = rsqrtf(ss * (1.0f / DM) + 1e-6f);
#pragma unroll
    for (int i = 0; i < 4; ++i) {
      const f32x4 gg = *(const f32x4*)(g + i * 256 + lane * 4);
      f32x4 o = {v[i][0] * rstd * gg[0], v[i][1] * rstd * gg[1], v[i][2] * rstd * gg[2], v[i][3] * rstd * gg[3]};
      *(f32x4*)(xr + i * 256 + lane * 4) = o;
    }
  }
}


namespace pg8 {
#define PG8_LAS __attribute__((address_space(3)))
typedef unsigned short bf16_t;
typedef short bf16x8 __attribute__((ext_vector_type(8)));
typedef float f32x4 __attribute__((ext_vector_type(4)));
typedef unsigned u32x4 __attribute__((ext_vector_type(4)));
constexpr int BM = 256, BK = 64, HALF = 128, HTB = HALF * BK * 2  , STAGE_BYTES = 8 * HTB, NXCD = 8, WGM = 8;

__host__ __device__ __forceinline__ int lds_byte(int r, int c) { const int st = (r >> 4) * 2 + (c >> 5), rr = r & 15, cc = c & 31, ob = rr * 64 + cc * 2; return st * 1024 + (ob ^ (((ob >> 9) & 1) << 5)); }
__host__ __device__ __forceinline__ void stage_rc(int b, int& R, int& C) { const int st = b / 1024, sb = b % 1024, swz = sb ^ (((sb >> 9) & 1) << 5); R = (st >> 1) * 16 + swz / 64; C = (st & 1) * 32 + (swz % 64) / 2; }
__host__ __device__ __forceinline__ int perm32(int rho) { const int n = rho >> 4, i = rho & 15; return 8 * (i >> 2) + 4 * n + (i & 3); }

struct Unit { int pm, pn; };
struct Gemm { const bf16_t* A; const bf16_t* Bt; int M, N, K, lda, ldb; };

struct StaticOrder {
    int nM, nN, nwg, G, c;
    __host__ __device__ void init(int M, int N, int G_, int c_) { nM = M / BM; nN = N / BM; nwg = nM * nN; G = G_; c = c_; }
    __host__ __device__ bool next(int i, Unit& u) const {
        const long L = (long)i * G + c; if (L >= nwg) return false;
        map((int)L, u); return true; }
    __host__ __device__ void map(int L, Unit& u) const {
        int wgid = L; { const int q = nwg / NXCD, r = nwg % NXCD, xcd = wgid % NXCD, off = wgid / NXCD; wgid = (xcd < r ? xcd * (q + 1) : r * (q + 1) + (xcd - r) * q) + off; }
        const int nig = WGM * nN, gid = wgid / nig, fm = gid * WGM, gsz = (nM - fm) < WGM ? (nM - fm) : WGM;
        u.pm = fm + ((wgid % nig) % gsz); u.pn = (wgid % nig) / gsz;
    }
    __device__ __forceinline__ void a_ready(const Unit&) const {}
    __device__ __forceinline__ void done(const Unit&) const {}
};
template <class Epi, class Sched, bool ALIGN_EPI = false, bool SP2 = false>
__device__ __forceinline__ void gemm_phase(PG8_LAS unsigned char* lds, const Gemm g, const Sched& S, const Epi& E) {
    int tid_ = threadIdx.x; asm volatile("" : "+v"(tid_)); const int tid = tid_, wid = __builtin_amdgcn_readfirstlane(tid >> 6), lane = tid & 63, wr = wid >> 2, wc = wid & 3, fr = lane & 15, fq = lane >> 4;
    const int K = g.K, nt = K / BK;
    unsigned voffA[2], voffB[2];
#pragma unroll
    for (int i = 0; i < 2; ++i) { int R, C; stage_rc(tid * 16 + i * 8192, R, C); const int Rb = Epi::PERM ? ((R & ~31) + perm32(R & 31)) : R;
        voffA[i] = (unsigned)(R * g.lda + C) * 2u; voffB[i] = (unsigned)(Rb * g.ldb + C) * 2u; }
    const size_t kstep = (size_t)(BK * 2);
    const size_t hA = (size_t)HALF * g.lda * 2, hB = (size_t)HALF * g.ldb * 2;
    const size_t tA = 2 * hA, tB = 2 * hB;
    const unsigned ldsw = (unsigned)wid * 1024u;
    const int aoff = lds_byte(wr * 64 + fr, fq * 8), boff = lds_byte(wc * 32 + fr, fq * 8);
#define PG8_SA(b, h) (((b) * 2 + (h)) * HTB)
#define PG8_SB(b, h) ((4 + (b) * 2 + (h)) * HTB)
#define PG8_STAGE(bufoff, gbase, voff) do { _Pragma("unroll") for (int _i = 0; _i < 2; ++_i) \
        __builtin_amdgcn_global_load_lds((const unsigned*)((const char*)(gbase) + (voff)[_i]), (PG8_LAS unsigned*)(lds + (bufoff) + ldsw + _i * 8192), 16, 0, 0); } while (0)
#define PG8_LDA(dst, b, h) do { _Pragma("unroll") for (int m = 0; m < 4; ++m) _Pragma("unroll") for (int k = 0; k < 2; ++k) dst[m][k] = *(const PG8_LAS bf16x8*)(lds + PG8_SA(b, h) + aoff + m * 2048 + k * 1024); } while (0)
#define PG8_LDB(dst, b, h) do { _Pragma("unroll") for (int n = 0; n < 2; ++n) _Pragma("unroll") for (int k = 0; k < 2; ++k) dst[n][k] = *(const PG8_LAS bf16x8*)(lds + PG8_SB(b, h) + boff + n * 2048 + k * 1024); } while (0)
#define PG8_MMA(ai, bj, At, Bt) do { __builtin_amdgcn_s_setprio(1); _Pragma("unroll") for (int m = 0; m < 4; ++m) _Pragma("unroll") for (int n = 0; n < 2; ++n) _Pragma("unroll") for (int k = 0; k < 2; ++k) \
        acc[ai][bj][m][n] = __builtin_amdgcn_mfma_f32_16x16x32_bf16(Bt[n][k], At[m][k], acc[ai][bj][m][n], 0, 0, 0); __builtin_amdgcn_s_setprio(0); } while (0)
#define PG8_WAIT_V(n) asm volatile("s_waitcnt vmcnt(" #n ")" ::: "memory")
#define PG8_WAIT_L(n) asm volatile("s_waitcnt lgkmcnt(" #n ")" ::: "memory")
#define PG8_BAR __builtin_amdgcn_s_barrier()
#define PG8_SCHED __builtin_amdgcn_sched_barrier(0)
    Unit cur, nxt; int ui = 0;
    if (!S.next(0, cur)) return;
    f32x4 acc[2][2][4][2];
#pragma unroll
    for (int a = 0; a < 2; ++a)
#pragma unroll
        for (int b = 0; b < 2; ++b)
#pragma unroll
            for (int m = 0; m < 4; ++m)
#pragma unroll
                for (int n = 0; n < 2; ++n) acc[a][b][m][n] = (f32x4){0.f, 0.f, 0.f, 0.f};
    bf16x8 At[4][2], B0[2][2], B1[2][2];
    const char* cA = (const char*)g.A + (size_t)cur.pm * tA; const char* cB = (const char*)g.Bt + (size_t)cur.pn * tB;
    S.a_ready(cur);
    if constexpr (SP2) {
        PG8_STAGE(PG8_SB(0, 0), cB, voffB); PG8_STAGE(PG8_SB(0, 1), cB + hB, voffB); PG8_STAGE(PG8_SA(0, 0), cA, voffA); PG8_STAGE(PG8_SA(0, 1), cA + hA, voffA);
        if (wr == 1) PG8_BAR;
        PG8_WAIT_V(2); PG8_BAR;
        PG8_STAGE(PG8_SB(1, 0), cB + kstep, voffB); PG8_STAGE(PG8_SA(1, 0), cA + kstep, voffA); PG8_STAGE(PG8_SB(1, 1), cB + hB + kstep, voffB);
        PG8_WAIT_V(6); PG8_BAR;
    } else {
        PG8_STAGE(PG8_SB(0, 0), cB, voffB); PG8_STAGE(PG8_SA(0, 0), cA, voffA); PG8_STAGE(PG8_SB(0, 1), cB + hB, voffB); PG8_STAGE(PG8_SA(0, 1), cA + hA, voffA);
        if (wr == 1) PG8_BAR;
        PG8_WAIT_V(4); PG8_BAR;
        PG8_STAGE(PG8_SB(1, 0), cB + kstep, voffB); PG8_STAGE(PG8_SA(1, 0), cA + kstep, voffA); PG8_STAGE(PG8_SB(1, 1), cB + hB + kstep, voffB);
        PG8_WAIT_V(6); PG8_BAR;
    }
    for (;;) {
        const bool has_next = S.next(ui + 1, nxt);
        const char* nA = has_next ? (const char*)g.A + (size_t)nxt.pm * tA : cA; const char* nB = has_next ? (const char*)g.Bt + (size_t)nxt.pn * tB : cB;
_Pragma("unroll 1")
        for (int t = 0; t < nt; t += 2) {
            const bool last = (t == nt - 2);
            const char* a1 = cA + (size_t)(t + 1) * kstep;
            const char* a2 = last ? nA : cA + (size_t)(t + 2) * kstep; const char* b2 = last ? nB : cB + (size_t)(t + 2) * kstep;
            const char* a3 = a2 + kstep; const char* b3 = b2 + kstep;
            if (last && has_next) S.a_ready(nxt);
            if constexpr (SP2) {
            PG8_LDB(B0, 0, 0); PG8_LDB(B1, 0, 1); PG8_SCHED; PG8_LDA(At, 0, 0); PG8_STAGE(PG8_SA(1, 1), a1 + hA, voffA);
            PG8_WAIT_V(8); PG8_WAIT_L(0); PG8_BAR; PG8_MMA(0, 0, At, B0); PG8_MMA(0, 1, At, B1); PG8_BAR; PG8_SCHED;
            PG8_LDA(At, 0, 1); PG8_STAGE(PG8_SB(0, 0), b2, voffB); PG8_STAGE(PG8_SB(0, 1), b2 + hB, voffB); PG8_STAGE(PG8_SA(0, 0), a2, voffA);
            PG8_WAIT_V(8); PG8_WAIT_L(0); PG8_BAR; PG8_MMA(1, 0, At, B0); PG8_MMA(1, 1, At, B1); PG8_BAR; PG8_SCHED;
            PG8_LDB(B0, 1, 0); PG8_LDB(B1, 1, 1); PG8_SCHED; PG8_LDA(At, 1, 0); PG8_STAGE(PG8_SA(0, 1), a2 + hA, voffA);
            PG8_WAIT_V(8); PG8_WAIT_L(0); PG8_BAR; PG8_MMA(0, 0, At, B0); PG8_MMA(0, 1, At, B1); PG8_BAR; PG8_SCHED;
            PG8_LDA(At, 1, 1); PG8_STAGE(PG8_SB(1, 0), b3, voffB); PG8_STAGE(PG8_SB(1, 1), b3 + hB, voffB); PG8_STAGE(PG8_SA(1, 0), a3, voffA);
            PG8_WAIT_V(8); PG8_WAIT_L(0); PG8_BAR; PG8_MMA(1, 0, At, B0); PG8_MMA(1, 1, At, B1); PG8_BAR; PG8_SCHED;
            } else {
            PG8_LDB(B0, 0, 0); PG8_SCHED; PG8_LDA(At, 0, 0); PG8_STAGE(PG8_SA(1, 1), a1 + hA, voffA);
            PG8_WAIT_L(8); PG8_BAR; PG8_WAIT_L(0); PG8_MMA(0, 0, At, B0); PG8_BAR; PG8_SCHED;
            PG8_LDB(B1, 0, 1); PG8_STAGE(PG8_SB(0, 0), b2, voffB);
            PG8_BAR; PG8_WAIT_L(0); PG8_MMA(0, 1, At, B1); PG8_BAR;
            PG8_LDA(At, 0, 1); PG8_STAGE(PG8_SA(0, 0), a2, voffA);
            PG8_BAR; PG8_WAIT_L(0); PG8_MMA(1, 0, At, B0); PG8_BAR; PG8_SCHED;
            PG8_STAGE(PG8_SB(0, 1), b2 + hB, voffB);
            PG8_WAIT_V(6); PG8_BAR; PG8_MMA(1, 1, At, B1); PG8_BAR;
            PG8_LDB(B0, 1, 0); PG8_SCHED; PG8_LDA(At, 1, 0); PG8_STAGE(PG8_SA(0, 1), a2 + hA, voffA);
            PG8_WAIT_L(8); PG8_BAR; PG8_WAIT_L(0); PG8_MMA(0, 0, At, B0); PG8_BAR; PG8_SCHED;
            PG8_LDB(B1, 1, 1); PG8_STAGE(PG8_SB(1, 0), b3, voffB);
            PG8_BAR; PG8_WAIT_L(0); PG8_MMA(0, 1, At, B1); PG8_BAR;
            PG8_LDA(At, 1, 1); PG8_STAGE(PG8_SA(1, 0), a3, voffA);
            PG8_BAR; PG8_WAIT_L(0); PG8_MMA(1, 0, At, B0); PG8_BAR; PG8_SCHED;
            PG8_STAGE(PG8_SB(1, 1), b3 + hB, voffB);
            PG8_WAIT_V(6); PG8_BAR; PG8_MMA(1, 1, At, B1); PG8_BAR;
            }
        }
        if constexpr (ALIGN_EPI) { if (wr == 0) PG8_BAR; }
        if constexpr (!Epi::AFTER_DRAIN) { E(acc, cur, wr, wc, fr, fq); S.done(cur); }
        if (!has_next) break;
#pragma unroll
        for (int a = 0; a < 2; ++a)
#pragma unroll
            for (int b = 0; b < 2; ++b)
#pragma unroll
                for (int m = 0; m < 4; ++m)
#pragma unroll
                    for (int n = 0; n < 2; ++n) acc[a][b][m][n] = (f32x4){0.f, 0.f, 0.f, 0.f};
        cur = nxt; cA = nA; cB = nB; ++ui;
        if constexpr (ALIGN_EPI) { if (wr == 1) PG8_BAR; }
    }
    PG8_WAIT_V(0);
    if constexpr (!ALIGN_EPI) { if (wr == 0) PG8_BAR; }
    PG8_BAR;
    if constexpr (Epi::AFTER_DRAIN) { E.fused(acc, cur, wr, wc, fr, fq, lds, wid, lane); S.done(cur); }
#undef PG8_SA
#undef PG8_SB
#undef PG8_STAGE
#undef PG8_LDA
#undef PG8_LDB
#undef PG8_MMA
#undef PG8_WAIT_V
#undef PG8_WAIT_L
#undef PG8_BAR
#undef PG8_SCHED
}
}

DI void rope_pair8(float (&x1)[8], float (&x2)[8], const f32x2* cs) {
#pragma unroll
  for (int j = 0; j < 8; ++j) { const f32x2 c = cs[j]; const float a = x1[j], b = x2[j]; x1[j] = a * c.x - b * c.y; x2[j] = a * c.y + b * c.x; }
}
typedef pg8::Unit Unit;
#define ACC_T const f32x4 (&acc)[2][2][4][2]
#define EROW(u, ai, m) ((u).pm * 256 + (ai) * 128 + wr * 64 + (m) * 16 + fr)
DI u32x4 pack_f8(const f32x4 a, const f32x4 b) { u32x4 w; w.x = pk2(a[0], a[1]); w.y = pk2(a[2], a[3]); w.z = pk2(b[0], b[1]); w.w = pk2(b[2], b[3]); return w; }

struct EpiInproj {
  static constexpr bool PERM = true, AFTER_DRAIN = false;
  bf16_t* Z; bf16_t* VCT; bf16_t* VBT; float* ssq_q; float* ssq_kv;
  DI void operator()(ACC_T, const Unit& u, int wr, int wc, int fr, int fq) const {
#pragma unroll
    for (int bj = 0; bj < 2; ++bj) {
      const int tt = 2 * u.pn + bj, cb = tt * 128 + wc * 32 + 8 * fq;
      int sh = 0; if (tt >= 6 && tt < 42) sh = 2 * (((tt - 6) >> 2) % 3);
      const int msk = (1 << sh) - 1;
      if (tt >= 38 && tt < 42) {
        bf16_t* vt = VBT + (size_t)(cb - GC_VB) * S + fr * (S >> 4) + u.pm * 16 + wr * 4;
#pragma unroll
        for (int ai = 0; ai < 2; ++ai)
#pragma unroll
          for (int n = 0; n < 2; ++n) {
            __builtin_amdgcn_sched_barrier(0);
#pragma unroll
            for (int e = 0; e < 4; ++e) {
              u32x2 w; w.x = pk2(acc[ai][bj][0][n][e], acc[ai][bj][1][n][e]); w.y = pk2(acc[ai][bj][2][n][e], acc[ai][bj][3][n][e]);
              *(u32x2*)(vt + (size_t)(4 * n + e) * S + ai * 8) = w;
            }
          }
      } else if (tt == 47 || (tt >= 30 && tt < 38)) {
        bf16_t* vt = (tt == 47) ? VCT + (size_t)(cb - GC_VC) * S : VBT + (size_t)(cb - GC_VB) * S;
#pragma unroll
        for (int ai = 0; ai < 2; ++ai)
#pragma unroll
          for (int m = 0; m < 4; ++m) {
            __builtin_amdgcn_sched_barrier(0);
            const int row = EROW(u, ai, m), prow = (row & msk) * (S >> sh) + (row >> sh);
            bf16_t* vp = vt + prow;
#pragma unroll
            for (int n = 0; n < 2; ++n)
#pragma unroll
              for (int e = 0; e < 4; ++e) vp[(size_t)(4 * n + e) * S] = f2bf(acc[ai][bj][m][n][e]);
          }
      } else {
        const int zc = cb < GC_VB ? cb : cb - 1536;
        float* ssq = (tt < 3) ? ssq_q : ((tt < 5) ? ssq_kv : nullptr);
#pragma unroll
        for (int ai = 0; ai < 2; ++ai)
#pragma unroll
          for (int m = 0; m < 4; ++m) {
            const int row = EROW(u, ai, m), prow = (row & msk) * (S >> sh) + (row >> sh);
            const f32x4 v0 = acc[ai][bj][m][0], v1 = acc[ai][bj][m][1];
            *(u32x4*)(Z + (size_t)prow * ZP + zc) = pack_f8(v0, v1);
            if (ssq) {
              float s = v0[0] * v0[0] + v0[1] * v0[1] + v0[2] * v0[2] + v0[3] * v0[3] + v1[0] * v1[0] + v1[1] * v1[1] + v1[2] * v1[2] + v1[3] * v1[3];
              s += __shfl_xor(s, 16); s += __shfl_xor(s, 32);
              if (fq == 0) __hip_atomic_fetch_add(ssq + row, s, __ATOMIC_RELAXED, __HIP_MEMORY_SCOPE_AGENT);
            }
          }
      }
    }
  }
};
struct EpiUpQ {
  static constexpr bool PERM = true, AFTER_DRAIN = false;
  bf16_t* QA; const float* ssq;
  DI void operator()(ACC_T, const Unit& u, int wr, int wc, int fr, int fq) const {
#pragma unroll
    for (int ai = 0; ai < 2; ++ai)
#pragma unroll
      for (int m = 0; m < 4; ++m) {
        const int row = EROW(u, ai, m); const float rs = rsqrtf(ssq[row] * (1.0f / 384.0f) + 1e-6f);
#pragma unroll
        for (int bj = 0; bj < 2; ++bj) {
          const int cb = u.pn * 256 + bj * 128 + wc * 32 + 8 * fq;
          *(u32x4*)(QA + (size_t)row * 768 + cb) = pack_f8(acc[ai][bj][m][0] * rs, acc[ai][bj][m][1] * rs);
        }
      }
  }
};
struct EpiUpKV {
  static constexpr bool PERM = true, AFTER_DRAIN = false;
  bf16_t* KA; bf16_t* VAT; const float* ssq;
  DI void operator()(ACC_T, const Unit& u, int wr, int wc, int fr, int fq) const {
#pragma unroll
    for (int ai = 0; ai < 2; ++ai)
#pragma unroll
      for (int m = 0; m < 4; ++m) {
        __builtin_amdgcn_sched_barrier(0);
        const int row = EROW(u, ai, m); const float rs = rsqrtf(ssq[row] * (1.0f / 256.0f) + 1e-6f);
#pragma unroll
        for (int bj = 0; bj < 2; ++bj) {
          const int head = 2 * u.pn + bj, w0 = wc * 32 + 8 * fq;
          if (wc < 2) {
            *(u32x4*)(KA + (size_t)row * 512 + head * 64 + w0) = pack_f8(acc[ai][bj][m][0] * rs, acc[ai][bj][m][1] * rs);
          } else {
            bf16_t* vp = VAT + (size_t)(head * 64 + w0 - 64) * S + row;
#pragma unroll
            for (int n = 0; n < 2; ++n)
#pragma unroll
              for (int e = 0; e < 4; ++e) vp[(size_t)(4 * n + e) * S] = f2bf(acc[ai][bj][m][n][e] * rs);
          }
        }
      }
  }
};
struct EpiMerge {
  static constexpr bool PERM = true, AFTER_DRAIN = false;
  const bf16_t* Z; bf16_t* MIX;
  DI void operator()(ACC_T, const Unit& u, int wr, int wc, int fr, int fq) const {
    const int b = u.pm >> 6, pm = u.pm & 63, pn = u.pn & 3;
#pragma unroll
    for (int ai = 0; ai < 2; ++ai)
#pragma unroll
      for (int m = 0; m < 4; ++m) {
        const int row = pm * 256 + ai * 128 + wr * 64 + m * 16 + fr;
#pragma unroll
        for (int bj = 0; bj < 2; ++bj) {
          const int col = pn * 256 + bj * 128 + wc * 32 + 8 * fq;
          const u32x4 g = *(const u32x4*)(Z + (size_t)row * ZP + ZC_GATE + b * 1024 + col);
          f32x4 v0 = acc[ai][bj][m][0], v1 = acc[ai][bj][m][1];
#pragma unroll
          for (int q = 0; q < 2; ++q) {
            v0[2 * q] *= 1.0f / (1.0f + __expf(-bflo(g[q]))); v0[2 * q + 1] *= 1.0f / (1.0f + __expf(-bfhi(g[q])));
            v1[2 * q] *= 1.0f / (1.0f + __expf(-bflo(g[2 + q]))); v1[2 * q + 1] *= 1.0f / (1.0f + __expf(-bfhi(g[2 + q])));
          }
          bf16_t* mp = MIX + (size_t)row * DM + col;
          if (b > 0) { const u32x4 o = *(const u32x4*)mp;
#pragma unroll
            for (int q = 0; q < 2; ++q) { v0[2 * q] += bflo(o[q]); v0[2 * q + 1] += bfhi(o[q]); v1[2 * q] += bflo(o[2 + q]); v1[2 * q + 1] += bfhi(o[2 + q]); } }
          *(u32x4*)mp = pack_f8(v0, v1);
        }
      }
  }
};
template <bool NORM_OUT> struct EpiResid {
  static constexpr bool PERM = false, AFTER_DRAIN = false;
  const float* xs; float* xd; bf16_t* xb; float* ssq;
  DI void operator()(ACC_T, const Unit& u, int wr, int wc, int fr, int fq) const {
#pragma unroll
    for (int ai = 0; ai < 2; ++ai)
#pragma unroll
      for (int m = 0; m < 4; ++m) {
        const int row = EROW(u, ai, m);
        const size_t ro = (size_t)row * DM + u.pn * 256 + wc * 32 + 4 * fq;
        float ss = 0.f;
#pragma unroll
        for (int bj = 0; bj < 2; ++bj)
#pragma unroll
          for (int n = 0; n < 2; ++n) {
            const size_t o = ro + bj * 128 + n * 16; const f32x4 x = *(const f32x4*)(xs + o) + acc[ai][bj][m][n]; *(f32x4*)(xd + o) = x;
            if (NORM_OUT) { u32x2 w; w.x = pk2(x[0], x[1]); w.y = pk2(x[2], x[3]); *(u32x2*)(xb + o) = w; ss += x[0] * x[0] + x[1] * x[1] + x[2] * x[2] + x[3] * x[3]; }
          }
        if (NORM_OUT) { ss += __shfl_xor(ss, 16); ss += __shfl_xor(ss, 32); if (fq == 0) __hip_atomic_fetch_add(ssq + row, ss, __ATOMIC_RELAXED, __HIP_MEMORY_SCOPE_AGENT); }
      }
  }
};
struct EpiRelu2 {
  static constexpr bool PERM = true, AFTER_DRAIN = false;
  bf16_t* HID; const float* ssq;
  DI void operator()(ACC_T, const Unit& u, int wr, int wc, int fr, int fq) const {
#pragma unroll
    for (int ai = 0; ai < 2; ++ai)
#pragma unroll
      for (int m = 0; m < 4; ++m) {
        const int row = EROW(u, ai, m); const float rs = rsqrtf(ssq[row] * (1.0f / DM) + 1e-6f);
#pragma unroll
        for (int bj = 0; bj < 2; ++bj) {
          f32x4 v0 = acc[ai][bj][m][0], v1 = acc[ai][bj][m][1];
#pragma unroll
          for (int e = 0; e < 4; ++e) { const float a = fmaxf(v0[e], 0.f) * rs, c = fmaxf(v1[e], 0.f) * rs; v0[e] = a * a; v1[e] = c * c; }
          *(u32x4*)(HID + (size_t)row * DFF + u.pn * 256 + bj * 128 + wc * 32 + 8 * fq) = pack_f8(v0, v1);
        }
      }
  }
};
struct DiagOrder {
  pg8::StaticOrder so; int G, c;
  DI void init(int G_, int c_) { so.init(S, 1024, G_, c_); G = G_; c = c_; }
  DI bool next(int i, Unit& u) const { const int tile = (i / 3) * G + c, b = i % 3; if (tile >= 256) return false; so.map(tile, u); u.pm += 64 * b; u.pn += 4 * b; return true; }
  DI void a_ready(const Unit&) const {}
  DI void done(const Unit&) const {}
};
#define GEMM_LDS ((PG8_LAS unsigned char*)smem)

DI void phase_kpost(const Params& p, int layer) {
  bf16_t* Z = (bf16_t*)(p.ws + OFF_Z);
  const f32x2* CS = (const f32x2*)(p.ws + OFF_CS);
  for (int it = (int)gridDim.x - 1 - (int)blockIdx.x; it < 96; it += gridDim.x) {
      const int tid = otid();
      const int idx = it * 512 + tid;
      const int unit = idx / S, tkn = idx % S;
      if (unit < 2) {
        bf16_t* kp = Z + (size_t)tkn * ZP + ZC_KC + unit * 64;
        float x[8][8]; float ss = 0.f;
#pragma unroll
        for (int c = 0; c < 8; ++c) { const u32x4 v = *(const u32x4*)(kp + c * 8);
#pragma unroll
          for (int q = 0; q < 4; ++q) { x[c][2 * q] = bflo(v[q]); x[c][2 * q + 1] = bfhi(v[q]); ss += x[c][2 * q] * x[c][2 * q] + x[c][2 * q + 1] * x[c][2 * q + 1]; } }
        const float rs = rsqrtf(ss * (1.0f / 64.0f) + 1e-6f);
        const float* gk = p.c_k_norm + layer * 64;
#pragma unroll
        for (int c = 0; c < 8; ++c)
#pragma unroll
          for (int q = 0; q < 8; ++q) x[c][q] *= rs * gk[c * 8 + q];
        const f32x2* cr = CS + (size_t)(tkn >> 6) * 16; const f32x2* cc = CS + (size_t)(tkn & 63) * 16;
        rope_pair8(x[0], x[2], cr); rope_pair8(x[1], x[3], cr + 8);
        rope_pair8(x[4], x[6], cc); rope_pair8(x[5], x[7], cc + 8);
#pragma unroll
        for (int c = 0; c < 8; ++c) { u32x4 w; w.x = pk2(x[c][0], x[c][1]); w.y = pk2(x[c][2], x[c][3]); w.z = pk2(x[c][4], x[c][5]); w.w = pk2(x[c][6], x[c][7]); *(u32x4*)(kp + c * 8) = w; }
      } else {
        bf16_t* kp = Z + (size_t)tkn * ZP + ZC_KR;
        float x[4][8];
#pragma unroll
        for (int c = 0; c < 4; ++c) { const u32x4 v = *(const u32x4*)(kp + c * 8);
#pragma unroll
          for (int q = 0; q < 4; ++q) { x[c][2 * q] = bflo(v[q]); x[c][2 * q + 1] = bfhi(v[q]); } }
        const f32x2* cp = CS + (size_t)tkn * 16;
        rope_pair8(x[0], x[2], cp); rope_pair8(x[1], x[3], cp + 8);
#pragma unroll
        for (int c = 0; c < 4; ++c) { u32x4 w; w.x = pk2(x[c][0], x[c][1]); w.y = pk2(x[c][2], x[c][3]); w.z = pk2(x[c][4], x[c][5]); w.w = pk2(x[c][6], x[c][7]); *(u32x4*)(kp + c * 8) = w; }
      }
  }
}

DI bf16x8 pack8(float a0, float a1, float a2, float a3, float a4, float a5, float a6, float a7) {
  u32x4 w; w.x = pk2(a0, a1); w.y = pk2(a2, a3); w.z = pk2(a4, a5); w.w = pk2(a6, a7); return __builtin_bit_cast(bf16x8, w);
}
DI void unpack8(const u32x4 v, float (&x)[8]) {
#pragma unroll
  for (int q = 0; q < 4; ++q) { x[2 * q] = bflo(v[q]); x[2 * q + 1] = bfhi(v[q]); }
}

constexpr int ATT_STAGE = 20480;

template <int TYPE>
DI void attn_dense_unit(const Params& p, int layer, int head, int qb, char* lds) {
  constexpr int NQK = TYPE == 0 ? 6 : 4;
  const int tid = otid(), lane = tid & 63, wid = wave_of(tid), r = lane & 31, h = lane >> 5;
  const bf16_t* Z = (const bf16_t*)(p.ws + OFF_Z);
  const f32x2* CS = (const f32x2*)(p.ws + OFF_CS);
  const bf16_t* Kn; int ldk; const bf16_t* VT; bf16_t* O;
  if (TYPE == 0) { Kn = (const bf16_t*)(p.ws + OFF_KA) + head * 64; ldk = 512; VT = (const bf16_t*)(p.ws + OFF_VAT) + (size_t)head * 64 * S; O = (bf16_t*)(p.ws + OFF_OA); }
  else { const int kvh = head >> 2; Kn = Z + ZC_KC + kvh * 64; ldk = ZP; VT = (const bf16_t*)(p.ws + OFF_VCT) + (size_t)kvh * 64 * S; O = (bf16_t*)(p.ws + OFF_OC); }
  const int q = qb * 256 + wid * 32 + r;
  bf16x8 qf[NQK];
  if (TYPE == 0) {
    const bf16_t* qp = (const bf16_t*)(p.ws + OFF_QA) + (size_t)q * 768 + head * 96 + 8 * h;
    float x[6][8];
#pragma unroll
    for (int d0 = 0; d0 < 6; ++d0) unpack8(*(const u32x4*)(qp + d0 * 16), x[d0]);
    rope_pair8(x[4], x[5], CS + (size_t)q * 16 + 8 * h);
    const float sc = 0.10206207261596577f * LOG2E;
#pragma unroll
    for (int d0 = 0; d0 < 6; ++d0) qf[d0] = pack8(x[d0][0] * sc, x[d0][1] * sc, x[d0][2] * sc, x[d0][3] * sc, x[d0][4] * sc, x[d0][5] * sc, x[d0][6] * sc, x[d0][7] * sc);
  } else {
    const bf16_t* qp = Z + (size_t)q * ZP + ZC_QC + head * 64 + 8 * h;
    float x[4][8]; float ss = 0.f;
#pragma unroll
    for (int d0 = 0; d0 < 4; ++d0) { unpack8(*(const u32x4*)(qp + d0 * 16), x[d0]);
#pragma unroll
      for (int j = 0; j < 8; ++j) ss += x[d0][j] * x[d0][j]; }
    ss += __shfl_xor(ss, 32);
    const float rs = rsqrtf(ss * (1.0f / 64.0f) + 1e-6f);
    const float* gq = p.c_q_norm + layer * 64;
#pragma unroll
    for (int d0 = 0; d0 < 4; ++d0)
#pragma unroll
      for (int j = 0; j < 8; ++j) x[d0][j] *= rs * gq[d0 * 16 + 8 * h + j];
    rope_pair8(x[0], x[1], CS + (size_t)(q >> 6) * 16 + 8 * h);
    rope_pair8(x[2], x[3], CS + (size_t)(q & 63) * 16 + 8 * h);
    const float sc = 0.125f * LOG2E;
#pragma unroll
    for (int d0 = 0; d0 < 4; ++d0) qf[d0] = pack8(x[d0][0] * sc, x[d0][1] * sc, x[d0][2] * sc, x[d0][3] * sc, x[d0][4] * sc, x[d0][5] * sc, x[d0][6] * sc, x[d0][7] * sc);
  }
  typedef __attribute__((address_space(3))) unsigned lds_u32;
  const int srow = tid >> 3, sch = (tid & 7) ^ ((srow >> 1) & 7);
  const bf16_t* gk = Kn + (size_t)srow * ldk + sch * 8;
  const bf16_t* gv = VT + (size_t)srow * S + sch * 8;
  const int rrow = tid >> 2, rch = (tid & 3) ^ ((rrow >> 2) & 3);
  const bf16_t* gr = Z + ZC_KR + (size_t)rrow * ZP + rch * 8;
  char* wbase = lds + wid * 1024;
#define DMA(t, soff) do { \
    __builtin_amdgcn_global_load_lds((const unsigned*)(gk + (size_t)(t) * 64 * ldk), (lds_u32*)(wbase + (soff)), 16, 0, 0); \
    __builtin_amdgcn_global_load_lds((const unsigned*)(gv + (size_t)(t) * 64), (lds_u32*)(wbase + (soff) + 8192), 16, 0, 0); \
    if (TYPE == 0 && wid < 4) __builtin_amdgcn_global_load_lds((const unsigned*)(gr + (size_t)(t) * 64 * ZP), (lds_u32*)(wbase + (soff) + 16384), 16, 0, 0); } while (0)
#define DMA_WAIT(keep) do { if (keep) { if (TYPE == 0 && wid < 4) asm volatile("s_waitcnt vmcnt(3)" ::: "memory"); else asm volatile("s_waitcnt vmcnt(2)" ::: "memory"); } \
    else asm volatile("s_waitcnt vmcnt(0)" ::: "memory"); } while (0)
#define BAR() do { asm volatile("s_waitcnt lgkmcnt(0)" ::: "memory"); __builtin_amdgcn_s_barrier(); asm volatile("" ::: "memory"); } while (0)
  constexpr int NONES = (TYPE == 0) ? 0 : 2;
  float m_run = 0.f, lsum = 0.f; f32x16 o0, o1, negm, la;
#pragma unroll
  for (int i = 0; i < 16; ++i) { o0[i] = 0.f; o1[i] = 0.f; negm[i] = 0.f; la[i] = 0.f; }
  const bf16x8 ones = {0x3F80, 0x3F80, 0x3F80, 0x3F80, 0x3F80, 0x3F80, 0x3F80, 0x3F80};
  const int rK = (r & ~12) | ((r & 4) << 1) | ((r & 8) >> 1);
  const int ksw = (rK >> 1) & 7, rsw = (rK >> 2) & 3, vsw = (r >> 1) & 7;
  int koff[4], roff[2], voff[4];
#pragma unroll
  for (int d0 = 0; d0 < 4; ++d0) { koff[d0] = rK * 128 + (((2 * d0 + h) ^ ksw) << 4); voff[d0] = 8192 + r * 128 + (((2 * d0 + h) ^ vsw) << 4); }
#pragma unroll
  for (int d0 = 0; d0 < 2; ++d0) roff[d0] = 16384 + rK * 64 + (((2 * d0 + h) ^ rsw) << 4);
  constexpr int NT = S / 64;
  constexpr float THR = 8.0f;
#define SB() __builtin_amdgcn_sched_barrier(0)
#define QKR(d0, K0, K1, SOFF) do { if ((d0) < 4) { K0 = *(const bf16x8*)(lds + (SOFF) + koff[(d0) & 3]); K1 = *(const bf16x8*)(lds + (SOFF) + 32 * 128 + koff[(d0) & 3]); } \
    else if ((d0) < NQK) { K0 = *(const bf16x8*)(lds + (SOFF) + roff[(d0) & 1]); K1 = *(const bf16x8*)(lds + (SOFF) + 32 * 64 + roff[(d0) & 1]); } } while (0)
#define QKM(N0, N1, d0, K0, K1) do { if ((d0) == 0) { N0 = MFMA(K0, qf[0], negm); N1 = MFMA(K1, qf[0], negm); } \
    else if ((d0) < NQK) { N0 = MFMA(K0, qf[(d0) < NQK ? (d0) : 0], N0); N1 = MFMA(K1, qf[(d0) < NQK ? (d0) : 0], N1); } } while (0)
#define EX4(CC, B, SI) do { __builtin_amdgcn_s_setprio(1); _Pragma("unroll") for (int i_ = 0; i_ < 4; ++i_) { CC[(B) + i_] = fexp2(CC[(B) + i_]); if ((SI) >= NONES) lsum += CC[(B) + i_]; } __builtin_amdgcn_s_setprio(0); } while (0)
#define PK8(PF, CC, B) do { PF = pack8(CC[(B)], CC[(B) + 1], CC[(B) + 2], CC[(B) + 3], CC[(B) + 4], CC[(B) + 5], CC[(B) + 6], CC[(B) + 7]); } while (0)
#define VR(s_, V0, V1, SOFF) do { V0 = *(const bf16x8*)(lds + (SOFF) + voff[s_]); V1 = *(const bf16x8*)(lds + (SOFF) + 32 * 128 + voff[s_]); } while (0)
#define PVM(s_, V0, V1) do { o0 = MFMA(V0, pf[s_], o0); o1 = MFMA(V1, pf[s_], o1); if ((s_) < NONES) la = MFMA(ones, pf[s_], la); } while (0)
#define MAXG(NN, B) do { ma_ = fmaxf(fmaxf(ma_, NN[(B)]), NN[(B) + 1]); mb_ = fmaxf(fmaxf(mb_, NN[(B) + 2]), NN[(B) + 3]); \
    ma_ = fmaxf(fmaxf(ma_, NN[(B) + 4]), NN[(B) + 5]); mb_ = fmaxf(fmaxf(mb_, NN[(B) + 6]), NN[(B) + 7]); } while (0)
#define ROWMAX(P0, P1, MX) do { float a_ = fmaxf(fmaxf(P0[0], P0[1]), P1[0]), c_ = fmaxf(fmaxf(P0[2], P0[3]), P1[1]); a_ = fmaxf(fmaxf(a_, P1[2]), P1[3]); \
    _Pragma("unroll") for (int i_ = 4; i_ < 16; i_ += 4) { a_ = fmaxf(fmaxf(a_, P0[i_]), P0[i_ + 1]); c_ = fmaxf(fmaxf(c_, P0[i_ + 2]), P0[i_ + 3]); a_ = fmaxf(fmaxf(a_, P1[i_]), P1[i_ + 1]); c_ = fmaxf(fmaxf(c_, P1[i_ + 2]), P1[i_ + 3]); } \
    a_ = fmaxf(a_, c_); MX = fmaxf(a_, __shfl_xor(a_, 32)); } while (0)
#define RESCALE(P0, P1, DELTA) do { const float dl_ = (DELTA); m_run += dl_; const float al_ = fexp2(-dl_); lsum *= al_; \
    _Pragma("unroll") for (int i_ = 0; i_ < 16; ++i_) { P0[i_] -= dl_; P1[i_] -= dl_; o0[i_] *= al_; o1[i_] *= al_; if (NONES > 0) la[i_] *= al_; negm[i_] = -m_run; } } while (0)
#define STEP(C0, C1, N0, N1, T, HAS_NEXT, HAS_LOAD, S0, S1, S3) do { \
    if (HAS_LOAD) DMA((T) + 3, S3); \
    bf16x8 pf[4]; bf16x8 ka0, ka1, kb0, kb1, va0, va1, vb0, vb1; \
    if (HAS_NEXT) QKR(0, ka0, ka1, S1); \
    SB(); if (HAS_NEXT) { QKR(1, kb0, kb1, S1); QKM(N0, N1, 0, ka0, ka1); } EX4(C0, 0, 0); \
    SB(); if (HAS_NEXT) { QKR(2, ka0, ka1, S1); QKM(N0, N1, 1, kb0, kb1); } EX4(C0, 4, 0); PK8(pf[0], C0, 0); \
    SB(); if (HAS_NEXT) { QKR(3, kb0, kb1, S1); QKM(N0, N1, 2, ka0, ka1); } EX4(C0, 8, 1); \
    SB(); if (HAS_NEXT) { QKR(4, ka0, ka1, S1); QKM(N0, N1, 3, kb0, kb1); } EX4(C0, 12, 1); PK8(pf[1], C0, 8); if (NQK == 4) VR(0, va0, va1, S0); \
    if (NQK > 4) { \
      SB(); if (HAS_NEXT) { QKR(5, kb0, kb1, S1); QKM(N0, N1, 4, ka0, ka1); } EX4(C1, 0, 2); \
      SB(); if (HAS_NEXT) QKM(N0, N1, 5, kb0, kb1); EX4(C1, 4, 2); PK8(pf[2], C1, 0); VR(0, va0, va1, S0); } \
    float ma_ = -1e30f, mb_ = -1e30f; \
    if (NQK == 4) { \
      SB(); VR(1, vb0, vb1, S0); PVM(0, va0, va1); EX4(C1, 0, 2); EX4(C1, 4, 2); PK8(pf[2], C1, 0); \
      SB(); VR(2, va0, va1, S0); PVM(1, vb0, vb1); EX4(C1, 8, 3); EX4(C1, 12, 3); PK8(pf[3], C1, 8); \
    } else { \
      SB(); VR(1, vb0, vb1, S0); PVM(0, va0, va1); EX4(C1, 8, 3); \
      SB(); VR(2, va0, va1, S0); PVM(1, vb0, vb1); EX4(C1, 12, 3); PK8(pf[3], C1, 8); } \
    SB(); VR(3, vb0, vb1, S0); PVM(2, va0, va1); if (HAS_NEXT) { MAXG(N0, 0); MAXG(N0, 8); } \
    SB(); PVM(3, vb0, vb1); if (HAS_NEXT) { MAXG(N1, 0); MAXG(N1, 8); } \
    SB(); \
    float mx_ = fmaxf(ma_, mb_); { const auto rr_ = __builtin_amdgcn_permlane32_swap(__float_as_uint(mx_), __float_as_uint(mx_), false, false); mx_ = fmaxf(__uint_as_float(rr_[0]), __uint_as_float(rr_[1])); } \
    DMA_WAIT(HAS_LOAD); BAR(); \
    if (HAS_NEXT) { if (__any(mx_ > THR)) RESCALE(N0, N1, fmaxf(mx_, 0.f)); } } while (0)
  constexpr int R0 = 0, R1 = ATT_STAGE, R2 = 2 * ATT_STAGE, R3 = 3 * ATT_STAGE;
  f32x16 sA0, sA1, sB0, sB1;
  DMA(0, R0); DMA(1, R1); DMA(2, R2); DMA_WAIT(true); BAR();
  { bf16x8 ka0, ka1;
#pragma unroll
    for (int d0 = 0; d0 < NQK; ++d0) { QKR(d0, ka0, ka1, R0); QKM(sA0, sA1, d0, ka0, ka1); } }
  { float mx0; ROWMAX(sA0, sA1, mx0); m_run = mx0;
#pragma unroll
    for (int i = 0; i < 16; ++i) { sA0[i] -= mx0; sA1[i] -= mx0; negm[i] = -mx0; } }
  for (int t = 0; t < NT - 4; t += 4) {
    STEP(sA0, sA1, sB0, sB1, t, true, true, R0, R1, R3);
    STEP(sB0, sB1, sA0, sA1, t + 1, true, true, R1, R2, R0);
    STEP(sA0, sA1, sB0, sB1, t + 2, true, true, R2, R3, R1);
    STEP(sB0, sB1, sA0, sA1, t + 3, true, true, R3, R0, R2);
  }
  STEP(sA0, sA1, sB0, sB1, NT - 4, true, true, R0, R1, R3);
  STEP(sB0, sB1, sA0, sA1, NT - 3, true, false, R1, R2, R0);
  STEP(sA0, sA1, sB0, sB1, NT - 2, true, false, R2, R3, R1);
  STEP(sB0, sB1, sA0, sA1, NT - 1, false, false, R3, R0, R2);
  const float l = (NONES > 0 ? la[0] : 0.f) + lsum + __shfl_xor(lsum, 32);
#undef DMA
#undef DMA_WAIT
#undef BAR
#undef SB
#undef QKR
#undef QKM
#undef EX4
#undef PK8
#undef VR
#undef PVM
#undef MAXG
#undef ROWMAX
#undef RESCALE
#undef STEP
  const float inv = 1.0f / l;
  bf16_t* op = O + (size_t)q * 512 + head * 64 + 4 * h;
#pragma unroll
  for (int g = 0; g < 4; ++g) {
    u32x2 w; w.x = pk2(o0[4 * g] * inv, o0[4 * g + 1] * inv); w.y = pk2(o0[4 * g + 2] * inv, o0[4 * g + 3] * inv);
    *(u32x2*)(op + 8 * g) = w;
    u32x2 w1; w1.x = pk2(o1[4 * g] * inv, o1[4 * g + 1] * inv); w1.y = pk2(o1[4 * g + 2] * inv, o1[4 * g + 3] * inv);
    *(u32x2*)(op + 32 + 8 * g) = w1;
  }
}

constexpr int BLV = 49152;
DI void b_issue_k(const Params& p, int x, char* lds, int tid, int wid) {
  typedef __attribute__((address_space(3))) unsigned lds_u32;
  const int g = x >> 9, head = (x >> 6) & 7, blk256 = x & 63;
  const int sh = 2 * g, Ls = S >> sh, P0 = blk256 * 256, sub = P0 / Ls, i0 = P0 & (Ls - 1), sub0 = sub * Ls;
  const bf16_t* Zk = (const bf16_t*)(p.ws + OFF_Z) + ZC_QKVB + ((1 * 3 + g) * 8 + head) * 64;
#pragma unroll
  for (int i = 0; i < 6; ++i) {
    const int sl = i * 512 + tid, row = sl >> 3, c = (sl & 7) ^ ((row >> 1) & 7); int key = i0 - 64 + row; key = key < 0 ? 0 : (key > Ls - 1 ? Ls - 1 : key);
    __builtin_amdgcn_global_load_lds((const unsigned*)(Zk + (size_t)(sub0 + key) * ZP + c * 8), (lds_u32*)(lds + (i * 512 + wid * 64) * 16), 16, 0, 0);
  }
}
DI void b_issue_v(const Params& p, int x, char* lds, int tid, int wid) {
  typedef __attribute__((address_space(3))) unsigned lds_u32;
  const int g = x >> 9, head = (x >> 6) & 7, blk256 = x & 63;
  const int sh = 2 * g, Ls = S >> sh, P0 = blk256 * 256, sub = P0 / Ls, i0 = P0 & (Ls - 1), sub0 = sub * Ls;
  const bf16_t* VTg = (const bf16_t*)(p.ws + OFF_VBT) + (size_t)((g * 8 + head) * 64) * S + sub0;
#pragma unroll
  for (int i = 0; i < 6; ++i) {
    const int sl = i * 512 + tid, d = sl / 48, c = (sl - d * 48) ^ (d & 15); int k0 = i0 - 64 + 8 * c; k0 = k0 < 0 ? 0 : (k0 > Ls - 8 ? Ls - 8 : k0);
    __builtin_amdgcn_global_load_lds((const unsigned*)(VTg + (size_t)d * S + k0), (lds_u32*)(lds + BLV + (i * 512 + wid * 64) * 16), 16, 0, 0);
  }
}
DI void attn_b_item(const Params& p, int x, int xnext, char* lds) {
  const int tid = otid(), lane = tid & 63, wid = wave_of(tid), r = lane & 31, h = lane >> 5;
  const int g = x >> 9, head = (x >> 6) & 7, blk256 = x & 63;
  const bf16_t* Z = (const bf16_t*)(p.ws + OFF_Z);
  const int sh = 2 * g, Ls = S >> sh, P0 = blk256 * 256, sub = P0 / Ls, i0 = P0 & (Ls - 1);
  const bf16_t* Zq = Z + ZC_QKVB + ((0 * 3 + g) * 8 + head) * 64;
  constexpr int LV = BLV;
  const int i0w = i0 + 32 * wid;
  const float* BT = (const float*)(p.ws + OFF_BT) + (g * 8 + head) * 256 + 32 - r + 8 * h;
  const int rK = (r & ~12) | ((r & 4) << 1) | ((r & 8) >> 1);
  bf16x8 qf[4];
  {
    const bf16_t* qp = Zq + (size_t)(P0 + 32 * wid + r) * ZP + 8 * h; const float scq = 0.125f * LOG2E;
#pragma unroll
    for (int d0 = 0; d0 < 4; ++d0) { float x8[8]; unpack8(*(const u32x4*)(qp + d0 * 16), x8); qf[d0] = pack8(x8[0] * scq, x8[1] * scq, x8[2] * scq, x8[3] * scq, x8[4] * scq, x8[5] * scq, x8[6] * scq, x8[7] * scq); }
  }
  float bvs[5][16];
#pragma unroll
  for (int c = 0; c < 5; ++c)
#pragma unroll
    for (int i = 0; i < 16; ++i) bvs[c][i] = BT[32 * c + (i & 3) + 4 * ((i >> 2) & 1) + 16 * (i >> 3)];
  asm volatile("s_waitcnt vmcnt(0)" ::: "memory"); __builtin_amdgcn_s_barrier(); asm volatile("" ::: "memory");
#pragma unroll
  for (int c = 0; c < 5; ++c)
#pragma unroll
    for (int i = 0; i < 16; ++i) asm volatile("" : "+v"(bvs[c][i]));
  f32x16 sc[5];
  const int ksw = (rK >> 1) & 7;
#pragma unroll
  for (int c = 0; c < 5; ++c) {
#pragma unroll
    for (int i = 0; i < 16; ++i) sc[c][i] = 0.f;
    const char* kp = lds + (32 * wid + 32 * c + rK) * 128;
#pragma unroll
    for (int d0 = 0; d0 < 4; ++d0) { const bf16x8 kf = *(const bf16x8*)(kp + (((2 * d0 + h) ^ ksw) << 4)); sc[c] = MFMA(kf, qf[d0], sc[c]); }
  }
  asm volatile("s_waitcnt lgkmcnt(0)" ::: "memory"); __builtin_amdgcn_s_barrier(); asm volatile("" ::: "memory");
  if (xnext >= 0) b_issue_k(p, xnext, lds, tid, wid);
  float mx = -1e30f;
#pragma unroll
  for (int c = 0; c < 5; ++c)
#pragma unroll
    for (int i = 0; i < 16; ++i) {
      const int prow = (i & 3) + 4 * ((i >> 2) & 1) + 8 * h + 16 * (i >> 3);
      const int rel = 32 * c - 64 + prow - r, key = i0w + r + rel;
      const bool valid = ((unsigned)(rel + 64) <= 128u) & ((unsigned)key < (unsigned)Ls);
      const float v = valid ? sc[c][i] + bvs[c][i] : -1e30f;
      sc[c][i] = v; mx = fmaxf(mx, v);
    }
  mx = fmaxf(mx, __shfl_xor(mx, 32));
  float l = 0.f;
#pragma unroll
  for (int c = 0; c < 5; ++c)
#pragma unroll
    for (int i = 0; i < 16; ++i) { const float e = fexp2(sc[c][i] - mx); sc[c][i] = e; l += e; }
  l += __shfl_xor(l, 32);
  f32x16 o0, o1;
#pragma unroll
  for (int i = 0; i < 16; ++i) { o0[i] = 0.f; o1[i] = 0.f; }
  const char* vp = lds + LV + r * 768; const int vsw = r & 15;
#pragma unroll
  for (int c = 0; c < 5; ++c)
#pragma unroll
    for (int s = 0; s < 2; ++s) {
      const bf16x8 pf = pack8(sc[c][8 * s], sc[c][8 * s + 1], sc[c][8 * s + 2], sc[c][8 * s + 3], sc[c][8 * s + 4], sc[c][8 * s + 5], sc[c][8 * s + 6], sc[c][8 * s + 7]);
      const int ch = ((4 * wid + 4 * c + 2 * s + h) ^ vsw) << 4;
      const bf16x8 v0 = *(const bf16x8*)(vp + ch), v1 = *(const bf16x8*)(vp + 32 * 768 + ch);
      o0 = MFMA(v0, pf, o0); o1 = MFMA(v1, pf, o1);
    }
  asm volatile("s_waitcnt lgkmcnt(0)" ::: "memory"); __builtin_amdgcn_s_barrier(); asm volatile("" ::: "memory");
  if (xnext >= 0) b_issue_v(p, xnext, lds, tid, wid);
  const float inv = 1.0f / l;
  const int tkn = ((i0w + r) << sh) + sub;
  bf16_t* OG = (g < 2) ? (bf16_t*)(p.ws + OFF_H) + (size_t)g * S * 512 : (bf16_t*)(p.ws + OFF_OB);
  bf16_t* op = OG + (size_t)tkn * 512 + head * 64 + 4 * h;
#pragma unroll
  for (int gg = 0; gg < 4; ++gg) {
    u32x2 w; w.x = pk2(o0[4 * gg] * inv, o0[4 * gg + 1] * inv); w.y = pk2(o0[4 * gg + 2] * inv, o0[4 * gg + 3] * inv);
    *(u32x2*)(op + 8 * gg) = w;
    u32x2 w1; w1.x = pk2(o1[4 * gg] * inv, o1[4 * gg + 1] * inv); w1.y = pk2(o1[4 * gg + 2] * inv, o1[4 * gg + 3] * inv);
    *(u32x2*)(op + 32 + 8 * gg) = w1;
  }
  if (h == 0) { float* LSE = (float*)(p.ws + OFF_LSE); LSE[((size_t)g * S + tkn) * 8 + head] = (mx + __builtin_amdgcn_logf(l)) * LN2; }
}

DI void phase_attn(const Params& p, int layer, char* smem) {
  const int n_dense = 1024, n_b = 1536, total = n_dense + n_b;
  int it = blockIdx.x;
  for (; it < n_dense; it += gridDim.x) {
    if (it < 512) { attn_dense_unit<0>(p, layer, it & 7, it >> 3, smem); }
    else { const int v = it - 512; attn_dense_unit<1>(p, layer, v & 7, v >> 3, smem); }
  }
  if (it < total) {
    const int tid = otid(), wid = wave_of(tid);
    b_issue_k(p, it - n_dense, smem, tid, wid); b_issue_v(p, it - n_dense, smem, tid, wid);
    for (; it < total; it += gridDim.x) {
      const int nx = it + (int)gridDim.x;
      attn_b_item(p, it - n_dense, nx < total ? nx - n_dense : -1, smem);
    }
  }
}

DI void phase_combine(const Params& p) {
  const bf16_t* G0 = (const bf16_t*)(p.ws + OFF_H); const bf16_t* G1 = G0 + (size_t)S * 512; bf16_t* OB = (bf16_t*)(p.ws + OFF_OB);
  const float* LSE = (const float*)(p.ws + OFF_LSE);
  for (int e = blockIdx.x * 512 + otid(); e < S * 64; e += gridDim.x * 512) {
    const int tkn = e >> 6, c = e & 63, head = c >> 3;
    const float l0 = LSE[((size_t)0 * S + tkn) * 8 + head], l1 = LSE[((size_t)1 * S + tkn) * 8 + head], l2 = LSE[((size_t)2 * S + tkn) * 8 + head];
    const float mm = fmaxf(l0, fmaxf(l1, l2));
    float w0 = __expf(l0 - mm), w1 = __expf(l1 - mm), w2 = __expf(l2 - mm);
    const float iw = 1.0f / (w0 + w1 + w2); w0 *= iw; w1 *= iw; w2 *= iw;
    const size_t off = (size_t)tkn * 512 + c * 8;
    const u32x4 a = *(const u32x4*)(G0 + off), b = *(const u32x4*)(G1 + off), d = *(const u32x4*)(OB + off);
    u32x4 o;
#pragma unroll
    for (int q = 0; q < 4; ++q) o[q] = pk2(w0 * bflo(a[q]) + w1 * bflo(b[q]) + w2 * bflo(d[q]), w0 * bfhi(a[q]) + w1 * bfhi(b[q]) + w2 * bfhi(d[q]));
    *(u32x4*)(OB + off) = o;
  }
}

#define XB_TMO      128
#define XB_XCNT(j)  (256  + 64 * (j))
#define XB_XSUB(j)  (1280 + 64 * (j))
#define XB_XGEN(j)  (2304 + 64 * (j))
#define XB_TOP      3328
#define XB_TOPGEN   3392
#define XCD_BAR_WORDS 3456
#define XB_SPIN_CAP (1u << 18)
#ifndef LAS
#define LAS __attribute__((address_space(3)))
#endif

__device__ __forceinline__ unsigned xb_ld(unsigned* p)              { return __hip_atomic_load(p, __ATOMIC_RELAXED, __HIP_MEMORY_SCOPE_AGENT); }
__device__ __forceinline__ unsigned xb_add(unsigned* p, unsigned v) { return __hip_atomic_fetch_add(p, v, __ATOMIC_RELAXED, __HIP_MEMORY_SCOPE_AGENT); }
__device__ __forceinline__ unsigned xb_xcc_id() { return (unsigned)__builtin_amdgcn_s_getreg((3 << 11) | 20) & 0xFu; }
#define XB_SPIN(cond, bar) do { unsigned _sp = 0; while (cond) { __builtin_amdgcn_s_sleep(1); \
    if ((++_sp & 255u) == 0u) { if (xb_ld(&(bar)[XB_TMO])) break; if (_sp > XB_SPIN_CAP) { atomicAdd(&(bar)[XB_TMO], 1u); break; } } } } while (0)

struct XcdBarrier {
    unsigned* bar; unsigned x;
    volatile LAS unsigned* st;
};

__device__ __forceinline__ XcdBarrier xcd_barrier_post(unsigned* bar, volatile LAS unsigned* st) {
    XcdBarrier b; b.bar = bar; b.x = xb_xcc_id(); b.st = st;
    if (threadIdx.x == 0) (void)xb_add(&bar[XB_XCNT(b.x)], 1u);
    return b;
}
__device__ __forceinline__ void xcd_barrier_complete(unsigned* bar, unsigned x, unsigned& nloc, unsigned& nx) {
    const unsigned G = gridDim.x * gridDim.y * gridDim.z;
    unsigned sum, cnt, mine, sp = 0u;
    for (;;) {
        sum = 0u; cnt = 0u; mine = 0u;
#pragma unroll
        for (unsigned j = 0; j < 16; ++j) { const unsigned c = xb_ld(&bar[XB_XCNT(j)]); sum += c; cnt += (c > 0u) ? 1u : 0u; mine = (j == x) ? c : mine; }
        if (sum == G) break;
        __builtin_amdgcn_s_sleep(1);
        if ((++sp & 255u) == 0u) { if (xb_ld(&bar[XB_TMO])) break; if (sp > XB_SPIN_CAP) { atomicAdd(&bar[XB_TMO], 1u); break; } }
    }
    nloc = mine > 0u ? mine : 1u; nx = cnt > 0u ? cnt : 1u;
}

__device__ __forceinline__ void xcd_barrier(const XcdBarrier& b) {
    asm volatile("s_waitcnt vmcnt(0)" ::: "memory");
    __syncthreads();
    if (threadIdx.x == 0) {
        unsigned* bar = b.bar;
        __builtin_amdgcn_s_waitcnt(0);
        unsigned nloc = b.st[0], nx = b.st[1];
        if (nloc == 0u) { xcd_barrier_complete(bar, b.x, nloc, nx); b.st[0] = nloc; b.st[1] = nx; }
        const unsigned old = xb_add(&bar[XB_XSUB(b.x)], 1u);
        const unsigned gen = old / nloc;
        if (old + 1u == (gen + 1u) * nloc) {
            __builtin_amdgcn_fence(__ATOMIC_RELEASE, "agent");
            asm volatile("s_waitcnt vmcnt(0)" ::: "memory");
            const unsigned og = xb_add(&bar[XB_TOP], 1u);
            const unsigned tg = og / nx;
            if (og + 1u == (tg + 1u) * nx) xb_add(&bar[XB_TOPGEN], 1u);
            else XB_SPIN(xb_ld(&bar[XB_TOPGEN]) == tg, bar);
            __builtin_amdgcn_fence(__ATOMIC_ACQUIRE, "agent");
            xb_add(&bar[XB_XGEN(b.x)], 1u);
            asm volatile("s_waitcnt vmcnt(0)" ::: "memory");
        } else {
            XB_SPIN(xb_ld(&bar[XB_XGEN(b.x)]) == gen, bar);
            __builtin_amdgcn_fence(__ATOMIC_ACQUIRE, "agent");
            asm volatile("s_waitcnt vmcnt(0)" ::: "memory");
        }
    }
    __syncthreads();
}

__global__ void __launch_bounds__(512) hybrid_encoder_mega(Params p) {
  extern __shared__ __attribute__((aligned(16))) char smem[];
  cg::grid_group grid = cg::this_grid();
  const int G = gridDim.x, bx = blockIdx.x;
  bf16_t* Z = (bf16_t*)(p.ws + OFF_Z); bf16_t* H = (bf16_t*)(p.ws + OFF_H);
  float* ssq_q = (float*)(p.ws + OFF_SSQ); float* ssq_kv = ssq_q + S; float* ssq_x = ssq_q + 2 * S;
  bf16_t* XB = (bf16_t*)(p.ws + OFF_OA);
  volatile LAS unsigned* xst = (volatile LAS unsigned*)(smem + 131072);
  if (threadIdx.x == 0) { xst[0] = 0u; xst[1] = 0u; xst[2] = 0u; xst[3] = 0u; }
  __syncthreads();
  const XcdBarrier xb = xcd_barrier_post((unsigned*)(p.ws + OFF_BAR), xst);
  bool first_sync = true;
#define GSYNC() do { if (first_sync) { grid.sync(); first_sync = false; } else xcd_barrier(xb); } while (0)
  build_tables(p);
  for (int layer = 0; layer < 2; ++layer) {
    convert_weights(p, layer, smem);
    for (int seq = 0; seq < 3; ++seq) {
      const float* xin = (layer == 0) ? (seq < 2 ? p.x_prompt + (size_t)seq * S * DM : p.x_sample) : p.out + (size_t)seq * S * DM;
      float* xo = p.out + (size_t)seq * S * DM;
      phase_norm(xin, p.norm_mix + layer * DM, H, S);
      { const int tz = otid();
_Pragma("nounroll")
        for (int b = bx; b < 96; b += G) ssq_q[b * 512 + tz] = 0.f; }
      GSYNC();
      { pg8::Gemm g{H, (const bf16_t*)(p.ws + WT_IN), S, 9216, DM, DM, DM}; pg8::StaticOrder so; so.init(S, 9216, G, bx);
        EpiInproj E{Z, (bf16_t*)(p.ws + OFF_VCT), (bf16_t*)(p.ws + OFF_VBT), ssq_q, ssq_kv};
        pg8::gemm_phase<EpiInproj, pg8::StaticOrder, true, true>(GEMM_LDS, g, so, E); }
      GSYNC();
      { pg8::Gemm g{Z + ZC_CQ, (const bf16_t*)(p.ws + WT_UQ), S, 768, 384, ZP, 384}; pg8::StaticOrder so; so.init(S, 768, G, bx);
        EpiUpQ E{(bf16_t*)(p.ws + OFF_QA), ssq_q};
        pg8::gemm_phase<EpiUpQ, pg8::StaticOrder, true, true>(GEMM_LDS, g, so, E); }
      { pg8::Gemm g{Z + ZC_CKV, (const bf16_t*)(p.ws + WT_UKV), S, 1024, 256, ZP, 256}; pg8::StaticOrder so; so.init(S, 1024, G, bx);
        EpiUpKV E{(bf16_t*)(p.ws + OFF_KA), (bf16_t*)(p.ws + OFF_VAT), ssq_kv};
        pg8::gemm_phase<EpiUpKV, pg8::StaticOrder, true, true>(GEMM_LDS, g, so, E); }
      phase_kpost(p, layer);
      GSYNC();
      phase_attn(p, layer, smem);
      GSYNC();
      phase_combine(p);
      GSYNC();
      { pg8::Gemm g{(const bf16_t*)(p.ws + OFF_OA), (const bf16_t*)(p.ws + WT_BRA), 3 * S, 3072, 512, 512, 512}; DiagOrder so; so.init(G, bx);
        EpiMerge E{Z, H};
        pg8::gemm_phase<EpiMerge, DiagOrder, true, true>(GEMM_LDS, g, so, E); }
      GSYNC();
      { pg8::Gemm g{H, (const bf16_t*)(p.ws + WT_OUT), S, 1024, DM, DM, DM}; pg8::StaticOrder so; so.init(S, 1024, G, bx);
        EpiResid<true> E{xin, xo, XB, ssq_x};
        pg8::gemm_phase<EpiResid<true>, pg8::StaticOrder, true, true>(GEMM_LDS, g, so, E); }
      GSYNC();
      { pg8::Gemm g{XB, (const bf16_t*)(p.ws + WT_UP), S, DFF, DM, DM, DM}; pg8::StaticOrder so; so.init(S, DFF, G, bx);
        EpiRelu2 E{Z, ssq_x};
        pg8::gemm_phase<EpiRelu2, pg8::StaticOrder, true, true>(GEMM_LDS, g, so, E); }
      GSYNC();
      { pg8::Gemm g{Z, (const bf16_t*)(p.ws + WT_DOWN), S, 1024, DFF, DFF, DFF}; pg8::StaticOrder so; so.init(S, 1024, G, bx);
        EpiResid<false> E{xo, xo, nullptr, nullptr};
        pg8::gemm_phase<EpiResid<false>, pg8::StaticOrder, true, true>(GEMM_LDS, g, so, E); }
      GSYNC();
    }
  }
  phase_final_norm(p.out, p.final_norm, 3 * S);
}

extern "C" void kernel_launch(void* const* d_in, const int* in_sizes, int n_in, void* d_out, int out_size, void* d_ws, size_t ws_size, hipStream_t stream) {
  static int grid_blocks = 0;
  if (!grid_blocks) {
    if (ws_size < WS_END) { fprintf(stderr, "kernel_launch: workspace too small: %zu < %zu\n", ws_size, (size_t)WS_END); return; }
    if (hipFuncSetAttribute((const void*)hybrid_encoder_mega, hipFuncAttributeMaxDynamicSharedMemorySize, LDS_BYTES) != hipSuccess) { fprintf(stderr, "hipFuncSetAttribute failed\n"); return; }
    int dev = 0, cus = 0, per_cu = 0;
    hipGetDevice(&dev);
    hipDeviceGetAttribute(&cus, hipDeviceAttributeMultiprocessorCount, dev);
    hipOccupancyMaxActiveBlocksPerMultiprocessor(&per_cu, hybrid_encoder_mega, 512, LDS_BYTES);
    if (per_cu < 1) { fprintf(stderr, "occupancy query returned %d\n", per_cu); return; }
    grid_blocks = cus;
  }
  Params p{};
  p.x_prompt = (const float*)d_in[0]; p.x_sample = (const float*)d_in[1];
  p.norm_mix = (const float*)d_in[2]; p.w_in = (const float*)d_in[3]; p.a_q_norm = (const float*)d_in[4]; p.a_kv_norm = (const float*)d_in[5];
  p.a_w_uq = (const float*)d_in[6]; p.a_w_ukv = (const float*)d_in[7]; p.c_q_norm = (const float*)d_in[8]; p.c_k_norm = (const float*)d_in[9];
  p.w_br_a = (const float*)d_in[10]; p.w_br_b = (const float*)d_in[11]; p.w_br_c = (const float*)d_in[12]; p.w_out = (const float*)d_in[13];
  p.norm_ffn = (const float*)d_in[14]; p.w_up = (const float*)d_in[15]; p.w_down = (const float*)d_in[16]; p.t5_table = (const float*)d_in[17];
  p.final_norm = (const float*)d_in[18];
  p.out = (float*)d_out; p.ws = (char*)d_ws;
  (void)hipMemsetAsync((char*)d_ws + OFF_BAR, 0, 16384, stream);
  void* args[] = {&p};
  hipError_t e = hipLaunchCooperativeKernel((const void*)hybrid_encoder_mega, dim3(grid_blocks), dim3(512), args, LDS_BYTES, stream);
  if (e != hipSuccess) fprintf(stderr, "cooperative launch failed: %s (grid %d)\n", hipGetErrorString(e), grid_blocks);
}
```

```cpp
#include <hip/hip_runtime.h>
#include <hip/hip_cooperative_groups.h>
#include <stdint.h>
#include <cstdio>
namespace cg = cooperative_groups;

typedef unsigned short bf16_t;
typedef short bf16x8 __attribute__((ext_vector_type(8)));
typedef short s16x4 __attribute__((ext_vector_type(4)));
typedef float f32x16 __attribute__((ext_vector_type(16)));
typedef float f32x4 __attribute__((ext_vector_type(4)));
typedef float f32x2 __attribute__((ext_vector_type(2)));
typedef unsigned u32x4 __attribute__((ext_vector_type(4)));
typedef unsigned u32x2 __attribute__((ext_vector_type(2)));
typedef __bf16 bf16x2_t __attribute__((ext_vector_type(2)));

#define DI __device__ __forceinline__
#define MFMA(a, b, c) __builtin_amdgcn_mfma_f32_32x32x16_bf16((a), (b), (c), 0, 0, 0)

DI unsigned pk2(float lo, float hi) { f32x2 v = {lo, hi}; bf16x2_t b = __builtin_convertvector(v, bf16x2_t); return __builtin_bit_cast(unsigned, b); }
DI bf16_t f2bf(float x) { return (bf16_t)(pk2(x, 0.f) & 0xffffu); }
DI float bflo(unsigned u) { return __uint_as_float(u << 16); }
DI float bfhi(unsigned u) { return __uint_as_float(u & 0xffff0000u); }
DI float bf2f(bf16_t b) { return __uint_as_float(((unsigned)b) << 16); }
DI int crow(int i, int h) { return (i & 3) + 8 * (i >> 2) + 4 * h; }
DI float fexp2(float x) { return __builtin_amdgcn_exp2f(x); }
DI int otid() { int t = threadIdx.x; asm volatile("" : "+v"(t)); return t; }
DI int wave_of(int tid) { return __builtin_amdgcn_readfirstlane(tid >> 6); }

constexpr int S = 16384, DM = 1024, ZP = 7680, DFF = 4096;
constexpr int ZC_CQ = 0, ZC_CKV = 384, ZC_KR = 640, ZC_QKVB = 768, ZC_QC = 3840, ZC_KC = 4352, ZC_GATE = 4608;
constexpr int GC_VB = 3840, GC_VC = 6016;
constexpr float LOG2E = 1.4426950408889634f, LN2 = 0.6931471805599453f;

constexpr size_t WT_IN = 0;
constexpr size_t WT_UQ = WT_IN + (size_t)9216 * 1024 * 2;
constexpr size_t WT_UKV = WT_UQ + (size_t)768 * 384 * 2;
constexpr size_t WT_BRA = WT_UKV + (size_t)1024 * 256 * 2;
constexpr size_t WT_BRB = WT_BRA + (size_t)1024 * 512 * 2;
constexpr size_t WT_BRC = WT_BRB + (size_t)1024 * 512 * 2;
constexpr size_t WT_OUT = WT_BRC + (size_t)1024 * 512 * 2;
constexpr size_t WT_UP = WT_OUT + (size_t)1024 * 3072 * 2;
constexpr size_t WT_DOWN = WT_UP + (size_t)4096 * 1024 * 2;
constexpr size_t OFF_CS = WT_DOWN + (size_t)1024 * 4096 * 2;
constexpr size_t OFF_BT = OFF_CS + (size_t)16384 * 16 * 8;
constexpr size_t OFF_Z = OFF_BT + 32768;
constexpr size_t OFF_H = OFF_Z + (size_t)S * ZP * 2;
constexpr size_t OFF_QA = OFF_H + (size_t)S * 1024 * 2;
constexpr size_t OFF_KA = OFF_QA + (size_t)S * 768 * 2;
constexpr size_t OFF_VAT = OFF_KA + (size_t)S * 512 * 2;
constexpr size_t OFF_VCT = OFF_VAT + (size_t)S * 512 * 2;
constexpr size_t OFF_OA = OFF_VCT + (size_t)S * 128 * 2;
constexpr size_t OFF_OB = OFF_OA + (size_t)S * 512 * 2;
constexpr size_t OFF_OC = OFF_OB + (size_t)S * 512 * 2;
constexpr size_t OFF_LSE = OFF_OC + (size_t)S * 512 * 2;
constexpr size_t OFF_SSQ = OFF_LSE + (size_t)3 * S * 8 * 4;
constexpr size_t OFF_VBT = OFF_SSQ + (size_t)3 * S * 4;
constexpr size_t OFF_BAR = OFF_VBT + (size_t)1536 * S * 2;
constexpr size_t WS_END = OFF_BAR + 16384;

constexpr int LDS_BYTES = 131072 + 1024;

struct Params {
  const float* x_prompt; const float* x_sample;
  const float* norm_mix; const float* w_in; const float* a_q_norm; const float* a_kv_norm; const float* a_w_uq; const float* a_w_ukv;
  const float* c_q_norm; const float* c_k_norm; const float* w_br_a; const float* w_br_b; const float* w_br_c; const float* w_out;
  const float* norm_ffn; const float* w_up; const float* w_down; const float* t5_table; const float* final_norm;
  float* out; char* ws;
};

DI void sincos_d(double x, float& c, float& s) {
  const double k = rint(x * 0.6366197723675814);
  double t = fma(-k, 1.5707963267948966, x); t = fma(-k, 6.123233995736766e-17, t);
  const double t2 = t * t;
  double sn = 1.0 - t2 / 210.0; sn = 1.0 - t2 / 156.0 * sn; sn = 1.0 - t2 / 110.0 * sn; sn = 1.0 - t2 / 72.0 * sn; sn = 1.0 - t2 / 42.0 * sn; sn = 1.0 - t2 / 20.0 * sn; sn = 1.0 - t2 / 6.0 * sn; sn *= t;
  double cs = 1.0 - t2 / 240.0; cs = 1.0 - t2 / 182.0 * cs; cs = 1.0 - t2 / 132.0 * cs; cs = 1.0 - t2 / 90.0 * cs; cs = 1.0 - t2 / 56.0 * cs; cs = 1.0 - t2 / 30.0 * cs; cs = 1.0 - t2 / 12.0 * cs; cs = 1.0 - t2 / 2.0 * cs;
  const int q = ((int)k) & 3;
  double so = (q == 0) ? sn : (q == 1) ? cs : (q == 2) ? -sn : -cs;
  double co = (q == 0) ? cs : (q == 1) ? -sn : (q == 2) ? -cs : sn;
  c = (float)co; s = (float)so;
}

DI void build_tables(const Params& p) {
  f32x2* CS = (f32x2*)(p.ws + OFF_CS);
  const int gsz = gridDim.x * 512, gid = blockIdx.x * 512 + otid();
  for (int e = gid; e < 16384 * 16; e += gsz) {
    const int pos = e >> 4, i = e & 15;
    double f = 1.0; for (int j = 0; j < i; ++j) f *= 0.5623413251903491;
    const float ff = (float)f; const float ang = (float)pos * ff;
    float c, s; sincos_d((double)ang, c, s);
    CS[e] = (f32x2){c, s};
  }
  float* BT = (float*)(p.ws + OFF_BT);
  for (int e = gid; e < 3 * 8 * 256; e += gsz) {
    const int gh = e >> 8, g = gh >> 3, hd = gh & 7, j = (e & 255) - 32;
    float v = 0.f;
    if (j >= 0 && j <= 128) {
      const int rel = (j - 64) << (2 * g);
      const int n = rel < 0 ? -rel : rel;
      int b = rel > 0 ? 16 : 0;
      if (n < 8) b += n; else { int lg = 31 - __clz(n); int vv = 5 + lg; b += (vv < 15 ? vv : 15); }
      v = p.t5_table[b * 24 + g * 8 + hd] * LOG2E;
    }
    BT[e] = v;
  }
}

DI void cvt_tile(const float* __restrict__ W, int ldw, int ldk, int koff, bf16_t* __restrict__ Wt, int k0, int n0, int mode, const float* __restrict__ rscale, float* tile) {
  const int tid = otid();
#pragma unroll
  for (int i = 0; i < 8; ++i) {
    const int kl = (tid >> 6) + 8 * i, nl = tid & 63, nn = n0 + nl;
    int src = nn;
    if (mode == 1) src = nn < 672 ? nn : (nn < 768 ? -1 : nn - 96);
    float v = 0.f;
    if (src >= 0) v = W[(size_t)(k0 + kl) * ldw + src];
    if (rscale) v *= rscale[k0 + kl];
    tile[kl * 65 + nl] = v;
  }
  __syncthreads();
#pragma unroll
  for (int i = 0; i < 8; ++i) {
    const int nl = (tid >> 6) + 8 * i, kl = tid & 63;
    Wt[(size_t)(n0 + nl) * ldk + koff + k0 + kl] = f2bf(tile[kl * 65 + nl]);
  }
  __syncthreads();
}

DI void convert_weights(const Params& p, int layer, char* smem) {
  float* tile = (float*)smem;
  int base = 0;
  for (int mtx = 0; mtx < 9; ++mtx) {
    const float* W; int K, Nsrc, Ndst, mode = 0, ldk = 0, koff = 0; const float* rs = nullptr; size_t off;
    switch (mtx) {
      case 0: W = p.w_in + (size_t)layer * 1024 * 9120; K = 1024; Nsrc = 9120; Ndst = 9216; mode = 1; off = WT_IN; break;
      case 1: W = p.a_w_uq + (size_t)layer * 384 * 768; K = 384; Nsrc = 768; Ndst = 768; rs = p.a_q_norm + layer * 384; off = WT_UQ; break;
      case 2: W = p.a_w_ukv + (size_t)layer * 256 * 1024; K = 256; Nsrc = 1024; Ndst = 1024; rs = p.a_kv_norm + layer * 256; off = WT_UKV; break;
      case 3: W = p.w_br_a + (size_t)layer * 512 * 1024; K = 512; Nsrc = 1024; Ndst = 1024; off = WT_BRA; break;
      case 4: W = p.w_br_b + (size_t)layer * 512 * 1024; K = 512; Nsrc = 1024; Ndst = 1024; off = WT_BRB; break;
      case 5: W = p.w_br_c + (size_t)layer * 512 * 1024; K = 512; Nsrc = 1024; Ndst = 1024; off = WT_BRC; break;
      case 6: W = p.w_out + (size_t)layer * 1024 * 1024; K = 1024; Nsrc = 1024; Ndst = 1024; off = WT_OUT; break;
      case 7: W = p.w_up + (size_t)layer * 1024 * 4096; K = 1024; Nsrc = 4096; Ndst = 4096; rs = p.norm_ffn + layer * DM; off = WT_UP; break;
      case 8: default: W = p.w_down + (size_t)layer * 4096 * 1024; K = 4096; Nsrc = 1024; Ndst = 1024; off = WT_DOWN; break;
    }
    if (ldk == 0) ldk = K;
    const int nk = K / 64, nn = Ndst / 64, cnt = nk * nn;
    bf16_t* Wt = (bf16_t*)(p.ws + off);
    int first = (int)blockIdx.x - (base % (int)gridDim.x); if (first < 0) first += gridDim.x;
    for (int it = first; it < cnt; it += gridDim.x) {
      const int kt = it % nk, nt = it / nk;
      cvt_tile(W, Nsrc, ldk, koff, Wt, kt * 64, nt * 64, mode, rs, tile);
    }
    base += cnt;
  }
}

DI void phase_norm(const float* __restrict__ x, const float* __restrict__ g, bf16_t* __restrict__ H, int rows) {
  const int tid = otid(), lane = tid & 63, wid = tid >> 6;
  for (int row = blockIdx.x * 8 + wid; row < rows; row += gridDim.x * 8) {
    const float* xr = x + (size_t)row * DM;
    f32x4 v[4]; float ss = 0.f;
#pragma unroll
    for (int i = 0; i < 4; ++i) { v[i] = *(const f32x4*)(xr + i * 256 + lane * 4); ss += v[i][0] * v[i][0] + v[i][1] * v[i][1] + v[i][2] * v[i][2] + v[i][3] * v[i][3]; }
#pragma unroll
    for (int o = 32; o >= 1; o >>= 1) ss += __shfl_xor(ss, o);
    const float rstd = rsqrtf(ss * (1.0f / DM) + 1e-6f);
#pragma unroll
    for (int i = 0; i < 4; ++i) {
      const f32x4 gg = *(const f32x4*)(g + i * 256 + lane * 4);
      u32x2 w; w.x = pk2(v[i][0] * rstd * gg[0], v[i][1] * rstd * gg[1]); w.y = pk2(v[i][2] * rstd * gg[2], v[i][3] * rstd * gg[3]);
      *(u32x2*)(H + (size_t)row * DM + i * 256 + lane * 4) = w;
    }
  }
}

DI void phase_final_norm(float* __restrict__ x, const float* __restrict__ g, int rows) {
  const int tid = otid(), lane = tid & 63, wid = tid >> 6;
  for (int row = blockIdx.x * 8 + wid; row < rows; row += gridDim.x * 8) {
    float* xr = x + (size_t)row * DM;
    f32x4 v[4]; float ss = 0.f;
#pragma unroll
    for (int i = 0; i < 4; ++i) { v[i] = *(const f32x4*)(xr + i * 256 + lane * 4); ss += v[i][0] * v[i][0] + v[i][1] * v[i][1] + v[i][2] * v[i][2] + v[i][3] * v[i][3]; }
#pragma unroll
    for (int o = 32; o >= 1; o >>= 1) ss += __shfl_xor(ss, o);
    const float rstd = rsqrtf(ss * (1.0f / DM) + 1e-6f);
#pragma unroll
    for (int i = 0; i < 4; ++i) {
      const f32x4 gg = *(const f32x4*)(g + i * 256 + lane * 4);
      f32x4 o = {v[i][0] * rstd * gg[0], v[i][1] * rstd * gg[1], v[i][2] * rstd * gg[2], v[i][3] * rstd * gg[3]};
      *(f32x4*)(xr + i * 256 + lane * 4) = o;
    }
  }
}


namespace pg8 {
#define PG8_LAS __attribute__((address_space(3)))
typedef unsigned short bf16_t;
typedef short bf16x8 __attribute__((ext_vector_type(8)));
typedef float f32x4 __attribute__((ext_vector_type(4)));
typedef unsigned u32x4 __attribute__((ext_vector_type(4)));
constexpr int BM = 256, BK = 64, HALF = 128, HTB = HALF * BK * 2  , STAGE_BYTES = 8 * HTB, NXCD = 8, WGM = 8;

__host__ __device__ __forceinline__ int lds_byte(int r, int c) { const int st = (r >> 4) * 2 + (c >> 5), rr = r & 15, cc = c & 31, ob = rr * 64 + cc * 2; return st * 1024 + (ob ^ (((ob >> 9) & 1) << 5)); }
__host__ __device__ __forceinline__ void stage_rc(int b, int& R, int& C) { const int st = b / 1024, sb = b % 1024, swz = sb ^ (((sb >> 9) & 1) << 5); R = (st >> 1) * 16 + swz / 64; C = (st & 1) * 32 + (swz % 64) / 2; }
__host__ __device__ __forceinline__ int perm32(int rho) { const int n = rho >> 4, i = rho & 15; return 8 * (i >> 2) + 4 * n + (i & 3); }

struct Unit { int pm, pn; };
struct Gemm { const bf16_t* A; const bf16_t* Bt; int M, N, K, lda, ldb; };

struct StaticOrder {
    int nM, nN, nwg, G, c;
    __host__ __device__ void init(int M, int N, int G_, int c_) { nM = M / BM; nN = N / BM; nwg = nM * nN; G = G_; c = c_; }
    __host__ __device__ bool next(int i, Unit& u) const {
        const long L = (long)i * G + c; if (L >= nwg) return false;
        map((int)L, u); return true; }
    __host__ __device__ void map(int L, Unit& u) const {
        int wgid = L; { const int q = nwg / NXCD, r = nwg % NXCD, xcd = wgid % NXCD, off = wgid / NXCD; wgid = (xcd < r ? xcd * (q + 1) : r * (q + 1) + (xcd - r) * q) + off; }
        const int nig = WGM * nN, gid = wgid / nig, fm = gid * WGM, gsz = (nM - fm) < WGM ? (nM - fm) : WGM;
        u.pm = fm + ((wgid % nig) % gsz); u.pn = (wgid % nig) / gsz;
    }
    __device__ __forceinline__ void a_ready(const Unit&) const {}
    __device__ __forceinline__ void done(const Unit&) const {}
};
template <class Epi, class Sched, bool ALIGN_EPI = false, bool SP2 = false>
__device__ __forceinline__ void gemm_phase(PG8_LAS unsigned char* lds, const Gemm g, const Sched& S, const Epi& E) {
    int tid_ = threadIdx.x; asm volatile("" : "+v"(tid_)); const int tid = tid_, wid = __builtin_amdgcn_readfirstlane(tid >> 6), lane = tid & 63, wr = wid >> 2, wc = wid & 3, fr = lane & 15, fq = lane >> 4;
    const int K = g.K, nt = K / BK;
    unsigned voffA[2], voffB[2];
#pragma unroll
    for (int i = 0; i < 2; ++i) { int R, C; stage_rc(tid * 16 + i * 8192, R, C); const int Rb = Epi::PERM ? ((R & ~31) + perm32(R & 31)) : R;
        voffA[i] = (unsigned)(R * g.lda + C) * 2u; voffB[i] = (unsigned)(Rb * g.ldb + C) * 2u; }
    const size_t kstep = (size_t)(BK * 2);
    const size_t hA = (size_t)HALF * g.lda * 2, hB = (size_t)HALF * g.ldb * 2;
    const size_t tA = 2 * hA, tB = 2 * hB;
    const unsigned ldsw = (unsigned)wid * 1024u;
    const int aoff = lds_byte(wr * 64 + fr, fq * 8), boff = lds_byte(wc * 32 + fr, fq * 8);
#define PG8_SA(b, h) (((b) * 2 + (h)) * HTB)
#define PG8_SB(b, h) ((4 + (b) * 2 + (h)) * HTB)
#define PG8_STAGE(bufoff, gbase, voff) do { _Pragma("unroll") for (int _i = 0; _i < 2; ++_i) \
        __builtin_amdgcn_global_load_lds((const unsigned*)((const char*)(gbase) + (voff)[_i]), (PG8_LAS unsigned*)(lds + (bufoff) + ldsw + _i * 8192), 16, 0, 0); } while (0)
#define PG8_LDA(dst, b, h) do { _Pragma("unroll") for (int m = 0; m < 4; ++m) _Pragma("unroll") for (int k = 0; k < 2; ++k) dst[m][k] = *(const PG8_LAS bf16x8*)(lds + PG8_SA(b, h) + aoff + m * 2048 + k * 1024); } while (0)
#define PG8_LDB(dst, b, h) do { _Pragma("unroll") for (int n = 0; n < 2; ++n) _Pragma("unroll") for (int k = 0; k < 2; ++k) dst[n][k] = *(const PG8_LAS bf16x8*)(lds + PG8_SB(b, h) + boff + n * 2048 + k * 1024); } while (0)
#define PG8_MMA(ai, bj, At, Bt) do { __builtin_amdgcn_s_setprio(1); _Pragma("unroll") for (int m = 0; m < 4; ++m) _Pragma("unroll") for (int n = 0; n < 2; ++n) _Pragma("unroll") for (int k = 0; k < 2; ++k) \
        acc[ai][bj][m][n] = __builtin_amdgcn_mfma_f32_16x16x32_bf16(Bt[n][k], At[m][k], acc[ai][bj][m][n], 0, 0, 0); __builtin_amdgcn_s_setprio(0); } while (0)
#define PG8_WAIT_V(n) asm volatile("s_waitcnt vmcnt(" #n ")" ::: "memory")
#define PG8_WAIT_L(n) asm volatile("s_waitcnt lgkmcnt(" #n ")" ::: "memory")
#define PG8_BAR __builtin_amdgcn_s_barrier()
#define PG8_SCHED __builtin_amdgcn_sched_barrier(0)
    Unit cur, nxt; int ui = 0;
    if (!S.next(0, cur)) return;
    f32x4 acc[2][2][4][2];
#pragma unroll
    for (int a = 0; a < 2; ++a)
#pragma unroll
        for (int b = 0; b < 2; ++b)
#pragma unroll
            for (int m = 0; m < 4; ++m)
#pragma unroll
                for (int n = 0; n < 2; ++n) acc[a][b][m][n] = (f32x4){0.f, 0.f, 0.f, 0.f};
    bf16x8 At[4][2], B0[2][2], B1[2][2];
    const char* cA = (const char*)g.A + (size_t)cur.pm * tA; const char* cB = (const char*)g.Bt + (size_t)cur.pn * tB;
    S.a_ready(cur);
    if constexpr (SP2) {
        PG8_STAGE(PG8_SB(0, 0), cB, voffB); PG8_STAGE(PG8_SB(0, 1), cB + hB, voffB); PG8_STAGE(PG8_SA(0, 0), cA, voffA); PG8_STAGE(PG8_SA(0, 1), cA + hA, voffA);
        if (wr == 1) PG8_BAR;
        PG8_WAIT_V(2); PG8_BAR;
        PG8_STAGE(PG8_SB(1, 0), cB + kstep, voffB); PG8_STAGE(PG8_SA(1, 0), cA + kstep, voffA); PG8_STAGE(PG8_SB(1, 1), cB + hB + kstep, voffB);
        PG8_WAIT_V(6); PG8_BAR;
    } else {
        PG8_STAGE(PG8_SB(0, 0), cB, voffB); PG8_STAGE(PG8_SA(0, 0), cA, voffA); PG8_STAGE(PG8_SB(0, 1), cB + hB, voffB); PG8_STAGE(PG8_SA(0, 1), cA + hA, voffA);
        if (wr == 1) PG8_BAR;
        PG8_WAIT_V(4); PG8_BAR;
        PG8_STAGE(PG8_SB(1, 0), cB + kstep, voffB); PG8_STAGE(PG8_SA(1, 0), cA + kstep, voffA); PG8_STAGE(PG8_SB(1, 1), cB + hB + kstep, voffB);
        PG8_WAIT_V(6); PG8_BAR;
    }
    for (;;) {
        const bool has_next = S.next(ui + 1, nxt);
        const char* nA = has_next ? (const char*)g.A + (size_t)nxt.pm * tA : cA; const char* nB = has_next ? (const char*)g.Bt + (size_t)nxt.pn * tB : cB;
_Pragma("unroll 1")
        for (int t = 0; t < nt; t += 2) {
            const bool last = (t == nt - 2);
            const char* a1 = cA + (size_t)(t + 1) * kstep;
            const char* a2 = last ? nA : cA + (size_t)(t + 2) * kstep; const char* b2 = last ? nB : cB + (size_t)(t + 2) * kstep;
            const char* a3 = a2 + kstep; const char* b3 = b2 + kstep;
            if (last && has_next) S.a_ready(nxt);
            if constexpr (SP2) {
            PG8_LDB(B0, 0, 0); PG8_LDB(B1, 0, 1); PG8_SCHED; PG8_LDA(At, 0, 0); PG8_STAGE(PG8_SA(1, 1), a1 + hA, voffA);
            PG8_WAIT_V(8); PG8_WAIT_L(0); PG8_BAR; PG8_MMA(0, 0, At, B0); PG8_MMA(0, 1, At, B1); PG8_BAR; PG8_SCHED;
            PG8_LDA(At, 0, 1); PG8_STAGE(PG8_SB(0, 0), b2, voffB); PG8_STAGE(PG8_SB(0, 1), b2 + hB, voffB); PG8_STAGE(PG8_SA(0, 0), a2, voffA);
            PG8_WAIT_V(8); PG8_WAIT_L(0); PG8_BAR; PG8_MMA(1, 0, At, B0); PG8_MMA(1, 1, At, B1); PG8_BAR; PG8_SCHED;
            PG8_LDB(B0, 1, 0); PG8_LDB(B1, 1, 1); PG8_SCHED; PG8_LDA(At, 1, 0); PG8_STAGE(PG8_SA(0, 1), a2 + hA, voffA);
            PG8_WAIT_V(8); PG8_WAIT_L(0); PG8_BAR; PG8_MMA(0, 0, At, B0); PG8_MMA(0, 1, At, B1); PG8_BAR; PG8_SCHED;
            PG8_LDA(At, 1, 1); PG8_STAGE(PG8_SB(1, 0), b3, voffB); PG8_STAGE(PG8_SB(1, 1), b3 + hB, voffB); PG8_STAGE(PG8_SA(1, 0), a3, voffA);
            PG8_WAIT_V(8); PG8_WAIT_L(0); PG8_BAR; PG8_MMA(1, 0, At, B0); PG8_MMA(1, 1, At, B1); PG8_BAR; PG8_SCHED;
            } else {
            PG8_LDB(B0, 0, 0); PG8_SCHED; PG8_LDA(At, 0, 0); PG8_STAGE(PG8_SA(1, 1), a1 + hA, voffA);
            PG8_WAIT_L(8); PG8_BAR; PG8_WAIT_L(0); PG8_MMA(0, 0, At, B0); PG8_BAR; PG8_SCHED;
            PG8_LDB(B1, 0, 1); PG8_STAGE(PG8_SB(0, 0), b2, voffB);
            PG8_BAR; PG8_WAIT_L(0); PG8_MMA(0, 1, At, B1); PG8_BAR;
            PG8_LDA(At, 0, 1); PG8_STAGE(PG8_SA(0, 0), a2, voffA);
            PG8_BAR; PG8_WAIT_L(0); PG8_MMA(1, 0, At, B0); PG8_BAR; PG8_SCHED;
            PG8_STAGE(PG8_SB(0, 1), b2 + hB, voffB);
            PG8_WAIT_V(6); PG8_BAR; PG8_MMA(1, 1, At, B1); PG8_BAR;
            PG8_LDB(B0, 1, 0); PG8_SCHED; PG8_LDA(At, 1, 0); PG8_STAGE(PG8_SA(0, 1), a2 + hA, voffA);
            PG8_WAIT_L(8); PG8_BAR; PG8_WAIT_L(0); PG8_MMA(0, 0, At, B0); PG8_BAR; PG8_SCHED;
            PG8_LDB(B1, 1, 1); PG8_STAGE(PG8_SB(1, 0), b3, voffB);
            PG8_BAR; PG8_WAIT_L(0); PG8_MMA(0, 1, At, B1); PG8_BAR;
            PG8_LDA(At, 1, 1); PG8_STAGE(PG8_SA(1, 0), a3, voffA);
            PG8_BAR; PG8_WAIT_L(0); PG8_MMA(1, 0, At, B0); PG8_BAR; PG8_SCHED;
            PG8_STAGE(PG8_SB(1, 1), b3 + hB, voffB);
            PG8_WAIT_V(6); PG8_BAR; PG8_MMA(1, 1, At, B1); PG8_BAR;
            }
        }
        if constexpr (ALIGN_EPI) { if (wr == 0) PG8_BAR; }
        if constexpr (!Epi::AFTER_DRAIN) { E(acc, cur, wr, wc, fr, fq); S.done(cur); }
        if (!has_next) break;
#pragma unroll
        for (int a = 0; a < 2; ++a)
#pragma unroll
            for (int b = 0; b < 2; ++b)
#pragma unroll
                for (int m = 0; m < 4; ++m)
#pragma unroll
                    for (int n = 0; n < 2; ++n) acc[a][b][m][n] = (f32x4){0.f, 0.f, 0.f, 0.f};
        cur = nxt; cA = nA; cB = nB; ++ui;
        if constexpr (ALIGN_EPI) { if (wr == 1) PG8_BAR; }
    }
    PG8_WAIT_V(0);
    if constexpr (!ALIGN_EPI) { if (wr == 0) PG8_BAR; }
    PG8_BAR;
    if constexpr (Epi::AFTER_DRAIN) { E.fused(acc, cur, wr, wc, fr, fq, lds, wid, lane); S.done(cur); }
#undef PG8_SA
#undef PG8_SB
#undef PG8_STAGE
#undef PG8_LDA
#undef PG8_LDB
#undef PG8_MMA
#undef PG8_WAIT_V
#undef PG8_WAIT_L
#undef PG8_BAR
#undef PG8_SCHED
}
}

DI void rope_pair8(float (&x1)[8], float (&x2)[8], const f32x2* cs) {
#pragma unroll
  for (int j = 0; j < 8; ++j) { const f32x2 c = cs[j]; const float a = x1[j], b = x2[j]; x1[j] = a * c.x - b * c.y; x2[j] = a * c.y + b * c.x; }
}
typedef pg8::Unit Unit;
#define ACC_T const f32x4 (&acc)[2][2][4][2]
#define EROW(u, ai, m) ((u).pm * 256 + (ai) * 128 + wr * 64 + (m) * 16 + fr)
DI u32x4 pack_f8(const f32x4 a, const f32x4 b) { u32x4 w; w.x = pk2(a[0], a[1]); w.y = pk2(a[2], a[3]); w.z = pk2(b[0], b[1]); w.w = pk2(b[2], b[3]); return w; }

struct EpiInproj {
  static constexpr bool PERM = true, AFTER_DRAIN = false;
  bf16_t* Z; bf16_t* VCT; bf16_t* VBT; float* ssq_q; float* ssq_kv;
  DI void operator()(ACC_T, const Unit& u, int wr, int wc, int fr, int fq) const {
#pragma unroll
    for (int bj = 0; bj < 2; ++bj) {
      const int tt = 2 * u.pn + bj, cb = tt * 128 + wc * 32 + 8 * fq;
      int sh = 0; if (tt >= 6 && tt < 42) sh = 2 * (((tt - 6) >> 2) % 3);
      const int msk = (1 << sh) - 1;
      if (tt >= 38 && tt < 42) {
        bf16_t* vt = VBT + (size_t)(cb - GC_VB) * S + fr * (S >> 4) + u.pm * 16 + wr * 4;
#pragma unroll
        for (int ai = 0; ai < 2; ++ai)
#pragma unroll
          for (int n = 0; n < 2; ++n) {
            __builtin_amdgcn_sched_barrier(0);
#pragma unroll
            for (int e = 0; e < 4; ++e) {
              u32x2 w; w.x = pk2(acc[ai][bj][0][n][e], acc[ai][bj][1][n][e]); w.y = pk2(acc[ai][bj][2][n][e], acc[ai][bj][3][n][e]);
              *(u32x2*)(vt + (size_t)(4 * n + e) * S + ai * 8) = w;
            }
          }
      } else if (tt == 47 || (tt >= 30 && tt < 38)) {
        bf16_t* vt = (tt == 47) ? VCT + (size_t)(cb - GC_VC) * S : VBT + (size_t)(cb - GC_VB) * S;
#pragma unroll
        for (int ai = 0; ai < 2; ++ai)
#pragma unroll
          for (int m = 0; m < 4; ++m) {
            __builtin_amdgcn_sched_barrier(0);
            const int row = EROW(u, ai, m), prow = (row & msk) * (S >> sh) + (row >> sh);
            bf16_t* vp = vt + prow;
#pragma unroll
            for (int n = 0; n < 2; ++n)
#pragma unroll
              for (int e = 0; e < 4; ++e) vp[(size_t)(4 * n + e) * S] = f2bf(acc[ai][bj][m][n][e]);
          }
      } else {
        const int zc = cb < GC_VB ? cb : cb - 1536;
        float* ssq = (tt < 3) ? ssq_q : ((tt < 5) ? ssq_kv : nullptr);
#pragma unroll
        for (int ai = 0; ai < 2; ++ai)
#pragma unroll
          for (int m = 0; m < 4; ++m) {
            const int row = EROW(u, ai, m), prow = (row & msk) * (S >> sh) + (row >> sh);
            const f32x4 v0 = acc[ai][bj][m][0], v1 = acc[ai][bj][m][1];
            *(u32x4*)(Z + (size_t)prow * ZP + zc) = pack_f8(v0, v1);
            if (ssq) {
              float s = v0[0] * v0[0] + v0[1] * v0[1] + v0[2] * v0[2] + v0[3] * v0[3] + v1[0] * v1[0] + v1[1] * v1[1] + v1[2] * v1[2] + v1[3] * v1[3];
              s += __shfl_xor(s, 16); s += __shfl_xor(s, 32);
              if (fq == 0) __hip_atomic_fetch_add(ssq + row, s, __ATOMIC_RELAXED, __HIP_MEMORY_SCOPE_AGENT);
            }
          }
      }
    }
  }
};
struct EpiUpQ {
  static constexpr bool PERM = true, AFTER_DRAIN = false;
  bf16_t* QA; const float* ssq;
  DI void operator()(ACC_T, const Unit& u, int wr, int wc, int fr, int fq) const {
#pragma unroll
    for (int ai = 0; ai < 2; ++ai)
#pragma unroll
      for (int m = 0; m < 4; ++m) {
        const int row = EROW(u, ai, m); const float rs = rsqrtf(ssq[row] * (1.0f / 384.0f) + 1e-6f);
#pragma unroll
        for (int bj = 0; bj < 2; ++bj) {
          const int cb = u.pn * 256 + bj * 128 + wc * 32 + 8 * fq;
          *(u32x4*)(QA + (size_t)row * 768 + cb) = pack_f8(acc[ai][bj][m][0] * rs, acc[ai][bj][m][1] * rs);
        }
      }
  }
};
struct EpiUpKV {
  static constexpr bool PERM = true, AFTER_DRAIN = false;
  bf16_t* KA; bf16_t* VAT; const float* ssq;
  DI void operator()(ACC_T, const Unit& u, int wr, int wc, int fr, int fq) const {
#pragma unroll
    for (int ai = 0; ai < 2; ++ai)
#pragma unroll
      for (int m = 0; m < 4; ++m) {
        __builtin_amdgcn_sched_barrier(0);
        const int row = EROW(u, ai, m); const float rs = rsqrtf(ssq[row] * (1.0f / 256.0f) + 1e-6f);
#pragma unroll
        for (int bj = 0; bj < 2; ++bj) {
          const int head = 2 * u.pn + bj, w0 = wc * 32 + 8 * fq;
          if (wc < 2) {
            *(u32x4*)(KA + (size_t)row * 512 + head * 64 + w0) = pack_f8(acc[ai][bj][m][0] * rs, acc[ai][bj][m][1] * rs);
          } else {
            bf16_t* vp = VAT + (size_t)(head * 64 + w0 - 64) * S + row;
#pragma unroll
            for (int n = 0; n < 2; ++n)
#pragma unroll
              for (int e = 0; e < 4; ++e) vp[(size_t)(4 * n + e) * S] = f2bf(acc[ai][bj][m][n][e] * rs);
          }
        }
      }
  }
};
struct EpiMerge {
  static constexpr bool PERM = true, AFTER_DRAIN = false;
  const bf16_t* Z; bf16_t* MIX;
  DI void operator()(ACC_T, const Unit& u, int wr, int wc, int fr, int fq) const {
    const int b = u.pm >> 6, pm = u.pm & 63, pn = u.pn & 3;
#pragma unroll
    for (int ai = 0; ai < 2; ++ai)
#pragma unroll
      for (int m = 0; m < 4; ++m) {
        const int row = pm * 256 + ai * 128 + wr * 64 + m * 16 + fr;
#pragma unroll
        for (int bj = 0; bj < 2; ++bj) {
          const int col = pn * 256 + bj * 128 + wc * 32 + 8 * fq;
          const u32x4 g = *(const u32x4*)(Z + (size_t)row * ZP + ZC_GATE + b * 1024 + col);
          f32x4 v0 = acc[ai][bj][m][0], v1 = acc[ai][bj][m][1];
#pragma unroll
          for (int q = 0; q < 2; ++q) {
            v0[2 * q] *= 1.0f / (1.0f + __expf(-bflo(g[q]))); v0[2 * q + 1] *= 1.0f / (1.0f + __expf(-bfhi(g[q])));
            v1[2 * q] *= 1.0f / (1.0f + __expf(-bflo(g[2 + q]))); v1[2 * q + 1] *= 1.0f / (1.0f + __expf(-bfhi(g[2 + q])));
          }
          bf16_t* mp = MIX + (size_t)row * DM + col;
          if (b > 0) { const u32x4 o = *(const u32x4*)mp;
#pragma unroll
            for (int q = 0; q < 2; ++q) { v0[2 * q] += bflo(o[q]); v0[2 * q + 1] += bfhi(o[q]); v1[2 * q] += bflo(o[2 + q]); v1[2 * q + 1] += bfhi(o[2 + q]); } }
          *(u32x4*)mp = pack_f8(v0, v1);
        }
      }
  }
};
template <bool NORM_OUT> struct EpiResid {
  static constexpr bool PERM = false, AFTER_DRAIN = false;
  const float* xs; float* xd; bf16_t* xb; float* ssq;
  DI void operator()(ACC_T, const Unit& u, int wr, int wc, int fr, int fq) const {
#pragma unroll
    for (int ai = 0; ai < 2; ++ai)
#pragma unroll
      for (int m = 0; m < 4; ++m) {
        const int row = EROW(u, ai, m);
        const size_t ro = (size_t)row * DM + u.pn * 256 + wc * 32 + 4 * fq;
        float ss = 0.f;
#pragma unroll
        for (int bj = 0; bj < 2; ++bj)
#pragma unroll
          for (int n = 0; n < 2; ++n) {
            const size_t o = ro + bj * 128 + n * 16; const f32x4 x = *(const f32x4*)(xs + o) + acc[ai][bj][m][n]; *(f32x4*)(xd + o) = x;
            if (NORM_OUT) { u32x2 w; w.x = pk2(x[0], x[1]); w.y = pk2(x[2], x[3]); *(u32x2*)(xb + o) = w; ss += x[0] * x[0] + x[1] * x[1] + x[2] * x[2] + x[3] * x[3]; }
          }
        if (NORM_OUT) { ss += __shfl_xor(ss, 16); ss += __shfl_xor(ss, 32); if (fq == 0) __hip_atomic_fetch_add(ssq + row, ss, __ATOMIC_RELAXED, __HIP_MEMORY_SCOPE_AGENT); }
      }
  }
};
struct EpiRelu2 {
  static constexpr bool PERM = true, AFTER_DRAIN = false;
  bf16_t* HID; const float* ssq;
  DI void operator()(ACC_T, const Unit& u, int wr, int wc, int fr, int fq) const {
#pragma unroll
    for (int ai = 0; ai < 2; ++ai)
#pragma unroll
      for (int m = 0; m < 4; ++m) {
        const int row = EROW(u, ai, m); const float rs = rsqrtf(ssq[row] * (1.0f / DM) + 1e-6f);
#pragma unroll
        for (int bj = 0; bj < 2; ++bj) {
          f32x4 v0 = acc[ai][bj][m][0], v1 = acc[ai][bj][m][1];
#pragma unroll
          for (int e = 0; e < 4; ++e) { const float a = fmaxf(v0[e], 0.f) * rs, c = fmaxf(v1[e], 0.f) * rs; v0[e] = a * a; v1[e] = c * c; }
          *(u32x4*)(HID + (size_t)row * DFF + u.pn * 256 + bj * 128 + wc * 32 + 8 * fq) = pack_f8(v0, v1);
        }
      }
  }
};
struct DiagOrder {
  pg8::StaticOrder so; int G, c;
  DI void init(int G_, int c_) { so.init(S, 1024, G_, c_); G = G_; c = c_; }
  DI bool next(int i, Unit& u) const { const int tile = (i / 3) * G + c, b = i % 3; if (tile >= 256) return false; so.map(tile, u); u.pm += 64 * b; u.pn += 4 * b; return true; }
  DI void a_ready(const Unit&) const {}
  DI void done(const Unit&) const {}
};
#define GEMM_LDS ((PG8_LAS unsigned char*)smem)

DI void phase_kpost(const Params& p, int layer) {
  bf16_t* Z = (bf16_t*)(p.ws + OFF_Z);
  const f32x2* CS = (const f32x2*)(p.ws + OFF_CS);
  for (int it = (int)gridDim.x - 1 - (int)blockIdx.x; it < 96; it += gridDim.x) {
      const int tid = otid();
      const int idx = it * 512 + tid;
      const int unit = idx / S, tkn = idx % S;
      if (unit < 2) {
        bf16_t* kp = Z + (size_t)tkn * ZP + ZC_KC + unit * 64;
        float x[8][8]; float ss = 0.f;
#pragma unroll
        for (int c = 0; c < 8; ++c) { const u32x4 v = *(const u32x4*)(kp + c * 8);
#pragma unroll
          for (int q = 0; q < 4; ++q) { x[c][2 * q] = bflo(v[q]); x[c][2 * q + 1] = bfhi(v[q]); ss += x[c][2 * q] * x[c][2 * q] + x[c][2 * q + 1] * x[c][2 * q + 1]; } }
        const float rs = rsqrtf(ss * (1.0f / 64.0f) + 1e-6f);
        const float* gk = p.c_k_norm + layer * 64;
#pragma unroll
        for (int c = 0; c < 8; ++c)
#pragma unroll
          for (int q = 0; q < 8; ++q) x[c][q] *= rs * gk[c * 8 + q];
        const f32x2* cr = CS + (size_t)(tkn >> 6) * 16; const f32x2* cc = CS + (size_t)(tkn & 63) * 16;
        rope_pair8(x[0], x[2], cr); rope_pair8(x[1], x[3], cr + 8);
        rope_pair8(x[4], x[6], cc); rope_pair8(x[5], x[7], cc + 8);
#pragma unroll
        for (int c = 0; c < 8; ++c) { u32x4 w; w.x = pk2(x[c][0], x[c][1]); w.y = pk2(x[c][2], x[c][3]); w.z = pk2(x[c][4], x[c][5]); w.w = pk2(x[c][6], x[c][7]); *(u32x4*)(kp + c * 8) = w; }
      } else {
        bf16_t* kp = Z + (size_t)tkn * ZP + ZC_KR;
        float x[4][8];
#pragma unroll
        for (int c = 0; c < 4; ++c) { const u32x4 v = *(const u32x4*)(kp + c * 8);
#pragma unroll
          for (int q = 0; q < 4; ++q) { x[c][2 * q] = bflo(v[q]); x[c][2 * q + 1] = bfhi(v[q]); } }
        const f32x2* cp = CS + (size_t)tkn * 16;
        rope_pair8(x[0], x[2], cp); rope_pair8(x[1], x[3], cp + 8);
#pragma unroll
        for (int c = 0; c < 4; ++c) { u32x4 w; w.x = pk2(x[c][0], x[c][1]); w.y = pk2(x[c][2], x[c][3]); w.z = pk2(x[c][4], x[c][5]); w.w = pk2(x[c][6], x[c][7]); *(u32x4*)(kp + c * 8) = w; }
      }
  }
}

DI bf16x8 pack8(float a0, float a1, float a2, float a3, float a4, float a5, float a6, float a7) {
  u32x4 w; w.x = pk2(a0, a1); w.y = pk2(a2, a3); w.z = pk2(a4, a5); w.w = pk2(a6, a7); return __builtin_bit_cast(bf16x8, w);
}
DI void unpack8(const u32x4 v, float (&x)[8]) {
#pragma unroll
  for (int q = 0; q < 4; ++q) { x[2 * q] = bflo(v[q]); x[2 * q + 1] = bfhi(v[q]); }
}

DI void store_o_wide(bf16_t* rowp, const f32x16& o, float inv, int h) {
#pragma unroll
  for (int pr = 0; pr < 2; ++pr) {
    const int g = 2 * pr;
    const unsigned ax = pk2(o[4 * g] * inv, o[4 * g + 1] * inv), ay = pk2(o[4 * g + 2] * inv, o[4 * g + 3] * inv);
    const unsigned bx = pk2(o[4 * g + 4] * inv, o[4 * g + 5] * inv), by = pk2(o[4 * g + 6] * inv, o[4 * g + 7] * inv);
    const auto sx = __builtin_amdgcn_permlane32_swap(ax, bx, false, false);
    const auto sy = __builtin_amdgcn_permlane32_swap(ay, by, false, false);
    const u32x4 w = {sx[0], sy[0], sx[1], sy[1]};
    *(u32x4*)(rowp + 8 * (g + h)) = w;
  }
}

constexpr int ATT_STAGE = 20480;

template <int TYPE>
DI void attn_dense_unit(const Params& p, int layer, int head, int qb, char* lds) {
  constexpr int NQK = TYPE == 0 ? 6 : 4;
  const int tid = otid(), lane = tid & 63, wid = wave_of(tid), r = lane & 31, h = lane >> 5;
  const bf16_t* Z = (const bf16_t*)(p.ws + OFF_Z);
  const f32x2* CS = (const f32x2*)(p.ws + OFF_CS);
  const bf16_t* Kn; int ldk; const bf16_t* VT; bf16_t* O;
  if (TYPE == 0) { Kn = (const bf16_t*)(p.ws + OFF_KA) + head * 64; ldk = 512; VT = (const bf16_t*)(p.ws + OFF_VAT) + (size_t)head * 64 * S; O = (bf16_t*)(p.ws + OFF_OA); }
  else { const int kvh = head >> 2; Kn = Z + ZC_KC + kvh * 64; ldk = ZP; VT = (const bf16_t*)(p.ws + OFF_VCT) + (size_t)kvh * 64 * S; O = (bf16_t*)(p.ws + OFF_OC); }
  const int q = qb * 256 + wid * 32 + r;
  bf16x8 qf[NQK];
  if (TYPE == 0) {
    const bf16_t* qp = (const bf16_t*)(p.ws + OFF_QA) + (size_t)q * 768 + head * 96 + 8 * h;
    float x[6][8];
#pragma unroll
    for (int d0 = 0; d0 < 6; ++d0) unpack8(*(const u32x4*)(qp + d0 * 16), x[d0]);
    rope_pair8(x[4], x[5], CS + (size_t)q * 16 + 8 * h);
    const float sc = 0.10206207261596577f * LOG2E;
#pragma unroll
    for (int d0 = 0; d0 < 6; ++d0) qf[d0] = pack8(x[d0][0] * sc, x[d0][1] * sc, x[d0][2] * sc, x[d0][3] * sc, x[d0][4] * sc, x[d0][5] * sc, x[d0][6] * sc, x[d0][7] * sc);
  } else {
    const bf16_t* qp = Z + (size_t)q * ZP + ZC_QC + head * 64 + 8 * h;
    float x[4][8]; float ss = 0.f;
#pragma unroll
    for (int d0 = 0; d0 < 4; ++d0) { unpack8(*(const u32x4*)(qp + d0 * 16), x[d0]);
#pragma unroll
      for (int j = 0; j < 8; ++j) ss += x[d0][j] * x[d0][j]; }
    ss += __shfl_xor(ss, 32);
    const float rs = rsqrtf(ss * (1.0f / 64.0f) + 1e-6f);
    const float* gq = p.c_q_norm + layer * 64;
#pragma unroll
    for (int d0 = 0; d0 < 4; ++d0)
#pragma unroll
      for (int j = 0; j < 8; ++j) x[d0][j] *= rs * gq[d0 * 16 + 8 * h + j];
    rope_pair8(x[0], x[1], CS + (size_t)(q >> 6) * 16 + 8 * h);
    rope_pair8(x[2], x[3], CS + (size_t)(q & 63) * 16 + 8 * h);
    const float sc = 0.125f * LOG2E;
#pragma unroll
    for (int d0 = 0; d0 < 4; ++d0) qf[d0] = pack8(x[d0][0] * sc, x[d0][1] * sc, x[d0][2] * sc, x[d0][3] * sc, x[d0][4] * sc, x[d0][5] * sc, x[d0][6] * sc, x[d0][7] * sc);
  }
  typedef __attribute__((address_space(3))) unsigned lds_u32;
  const int srow = tid >> 3, sch = (tid & 7) ^ ((srow >> 1) & 7);
  const bf16_t* gk = Kn + (size_t)srow * ldk + sch * 8;
  const bf16_t* gv = VT + (size_t)srow * S + sch * 8;
  const int rrow = tid >> 2, rch = (tid & 3) ^ ((rrow >> 2) & 3);
  const bf16_t* gr = Z + ZC_KR + (size_t)rrow * ZP + rch * 8;
  char* wbase = lds + wid * 1024;
#define DMA(t, soff) do { \
    __builtin_amdgcn_global_load_lds((const unsigned*)(gk + (size_t)(t) * 64 * ldk), (lds_u32*)(wbase + (soff)), 16, 0, 0); \
    __builtin_amdgcn_global_load_lds((const unsigned*)(gv + (size_t)(t) * 64), (lds_u32*)(wbase + (soff) + 8192), 16, 0, 0); \
    if (TYPE == 0 && wid < 4) __builtin_amdgcn_global_load_lds((const unsigned*)(gr + (size_t)(t) * 64 * ZP), (lds_u32*)(wbase + (soff) + 16384), 16, 0, 0); } while (0)
#define DMA_WAIT(keep) do { if (keep) { if (TYPE == 0 && wid < 4) asm volatile("s_waitcnt vmcnt(3)" ::: "memory"); else asm volatile("s_waitcnt vmcnt(2)" ::: "memory"); } \
    else asm volatile("s_waitcnt vmcnt(0)" ::: "memory"); } while (0)
#define BAR() do { asm volatile("s_waitcnt lgkmcnt(0)" ::: "memory"); __builtin_amdgcn_s_barrier(); asm volatile("" ::: "memory"); } while (0)
  constexpr int NONES = (TYPE == 0) ? 0 : 2;
  float m_run = 0.f, lsum = 0.f; f32x16 o0, o1, negm, la;
#pragma unroll
  for (int i = 0; i < 16; ++i) { o0[i] = 0.f; o1[i] = 0.f; negm[i] = 0.f; la[i] = 0.f; }
  const bf16x8 ones = {0x3F80, 0x3F80, 0x3F80, 0x3F80, 0x3F80, 0x3F80, 0x3F80, 0x3F80};
  const int rK = (r & ~12) | ((r & 4) << 1) | ((r & 8) >> 1);
  const int ksw = (rK >> 1) & 7, rsw = (rK >> 2) & 3, vsw = (r >> 1) & 7;
  int koff[4], roff[2], voff[4];
#pragma unroll
  for (int d0 = 0; d0 < 4; ++d0) { koff[d0] = rK * 128 + (((2 * d0 + h) ^ ksw) << 4); voff[d0] = 8192 + r * 128 + (((2 * d0 + h) ^ vsw) << 4); }
#pragma unroll
  for (int d0 = 0; d0 < 2; ++d0) roff[d0] = 16384 + rK * 64 + (((2 * d0 + h) ^ rsw) << 4);
  constexpr int NT = S / 64;
  constexpr float THR = 8.0f;
#define SB() __builtin_amdgcn_sched_barrier(0)
#define QKR(d0, K0, K1, SOFF) do { if ((d0) < 4) { K0 = *(const bf16x8*)(lds + (SOFF) + koff[(d0) & 3]); K1 = *(const bf16x8*)(lds + (SOFF) + 32 * 128 + koff[(d0) & 3]); } \
    else if ((d0) < NQK) { K0 = *(const bf16x8*)(lds + (SOFF) + roff[(d0) & 1]); K1 = *(const bf16x8*)(lds + (SOFF) + 32 * 64 + roff[(d0) & 1]); } } while (0)
#define QKM(N0, N1, d0, K0, K1) do { if ((d0) == 0) { N0 = MFMA(K0, qf[0], negm); N1 = MFMA(K1, qf[0], negm); } \
    else if ((d0) < NQK) { N0 = MFMA(K0, qf[(d0) < NQK ? (d0) : 0], N0); N1 = MFMA(K1, qf[(d0) < NQK ? (d0) : 0], N1); } } while (0)
#define EX4(CC, B, SI) do { __builtin_amdgcn_s_setprio(1); _Pragma("unroll") for (int i_ = 0; i_ < 4; ++i_) { CC[(B) + i_] = fexp2(CC[(B) + i_]); if ((SI) >= NONES) lsum += CC[(B) + i_]; } __builtin_amdgcn_s_setprio(0); } while (0)
#define PK8(PF, CC, B) do { PF = pack8(CC[(B)], CC[(B) + 1], CC[(B) + 2], CC[(B) + 3], CC[(B) + 4], CC[(B) + 5], CC[(B) + 6], CC[(B) + 7]); } while (0)
#define VR(s_, V0, V1, SOFF) do { V0 = *(const bf16x8*)(lds + (SOFF) + voff[s_]); V1 = *(const bf16x8*)(lds + (SOFF) + 32 * 128 + voff[s_]); } while (0)
#define PVM(s_, V0, V1) do { o0 = MFMA(V0, pf[s_], o0); o1 = MFMA(V1, pf[s_], o1); if ((s_) < NONES) la = MFMA(ones, pf[s_], la); } while (0)
#define MAXG(NN, B) do { ma_ = fmaxf(fmaxf(ma_, NN[(B)]), NN[(B) + 1]); mb_ = fmaxf(fmaxf(mb_, NN[(B) + 2]), NN[(B) + 3]); \
    ma_ = fmaxf(fmaxf(ma_, NN[(B) + 4]), NN[(B) + 5]); mb_ = fmaxf(fmaxf(mb_, NN[(B) + 6]), NN[(B) + 7]); } while (0)
#define ROWMAX(P0, P1, MX) do { float a_ = fmaxf(fmaxf(P0[0], P0[1]), P1[0]), c_ = fmaxf(fmaxf(P0[2], P0[3]), P1[1]); a_ = fmaxf(fmaxf(a_, P1[2]), P1[3]); \
    _Pragma("unroll") for (int i_ = 4; i_ < 16; i_ += 4) { a_ = fmaxf(fmaxf(a_, P0[i_]), P0[i_ + 1]); c_ = fmaxf(fmaxf(c_, P0[i_ + 2]), P0[i_ + 3]); a_ = fmaxf(fmaxf(a_, P1[i_]), P1[i_ + 1]); c_ = fmaxf(fmaxf(c_, P1[i_ + 2]), P1[i_ + 3]); } \
    a_ = fmaxf(a_, c_); MX = fmaxf(a_, __shfl_xor(a_, 32)); } while (0)
#define RESCALE(P0, P1, DELTA) do { const float dl_ = (DELTA); m_run += dl_; const float al_ = fexp2(-dl_); lsum *= al_; \
    _Pragma("unroll") for (int i_ = 0; i_ < 16; ++i_) { P0[i_] -= dl_; P1[i_] -= dl_; o0[i_] *= al_; o1[i_] *= al_; if (NONES > 0) la[i_] *= al_; negm[i_] = -m_run; } } while (0)
#define STEP(C0, C1, N0, N1, T, HAS_NEXT, HAS_LOAD, S0, S1, S3) do { \
    if (HAS_LOAD) DMA((T) + 3, S3); \
    bf16x8 pf[4]; bf16x8 ka0, ka1, kb0, kb1, va0, va1, vb0, vb1; \
    if (HAS_NEXT) QKR(0, ka0, ka1, S1); \
    SB(); if (HAS_NEXT) { QKR(1, kb0, kb1, S1); QKM(N0, N1, 0, ka0, ka1); } EX4(C0, 0, 0); \
    SB(); if (HAS_NEXT) { QKR(2, ka0, ka1, S1); QKM(N0, N1, 1, kb0, kb1); } EX4(C0, 4, 0); PK8(pf[0], C0, 0); \
    SB(); if (HAS_NEXT) { QKR(3, kb0, kb1, S1); QKM(N0, N1, 2, ka0, ka1); } EX4(C0, 8, 1); \
    SB(); if (HAS_NEXT) { QKR(4, ka0, ka1, S1); QKM(N0, N1, 3, kb0, kb1); } EX4(C0, 12, 1); PK8(pf[1], C0, 8); if (NQK == 4) VR(0, va0, va1, S0); \
    if (NQK > 4) { \
      SB(); if (HAS_NEXT) { QKR(5, kb0, kb1, S1); QKM(N0, N1, 4, ka0, ka1); } EX4(C1, 0, 2); \
      SB(); if (HAS_NEXT) QKM(N0, N1, 5, kb0, kb1); EX4(C1, 4, 2); PK8(pf[2], C1, 0); VR(0, va0, va1, S0); } \
    float ma_ = -1e30f, mb_ = -1e30f; \
    if (NQK == 4) { \
      SB(); VR(1, vb0, vb1, S0); PVM(0, va0, va1); EX4(C1, 0, 2); EX4(C1, 4, 2); PK8(pf[2], C1, 0); \
      SB(); VR(2, va0, va1, S0); PVM(1, vb0, vb1); EX4(C1, 8, 3); EX4(C1, 12, 3); PK8(pf[3], C1, 8); \
    } else { \
      SB(); VR(1, vb0, vb1, S0); PVM(0, va0, va1); EX4(C1, 8, 3); \
      SB(); VR(2, va0, va1, S0); PVM(1, vb0, vb1); EX4(C1, 12, 3); PK8(pf[3], C1, 8); } \
    SB(); VR(3, vb0, vb1, S0); PVM(2, va0, va1); if (HAS_NEXT) { MAXG(N0, 0); MAXG(N0, 8); } \
    SB(); PVM(3, vb0, vb1); if (HAS_NEXT) { MAXG(N1, 0); MAXG(N1, 8); } \
    SB(); \
    float mx_ = fmaxf(ma_, mb_); { const auto rr_ = __builtin_amdgcn_permlane32_swap(__float_as_uint(mx_), __float_as_uint(mx_), false, false); mx_ = fmaxf(__uint_as_float(rr_[0]), __uint_as_float(rr_[1])); } \
    DMA_WAIT(HAS_LOAD); BAR(); \
    if (HAS_NEXT) { if (__any(mx_ > THR)) RESCALE(N0, N1, fmaxf(mx_, 0.f)); } } while (0)
  constexpr int R0 = 0, R1 = ATT_STAGE, R2 = 2 * ATT_STAGE, R3 = 3 * ATT_STAGE;
  f32x16 sA0, sA1, sB0, sB1;
  DMA(0, R0); DMA(1, R1); DMA(2, R2); DMA_WAIT(true); BAR();
  { bf16x8 ka0, ka1;
#pragma unroll
    for (int d0 = 0; d0 < NQK; ++d0) { QKR(d0, ka0, ka1, R0); QKM(sA0, sA1, d0, ka0, ka1); } }
  { float mx0; ROWMAX(sA0, sA1, mx0); m_run = mx0;
#pragma unroll
    for (int i = 0; i < 16; ++i) { sA0[i] -= mx0; sA1[i] -= mx0; negm[i] = -mx0; } }
  for (int t = 0; t < NT - 4; t += 4) {
    STEP(sA0, sA1, sB0, sB1, t, true, true, R0, R1, R3);
    STEP(sB0, sB1, sA0, sA1, t + 1, true, true, R1, R2, R0);
    STEP(sA0, sA1, sB0, sB1, t + 2, true, true, R2, R3, R1);
    STEP(sB0, sB1, sA0, sA1, t + 3, true, true, R3, R0, R2);
  }
  STEP(sA0, sA1, sB0, sB1, NT - 4, true, true, R0, R1, R3);
  STEP(sB0, sB1, sA0, sA1, NT - 3, true, false, R1, R2, R0);
  STEP(sA0, sA1, sB0, sB1, NT - 2, true, false, R2, R3, R1);
  STEP(sB0, sB1, sA0, sA1, NT - 1, false, false, R3, R0, R2);
  const float l = (NONES > 0 ? la[0] : 0.f) + lsum + __shfl_xor(lsum, 32);
#undef DMA
#undef DMA_WAIT
#undef BAR
#undef SB
#undef QKR
#undef QKM
#undef EX4
#undef PK8
#undef VR
#undef PVM
#undef MAXG
#undef ROWMAX
#undef RESCALE
#undef STEP
  const float inv = 1.0f / l;
  bf16_t* op = O + (size_t)q * 512 + head * 64;
  store_o_wide(op, o0, inv, h); store_o_wide(op + 32, o1, inv, h);
}

constexpr int BLV = 49152;
DI void b_issue_k(const Params& p, int x, char* lds, int tid, int wid) {
  typedef __attribute__((address_space(3))) unsigned lds_u32;
  const int g = x >> 9, head = (x >> 6) & 7, blk256 = x & 63;
  const int sh = 2 * g, Ls = S >> sh, P0 = blk256 * 256, sub = P0 / Ls, i0 = P0 & (Ls - 1), sub0 = sub * Ls;
  const bf16_t* Zk = (const bf16_t*)(p.ws + OFF_Z) + ZC_QKVB + ((1 * 3 + g) * 8 + head) * 64;
#pragma unroll
  for (int i = 0; i < 6; ++i) {
    const int sl = i * 512 + tid, row = sl >> 3, c = (sl & 7) ^ ((row >> 1) & 7); int key = i0 - 64 + row; key = key < 0 ? 0 : (key > Ls - 1 ? Ls - 1 : key);
    __builtin_amdgcn_global_load_lds((const unsigned*)(Zk + (size_t)(sub0 + key) * ZP + c * 8), (lds_u32*)(lds + (i * 512 + wid * 64) * 16), 16, 0, 0);
  }
}
DI void b_issue_v(const Params& p, int x, char* lds, int tid, int wid) {
  typedef __attribute__((address_space(3))) unsigned lds_u32;
  const int g = x >> 9, head = (x >> 6) & 7, blk256 = x & 63;
  const int sh = 2 * g, Ls = S >> sh, P0 = blk256 * 256, sub = P0 / Ls, i0 = P0 & (Ls - 1), sub0 = sub * Ls;
  const bf16_t* VTg = (const bf16_t*)(p.ws + OFF_VBT) + (size_t)((g * 8 + head) * 64) * S + sub0;
#pragma unroll
  for (int i = 0; i < 6; ++i) {
    const int sl = i * 512 + tid, d = sl / 48, c = (sl - d * 48) ^ (d & 15); int k0 = i0 - 64 + 8 * c; k0 = k0 < 0 ? 0 : (k0 > Ls - 8 ? Ls - 8 : k0);
    __builtin_amdgcn_global_load_lds((const unsigned*)(VTg + (size_t)d * S + k0), (lds_u32*)(lds + BLV + (i * 512 + wid * 64) * 16), 16, 0, 0);
  }
}
DI void attn_b_item(const Params& p, int x, int xnext, char* lds) {
  const int tid = otid(), lane = tid & 63, wid = wave_of(tid), r = lane & 31, h = lane >> 5;
  const int g = x >> 9, head = (x >> 6) & 7, blk256 = x & 63;
  const bf16_t* Z = (const bf16_t*)(p.ws + OFF_Z);
  const int sh = 2 * g, Ls = S >> sh, P0 = blk256 * 256, sub = P0 / Ls, i0 = P0 & (Ls - 1);
  const bf16_t* Zq = Z + ZC_QKVB + ((0 * 3 + g) * 8 + head) * 64;
  constexpr int LV = BLV;
  const int i0w = i0 + 32 * wid;
  const float* BT = (const float*)(p.ws + OFF_BT) + (g * 8 + head) * 256 + 32 - r + 8 * h;
  const int rK = (r & ~12) | ((r & 4) << 1) | ((r & 8) >> 1);
  bf16x8 qf[4];
  {
    const bf16_t* qp = Zq + (size_t)(P0 + 32 * wid + r) * ZP + 8 * h; const float scq = 0.125f * LOG2E;
#pragma unroll
    for (int d0 = 0; d0 < 4; ++d0) { float x8[8]; unpack8(*(const u32x4*)(qp + d0 * 16), x8); qf[d0] = pack8(x8[0] * scq, x8[1] * scq, x8[2] * scq, x8[3] * scq, x8[4] * scq, x8[5] * scq, x8[6] * scq, x8[7] * scq); }
  }
  float bvs[5][16];
#pragma unroll
  for (int c = 0; c < 5; ++c)
#pragma unroll
    for (int i = 0; i < 16; ++i) bvs[c][i] = BT[32 * c + (i & 3) + 4 * ((i >> 2) & 1) + 16 * (i >> 3)];
  asm volatile("s_waitcnt vmcnt(0)" ::: "memory"); __builtin_amdgcn_s_barrier(); asm volatile("" ::: "memory");
#pragma unroll
  for (int c = 0; c < 5; ++c)
#pragma unroll
    for (int i = 0; i < 16; ++i) asm volatile("" : "+v"(bvs[c][i]));
  f32x16 sc[5];
  const int ksw = (rK >> 1) & 7;
#pragma unroll
  for (int c = 0; c < 5; ++c) {
#pragma unroll
    for (int i = 0; i < 16; ++i) sc[c][i] = 0.f;
    const char* kp = lds + (32 * wid + 32 * c + rK) * 128;
#pragma unroll
    for (int d0 = 0; d0 < 4; ++d0) { const bf16x8 kf = *(const bf16x8*)(kp + (((2 * d0 + h) ^ ksw) << 4)); sc[c] = MFMA(kf, qf[d0], sc[c]); }
  }
  asm volatile("s_waitcnt lgkmcnt(0)" ::: "memory"); __builtin_amdgcn_s_barrier(); asm volatile("" ::: "memory");
  if (xnext >= 0) b_issue_k(p, xnext, lds, tid, wid);
  float mx = -1e30f;
#pragma unroll
  for (int c = 0; c < 5; ++c)
#pragma unroll
    for (int i = 0; i < 16; ++i) {
      const int prow = (i & 3) + 4 * ((i >> 2) & 1) + 8 * h + 16 * (i >> 3);
      const int rel = 32 * c - 64 + prow - r, key = i0w + r + rel;
      const bool valid = ((unsigned)(rel + 64) <= 128u) & ((unsigned)key < (unsigned)Ls);
      const float v = valid ? sc[c][i] + bvs[c][i] : -1e30f;
      sc[c][i] = v; mx = fmaxf(mx, v);
    }
  mx = fmaxf(mx, __shfl_xor(mx, 32));
  float l = 0.f;
#pragma unroll
  for (int c = 0; c < 5; ++c)
#pragma unroll
    for (int i = 0; i < 16; ++i) { const float e = fexp2(sc[c][i] - mx); sc[c][i] = e; l += e; }
  l += __shfl_xor(l, 32);
  f32x16 o0, o1;
#pragma unroll
  for (int i = 0; i < 16; ++i) { o0[i] = 0.f; o1[i] = 0.f; }
  const char* vp = lds + LV + r * 768; const int vsw = r & 15;
#pragma unroll
  for (int c = 0; c < 5; ++c)
#pragma unroll
    for (int s = 0; s < 2; ++s) {
      const bf16x8 pf = pack8(sc[c][8 * s], sc[c][8 * s + 1], sc[c][8 * s + 2], sc[c][8 * s + 3], sc[c][8 * s + 4], sc[c][8 * s + 5], sc[c][8 * s + 6], sc[c][8 * s + 7]);
      const int ch = ((4 * wid + 4 * c + 2 * s + h) ^ vsw) << 4;
      const bf16x8 v0 = *(const bf16x8*)(vp + ch), v1 = *(const bf16x8*)(vp + 32 * 768 + ch);
      o0 = MFMA(v0, pf, o0); o1 = MFMA(v1, pf, o1);
    }
  asm volatile("s_waitcnt lgkmcnt(0)" ::: "memory"); __builtin_amdgcn_s_barrier(); asm volatile("" ::: "memory");
  if (xnext >= 0) b_issue_v(p, xnext, lds, tid, wid);
  const float inv = 1.0f / l;
  const int tkn = ((i0w + r) << sh) + sub;
  bf16_t* OG = (g < 2) ? (bf16_t*)(p.ws + OFF_H) + (size_t)g * S * 512 : (bf16_t*)(p.ws + OFF_OB);
  bf16_t* op = OG + (size_t)tkn * 512 + head * 64;
  store_o_wide(op, o0, inv, h); store_o_wide(op + 32, o1, inv, h);
  if (h == 0) { float* LSE = (float*)(p.ws + OFF_LSE); LSE[((size_t)g * S + tkn) * 8 + head] = (mx + __builtin_amdgcn_logf(l)) * LN2; }
}

DI void phase_attn(const Params& p, int layer, char* smem) {
  const int n_dense = 1024, n_b = 1536, total = n_dense + n_b;
  int it = blockIdx.x;
  for (; it < n_dense; it += gridDim.x) {
    if (it < 512) { attn_dense_unit<0>(p, layer, it & 7, it >> 3, smem); }
    else { const int v = it - 512; attn_dense_unit<1>(p, layer, v & 7, v >> 3, smem); }
  }
  if (it < total) {
    const int tid = otid(), wid = wave_of(tid);
    b_issue_k(p, it - n_dense, smem, tid, wid); b_issue_v(p, it - n_dense, smem, tid, wid);
    for (; it < total; it += gridDim.x) {
      const int nx = it + (int)gridDim.x;
      attn_b_item(p, it - n_dense, nx < total ? nx - n_dense : -1, smem);
    }
  }
}

DI void phase_combine(const Params& p) {
  const bf16_t* G0 = (const bf16_t*)(p.ws + OFF_H); const bf16_t* G1 = G0 + (size_t)S * 512; bf16_t* OB = (bf16_t*)(p.ws + OFF_OB);
  const float* LSE = (const float*)(p.ws + OFF_LSE);
  for (int e = blockIdx.x * 512 + otid(); e < S * 64; e += gridDim.x * 512) {
    const int tkn = e >> 6, c = e & 63, head = c >> 3;
    const float l0 = LSE[((size_t)0 * S + tkn) * 8 + head], l1 = LSE[((size_t)1 * S + tkn) * 8 + head], l2 = LSE[((size_t)2 * S + tkn) * 8 + head];
    const float mm = fmaxf(l0, fmaxf(l1, l2));
    float w0 = __expf(l0 - mm), w1 = __expf(l1 - mm), w2 = __expf(l2 - mm);
    const float iw = 1.0f / (w0 + w1 + w2); w0 *= iw; w1 *= iw; w2 *= iw;
    const size_t off = (size_t)tkn * 512 + c * 8;
    const u32x4 a = *(const u32x4*)(G0 + off), b = *(const u32x4*)(G1 + off), d = *(const u32x4*)(OB + off);
    u32x4 o;
#pragma unroll
    for (int q = 0; q < 4; ++q) o[q] = pk2(w0 * bflo(a[q]) + w1 * bflo(b[q]) + w2 * bflo(d[q]), w0 * bfhi(a[q]) + w1 * bfhi(b[q]) + w2 * bfhi(d[q]));
    *(u32x4*)(OB + off) = o;
  }
}

#define XB_TMO      128
#define XB_XCNT(j)  (256  + 64 * (j))
#define XB_XSUB(j)  (1280 + 64 * (j))
#define XB_XGEN(j)  (2304 + 64 * (j))
#define XB_TOP      3328
#define XB_TOPGEN   3392
#define XCD_BAR_WORDS 3456
#define XB_SPIN_CAP (1u << 18)
#ifndef LAS
#define LAS __attribute__((address_space(3)))
#endif

__device__ __forceinline__ unsigned xb_ld(unsigned* p)              { return __hip_atomic_load(p, __ATOMIC_RELAXED, __HIP_MEMORY_SCOPE_AGENT); }
__device__ __forceinline__ unsigned xb_add(unsigned* p, unsigned v) { return __hip_atomic_fetch_add(p, v, __ATOMIC_RELAXED, __HIP_MEMORY_SCOPE_AGENT); }
__device__ __forceinline__ unsigned xb_xcc_id() { return (unsigned)__builtin_amdgcn_s_getreg((3 << 11) | 20) & 0xFu; }
#define XB_SPIN(cond, bar) do { unsigned _sp = 0; while (cond) { __builtin_amdgcn_s_sleep(1); \
    if ((++_sp & 255u) == 0u) { if (xb_ld(&(bar)[XB_TMO])) break; if (_sp > XB_SPIN_CAP) { atomicAdd(&(bar)[XB_TMO], 1u); break; } } } } while (0)

struct XcdBarrier {
    unsigned* bar; unsigned x;
    volatile LAS unsigned* st;
};

__device__ __forceinline__ XcdBarrier xcd_barrier_post(unsigned* bar, volatile LAS unsigned* st) {
    XcdBarrier b; b.bar = bar; b.x = xb_xcc_id(); b.st = st;
    if (threadIdx.x == 0) (void)xb_add(&bar[XB_XCNT(b.x)], 1u);
    return b;
}
__device__ __forceinline__ void xcd_barrier_complete(unsigned* bar, unsigned x, unsigned& nloc, unsigned& nx) {
    const unsigned G = gridDim.x * gridDim.y * gridDim.z;
    unsigned sum, cnt, mine, sp = 0u;
    for (;;) {
        sum = 0u; cnt = 0u; mine = 0u;
#pragma unroll
        for (unsigned j = 0; j < 16; ++j) { const unsigned c = xb_ld(&bar[XB_XCNT(j)]); sum += c; cnt += (c > 0u) ? 1u : 0u; mine = (j == x) ? c : mine; }
        if (sum == G) break;
        __builtin_amdgcn_s_sleep(1);
        if ((++sp & 255u) == 0u) { if (xb_ld(&bar[XB_TMO])) break; if (sp > XB_SPIN_CAP) { atomicAdd(&bar[XB_TMO], 1u); break; } }
    }
    nloc = mine > 0u ? mine : 1u; nx = cnt > 0u ? cnt : 1u;
}

__device__ __forceinline__ void xcd_barrier(const XcdBarrier& b) {
    asm volatile("s_waitcnt vmcnt(0)" ::: "memory");
    __syncthreads();
    if (threadIdx.x == 0) {
        unsigned* bar = b.bar;
        __builtin_amdgcn_s_waitcnt(0);
        unsigned nloc = b.st[0], nx = b.st[1];
        if (nloc == 0u) { xcd_barrier_complete(bar, b.x, nloc, nx); b.st[0] = nloc; b.st[1] = nx; }
        const unsigned old = xb_add(&bar[XB_XSUB(b.x)], 1u);
        const unsigned gen = old / nloc;
        if (old + 1u == (gen + 1u) * nloc) {
            __builtin_amdgcn_fence(__ATOMIC_RELEASE, "agent");
            asm volatile("s_waitcnt vmcnt(0)" ::: "memory");
            const unsigned og = xb_add(&bar[XB_TOP], 1u);
            const unsigned tg = og / nx;
            if (og + 1u == (tg + 1u) * nx) xb_add(&bar[XB_TOPGEN], 1u);
            else XB_SPIN(xb_ld(&bar[XB_TOPGEN]) == tg, bar);
            __builtin_amdgcn_fence(__ATOMIC_ACQUIRE, "agent");
            xb_add(&bar[XB_XGEN(b.x)], 1u);
            asm volatile("s_waitcnt vmcnt(0)" ::: "memory");
        } else {
            XB_SPIN(xb_ld(&bar[XB_XGEN(b.x)]) == gen, bar);
            __builtin_amdgcn_fence(__ATOMIC_ACQUIRE, "agent");
            asm volatile("s_waitcnt vmcnt(0)" ::: "memory");
        }
    }
    __syncthreads();
}

__global__ void __launch_bounds__(512) hybrid_encoder_mega(Params p) {
  extern __shared__ __attribute__((aligned(16))) char smem[];
  cg::grid_group grid = cg::this_grid();
  const int G = gridDim.x, bx = blockIdx.x;
  bf16_t* Z = (bf16_t*)(p.ws + OFF_Z); bf16_t* H = (bf16_t*)(p.ws + OFF_H);
  float* ssq_q = (float*)(p.ws + OFF_SSQ); float* ssq_kv = ssq_q + S; float* ssq_x = ssq_q + 2 * S;
  bf16_t* XB = (bf16_t*)(p.ws + OFF_OA);
  volatile LAS unsigned* xst = (volatile LAS unsigned*)(smem + 131072);
  if (threadIdx.x == 0) { xst[0] = 0u; xst[1] = 0u; xst[2] = 0u; xst[3] = 0u; }
  __syncthreads();
  const XcdBarrier xb = xcd_barrier_post((unsigned*)(p.ws + OFF_BAR), xst);
  bool first_sync = true;
#define GSYNC() do { if (first_sync) { grid.sync(); first_sync = false; } else xcd_barrier(xb); } while (0)
  build_tables(p);
  for (int layer = 0; layer < 2; ++layer) {
    convert_weights(p, layer, smem);
    for (int seq = 0; seq < 3; ++seq) {
      const float* xin = (layer == 0) ? (seq < 2 ? p.x_prompt + (size_t)seq * S * DM : p.x_sample) : p.out + (size_t)seq * S * DM;
      float* xo = p.out + (size_t)seq * S * DM;
      phase_norm(xin, p.norm_mix + layer * DM, H, S);
      { const int tz = otid();
_Pragma("nounroll")
        for (int b = bx; b < 96; b += G) ssq_q[b * 512 + tz] = 0.f; }
      GSYNC();
      { pg8::Gemm g{H, (const bf16_t*)(p.ws + WT_IN), S, 9216, DM, DM, DM}; pg8::StaticOrder so; so.init(S, 9216, G, bx);
        EpiInproj E{Z, (bf16_t*)(p.ws + OFF_VCT), (bf16_t*)(p.ws + OFF_VBT), ssq_q, ssq_kv};
        pg8::gemm_phase<EpiInproj, pg8::StaticOrder, true, true>(GEMM_LDS, g, so, E); }
      GSYNC();
      { pg8::Gemm g{Z + ZC_CQ, (const bf16_t*)(p.ws + WT_UQ), S, 768, 384, ZP, 384}; pg8::StaticOrder so; so.init(S, 768, G, bx);
        EpiUpQ E{(bf16_t*)(p.ws + OFF_QA), ssq_q};
        pg8::gemm_phase<EpiUpQ, pg8::StaticOrder, true, true>(GEMM_LDS, g, so, E); }
      { pg8::Gemm g{Z + ZC_CKV, (const bf16_t*)(p.ws + WT_UKV), S, 1024, 256, ZP, 256}; pg8::StaticOrder so; so.init(S, 1024, G, bx);
        EpiUpKV E{(bf16_t*)(p.ws + OFF_KA), (bf16_t*)(p.ws + OFF_VAT), ssq_kv};
        pg8::gemm_phase<EpiUpKV, pg8::StaticOrder, true, true>(GEMM_LDS, g, so, E); }
      phase_kpost(p, layer);
      GSYNC();
      phase_attn(p, layer, smem);
      GSYNC();
      phase_combine(p);
      GSYNC();
      { pg8::Gemm g{(const bf16_t*)(p.ws + OFF_OA), (const bf16_t*)(p.ws + WT_BRA), 3 * S, 3072, 512, 512, 512}; DiagOrder so; so.init(G, bx);
        EpiMerge E{Z, H};
        pg8::gemm_phase<EpiMerge, DiagOrder, true, true>(GEMM_LDS, g, so, E); }
      GSYNC();
      { pg8::Gemm g{H, (const bf16_t*)(p.ws + WT_OUT), S, 1024, DM, DM, DM}; pg8::StaticOrder so; so.init(S, 1024, G, bx);
        EpiResid<true> E{xin, xo, XB, ssq_x};
        pg8::gemm_phase<EpiResid<true>, pg8::StaticOrder, true, true>(GEMM_LDS, g, so, E); }
      GSYNC();
      { pg8::Gemm g{XB, (const bf16_t*)(p.ws + WT_UP), S, DFF, DM, DM, DM}; pg8::StaticOrder so; so.init(S, DFF, G, bx);
        EpiRelu2 E{Z, ssq_x};
        pg8::gemm_phase<EpiRelu2, pg8::StaticOrder, true, true>(GEMM_LDS, g, so, E); }
      GSYNC();
      { pg8::Gemm g{Z, (const bf16_t*)(p.ws + WT_DOWN), S, 1024, DFF, DFF, DFF}; pg8::StaticOrder so; so.init(S, 1024, G, bx);
        EpiResid<false> E{xo, xo, nullptr, nullptr};
        pg8::gemm_phase<EpiResid<false>, pg8::StaticOrder, true, true>(GEMM_LDS, g, so, E); }
      GSYNC();
    }
  }
  phase_final_norm(p.out, p.final_norm, 3 * S);
}

extern "C" void kernel_launch(void* const* d_in, const int* in_sizes, int n_in, void* d_out, int out_size, void* d_ws, size_t ws_size, hipStream_t stream) {
  static int grid_blocks = 0;
  if (!grid_blocks) {
    if (ws_size < WS_END) { fprintf(stderr, "kernel_launch: workspace too small: %zu < %zu\n", ws_size, (size_t)WS_END); return; }
    if (hipFuncSetAttribute((const void*)hybrid_encoder_mega, hipFuncAttributeMaxDynamicSharedMemorySize, LDS_BYTES) != hipSuccess) { fprintf(stderr, "hipFuncSetAttribute failed\n"); return; }
    int dev = 0, cus = 0, per_cu = 0;
    hipGetDevice(&dev);
    hipDeviceGetAttribute(&cus, hipDeviceAttributeMultiprocessorCount, dev);
    hipOccupancyMaxActiveBlocksPerMultiprocessor(&per_cu, hybrid_encoder_mega, 512, LDS_BYTES);
    if (per_cu < 1) { fprintf(stderr, "occupancy query returned %d\n", per_cu); return; }
    grid_blocks = cus;
  }
  Params p{};
  p.x_prompt = (const float*)d_in[0]; p.x_sample = (const float*)d_in[1];
  p.norm_mix = (const float*)d_in[2]; p.w_in = (const float*)d_in[3]; p.a_q_norm = (const float*)d_in[4]; p.a_kv_norm = (const float*)d_in[5];
  p.a_w_uq = (const float*)d_in[6]; p.a_w_ukv = (const float*)d_in[7]; p.c_q_norm = (const float*)d_in[8]; p.c_k_norm = (const float*)d_in[9];
  p.w_br_a = (const float*)d_in[10]; p.w_br_b = (const float*)d_in[11]; p.w_br_c = (const float*)d_in[12]; p.w_out = (const float*)d_in[13];
  p.norm_ffn = (const float*)d_in[14]; p.w_up = (const float*)d_in[15]; p.w_down = (const float*)d_in[16]; p.t5_table = (const float*)d_in[17];
  p.final_norm = (const float*)d_in[18];
  p.out = (float*)d_out; p.ws = (char*)d_ws;
  (void)hipMemsetAsync((char*)d_ws + OFF_BAR, 0, 16384, stream);
  void* args[] = {&p};
  hipError_t e = hipLaunchCooperativeKernel((const void*)hybrid_encoder_mega, dim3(grid_blocks), dim3(512), args, LDS_BYTES, stream);
  if (e != hipSuccess) fprintf(stderr, "cooperative launch failed: %s (grid %d)\n", hipGetErrorString(e), grid_blocks);
}
```

```cpp
#include <hip/hip_runtime.h>
#include <hip/hip_cooperative_groups.h>
#include <stdint.h>
#include <cstdio>
namespace cg = cooperative_groups;

typedef unsigned short bf16_t;
typedef short bf16x8 __attribute__((ext_vector_type(8)));
typedef short s16x4 __attribute__((ext_vector_type(4)));
typedef float f32x16 __attribute__((ext_vector_type(16)));
typedef float f32x4 __attribute__((ext_vector_type(4)));
typedef float f32x2 __attribute__((ext_vector_type(2)));
typedef unsigned u32x4 __attribute__((ext_vector_type(4)));
typedef unsigned u32x2 __attribute__((ext_vector_type(2)));
typedef __bf16 bf16x2_t __attribute__((ext_vector_type(2)));

#define DI __device__ __forceinline__
#define MFMA(a, b, c) __builtin_amdgcn_mfma_f32_32x32x16_bf16((a), (b), (c), 0, 0, 0)

DI unsigned pk2(float lo, float hi) { f32x2 v = {lo, hi}; bf16x2_t b = __builtin_convertvector(v, bf16x2_t); return __builtin_bit_cast(unsigned, b); }
DI bf16_t f2bf(float x) { return (bf16_t)(pk2(x, 0.f) & 0xffffu); }
DI float bflo(unsigned u) { return __uint_as_float(u << 16); }
DI float bfhi(unsigned u) { return __uint_as_float(u & 0xffff0000u); }
DI float bf2f(bf16_t b) { return __uint_as_float(((unsigned)b) << 16); }
DI int crow(int i, int h) { return (i & 3) + 8 * (i >> 2) + 4 * h; }
DI float fexp2(float x) { return __builtin_amdgcn_exp2f(x); }
DI int otid() { int t = threadIdx.x; asm volatile("" : "+v"(t)); return t; }
DI int wave_of(int tid) { return __builtin_amdgcn_readfirstlane(tid >> 6); }

constexpr int S = 16384, DM = 1024, ZP = 7680, DFF = 4096;
constexpr int ZC_CQ = 0, ZC_CKV = 384, ZC_KR = 640, ZC_QKVB = 768, ZC_QC = 3840, ZC_KC = 4352, ZC_GATE = 4608;
constexpr int GC_VB = 3840, GC_VC = 6016;
constexpr float LOG2E = 1.4426950408889634f, LN2 = 0.6931471805599453f;

constexpr size_t WT_IN = 0;
constexpr size_t WT_UQ = WT_IN + (size_t)9216 * 1024 * 2;
constexpr size_t WT_UKV = WT_UQ + (size_t)768 * 384 * 2;
constexpr size_t WT_BRA = WT_UKV + (size_t)1024 * 256 * 2;
constexpr size_t WT_BRB = WT_BRA + (size_t)1024 * 512 * 2;
constexpr size_t WT_BRC = WT_BRB + (size_t)1024 * 512 * 2;
constexpr size_t WT_OUT = WT_BRC + (size_t)1024 * 512 * 2;
constexpr size_t WT_UP = WT_OUT + (size_t)1024 * 3072 * 2;
constexpr size_t WT_DOWN = WT_UP + (size_t)4096 * 1024 * 2;
constexpr size_t OFF_CS = WT_DOWN + (size_t)1024 * 4096 * 2;
constexpr size_t OFF_BT = OFF_CS + (size_t)16384 * 16 * 8;
constexpr size_t OFF_Z = OFF_BT + 32768;
constexpr size_t OFF_H = OFF_Z + (size_t)S * ZP * 2;
constexpr size_t OFF_QA = OFF_H + (size_t)S * 1024 * 2;
constexpr size_t OFF_KA = OFF_QA + (size_t)S * 768 * 2;
constexpr size_t OFF_VAT = OFF_KA + (size_t)S * 512 * 2;
constexpr size_t OFF_VCT = OFF_VAT + (size_t)S * 512 * 2;
constexpr size_t OFF_OA = OFF_VCT + (size_t)S * 128 * 2;
constexpr size_t OFF_OB = OFF_OA + (size_t)S * 512 * 2;
constexpr size_t OFF_OC = OFF_OB + (size_t)S * 512 * 2;
constexpr size_t OFF_LSE = OFF_OC + (size_t)S * 512 * 2;
constexpr size_t OFF_SSQ = OFF_LSE + (size_t)3 * S * 8 * 4;
constexpr size_t OFF_VBT = OFF_SSQ + (size_t)3 * S * 4;
constexpr size_t OFF_BAR = OFF_VBT + (size_t)1536 * S * 2;
constexpr size_t WS_END = OFF_BAR + 16384;

constexpr int LDS_BYTES = 131072 + 1024;

struct Params {
  const float* x_prompt; const float* x_sample;
  const float* norm_mix; const float* w_in; const float* a_q_norm; const float* a_kv_norm; const float* a_w_uq; const float* a_w_ukv;
  const float* c_q_norm; const float* c_k_norm; const float* w_br_a; const float* w_br_b; const float* w_br_c; const float* w_out;
  const float* norm_ffn; const float* w_up; const float* w_down; const float* t5_table; const float* final_norm;
  float* out; char* ws;
};

DI void sincos_d(double x, float& c, float& s) {
  const double k = rint(x * 0.6366197723675814);
  double t = fma(-k, 1.5707963267948966, x); t = fma(-k, 6.123233995736766e-17, t);
  const double t2 = t * t;
  double sn = 1.0 - t2 / 210.0; sn = 1.0 - t2 / 156.0 * sn; sn = 1.0 - t2 / 110.0 * sn; sn = 1.0 - t2 / 72.0 * sn; sn = 1.0 - t2 / 42.0 * sn; sn = 1.0 - t2 / 20.0 * sn; sn = 1.0 - t2 / 6.0 * sn; sn *= t;
  double cs = 1.0 - t2 / 240.0; cs = 1.0 - t2 / 182.0 * cs; cs = 1.0 - t2 / 132.0 * cs; cs = 1.0 - t2 / 90.0 * cs; cs = 1.0 - t2 / 56.0 * cs; cs = 1.0 - t2 / 30.0 * cs; cs = 1.0 - t2 / 12.0 * cs; cs = 1.0 - t2 / 2.0 * cs;
  const int q = ((int)k) & 3;
  double so = (q == 0) ? sn : (q == 1) ? cs : (q == 2) ? -sn : -cs;
  double co = (q == 0) ? cs : (q == 1) ? -sn : (q == 2) ? -cs : sn;
  c = (float)co; s = (float)so;
}

DI void build_tables(const Params& p) {
  f32x2* CS = (f32x2*)(p.ws + OFF_CS);
  const int gsz = gridDim.x * 512, gid = blockIdx.x * 512 + otid();
  for (int e = gid; e < 16384 * 16; e += gsz) {
    const int pos = e >> 4, i = e & 15;
    double f = 1.0; for (int j = 0; j < i; ++j) f *= 0.5623413251903491;
    const float ff = (float)f; const float ang = (float)pos * ff;
    float c, s; sincos_d((double)ang, c, s);
    CS[e] = (f32x2){c, s};
  }
  float* BT = (float*)(p.ws + OFF_BT);
  for (int e = gid; e < 3 * 8 * 256; e += gsz) {
    const int gh = e >> 8, g = gh >> 3, hd = gh & 7, j = (e & 255) - 32;
    float v = 0.f;
    if (j >= 0 && j <= 128) {
      const int rel = (j - 64) << (2 * g);
      const int n = rel < 0 ? -rel : rel;
      int b = rel > 0 ? 16 : 0;
      if (n < 8) b += n; else { int lg = 31 - __clz(n); int vv = 5 + lg; b += (vv < 15 ? vv : 15); }
      v = p.t5_table[b * 24 + g * 8 + hd] * LOG2E;
    }
    BT[e] = v;
  }
}

DI void cvt_tile(const float* __restrict__ W, int ldw, int ldk, int koff, bf16_t* __restrict__ Wt, int k0, int n0, int mode, const float* __restrict__ rscale, float* tile) {
  const int tid = otid();
#pragma unroll
  for (int i = 0; i < 8; ++i) {
    const int kl = (tid >> 6) + 8 * i, nl = tid & 63, nn = n0 + nl;
    int src = nn;
    if (mode == 1) src = nn < 672 ? nn : (nn < 768 ? -1 : nn - 96);
    float v = 0.f;
    if (src >= 0) v = W[(size_t)(k0 + kl) * ldw + src];
    if (rscale) v *= rscale[k0 + kl];
    tile[kl * 65 + nl] = v;
  }
  __syncthreads();
#pragma unroll
  for (int i = 0; i < 8; ++i) {
    const int nl = (tid >> 6) + 8 * i, kl = tid & 63;
    Wt[(size_t)(n0 + nl) * ldk + koff + k0 + kl] = f2bf(tile[kl * 65 + nl]);
  }
  __syncthreads();
}

DI void convert_weights(const Params& p, int layer, char* smem) {
  float* tile = (float*)smem;
  int base = 0;
  for (int mtx = 0; mtx < 9; ++mtx) {
    const float* W; int K, Nsrc, Ndst, mode = 0, ldk = 0, koff = 0; const float* rs = nullptr; size_t off;
    switch (mtx) {
      case 0: W = p.w_in + (size_t)layer * 1024 * 9120; K = 1024; Nsrc = 9120; Ndst = 9216; mode = 1; off = WT_IN; break;
      case 1: W = p.a_w_uq + (size_t)layer * 384 * 768; K = 384; Nsrc = 768; Ndst = 768; rs = p.a_q_norm + layer * 384; off = WT_UQ; break;
      case 2: W = p.a_w_ukv + (size_t)layer * 256 * 1024; K = 256; Nsrc = 1024; Ndst = 1024; rs = p.a_kv_norm + layer * 256; off = WT_UKV; break;
      case 3: W = p.w_br_a + (size_t)layer * 512 * 1024; K = 512; Nsrc = 1024; Ndst = 1024; off = WT_BRA; break;
      case 4: W = p.w_br_b + (size_t)layer * 512 * 1024; K = 512; Nsrc = 1024; Ndst = 1024; off = WT_BRB; break;
      case 5: W = p.w_br_c + (size_t)layer * 512 * 1024; K = 512; Nsrc = 1024; Ndst = 1024; off = WT_BRC; break;
      case 6: W = p.w_out + (size_t)layer * 1024 * 1024; K = 1024; Nsrc = 1024; Ndst = 1024; off = WT_OUT; break;
      case 7: W = p.w_up + (size_t)layer * 1024 * 4096; K = 1024; Nsrc = 4096; Ndst = 4096; rs = p.norm_ffn + layer * DM; off = WT_UP; break;
      case 8: default: W = p.w_down + (size_t)layer * 4096 * 1024; K = 4096; Nsrc = 1024; Ndst = 1024; off = WT_DOWN; break;
    }
    if (ldk == 0) ldk = K;
    const int nk = K / 64, nn = Ndst / 64, cnt = nk * nn;
    bf16_t* Wt = (bf16_t*)(p.ws + off);
    int first = (int)blockIdx.x - (base % (int)gridDim.x); if (first < 0) first += gridDim.x;
    for (int it = first; it < cnt; it += gridDim.x) {
      const int kt = it % nk, nt = it / nk;
      cvt_tile(W, Nsrc, ldk, koff, Wt, kt * 64, nt * 64, mode, rs, tile);
    }
    base += cnt;
  }
}

DI void phase_norm(const float* __restrict__ x, const float* __restrict__ g, bf16_t* __restrict__ H, int rows) {
  const int tid = otid(), lane = tid & 63, wid = tid >> 6;
  for (int row = blockIdx.x * 8 + wid; row < rows; row += gridDim.x * 8) {
    const float* xr = x + (size_t)row * DM;
    f32x4 v[4]; float ss = 0.f;
#pragma unroll
    for (int i = 0; i < 4; ++i) { v[i] = *(const f32x4*)(xr + i * 256 + lane * 4); ss += v[i][0] * v[i][0] + v[i][1] * v[i][1] + v[i][2] * v[i][2] + v[i][3] * v[i][3]; }
#pragma unroll
    for (int o = 32; o >= 1; o >>= 1) ss += __shfl_xor(ss, o);
    const float rstd = rsqrtf(ss * (1.0f / DM) + 1e-6f);
#pragma unroll
    for (int i = 0; i < 4; ++i) {
      const f32x4 gg = *(const f32x4*)(g + i * 256 + lane * 4);
      u32x2 w; w.x = pk2(v[i][0] * rstd * gg[0], v[i][1] * rstd * gg[1]); w.y = pk2(v[i][2] * rstd * gg[2], v[i][3] * rstd * gg[3]);
      *(u32x2*)(H + (size_t)row * DM + i * 256 + lane * 4) = w;
    }
  }
}

DI void phase_final_norm(float* __restrict__ x, const float* __restrict__ g, int rows) {
  const int tid = otid(), lane = tid & 63, wid = tid >> 6;
  for (int row = blockIdx.x * 8 + wid; row < rows; row += gridDim.x * 8) {
    float* xr = x + (size_t)row * DM;
    f32x4 v[4]; float ss = 0.f;
#pragma unroll
    for (int i = 0; i < 4; ++i) { v[i] = *(const f32x4*)(xr + i * 256 + lane * 4); ss += v[i][0] * v[i][0] + v[i][1] * v[i][1] + v[i][2] * v[i][2] + v[i][3] * v[i][3]; }
#pragma unroll
    for (int o = 32; o >= 1; o >>= 1) ss += __shfl_xor(ss, o);
    const float rstd = rsqrtf(ss * (1.0f / DM) + 1e-6f);
#pragma unroll
    for (int i = 0; i < 4; ++i) {
      const f32x4 gg = *(const f32x4*)(g + i * 256 + lane * 4);
      f32x4 o = {v[i][0] * rstd * gg[0], v[i][1] * rstd * gg[1], v[i][2] * rstd * gg[2], v[i][3] * rstd * gg[3]};
      *(f32x4*)(xr + i * 256 + lane * 4) = o;
    }
  }
}


namespace pg8 {
#define PG8_LAS __attribute__((address_space(3)))
typedef unsigned short bf16_t;
typedef short bf16x8 __attribute__((ext_vector_type(8)));
typedef float f32x4 __attribute__((ext_vector_type(4)));
typedef unsigned u32x4 __attribute__((ext_vector_type(4)));
constexpr int BM = 256, BK = 64, HALF = 128, HTB = HALF * BK * 2  , STAGE_BYTES = 8 * HTB, NXCD = 8, WGM = 8;

__host__ __device__ __forceinline__ int lds_byte(int r, int c) { const int st = (r >> 4) * 2 + (c >> 5), rr = r & 15, cc = c & 31, ob = rr * 64 + cc * 2; return st * 1024 + (ob ^ (((ob >> 9) & 1) << 5)); }
__host__ __device__ __forceinline__ void stage_rc(int b, int& R, int& C) { const int st = b / 1024, sb = b % 1024, swz = sb ^ (((sb >> 9) & 1) << 5); R = (st >> 1) * 16 + swz / 64; C = (st & 1) * 32 + (swz % 64) / 2; }
__host__ __device__ __forceinline__ int perm32(int rho) { const int n = rho >> 4, i = rho & 15; return 8 * (i >> 2) + 4 * n + (i & 3); }

struct Unit { int pm, pn; };
struct Gemm { const bf16_t* A; const bf16_t* Bt; int M, N, K, lda, ldb; };

struct StaticOrder {
    int nM, nN, nwg, G, c;
    __host__ __device__ void init(int M, int N, int G_, int c_) { nM = M / BM; nN = N / BM; nwg = nM * nN; G = G_; c = c_; }
    __host__ __device__ bool next(int i, Unit& u) const {
        const long L = (long)i * G + c; if (L >= nwg) return false;
        map((int)L, u); return true; }
    __host__ __device__ void map(int L, Unit& u) const {
        int wgid = L; { const int q = nwg / NXCD, r = nwg % NXCD, xcd = wgid % NXCD, off = wgid / NXCD; wgid = (xcd < r ? xcd * (q + 1) : r * (q + 1) + (xcd - r) * q) + off; }
        const int nig = WGM * nN, gid = wgid / nig, fm = gid * WGM, gsz = (nM - fm) < WGM ? (nM - fm) : WGM;
        u.pm = fm + ((wgid % nig) % gsz); u.pn = (wgid % nig) / gsz;
    }
    __device__ __forceinline__ void a_ready(const Unit&) const {}
    __device__ __forceinline__ void done(const Unit&) const {}
};
template <class Epi, class Sched, bool ALIGN_EPI = false, bool SP2 = false>
__device__ __forceinline__ void gemm_phase(PG8_LAS unsigned char* lds, const Gemm g, const Sched& S, const Epi& E) {
    int tid_ = threadIdx.x; asm volatile("" : "+v"(tid_)); const int tid = tid_, wid = __builtin_amdgcn_readfirstlane(tid >> 6), lane = tid & 63, wr = wid >> 2, wc = wid & 3, fr = lane & 15, fq = lane >> 4;
    const int K = g.K, nt = K / BK;
    unsigned voffA[2], voffB[2];
#pragma unroll
    for (int i = 0; i < 2; ++i) { int R, C; stage_rc(tid * 16 + i * 8192, R, C); const int Rb = Epi::PERM ? ((R & ~31) + perm32(R & 31)) : R;
        voffA[i] = (unsigned)(R * g.lda + C) * 2u; voffB[i] = (unsigned)(Rb * g.ldb + C) * 2u; }
    const size_t kstep = (size_t)(BK * 2);
    const size_t hA = (size_t)HALF * g.lda * 2, hB = (size_t)HALF * g.ldb * 2;
    const size_t tA = 2 * hA, tB = 2 * hB;
    const unsigned ldsw = (unsigned)wid * 1024u;
    const int aoff = lds_byte(wr * 64 + fr, fq * 8), boff = lds_byte(wc * 32 + fr, fq * 8);
#define PG8_SA(b, h) (((b) * 2 + (h)) * HTB)
#define PG8_SB(b, h) ((4 + (b) * 2 + (h)) * HTB)
#define PG8_STAGE(bufoff, gbase, voff) do { _Pragma("unroll") for (int _i = 0; _i < 2; ++_i) \
        __builtin_amdgcn_global_load_lds((const unsigned*)((const char*)(gbase) + (voff)[_i]), (PG8_LAS unsigned*)(lds + (bufoff) + ldsw + _i * 8192), 16, 0, 0); } while (0)
#define PG8_LDA(dst, b, h) do { _Pragma("unroll") for (int m = 0; m < 4; ++m) _Pragma("unroll") for (int k = 0; k < 2; ++k) dst[m][k] = *(const PG8_LAS bf16x8*)(lds + PG8_SA(b, h) + aoff + m * 2048 + k * 1024); } while (0)
#define PG8_LDB(dst, b, h) do { _Pragma("unroll") for (int n = 0; n < 2; ++n) _Pragma("unroll") for (int k = 0; k < 2; ++k) dst[n][k] = *(const PG8_LAS bf16x8*)(lds + PG8_SB(b, h) + boff + n * 2048 + k * 1024); } while (0)
#define PG8_MMA(ai, bj, At, Bt) do { __builtin_amdgcn_s_setprio(1); _Pragma("unroll") for (int m = 0; m < 4; ++m) _Pragma("unroll") for (int n = 0; n < 2; ++n) _Pragma("unroll") for (int k = 0; k < 2; ++k) \
        acc[ai][bj][m][n] = __builtin_amdgcn_mfma_f32_16x16x32_bf16(Bt[n][k], At[m][k], acc[ai][bj][m][n], 0, 0, 0); __builtin_amdgcn_s_setprio(0); } while (0)
#define PG8_WAIT_V(n) asm volatile("s_waitcnt vmcnt(" #n ")" ::: "memory")
#define PG8_WAIT_L(n) asm volatile("s_waitcnt lgkmcnt(" #n ")" ::: "memory")
#define PG8_BAR __builtin_amdgcn_s_barrier()
#define PG8_SCHED __builtin_amdgcn_sched_barrier(0)
    Unit cur, nxt; int ui = 0;
    if (!S.next(0, cur)) return;
    f32x4 acc[2][2][4][2];
#pragma unroll
    for (int a = 0; a < 2; ++a)
#pragma unroll
        for (int b = 0; b < 2; ++b)
#pragma unroll
            for (int m = 0; m < 4; ++m)
#pragma unroll
                for (int n = 0; n < 2; ++n) acc[a][b][m][n] = (f32x4){0.f, 0.f, 0.f, 0.f};
    bf16x8 At[4][2], B0[2][2], B1[2][2];
    const char* cA = (const char*)g.A + (size_t)cur.pm * tA; const char* cB = (const char*)g.Bt + (size_t)cur.pn * tB;
    S.a_ready(cur);
    if constexpr (SP2) {
        PG8_STAGE(PG8_SB(0, 0), cB, voffB); PG8_STAGE(PG8_SB(0, 1), cB + hB, voffB); PG8_STAGE(PG8_SA(0, 0), cA, voffA); PG8_STAGE(PG8_SA(0, 1), cA + hA, voffA);
        if (wr == 1) PG8_BAR;
        PG8_WAIT_V(2); PG8_BAR;
        PG8_STAGE(PG8_SB(1, 0), cB + kstep, voffB); PG8_STAGE(PG8_SA(1, 0), cA + kstep, voffA); PG8_STAGE(PG8_SB(1, 1), cB + hB + kstep, voffB);
        PG8_WAIT_V(6); PG8_BAR;
    } else {
        PG8_STAGE(PG8_SB(0, 0), cB, voffB); PG8_STAGE(PG8_SA(0, 0), cA, voffA); PG8_STAGE(PG8_SB(0, 1), cB + hB, voffB); PG8_STAGE(PG8_SA(0, 1), cA + hA, voffA);
        if (wr == 1) PG8_BAR;
        PG8_WAIT_V(4); PG8_BAR;
        PG8_STAGE(PG8_SB(1, 0), cB + kstep, voffB); PG8_STAGE(PG8_SA(1, 0), cA + kstep, voffA); PG8_STAGE(PG8_SB(1, 1), cB + hB + kstep, voffB);
        PG8_WAIT_V(6); PG8_BAR;
    }
    for (;;) {
        const bool has_next = S.next(ui + 1, nxt);
        const char* nA = has_next ? (const char*)g.A + (size_t)nxt.pm * tA : cA; const char* nB = has_next ? (const char*)g.Bt + (size_t)nxt.pn * tB : cB;
_Pragma("unroll 1")
        for (int t = 0; t < nt; t += 2) {
            const bool last = (t == nt - 2);
            const char* a1 = cA + (size_t)(t + 1) * kstep;
            const char* a2 = last ? nA : cA + (size_t)(t + 2) * kstep; const char* b2 = last ? nB : cB + (size_t)(t + 2) * kstep;
            const char* a3 = a2 + kstep; const char* b3 = b2 + kstep;
            if (last && has_next) S.a_ready(nxt);
            if constexpr (SP2) {
            PG8_LDB(B0, 0, 0); PG8_LDB(B1, 0, 1); PG8_SCHED; PG8_LDA(At, 0, 0); PG8_STAGE(PG8_SA(1, 1), a1 + hA, voffA);
            PG8_WAIT_V(8); PG8_WAIT_L(0); PG8_BAR; PG8_MMA(0, 0, At, B0); PG8_MMA(0, 1, At, B1); PG8_BAR; PG8_SCHED;
            PG8_LDA(At, 0, 1); PG8_STAGE(PG8_SB(0, 0), b2, voffB); PG8_STAGE(PG8_SB(0, 1), b2 + hB, voffB); PG8_STAGE(PG8_SA(0, 0), a2, voffA);
            PG8_WAIT_V(8); PG8_WAIT_L(0); PG8_BAR; PG8_MMA(1, 0, At, B0); PG8_MMA(1, 1, At, B1); PG8_BAR; PG8_SCHED;
            PG8_LDB(B0, 1, 0); PG8_LDB(B1, 1, 1); PG8_SCHED; PG8_LDA(At, 1, 0); PG8_STAGE(PG8_SA(0, 1), a2 + hA, voffA);
            PG8_WAIT_V(8); PG8_WAIT_L(0); PG8_BAR; PG8_MMA(0, 0, At, B0); PG8_MMA(0, 1, At, B1); PG8_BAR; PG8_SCHED;
            PG8_LDA(At, 1, 1); PG8_STAGE(PG8_SB(1, 0), b3, voffB); PG8_STAGE(PG8_SB(1, 1), b3 + hB, voffB); PG8_STAGE(PG8_SA(1, 0), a3, voffA);
            PG8_WAIT_V(8); PG8_WAIT_L(0); PG8_BAR; PG8_MMA(1, 0, At, B0); PG8_MMA(1, 1, At, B1); PG8_BAR; PG8_SCHED;
            } else {
            PG8_LDB(B0, 0, 0); PG8_SCHED; PG8_LDA(At, 0, 0); PG8_STAGE(PG8_SA(1, 1), a1 + hA, voffA);
            PG8_WAIT_L(8); PG8_BAR; PG8_WAIT_L(0); PG8_MMA(0, 0, At, B0); PG8_BAR; PG8_SCHED;
            PG8_LDB(B1, 0, 1); PG8_STAGE(PG8_SB(0, 0), b2, voffB);
            PG8_BAR; PG8_WAIT_L(0); PG8_MMA(0, 1, At, B1); PG8_BAR;
            PG8_LDA(At, 0, 1); PG8_STAGE(PG8_SA(0, 0), a2, voffA);
            PG8_BAR; PG8_WAIT_L(0); PG8_MMA(1, 0, At, B0); PG8_BAR; PG8_SCHED;
            PG8_STAGE(PG8_SB(0, 1), b2 + hB, voffB);
            PG8_WAIT_V(6); PG8_BAR; PG8_MMA(1, 1, At, B1); PG8_BAR;
            PG8_LDB(B0, 1, 0); PG8_SCHED; PG8_LDA(At, 1, 0); PG8_STAGE(PG8_SA(0, 1), a2 + hA, voffA);
            PG8_WAIT_L(8); PG8_BAR; PG8_WAIT_L(0); PG8_MMA(0, 0, At, B0); PG8_BAR; PG8_SCHED;
            PG8_LDB(B1, 1, 1); PG8_STAGE(PG8_SB(1, 0), b3, voffB);
            PG8_BAR; PG8_WAIT_L(0); PG8_MMA(0, 1, At, B1); PG8_BAR;
            PG8_LDA(At, 1, 1); PG8_STAGE(PG8_SA(1, 0), a3, voffA);
            PG8_BAR; PG8_WAIT_L(0); PG8_MMA(1, 0, At, B0); PG8_BAR; PG8_SCHED;
            PG8_STAGE(PG8_SB(1, 1), b3 + hB, voffB);
            PG8_WAIT_V(6); PG8_BAR; PG8_MMA(1, 1, At, B1); PG8_BAR;
            }
        }
        if constexpr (ALIGN_EPI) { if (wr == 0) PG8_BAR; }
        if constexpr (!Epi::AFTER_DRAIN) { E(acc, cur, wr, wc, fr, fq); S.done(cur); }
        if (!has_next) break;
#pragma unroll
        for (int a = 0; a < 2; ++a)
#pragma unroll
            for (int b = 0; b < 2; ++b)
#pragma unroll
                for (int m = 0; m < 4; ++m)
#pragma unroll
                    for (int n = 0; n < 2; ++n) acc[a][b][m][n] = (f32x4){0.f, 0.f, 0.f, 0.f};
        cur = nxt; cA = nA; cB = nB; ++ui;
        if constexpr (ALIGN_EPI) { if (wr == 1) PG8_BAR; }
    }
    PG8_WAIT_V(0);
    if constexpr (!ALIGN_EPI) { if (wr == 0) PG8_BAR; }
    PG8_BAR;
    if constexpr (Epi::AFTER_DRAIN) { E.fused(acc, cur, wr, wc, fr, fq, lds, wid, lane); S.done(cur); }
#undef PG8_SA
#undef PG8_SB
#undef PG8_STAGE
#undef PG8_LDA
#undef PG8_LDB
#undef PG8_MMA
#undef PG8_WAIT_V
#undef PG8_WAIT_L
#undef PG8_BAR
#undef PG8_SCHED
}
}

DI void rope_pair8(float (&x1)[8], float (&x2)[8], const f32x2* cs) {
#pragma unroll
  for (int j = 0; j < 8; ++j) { const f32x2 c = cs[j]; const float a = x1[j], b = x2[j]; x1[j] = a * c.x - b * c.y; x2[j] = a * c.y + b * c.x; }
}
typedef pg8::Unit Unit;
#define ACC_T const f32x4 (&acc)[2][2][4][2]
#define EROW(u, ai, m) ((u).pm * 256 + (ai) * 128 + wr * 64 + (m) * 16 + fr)
DI u32x4 pack_f8(const f32x4 a, const f32x4 b) { u32x4 w; w.x = pk2(a[0], a[1]); w.y = pk2(a[2], a[3]); w.z = pk2(b[0], b[1]); w.w = pk2(b[2], b[3]); return w; }

struct EpiInproj {
  static constexpr bool PERM = true, AFTER_DRAIN = false;
  bf16_t* Z; bf16_t* VCT; bf16_t* VBT; float* ssq_q; float* ssq_kv;
  DI void operator()(ACC_T, const Unit& u, int wr, int wc, int fr, int fq) const {
#pragma unroll
    for (int bj = 0; bj < 2; ++bj) {
      const int tt = 2 * u.pn + bj, cb = tt * 128 + wc * 32 + 8 * fq;
      int sh = 0; if (tt >= 6 && tt < 42) sh = 2 * (((tt - 6) >> 2) % 3);
      const int msk = (1 << sh) - 1;
      if (tt >= 38 && tt < 42) {
        bf16_t* vt = VBT + (size_t)(cb - GC_VB) * S + fr * (S >> 4) + u.pm * 16 + wr * 4;
#pragma unroll
        for (int ai = 0; ai < 2; ++ai)
#pragma unroll
          for (int n = 0; n < 2; ++n) {
            __builtin_amdgcn_sched_barrier(0);
#pragma unroll
            for (int e = 0; e < 4; ++e) {
              u32x2 w; w.x = pk2(acc[ai][bj][0][n][e], acc[ai][bj][1][n][e]); w.y = pk2(acc[ai][bj][2][n][e], acc[ai][bj][3][n][e]);
              *(u32x2*)(vt + (size_t)(4 * n + e) * S + ai * 8) = w;
            }
          }
      } else if (tt == 47 || (tt >= 30 && tt < 38)) {
        bf16_t* vt = (tt == 47) ? VCT + (size_t)(cb - GC_VC) * S : VBT + (size_t)(cb - GC_VB) * S;
#pragma unroll
        for (int ai = 0; ai < 2; ++ai)
#pragma unroll
          for (int m = 0; m < 4; ++m) {
            __builtin_amdgcn_sched_barrier(0);
            const int row = EROW(u, ai, m), prow = (row & msk) * (S >> sh) + (row >> sh);
            bf16_t* vp = vt + prow;
#pragma unroll
            for (int n = 0; n < 2; ++n)
#pragma unroll
              for (int e = 0; e < 4; ++e) vp[(size_t)(4 * n + e) * S] = f2bf(acc[ai][bj][m][n][e]);
          }
      } else {
        const int zc = cb < GC_VB ? cb : cb - 1536;
        float* ssq = (tt < 3) ? ssq_q : ((tt < 5) ? ssq_kv : nullptr);
#pragma unroll
        for (int ai = 0; ai < 2; ++ai)
#pragma unroll
          for (int m = 0; m < 4; ++m) {
            const int row = EROW(u, ai, m), prow = (row & msk) * (S >> sh) + (row >> sh);
            const f32x4 v0 = acc[ai][bj][m][0], v1 = acc[ai][bj][m][1];
            *(u32x4*)(Z + (size_t)prow * ZP + zc) = pack_f8(v0, v1);
            if (ssq) {
              float s = v0[0] * v0[0] + v0[1] * v0[1] + v0[2] * v0[2] + v0[3] * v0[3] + v1[0] * v1[0] + v1[1] * v1[1] + v1[2] * v1[2] + v1[3] * v1[3];
              s += __shfl_xor(s, 16); s += __shfl_xor(s, 32);
              if (fq == 0) __hip_atomic_fetch_add(ssq + row, s, __ATOMIC_RELAXED, __HIP_MEMORY_SCOPE_AGENT);
            }
          }
      }
    }
  }
};
struct EpiUpQ {
  static constexpr bool PERM = true, AFTER_DRAIN = false;
  bf16_t* QA; const float* ssq;
  DI void operator()(ACC_T, const Unit& u, int wr, int wc, int fr, int fq) const {
#pragma unroll
    for (int ai = 0; ai < 2; ++ai)
#pragma unroll
      for (int m = 0; m < 4; ++m) {
        const int row = EROW(u, ai, m); const float rs = rsqrtf(ssq[row] * (1.0f / 384.0f) + 1e-6f);
#pragma unroll
        for (int bj = 0; bj < 2; ++bj) {
          const int cb = u.pn * 256 + bj * 128 + wc * 32 + 8 * fq;
          *(u32x4*)(QA + (size_t)row * 768 + cb) = pack_f8(acc[ai][bj][m][0] * rs, acc[ai][bj][m][1] * rs);
        }
      }
  }
};
struct EpiUpKV {
  static constexpr bool PERM = true, AFTER_DRAIN = false;
  bf16_t* KA; bf16_t* VAT; const float* ssq;
  DI void operator()(ACC_T, const Unit& u, int wr, int wc, int fr, int fq) const {
#pragma unroll
    for (int ai = 0; ai < 2; ++ai)
#pragma unroll
      for (int m = 0; m < 4; ++m) {
        __builtin_amdgcn_sched_barrier(0);
        const int row = EROW(u, ai, m); const float rs = rsqrtf(ssq[row] * (1.0f / 256.0f) + 1e-6f);
#pragma unroll
        for (int bj = 0; bj < 2; ++bj) {
          const int head = 2 * u.pn + bj, w0 = wc * 32 + 8 * fq;
          if (wc < 2) {
            *(u32x4*)(KA + (size_t)row * 512 + head * 64 + w0) = pack_f8(acc[ai][bj][m][0] * rs, acc[ai][bj][m][1] * rs);
          } else {
            bf16_t* vp = VAT + (size_t)(head * 64 + w0 - 64) * S + row;
#pragma unroll
            for (int n = 0; n < 2; ++n)
#pragma unroll
              for (int e = 0; e < 4; ++e) vp[(size_t)(4 * n + e) * S] = f2bf(acc[ai][bj][m][n][e] * rs);
          }
        }
      }
  }
};
struct EpiMerge {
  static constexpr bool PERM = true, AFTER_DRAIN = false;
  const bf16_t* Z; bf16_t* MIX;
  DI void operator()(ACC_T, const Unit& u, int wr, int wc, int fr, int fq) const {
    const int b = u.pm >> 6, pm = u.pm & 63, pn = u.pn & 3;
#pragma unroll
    for (int ai = 0; ai < 2; ++ai)
#pragma unroll
      for (int m = 0; m < 4; ++m) {
        const int row = pm * 256 + ai * 128 + wr * 64 + m * 16 + fr;
#pragma unroll
        for (int bj = 0; bj < 2; ++bj) {
          const int col = pn * 256 + bj * 128 + wc * 32 + 8 * fq;
          const u32x4 g = *(const u32x4*)(Z + (size_t)row * ZP + ZC_GATE + b * 1024 + col);
          f32x4 v0 = acc[ai][bj][m][0], v1 = acc[ai][bj][m][1];
#pragma unroll
          for (int q = 0; q < 2; ++q) {
            v0[2 * q] *= 1.0f / (1.0f + __expf(-bflo(g[q]))); v0[2 * q + 1] *= 1.0f / (1.0f + __expf(-bfhi(g[q])));
            v1[2 * q] *= 1.0f / (1.0f + __expf(-bflo(g[2 + q]))); v1[2 * q + 1] *= 1.0f / (1.0f + __expf(-bfhi(g[2 + q])));
          }
          bf16_t* mp = MIX + (size_t)row * DM + col;
          if (b > 0) { const u32x4 o = *(const u32x4*)mp;
#pragma unroll
            for (int q = 0; q < 2; ++q) { v0[2 * q] += bflo(o[q]); v0[2 * q + 1] += bfhi(o[q]); v1[2 * q] += bflo(o[2 + q]); v1[2 * q + 1] += bfhi(o[2 + q]); } }
          *(u32x4*)mp = pack_f8(v0, v1);
        }
      }
  }
};
template <bool NORM_OUT> struct EpiResid {
  static constexpr bool PERM = false, AFTER_DRAIN = false;
  const float* xs; float* xd; bf16_t* xb; float* ssq;
  DI void operator()(ACC_T, const Unit& u, int wr, int wc, int fr, int fq) const {
#pragma unroll
    for (int ai = 0; ai < 2; ++ai)
#pragma unroll
      for (int m = 0; m < 4; ++m) {
        const int row = EROW(u, ai, m);
        const size_t ro = (size_t)row * DM + u.pn * 256 + wc * 32 + 4 * fq;
        float ss = 0.f;
#pragma unroll
        for (int bj = 0; bj < 2; ++bj)
#pragma unroll
          for (int n = 0; n < 2; ++n) {
            const size_t o = ro + bj * 128 + n * 16; const f32x4 x = *(const f32x4*)(xs + o) + acc[ai][bj][m][n]; *(f32x4*)(xd + o) = x;
            if (NORM_OUT) { u32x2 w; w.x = pk2(x[0], x[1]); w.y = pk2(x[2], x[3]); *(u32x2*)(xb + o) = w; ss += x[0] * x[0] + x[1] * x[1] + x[2] * x[2] + x[3] * x[3]; }
          }
        if (NORM_OUT) { ss += __shfl_xor(ss, 16); ss += __shfl_xor(ss, 32); if (fq == 0) __hip_atomic_fetch_add(ssq + row, ss, __ATOMIC_RELAXED, __HIP_MEMORY_SCOPE_AGENT); }
      }
  }
};
struct EpiRelu2 {
  static constexpr bool PERM = true, AFTER_DRAIN = false;
  bf16_t* HID; const float* ssq;
  DI void operator()(ACC_T, const Unit& u, int wr, int wc, int fr, int fq) const {
#pragma unroll
    for (int ai = 0; ai < 2; ++ai)
#pragma unroll
      for (int m = 0; m < 4; ++m) {
        const int row = EROW(u, ai, m); const float rs = rsqrtf(ssq[row] * (1.0f / DM) + 1e-6f);
#pragma unroll
        for (int bj = 0; bj < 2; ++bj) {
          f32x4 v0 = acc[ai][bj][m][0], v1 = acc[ai][bj][m][1];
#pragma unroll
          for (int e = 0; e < 4; ++e) { const float a = fmaxf(v0[e], 0.f) * rs, c = fmaxf(v1[e], 0.f) * rs; v0[e] = a * a; v1[e] = c * c; }
          *(u32x4*)(HID + (size_t)row * DFF + u.pn * 256 + bj * 128 + wc * 32 + 8 * fq) = pack_f8(v0, v1);
        }
      }
  }
};
struct DiagOrder {
  pg8::StaticOrder so; int G, c;
  DI void init(int G_, int c_) { so.init(S, 1024, G_, c_); G = G_; c = c_; }
  DI bool next(int i, Unit& u) const { const int tile = (i / 3) * G + c, b = i % 3; if (tile >= 256) return false; so.map(tile, u); u.pm += 64 * b; u.pn += 4 * b; return true; }
  DI void a_ready(const Unit&) const {}
  DI void done(const Unit&) const {}
};
#define GEMM_LDS ((PG8_LAS unsigned char*)smem)

DI void phase_kpost(const Params& p, int layer) {
  bf16_t* Z = (bf16_t*)(p.ws + OFF_Z);
  const f32x2* CS = (const f32x2*)(p.ws + OFF_CS);
  for (int it = (int)gridDim.x - 1 - (int)blockIdx.x; it < 96; it += gridDim.x) {
      const int tid = otid();
      const int idx = it * 512 + tid;
      const int unit = idx / S, tkn = idx % S;
      if (unit < 2) {
        bf16_t* kp = Z + (size_t)tkn * ZP + ZC_KC + unit * 64;
        float x[8][8]; float ss = 0.f;
#pragma unroll
        for (int c = 0; c < 8; ++c) { const u32x4 v = *(const u32x4*)(kp + c * 8);
#pragma unroll
          for (int q = 0; q < 4; ++q) { x[c][2 * q] = bflo(v[q]); x[c][2 * q + 1] = bfhi(v[q]); ss += x[c][2 * q] * x[c][2 * q] + x[c][2 * q + 1] * x[c][2 * q + 1]; } }
        const float rs = rsqrtf(ss * (1.0f / 64.0f) + 1e-6f);
        const float* gk = p.c_k_norm + layer * 64;
#pragma unroll
        for (int c = 0; c < 8; ++c)
#pragma unroll
          for (int q = 0; q < 8; ++q) x[c][q] *= rs * gk[c * 8 + q];
        const f32x2* cr = CS + (size_t)(tkn >> 6) * 16; const f32x2* cc = CS + (size_t)(tkn & 63) * 16;
        rope_pair8(x[0], x[2], cr); rope_pair8(x[1], x[3], cr + 8);
        rope_pair8(x[4], x[6], cc); rope_pair8(x[5], x[7], cc + 8);
#pragma unroll
        for (int c = 0; c < 8; ++c) { u32x4 w; w.x = pk2(x[c][0], x[c][1]); w.y = pk2(x[c][2], x[c][3]); w.z = pk2(x[c][4], x[c][5]); w.w = pk2(x[c][6], x[c][7]); *(u32x4*)(kp + c * 8) = w; }
      } else {
        bf16_t* kp = Z + (size_t)tkn * ZP + ZC_KR;
        float x[4][8];
#pragma unroll
        for (int c = 0; c < 4; ++c) { const u32x4 v = *(const u32x4*)(kp + c * 8);
#pragma unroll
          for (int q = 0; q < 4; ++q) { x[c][2 * q] = bflo(v[q]); x[c][2 * q + 1] = bfhi(v[q]); } }
        const f32x2* cp = CS + (size_t)tkn * 16;
        rope_pair8(x[0], x[2], cp); rope_pair8(x[1], x[3], cp + 8);
#pragma unroll
        for (int c = 0; c < 4; ++c) { u32x4 w; w.x = pk2(x[c][0], x[c][1]); w.y = pk2(x[c][2], x[c][3]); w.z = pk2(x[c][4], x[c][5]); w.w = pk2(x[c][6], x[c][7]); *(u32x4*)(kp + c * 8) = w; }
      }
  }
}

DI bf16x8 pack8(float a0, float a1, float a2, float a3, float a4, float a5, float a6, float a7) {
  u32x4 w; w.x = pk2(a0, a1); w.y = pk2(a2, a3); w.z = pk2(a4, a5); w.w = pk2(a6, a7); return __builtin_bit_cast(bf16x8, w);
}
DI void unpack8(const u32x4 v, float (&x)[8]) {
#pragma unroll
  for (int q = 0; q < 4; ++q) { x[2 * q] = bflo(v[q]); x[2 * q + 1] = bfhi(v[q]); }
}

DI void store_o_wide(bf16_t* rowp, const f32x16& o, float inv, int h) {
#pragma unroll
  for (int pr = 0; pr < 2; ++pr) {
    const int g = 2 * pr;
    const unsigned ax = pk2(o[4 * g] * inv, o[4 * g + 1] * inv), ay = pk2(o[4 * g + 2] * inv, o[4 * g + 3] * inv);
    const unsigned bx = pk2(o[4 * g + 4] * inv, o[4 * g + 5] * inv), by = pk2(o[4 * g + 6] * inv, o[4 * g + 7] * inv);
    const auto sx = __builtin_amdgcn_permlane32_swap(ax, bx, false, false);
    const auto sy = __builtin_amdgcn_permlane32_swap(ay, by, false, false);
    const u32x4 w = {sx[0], sy[0], sx[1], sy[1]};
    *(u32x4*)(rowp + 8 * (g + h)) = w;
  }
}

constexpr int ATT_STAGE = 20480;

template <int TYPE>
DI void attn_dense_unit(const Params& p, int layer, int head, int qb, char* lds) {
  constexpr int NQK = TYPE == 0 ? 6 : 4;
  const int tid = otid(), lane = tid & 63, wid = wave_of(tid), r = lane & 31, h = lane >> 5;
  const bf16_t* Z = (const bf16_t*)(p.ws + OFF_Z);
  const f32x2* CS = (const f32x2*)(p.ws + OFF_CS);
  const bf16_t* Kn; int ldk; const bf16_t* VT; bf16_t* O;
  if (TYPE == 0) { Kn = (const bf16_t*)(p.ws + OFF_KA) + head * 64; ldk = 512; VT = (const bf16_t*)(p.ws + OFF_VAT) + (size_t)head * 64 * S; O = (bf16_t*)(p.ws + OFF_OA); }
  else { const int kvh = head >> 2; Kn = Z + ZC_KC + kvh * 64; ldk = ZP; VT = (const bf16_t*)(p.ws + OFF_VCT) + (size_t)kvh * 64 * S; O = (bf16_t*)(p.ws + OFF_OC); }
  const int q = qb * 256 + wid * 32 + r;
  bf16x8 qf[NQK];
  if (TYPE == 0) {
    const bf16_t* qp = (const bf16_t*)(p.ws + OFF_QA) + (size_t)q * 768 + head * 96 + 8 * h;
    float x[6][8];
#pragma unroll
    for (int d0 = 0; d0 < 6; ++d0) unpack8(*(const u32x4*)(qp + d0 * 16), x[d0]);
    rope_pair8(x[4], x[5], CS + (size_t)q * 16 + 8 * h);
    const float sc = 0.10206207261596577f * LOG2E;
#pragma unroll
    for (int d0 = 0; d0 < 6; ++d0) qf[d0] = pack8(x[d0][0] * sc, x[d0][1] * sc, x[d0][2] * sc, x[d0][3] * sc, x[d0][4] * sc, x[d0][5] * sc, x[d0][6] * sc, x[d0][7] * sc);
  } else {
    const bf16_t* qp = Z + (size_t)q * ZP + ZC_QC + head * 64 + 8 * h;
    float x[4][8]; float ss = 0.f;
#pragma unroll
    for (int d0 = 0; d0 < 4; ++d0) { unpack8(*(const u32x4*)(qp + d0 * 16), x[d0]);
#pragma unroll
      for (int j = 0; j < 8; ++j) ss += x[d0][j] * x[d0][j]; }
    ss += __shfl_xor(ss, 32);
    const float rs = rsqrtf(ss * (1.0f / 64.0f) + 1e-6f);
    const float* gq = p.c_q_norm + layer * 64;
#pragma unroll
    for (int d0 = 0; d0 < 4; ++d0)
#pragma unroll
      for (int j = 0; j < 8; ++j) x[d0][j] *= rs * gq[d0 * 16 + 8 * h + j];
    rope_pair8(x[0], x[1], CS + (size_t)(q >> 6) * 16 + 8 * h);
    rope_pair8(x[2], x[3], CS + (size_t)(q & 63) * 16 + 8 * h);
    const float sc = 0.125f * LOG2E;
#pragma unroll
    for (int d0 = 0; d0 < 4; ++d0) qf[d0] = pack8(x[d0][0] * sc, x[d0][1] * sc, x[d0][2] * sc, x[d0][3] * sc, x[d0][4] * sc, x[d0][5] * sc, x[d0][6] * sc, x[d0][7] * sc);
  }
  typedef __attribute__((address_space(3))) unsigned lds_u32;
  const int srow = tid >> 3, sch = (tid & 7) ^ ((srow >> 1) & 7);
  const bf16_t* gk = Kn + (size_t)srow * ldk + sch * 8;
  const bf16_t* gv = VT + (size_t)srow * S + sch * 8;
  const int rrow = tid >> 2, rch = (tid & 3) ^ ((rrow >> 2) & 3);
  const bf16_t* gr = Z + ZC_KR + (size_t)rrow * ZP + rch * 8;
  char* wbase = lds + wid * 1024;
#define DMA(t, soff) do { \
    __builtin_amdgcn_global_load_lds((const unsigned*)(gk + (size_t)(t) * 64 * ldk), (lds_u32*)(wbase + (soff)), 16, 0, 0); \
    __builtin_amdgcn_global_load_lds((const unsigned*)(gv + (size_t)(t) * 64), (lds_u32*)(wbase + (soff) + 8192), 16, 0, 0); \
    if (TYPE == 0 && wid < 4) __builtin_amdgcn_global_load_lds((const unsigned*)(gr + (size_t)(t) * 64 * ZP), (lds_u32*)(wbase + (soff) + 16384), 16, 0, 0); } while (0)
#define DMA_WAIT(keep) do { if (keep) { if (TYPE == 0 && wid < 4) asm volatile("s_waitcnt vmcnt(3)" ::: "memory"); else asm volatile("s_waitcnt vmcnt(2)" ::: "memory"); } \
    else asm volatile("s_waitcnt vmcnt(0)" ::: "memory"); } while (0)
#define BAR() do { asm volatile("s_waitcnt lgkmcnt(0)" ::: "memory"); __builtin_amdgcn_s_barrier(); asm volatile("" ::: "memory"); } while (0)
  constexpr int NONES = (TYPE == 0) ? 0 : 2;
  float m_run = 0.f, lsum = 0.f, ls0 = 0.f, ls1 = 0.f, ls2 = 0.f; f32x16 o0, o1, negm, la;
#pragma unroll
  for (int i = 0; i < 16; ++i) { o0[i] = 0.f; o1[i] = 0.f; negm[i] = 0.f; la[i] = 0.f; }
  const bf16x8 ones = {0x3F80, 0x3F80, 0x3F80, 0x3F80, 0x3F80, 0x3F80, 0x3F80, 0x3F80};
  const int rK = (r & ~12) | ((r & 4) << 1) | ((r & 8) >> 1);
  const int ksw = (rK >> 1) & 7, rsw = (rK >> 2) & 3, vsw = (r >> 1) & 7;
  int koff[4], roff[2], voff[4];
#pragma unroll
  for (int d0 = 0; d0 < 4; ++d0) { koff[d0] = rK * 128 + (((2 * d0 + h) ^ ksw) << 4); voff[d0] = 8192 + r * 128 + (((2 * d0 + h) ^ vsw) << 4); }
#pragma unroll
  for (int d0 = 0; d0 < 2; ++d0) roff[d0] = 16384 + rK * 64 + (((2 * d0 + h) ^ rsw) << 4);
  constexpr int NT = S / 64;
  constexpr float THR = 8.0f;
#define SB() __builtin_amdgcn_sched_barrier(0)
#define QKR(d0, K0, K1, SOFF) do { if ((d0) < 4) { K0 = *(const bf16x8*)(lds + (SOFF) + koff[(d0) & 3]); K1 = *(const bf16x8*)(lds + (SOFF) + 32 * 128 + koff[(d0) & 3]); } \
    else if ((d0) < NQK) { K0 = *(const bf16x8*)(lds + (SOFF) + roff[(d0) & 1]); K1 = *(const bf16x8*)(lds + (SOFF) + 32 * 64 + roff[(d0) & 1]); } } while (0)
#define QKM(N0, N1, d0, K0, K1) do { if ((d0) == 0) { N0 = MFMA(K0, qf[0], negm); N1 = MFMA(K1, qf[0], negm); } \
    else if ((d0) < NQK) { N0 = MFMA(K0, qf[(d0) < NQK ? (d0) : 0], N0); N1 = MFMA(K1, qf[(d0) < NQK ? (d0) : 0], N1); } } while (0)
#define EX4(CC, B, SI) do { __builtin_amdgcn_s_setprio(1); _Pragma("unroll") for (int i_ = 0; i_ < 4; ++i_) { CC[(B) + i_] = fexp2(CC[(B) + i_]); if ((SI) >= NONES) { if (i_ == 0) ls0 += CC[(B) + i_]; else if (i_ == 1) ls1 += CC[(B) + i_]; else if (i_ == 2) ls2 += CC[(B) + i_]; else lsum += CC[(B) + i_]; } } __builtin_amdgcn_s_setprio(0); } while (0)
#define PK8(PF, CC, B) do { PF = pack8(CC[(B)], CC[(B) + 1], CC[(B) + 2], CC[(B) + 3], CC[(B) + 4], CC[(B) + 5], CC[(B) + 6], CC[(B) + 7]); } while (0)
#define VR(s_, V0, V1, SOFF) do { V0 = *(const bf16x8*)(lds + (SOFF) + voff[s_]); V1 = *(const bf16x8*)(lds + (SOFF) + 32 * 128 + voff[s_]); } while (0)
#define PVM(s_, V0, V1) do { o0 = MFMA(V0, pf[s_], o0); o1 = MFMA(V1, pf[s_], o1); if ((s_) < NONES) la = MFMA(ones, pf[s_], la); } while (0)
#define MAXG(NN, B) do { ma_ = fmaxf(fmaxf(ma_, NN[(B)]), NN[(B) + 1]); mb_ = fmaxf(fmaxf(mb_, NN[(B) + 2]), NN[(B) + 3]); \
    ma_ = fmaxf(fmaxf(ma_, NN[(B) + 4]), NN[(B) + 5]); mb_ = fmaxf(fmaxf(mb_, NN[(B) + 6]), NN[(B) + 7]); } while (0)
#define ROWMAX(P0, P1, MX) do { float a_ = fmaxf(fmaxf(P0[0], P0[1]), P1[0]), c_ = fmaxf(fmaxf(P0[2], P0[3]), P1[1]); a_ = fmaxf(fmaxf(a_, P1[2]), P1[3]); \
    _Pragma("unroll") for (int i_ = 4; i_ < 16; i_ += 4) { a_ = fmaxf(fmaxf(a_, P0[i_]), P0[i_ + 1]); c_ = fmaxf(fmaxf(c_, P0[i_ + 2]), P0[i_ + 3]); a_ = fmaxf(fmaxf(a_, P1[i_]), P1[i_ + 1]); c_ = fmaxf(fmaxf(c_, P1[i_ + 2]), P1[i_ + 3]); } \
    a_ = fmaxf(a_, c_); MX = fmaxf(a_, __shfl_xor(a_, 32)); } while (0)
#define RESCALE(P0, P1, DELTA) do { const float dl_ = (DELTA); m_run += dl_; const float al_ = fexp2(-dl_); lsum *= al_; ls0 *= al_; ls1 *= al_; ls2 *= al_; \
    _Pragma("unroll") for (int i_ = 0; i_ < 16; ++i_) { P0[i_] -= dl_; P1[i_] -= dl_; o0[i_] *= al_; o1[i_] *= al_; if (NONES > 0) la[i_] *= al_; negm[i_] = -m_run; } } while (0)
#define STEP(C0, C1, N0, N1, T, HAS_NEXT, HAS_LOAD, S0, S1, S3) do { \
    if (HAS_LOAD) DMA((T) + 3, S3); \
    bf16x8 pf[4]; bf16x8 ka0, ka1, kb0, kb1, va0, va1, vb0, vb1; \
    if (HAS_NEXT) QKR(0, ka0, ka1, S1); \
    SB(); if (HAS_NEXT) { QKR(1, kb0, kb1, S1); QKM(N0, N1, 0, ka0, ka1); } EX4(C0, 0, 0); \
    SB(); if (HAS_NEXT) { QKR(2, ka0, ka1, S1); QKM(N0, N1, 1, kb0, kb1); } EX4(C0, 4, 0); PK8(pf[0], C0, 0); \
    SB(); if (HAS_NEXT) { QKR(3, kb0, kb1, S1); QKM(N0, N1, 2, ka0, ka1); } EX4(C0, 8, 1); \
    SB(); if (HAS_NEXT) { QKR(4, ka0, ka1, S1); QKM(N0, N1, 3, kb0, kb1); } EX4(C0, 12, 1); PK8(pf[1], C0, 8); if (NQK == 4) VR(0, va0, va1, S0); \
    if (NQK > 4) { \
      SB(); if (HAS_NEXT) { QKR(5, kb0, kb1, S1); QKM(N0, N1, 4, ka0, ka1); } EX4(C1, 0, 2); \
      SB(); if (HAS_NEXT) QKM(N0, N1, 5, kb0, kb1); EX4(C1, 4, 2); PK8(pf[2], C1, 0); VR(0, va0, va1, S0); } \
    float ma_ = -1e30f, mb_ = -1e30f; \
    if (NQK == 4) { \
      SB(); VR(1, vb0, vb1, S0); PVM(0, va0, va1); EX4(C1, 0, 2); EX4(C1, 4, 2); PK8(pf[2], C1, 0); \
      SB(); VR(2, va0, va1, S0); PVM(1, vb0, vb1); EX4(C1, 8, 3); EX4(C1, 12, 3); PK8(pf[3], C1, 8); \
    } else { \
      SB(); VR(1, vb0, vb1, S0); PVM(0, va0, va1); EX4(C1, 8, 3); \
      SB(); VR(2, va0, va1, S0); PVM(1, vb0, vb1); EX4(C1, 12, 3); PK8(pf[3], C1, 8); } \
    SB(); VR(3, vb0, vb1, S0); PVM(2, va0, va1); if (HAS_NEXT) { MAXG(N0, 0); MAXG(N0, 8); } \
    SB(); PVM(3, vb0, vb1); if (HAS_NEXT) { MAXG(N1, 0); MAXG(N1, 8); } \
    SB(); \
    float mx_ = fmaxf(ma_, mb_); { const auto rr_ = __builtin_amdgcn_permlane32_swap(__float_as_uint(mx_), __float_as_uint(mx_), false, false); mx_ = fmaxf(__uint_as_float(rr_[0]), __uint_as_float(rr_[1])); } \
    DMA_WAIT(HAS_LOAD); BAR(); \
    if (HAS_NEXT) { if (__any(mx_ > THR)) RESCALE(N0, N1, fmaxf(mx_, 0.f)); } } while (0)
  constexpr int R0 = 0, R1 = ATT_STAGE, R2 = 2 * ATT_STAGE, R3 = 3 * ATT_STAGE;
  f32x16 sA0, sA1, sB0, sB1;
  DMA(0, R0); DMA(1, R1); DMA(2, R2); DMA_WAIT(true); BAR();
  { bf16x8 ka0, ka1;
#pragma unroll
    for (int d0 = 0; d0 < NQK; ++d0) { QKR(d0, ka0, ka1, R0); QKM(sA0, sA1, d0, ka0, ka1); } }
  { float mx0; ROWMAX(sA0, sA1, mx0); m_run = mx0;
#pragma unroll
    for (int i = 0; i < 16; ++i) { sA0[i] -= mx0; sA1[i] -= mx0; negm[i] = -mx0; } }
  for (int t = 0; t < NT - 4; t += 4) {
    STEP(sA0, sA1, sB0, sB1, t, true, true, R0, R1, R3);
    STEP(sB0, sB1, sA0, sA1, t + 1, true, true, R1, R2, R0);
    STEP(sA0, sA1, sB0, sB1, t + 2, true, true, R2, R3, R1);
    STEP(sB0, sB1, sA0, sA1, t + 3, true, true, R3, R0, R2);
  }
  STEP(sA0, sA1, sB0, sB1, NT - 4, true, true, R0, R1, R3);
  STEP(sB0, sB1, sA0, sA1, NT - 3, true, false, R1, R2, R0);
  STEP(sA0, sA1, sB0, sB1, NT - 2, true, false, R2, R3, R1);
  STEP(sB0, sB1, sA0, sA1, NT - 1, false, false, R3, R0, R2);
  lsum += ls0 + ls1 + ls2;
  const float l = (NONES > 0 ? la[0] : 0.f) + lsum + __shfl_xor(lsum, 32);
#undef DMA
#undef DMA_WAIT
#undef BAR
#undef SB
#undef QKR
#undef QKM
#undef EX4
#undef PK8
#undef VR
#undef PVM
#undef MAXG
#undef ROWMAX
#undef RESCALE
#undef STEP
  const float inv = 1.0f / l;
  bf16_t* op = O + (size_t)q * 512 + head * 64;
  store_o_wide(op, o0, inv, h); store_o_wide(op + 32, o1, inv, h);
}

constexpr int BLV = 49152;
DI void b_issue_k(const Params& p, int x, char* lds, int tid, int wid) {
  typedef __attribute__((address_space(3))) unsigned lds_u32;
  const int g = x >> 9, head = (x >> 6) & 7, blk256 = x & 63;
  const int sh = 2 * g, Ls = S >> sh, P0 = blk256 * 256, sub = P0 / Ls, i0 = P0 & (Ls - 1), sub0 = sub * Ls;
  const bf16_t* Zk = (const bf16_t*)(p.ws + OFF_Z) + ZC_QKVB + ((1 * 3 + g) * 8 + head) * 64;
#pragma unroll
  for (int i = 0; i < 6; ++i) {
    const int sl = i * 512 + tid, row = sl >> 3, c = (sl & 7) ^ ((row >> 1) & 7); int key = i0 - 64 + row; key = key < 0 ? 0 : (key > Ls - 1 ? Ls - 1 : key);
    __builtin_amdgcn_global_load_lds((const unsigned*)(Zk + (size_t)(sub0 + key) * ZP + c * 8), (lds_u32*)(lds + (i * 512 + wid * 64) * 16), 16, 0, 0);
  }
}
DI void b_issue_v(const Params& p, int x, char* lds, int tid, int wid) {
  typedef __attribute__((address_space(3))) unsigned lds_u32;
  const int g = x >> 9, head = (x >> 6) & 7, blk256 = x & 63;
  const int sh = 2 * g, Ls = S >> sh, P0 = blk256 * 256, sub = P0 / Ls, i0 = P0 & (Ls - 1), sub0 = sub * Ls;
  const bf16_t* VTg = (const bf16_t*)(p.ws + OFF_VBT) + (size_t)((g * 8 + head) * 64) * S + sub0;
#pragma unroll
  for (int i = 0; i < 6; ++i) {
    const int sl = i * 512 + tid, d = sl / 48, c = (sl - d * 48) ^ (d & 15); int k0 = i0 - 64 + 8 * c; k0 = k0 < 0 ? 0 : (k0 > Ls - 8 ? Ls - 8 : k0);
    __builtin_amdgcn_global_load_lds((const unsigned*)(VTg + (size_t)d * S + k0), (lds_u32*)(lds + BLV + (i * 512 + wid * 64) * 16), 16, 0, 0);
  }
}
DI void attn_b_item(const Params& p, int x, int xnext, char* lds) {
  const int tid = otid(), lane = tid & 63, wid = wave_of(tid), r = lane & 31, h = lane >> 5;
  const int g = x >> 9, head = (x >> 6) & 7, blk256 = x & 63;
  const bf16_t* Z = (const bf16_t*)(p.ws + OFF_Z);
  const int sh = 2 * g, Ls = S >> sh, P0 = blk256 * 256, sub = P0 / Ls, i0 = P0 & (Ls - 1);
  const bf16_t* Zq = Z + ZC_QKVB + ((0 * 3 + g) * 8 + head) * 64;
  constexpr int LV = BLV;
  const int i0w = i0 + 32 * wid;
  const float* BT = (const float*)(p.ws + OFF_BT) + (g * 8 + head) * 256 + 32 - r + 8 * h;
  const int rK = (r & ~12) | ((r & 4) << 1) | ((r & 8) >> 1);
  bf16x8 qf[4];
  {
    const bf16_t* qp = Zq + (size_t)(P0 + 32 * wid + r) * ZP + 8 * h; const float scq = 0.125f * LOG2E;
#pragma unroll
    for (int d0 = 0; d0 < 4; ++d0) { float x8[8]; unpack8(*(const u32x4*)(qp + d0 * 16), x8); qf[d0] = pack8(x8[0] * scq, x8[1] * scq, x8[2] * scq, x8[3] * scq, x8[4] * scq, x8[5] * scq, x8[6] * scq, x8[7] * scq); }
  }
  float bvs[5][16];
#pragma unroll
  for (int c = 0; c < 5; ++c)
#pragma unroll
    for (int i = 0; i < 16; ++i) bvs[c][i] = BT[32 * c + (i & 3) + 4 * ((i >> 2) & 1) + 16 * (i >> 3)];
  asm volatile("s_waitcnt vmcnt(0)" ::: "memory"); __builtin_amdgcn_s_barrier(); asm volatile("" ::: "memory");
#pragma unroll
  for (int c = 0; c < 5; ++c)
#pragma unroll
    for (int i = 0; i < 16; ++i) asm volatile("" : "+v"(bvs[c][i]));
  f32x16 sc[5];
  const int ksw = (rK >> 1) & 7;
#pragma unroll
  for (int c = 0; c < 5; ++c) {
#pragma unroll
    for (int i = 0; i < 16; ++i) sc[c][i] = 0.f;
    const char* kp = lds + (32 * wid + 32 * c + rK) * 128;
#pragma unroll
    for (int d0 = 0; d0 < 4; ++d0) { const bf16x8 kf = *(const bf16x8*)(kp + (((2 * d0 + h) ^ ksw) << 4)); sc[c] = MFMA(kf, qf[d0], sc[c]); }
  }
  asm volatile("s_waitcnt lgkmcnt(0)" ::: "memory"); __builtin_amdgcn_s_barrier(); asm volatile("" ::: "memory");
  if (xnext >= 0) b_issue_k(p, xnext, lds, tid, wid);
  float mx = -1e30f;
#pragma unroll
  for (int c = 0; c < 5; ++c)
#pragma unroll
    for (int i = 0; i < 16; ++i) {
      const int prow = (i & 3) + 4 * ((i >> 2) & 1) + 8 * h + 16 * (i >> 3);
      const int rel = 32 * c - 64 + prow - r, key = i0w + r + rel;
      const bool valid = ((unsigned)(rel + 64) <= 128u) & ((unsigned)key < (unsigned)Ls);
      const float v = valid ? sc[c][i] + bvs[c][i] : -1e30f;
      sc[c][i] = v; mx = fmaxf(mx, v);
    }
  mx = fmaxf(mx, __shfl_xor(mx, 32));
  float l = 0.f;
#pragma unroll
  for (int c = 0; c < 5; ++c)
#pragma unroll
    for (int i = 0; i < 16; ++i) { const float e = fexp2(sc[c][i] - mx); sc[c][i] = e; l += e; }
  l += __shfl_xor(l, 32);
  f32x16 o0, o1;
#pragma unroll
  for (int i = 0; i < 16; ++i) { o0[i] = 0.f; o1[i] = 0.f; }
  const char* vp = lds + LV + r * 768; const int vsw = r & 15;
#pragma unroll
  for (int c = 0; c < 5; ++c)
#pragma unroll
    for (int s = 0; s < 2; ++s) {
      const bf16x8 pf = pack8(sc[c][8 * s], sc[c][8 * s + 1], sc[c][8 * s + 2], sc[c][8 * s + 3], sc[c][8 * s + 4], sc[c][8 * s + 5], sc[c][8 * s + 6], sc[c][8 * s + 7]);
      const int ch = ((4 * wid + 4 * c + 2 * s + h) ^ vsw) << 4;
      const bf16x8 v0 = *(const bf16x8*)(vp + ch), v1 = *(const bf16x8*)(vp + 32 * 768 + ch);
      o0 = MFMA(v0, pf, o0); o1 = MFMA(v1, pf, o1);
    }
  asm volatile("s_waitcnt lgkmcnt(0)" ::: "memory"); __builtin_amdgcn_s_barrier(); asm volatile("" ::: "memory");
  if (xnext >= 0) b_issue_v(p, xnext, lds, tid, wid);
  const float inv = 1.0f / l;
  const int tkn = ((i0w + r) << sh) + sub;
  bf16_t* OG = (g < 2) ? (bf16_t*)(p.ws + OFF_H) + (size_t)g * S * 512 : (bf16_t*)(p.ws + OFF_OB);
  bf16_t* op = OG + (size_t)tkn * 512 + head * 64;
  store_o_wide(op, o0, inv, h); store_o_wide(op + 32, o1, inv, h);
  if (h == 0) { float* LSE = (float*)(p.ws + OFF_LSE); LSE[((size_t)g * S + tkn) * 8 + head] = (mx + __builtin_amdgcn_logf(l)) * LN2; }
}

DI void phase_attn(const Params& p, int layer, char* smem) {
  const int n_dense = 1024, n_b = 1536, total = n_dense + n_b;
  int it = blockIdx.x;
  for (; it < n_dense; it += gridDim.x) {
    if (it < 512) { attn_dense_unit<0>(p, layer, it & 7, it >> 3, smem); }
    else { const int v = it - 512; attn_dense_unit<1>(p, layer, v & 7, v >> 3, smem); }
  }
  if (it < total) {
    const int tid = otid(), wid = wave_of(tid);
    b_issue_k(p, it - n_dense, smem, tid, wid); b_issue_v(p, it - n_dense, smem, tid, wid);
    for (; it < total; it += gridDim.x) {
      const int nx = it + (int)gridDim.x;
      attn_b_item(p, it - n_dense, nx < total ? nx - n_dense : -1, smem);
    }
  }
}

DI void phase_combine(const Params& p) {
  const bf16_t* G0 = (const bf16_t*)(p.ws + OFF_H); const bf16_t* G1 = G0 + (size_t)S * 512; bf16_t* OB = (bf16_t*)(p.ws + OFF_OB);
  const float* LSE = (const float*)(p.ws + OFF_LSE);
  for (int e = blockIdx.x * 512 + otid(); e < S * 64; e += gridDim.x * 512) {
    const int tkn = e >> 6, c = e & 63, head = c >> 3;
    const float l0 = LSE[((size_t)0 * S + tkn) * 8 + head], l1 = LSE[((size_t)1 * S + tkn) * 8 + head], l2 = LSE[((size_t)2 * S + tkn) * 8 + head];
    const float mm = fmaxf(l0, fmaxf(l1, l2));
    float w0 = __expf(l0 - mm), w1 = __expf(l1 - mm), w2 = __expf(l2 - mm);
    const float iw = 1.0f / (w0 + w1 + w2); w0 *= iw; w1 *= iw; w2 *= iw;
    const size_t off = (size_t)tkn * 512 + c * 8;
    const u32x4 a = *(const u32x4*)(G0 + off), b = *(const u32x4*)(G1 + off), d = *(const u32x4*)(OB + off);
    u32x4 o;
#pragma unroll
    for (int q = 0; q < 4; ++q) o[q] = pk2(w0 * bflo(a[q]) + w1 * bflo(b[q]) + w2 * bflo(d[q]), w0 * bfhi(a[q]) + w1 * bfhi(b[q]) + w2 * bfhi(d[q]));
    *(u32x4*)(OB + off) = o;
  }
}

#define XB_TMO      128
#define XB_XCNT(j)  (256  + 64 * (j))
#define XB_XSUB(j)  (1280 + 64 * (j))
#define XB_XGEN(j)  (2304 + 64 * (j))
#define XB_TOP      3328
#define XB_TOPGEN   3392
#define XCD_BAR_WORDS 3456
#define XB_SPIN_CAP (1u << 18)
#ifndef LAS
#define LAS __attribute__((address_space(3)))
#endif

__device__ __forceinline__ unsigned xb_ld(unsigned* p)              { return __hip_atomic_load(p, __ATOMIC_RELAXED, __HIP_MEMORY_SCOPE_AGENT); }
__device__ __forceinline__ unsigned xb_add(unsigned* p, unsigned v) { return __hip_atomic_fetch_add(p, v, __ATOMIC_RELAXED, __HIP_MEMORY_SCOPE_AGENT); }
__device__ __forceinline__ unsigned xb_xcc_id() { return (unsigned)__builtin_amdgcn_s_getreg((3 << 11) | 20) & 0xFu; }
#define XB_SPIN(cond, bar) do { unsigned _sp = 0; while (cond) { __builtin_amdgcn_s_sleep(1); \
    if ((++_sp & 255u) == 0u) { if (xb_ld(&(bar)[XB_TMO])) break; if (_sp > XB_SPIN_CAP) { atomicAdd(&(bar)[XB_TMO], 1u); break; } } } } while (0)

struct XcdBarrier {
    unsigned* bar; unsigned x;
    volatile LAS unsigned* st;
};

__device__ __forceinline__ XcdBarrier xcd_barrier_post(unsigned* bar, volatile LAS unsigned* st) {
    XcdBarrier b; b.bar = bar; b.x = xb_xcc_id(); b.st = st;
    if (threadIdx.x == 0) (void)xb_add(&bar[XB_XCNT(b.x)], 1u);
    return b;
}
__device__ __forceinline__ void xcd_barrier_complete(unsigned* bar, unsigned x, unsigned& nloc, unsigned& nx) {
    const unsigned G = gridDim.x * gridDim.y * gridDim.z;
    unsigned sum, cnt, mine, sp = 0u;
    for (;;) {
        sum = 0u; cnt = 0u; mine = 0u;
#pragma unroll
        for (unsigned j = 0; j < 16; ++j) { const unsigned c = xb_ld(&bar[XB_XCNT(j)]); sum += c; cnt += (c > 0u) ? 1u : 0u; mine = (j == x) ? c : mine; }
        if (sum == G) break;
        __builtin_amdgcn_s_sleep(1);
        if ((++sp & 255u) == 0u) { if (xb_ld(&bar[XB_TMO])) break; if (sp > XB_SPIN_CAP) { atomicAdd(&bar[XB_TMO], 1u); break; } }
    }
    nloc = mine > 0u ? mine : 1u; nx = cnt > 0u ? cnt : 1u;
}

__device__ __forceinline__ void xcd_barrier(const XcdBarrier& b) {
    asm volatile("s_waitcnt vmcnt(0)" ::: "memory");
    __syncthreads();
    if (threadIdx.x == 0) {
        unsigned* bar = b.bar;
        __builtin_amdgcn_s_waitcnt(0);
        unsigned nloc = b.st[0], nx = b.st[1];
        if (nloc == 0u) { xcd_barrier_complete(bar, b.x, nloc, nx); b.st[0] = nloc; b.st[1] = nx; }
        const unsigned old = xb_add(&bar[XB_XSUB(b.x)], 1u);
        const unsigned gen = old / nloc;
        if (old + 1u == (gen + 1u) * nloc) {
            __builtin_amdgcn_fence(__ATOMIC_RELEASE, "agent");
            asm volatile("s_waitcnt vmcnt(0)" ::: "memory");
            const unsigned og = xb_add(&bar[XB_TOP], 1u);
            const unsigned tg = og / nx;
            if (og + 1u == (tg + 1u) * nx) xb_add(&bar[XB_TOPGEN], 1u);
            else XB_SPIN(xb_ld(&bar[XB_TOPGEN]) == tg, bar);
            __builtin_amdgcn_fence(__ATOMIC_ACQUIRE, "agent");
            xb_add(&bar[XB_XGEN(b.x)], 1u);
            asm volatile("s_waitcnt vmcnt(0)" ::: "memory");
        } else {
            XB_SPIN(xb_ld(&bar[XB_XGEN(b.x)]) == gen, bar);
            __builtin_amdgcn_fence(__ATOMIC_ACQUIRE, "agent");
            asm volatile("s_waitcnt vmcnt(0)" ::: "memory");
        }
    }
    __syncthreads();
}

__global__ void __launch_bounds__(512) hybrid_encoder_mega(Params p) {
  extern __shared__ __attribute__((aligned(16))) char smem[];
  cg::grid_group grid = cg::this_grid();
  const int G = gridDim.x, bx = blockIdx.x;
  bf16_t* Z = (bf16_t*)(p.ws + OFF_Z); bf16_t* H = (bf16_t*)(p.ws + OFF_H);
  float* ssq_q = (float*)(p.ws + OFF_SSQ); float* ssq_kv = ssq_q + S; float* ssq_x = ssq_q + 2 * S;
  bf16_t* XB = (bf16_t*)(p.ws + OFF_OA);
  volatile LAS unsigned* xst = (volatile LAS unsigned*)(smem + 131072);
  if (threadIdx.x == 0) { xst[0] = 0u; xst[1] = 0u; xst[2] = 0u; xst[3] = 0u; }
  __syncthreads();
  const XcdBarrier xb = xcd_barrier_post((unsigned*)(p.ws + OFF_BAR), xst);
  bool first_sync = true;
#define GSYNC() do { if (first_sync) { grid.sync(); first_sync = false; } else xcd_barrier(xb); } while (0)
  build_tables(p);
  for (int layer = 0; layer < 2; ++layer) {
    convert_weights(p, layer, smem);
    for (int seq = 0; seq < 3; ++seq) {
      const float* xin = (layer == 0) ? (seq < 2 ? p.x_prompt + (size_t)seq * S * DM : p.x_sample) : p.out + (size_t)seq * S * DM;
      float* xo = p.out + (size_t)seq * S * DM;
      phase_norm(xin, p.norm_mix + layer * DM, H, S);
      { const int tz = otid();
_Pragma("nounroll")
        for (int b = bx; b < 96; b += G) ssq_q[b * 512 + tz] = 0.f; }
      GSYNC();
      { pg8::Gemm g{H, (const bf16_t*)(p.ws + WT_IN), S, 9216, DM, DM, DM}; pg8::StaticOrder so; so.init(S, 9216, G, bx);
        EpiInproj E{Z, (bf16_t*)(p.ws + OFF_VCT), (bf16_t*)(p.ws + OFF_VBT), ssq_q, ssq_kv};
        pg8::gemm_phase<EpiInproj, pg8::StaticOrder, true, true>(GEMM_LDS, g, so, E); }
      GSYNC();
      { pg8::Gemm g{Z + ZC_CQ, (const bf16_t*)(p.ws + WT_UQ), S, 768, 384, ZP, 384}; pg8::StaticOrder so; so.init(S, 768, G, bx);
        EpiUpQ E{(bf16_t*)(p.ws + OFF_QA), ssq_q};
        pg8::gemm_phase<EpiUpQ, pg8::StaticOrder, true, true>(GEMM_LDS, g, so, E); }
      { pg8::Gemm g{Z + ZC_CKV, (const bf16_t*)(p.ws + WT_UKV), S, 1024, 256, ZP, 256}; pg8::StaticOrder so; so.init(S, 1024, G, bx);
        EpiUpKV E{(bf16_t*)(p.ws + OFF_KA), (bf16_t*)(p.ws + OFF_VAT), ssq_kv};
        pg8::gemm_phase<EpiUpKV, pg8::StaticOrder, true, true>(GEMM_LDS, g, so, E); }
      phase_kpost(p, layer);
      GSYNC();
      phase_attn(p, layer, smem);
      GSYNC();
      phase_combine(p);
      GSYNC();
      { pg8::Gemm g{(const bf16_t*)(p.ws + OFF_OA), (const bf16_t*)(p.ws + WT_BRA), 3 * S, 3072, 512, 512, 512}; DiagOrder so; so.init(G, bx);
        EpiMerge E{Z, H};
        pg8::gemm_phase<EpiMerge, DiagOrder, true, true>(GEMM_LDS, g, so, E); }
      GSYNC();
      { pg8::Gemm g{H, (const bf16_t*)(p.ws + WT_OUT), S, 1024, DM, DM, DM}; pg8::StaticOrder so; so.init(S, 1024, G, bx);
        EpiResid<true> E{xin, xo, XB, ssq_x};
        pg8::gemm_phase<EpiResid<true>, pg8::StaticOrder, true, true>(GEMM_LDS, g, so, E); }
      GSYNC();
      { pg8::Gemm g{XB, (const bf16_t*)(p.ws + WT_UP), S, DFF, DM, DM, DM}; pg8::StaticOrder so; so.init(S, DFF, G, bx);
        EpiRelu2 E{Z, ssq_x};
        pg8::gemm_phase<EpiRelu2, pg8::StaticOrder, true, true>(GEMM_LDS, g, so, E); }
      GSYNC();
      { pg8::Gemm g{Z, (const bf16_t*)(p.ws + WT_DOWN), S, 1024, DFF, DFF, DFF}; pg8::StaticOrder so; so.init(S, 1024, G, bx);
        EpiResid<false> E{xo, xo, nullptr, nullptr};
        pg8::gemm_phase<EpiResid<false>, pg8::StaticOrder, true, true>(GEMM_LDS, g, so, E); }
      GSYNC();
    }
  }
  phase_final_norm(p.out, p.final_norm, 3 * S);
}

extern "C" void kernel_launch(void* const* d_in, const int* in_sizes, int n_in, void* d_out, int out_size, void* d_ws, size_t ws_size, hipStream_t stream) {
  static int grid_blocks = 0;
  if (!grid_blocks) {
    if (ws_size < WS_END) { fprintf(stderr, "kernel_launch: workspace too small: %zu < %zu\n", ws_size, (size_t)WS_END); return; }
    if (hipFuncSetAttribute((const void*)hybrid_encoder_mega, hipFuncAttributeMaxDynamicSharedMemorySize, LDS_BYTES) != hipSuccess) { fprintf(stderr, "hipFuncSetAttribute failed\n"); return; }
    int dev = 0, cus = 0, per_cu = 0;
    hipGetDevice(&dev);
    hipDeviceGetAttribute(&cus, hipDeviceAttributeMultiprocessorCount, dev);
    hipOccupancyMaxActiveBlocksPerMultiprocessor(&per_cu, hybrid_encoder_mega, 512, LDS_BYTES);
    if (per_cu < 1) { fprintf(stderr, "occupancy query returned %d\n", per_cu); return; }
    grid_blocks = cus;
  }
  Params p{};
  p.x_prompt = (const float*)d_in[0]; p.x_sample = (const float*)d_in[1];
  p.norm_mix = (const float*)d_in[2]; p.w_in = (const float*)d_in[3]; p.a_q_norm = (const float*)d_in[4]; p.a_kv_norm = (const float*)d_in[5];
  p.a_w_uq = (const float*)d_in[6]; p.a_w_ukv = (const float*)d_in[7]; p.c_q_norm = (const float*)d_in[8]; p.c_k_norm = (const float*)d_in[9];
  p.w_br_a = (const float*)d_in[10]; p.w_br_b = (const float*)d_in[11]; p.w_br_c = (const float*)d_in[12]; p.w_out = (const float*)d_in[13];
  p.norm_ffn = (const float*)d_in[14]; p.w_up = (const float*)d_in[15]; p.w_down = (const float*)d_in[16]; p.t5_table = (const float*)d_in[17];
  p.final_norm = (const float*)d_in[18];
  p.out = (float*)d_out; p.ws = (char*)d_ws;
  (void)hipMemsetAsync((char*)d_ws + OFF_BAR, 0, 16384, stream);
  void* args[] = {&p};
  hipError_t e = hipLaunchCooperativeKernel((const void*)hybrid_encoder_mega, dim3(grid_blocks), dim3(512), args, LDS_BYTES, stream);
  if (e != hipSuccess) fprintf(stderr, "cooperative launch failed: %s (grid %d)\n", hipGetErrorString(e), grid_blocks);
}
```

```cpp
#include <hip/hip_runtime.h>
#include <hip/hip_cooperative_groups.h>
#include <stdint.h>
#include <cstdio>
namespace cg = cooperative_groups;

typedef unsigned short bf16_t;
typedef short bf16x8 __attribute__((ext_vector_type(8)));
typedef short s16x4 __attribute__((ext_vector_type(4)));
typedef float f32x16 __attribute__((ext_vector_type(16)));
typedef float f32x4 __attribute__((ext_vector_type(4)));
typedef float f32x2 __attribute__((ext_vector_type(2)));
typedef unsigned u32x4 __attribute__((ext_vector_type(4)));
typedef unsigned u32x2 __attribute__((ext_vector_type(2)));
typedef __bf16 bf16x2_t __attribute__((ext_vector_type(2)));

#define DI __device__ __forceinline__
#define MFMA(a, b, c) __builtin_amdgcn_mfma_f32_32x32x16_bf16((a), (b), (c), 0, 0, 0)

DI unsigned pk2(float lo, float hi) { f32x2 v = {lo, hi}; bf16x2_t b = __builtin_convertvector(v, bf16x2_t); return __builtin_bit_cast(unsigned, b); }
DI bf16_t f2bf(float x) { return (bf16_t)(pk2(x, 0.f) & 0xffffu); }
DI float bflo(unsigned u) { return __uint_as_float(u << 16); }
DI float bfhi(unsigned u) { return __uint_as_float(u & 0xffff0000u); }
DI float bf2f(bf16_t b) { return __uint_as_float(((unsigned)b) << 16); }
DI int crow(int i, int h) { return (i & 3) + 8 * (i >> 2) + 4 * h; }
DI float fexp2(float x) { return __builtin_amdgcn_exp2f(x); }
DI int otid() { int t = threadIdx.x; asm volatile("" : "+v"(t)); return t; }
DI int wave_of(int tid) { return __builtin_amdgcn_readfirstlane(tid >> 6); }

constexpr int S = 16384, DM = 1024, ZP = 7680, DFF = 4096;
constexpr int ZC_CQ = 0, ZC_CKV = 384, ZC_KR = 640, ZC_QKVB = 768, ZC_QC = 3840, ZC_KC = 4352, ZC_GATE = 4608;
constexpr int GC_VB = 3840, GC_VC = 6016;
constexpr float LOG2E = 1.4426950408889634f, LN2 = 0.6931471805599453f;

constexpr size_t WT_IN = 0;
constexpr size_t WT_UQ = WT_IN + (size_t)9216 * 1024 * 2;
constexpr size_t WT_UKV = WT_UQ + (size_t)768 * 384 * 2;
constexpr size_t WT_BRA = WT_UKV + (size_t)1024 * 256 * 2;
constexpr size_t WT_BRB = WT_BRA + (size_t)1024 * 512 * 2;
constexpr size_t WT_BRC = WT_BRB + (size_t)1024 * 512 * 2;
constexpr size_t WT_OUT = WT_BRC + (size_t)1024 * 512 * 2;
constexpr size_t WT_UP = WT_OUT + (size_t)1024 * 3072 * 2;
constexpr size_t WT_DOWN = WT_UP + (size_t)4096 * 1024 * 2;
constexpr size_t OFF_CS = WT_DOWN + (size_t)1024 * 4096 * 2;
constexpr size_t OFF_BT = OFF_CS + (size_t)16384 * 16 * 8;
constexpr size_t OFF_Z = OFF_BT + 32768;
constexpr size_t OFF_H = OFF_Z + (size_t)S * ZP * 2;
constexpr size_t OFF_QA = OFF_H + (size_t)S * 1024 * 2;
constexpr size_t OFF_KA = OFF_QA + (size_t)S * 768 * 2;
constexpr size_t OFF_VAT = OFF_KA + (size_t)S * 512 * 2;
constexpr size_t OFF_VCT = OFF_VAT + (size_t)S * 512 * 2;
constexpr size_t OFF_OA = OFF_VCT + (size_t)S * 128 * 2;
constexpr size_t OFF_OB = OFF_OA + (size_t)S * 512 * 2;
constexpr size_t OFF_OC = OFF_OB + (size_t)S * 512 * 2;
constexpr size_t OFF_LSE = OFF_OC + (size_t)S * 512 * 2;
constexpr size_t OFF_SSQ = OFF_LSE + (size_t)3 * S * 8 * 4;
constexpr size_t OFF_VBT = OFF_SSQ + (size_t)3 * S * 4;
constexpr size_t OFF_BAR = OFF_VBT + (size_t)1536 * S * 2;
constexpr size_t WS_END = OFF_BAR + 16384;

constexpr int LDS_BYTES = 131072 + 1024;

struct Params {
  const float* x_prompt; const float* x_sample;
  const float* norm_mix; const float* w_in; const float* a_q_norm; const float* a_kv_norm; const float* a_w_uq; const float* a_w_ukv;
  const float* c_q_norm; const float* c_k_norm; const float* w_br_a; const float* w_br_b; const float* w_br_c; const float* w_out;
  const float* norm_ffn; const float* w_up; const float* w_down; const float* t5_table; const float* final_norm;
  float* out; char* ws;
};

DI void sincos_d(double x, float& c, float& s) {
  const double k = rint(x * 0.6366197723675814);
  double t = fma(-k, 1.5707963267948966, x); t = fma(-k, 6.123233995736766e-17, t);
  const double t2 = t * t;
  double sn = 1.0 - t2 / 210.0; sn = 1.0 - t2 / 156.0 * sn; sn = 1.0 - t2 / 110.0 * sn; sn = 1.0 - t2 / 72.0 * sn; sn = 1.0 - t2 / 42.0 * sn; sn = 1.0 - t2 / 20.0 * sn; sn = 1.0 - t2 / 6.0 * sn; sn *= t;
  double cs = 1.0 - t2 / 240.0; cs = 1.0 - t2 / 182.0 * cs; cs = 1.0 - t2 / 132.0 * cs; cs = 1.0 - t2 / 90.0 * cs; cs = 1.0 - t2 / 56.0 * cs; cs = 1.0 - t2 / 30.0 * cs; cs = 1.0 - t2 / 12.0 * cs; cs = 1.0 - t2 / 2.0 * cs;
  const int q = ((int)k) & 3;
  double so = (q == 0) ? sn : (q == 1) ? cs : (q == 2) ? -sn : -cs;
  double co = (q == 0) ? cs : (q == 1) ? -sn : (q == 2) ? -cs : sn;
  c = (float)co; s = (float)so;
}

DI void build_tables(const Params& p) {
  f32x2* CS = (f32x2*)(p.ws + OFF_CS);
  const int gsz = gridDim.x * 512, gid = blockIdx.x * 512 + otid();
  for (int e = gid; e < 16384 * 16; e += gsz) {
    const int pos = e >> 4, i = e & 15;
    double f = 1.0; for (int j = 0; j < i; ++j) f *= 0.5623413251903491;
    const float ff = (float)f; const float ang = (float)pos * ff;
    float c, s; sincos_d((double)ang, c, s);
    CS[e] = (f32x2){c, s};
  }
  float* BT = (float*)(p.ws + OFF_BT);
  for (int e = gid; e < 3 * 8 * 256; e += gsz) {
    const int gh = e >> 8, g = gh >> 3, hd = gh & 7, j = (e & 255) - 32;
    float v = 0.f;
    if (j >= 0 && j <= 128) {
      const int rel = (j - 64) << (2 * g);
      const int n = rel < 0 ? -rel : rel;
      int b = rel > 0 ? 16 : 0;
      if (n < 8) b += n; else { int lg = 31 - __clz(n); int vv = 5 + lg; b += (vv < 15 ? vv : 15); }
      v = p.t5_table[b * 24 + g * 8 + hd] * LOG2E;
    }
    BT[e] = v;
  }
}

DI void cvt_tile(const float* __restrict__ W, int ldw, int ldk, int koff, bf16_t* __restrict__ Wt, int k0, int n0, int mode, const float* __restrict__ rscale, float* tile) {
  const int tid = otid();
#pragma unroll
  for (int i = 0; i < 8; ++i) {
    const int kl = (tid >> 6) + 8 * i, nl = tid & 63, nn = n0 + nl;
    int src = nn;
    if (mode == 1) src = nn < 672 ? nn : (nn < 768 ? -1 : nn - 96);
    float v = 0.f;
    if (src >= 0) v = W[(size_t)(k0 + kl) * ldw + src];
    if (rscale) v *= rscale[k0 + kl];
    tile[kl * 65 + nl] = v;
  }
  __syncthreads();
#pragma unroll
  for (int i = 0; i < 8; ++i) {
    const int nl = (tid >> 6) + 8 * i, kl = tid & 63;
    Wt[(size_t)(n0 + nl) * ldk + koff + k0 + kl] = f2bf(tile[kl * 65 + nl]);
  }
  __syncthreads();
}

DI void convert_weights(const Params& p, int layer, char* smem) {
  float* tile = (float*)smem;
  int base = 0;
  for (int mtx = 0; mtx < 9; ++mtx) {
    const float* W; int K, Nsrc, Ndst, mode = 0, ldk = 0, koff = 0; const float* rs = nullptr; size_t off;
    switch (mtx) {
      case 0: W = p.w_in + (size_t)layer * 1024 * 9120; K = 1024; Nsrc = 9120; Ndst = 9216; mode = 1; off = WT_IN; break;
      case 1: W = p.a_w_uq + (size_t)layer * 384 * 768; K = 384; Nsrc = 768; Ndst = 768; rs = p.a_q_norm + layer * 384; off = WT_UQ; break;
      case 2: W = p.a_w_ukv + (size_t)layer * 256 * 1024; K = 256; Nsrc = 1024; Ndst = 1024; rs = p.a_kv_norm + layer * 256; off = WT_UKV; break;
      case 3: W = p.w_br_a + (size_t)layer * 512 * 1024; K = 512; Nsrc = 1024; Ndst = 1024; off = WT_BRA; break;
      case 4: W = p.w_br_b + (size_t)layer * 512 * 1024; K = 512; Nsrc = 1024; Ndst = 1024; off = WT_BRB; break;
      case 5: W = p.w_br_c + (size_t)layer * 512 * 1024; K = 512; Nsrc = 1024; Ndst = 1024; off = WT_BRC; break;
      case 6: W = p.w_out + (size_t)layer * 1024 * 1024; K = 1024; Nsrc = 1024; Ndst = 1024; off = WT_OUT; break;
      case 7: W = p.w_up + (size_t)layer * 1024 * 4096; K = 1024; Nsrc = 4096; Ndst = 4096; rs = p.norm_ffn + layer * DM; off = WT_UP; break;
      case 8: default: W = p.w_down + (size_t)layer * 4096 * 1024; K = 4096; Nsrc = 1024; Ndst = 1024; off = WT_DOWN; break;
    }
    if (ldk == 0) ldk = K;
    const int nk = K / 64, nn = Ndst / 64, cnt = nk * nn;
    bf16_t* Wt = (bf16_t*)(p.ws + off);
    int first = (int)blockIdx.x - (base % (int)gridDim.x); if (first < 0) first += gridDim.x;
    for (int it = first; it < cnt; it += gridDim.x) {
      const int kt = it % nk, nt = it / nk;
      cvt_tile(W, Nsrc, ldk, koff, Wt, kt * 64, nt * 64, mode, rs, tile);
    }
    base += cnt;
  }
}

DI void phase_norm(const float* __restrict__ x, const float* __restrict__ g, bf16_t* __restrict__ H, int rows) {
  const int tid = otid(), lane = tid & 63, wid = tid >> 6;
  for (int row = blockIdx.x * 8 + wid; row < rows; row += gridDim.x * 8) {
    const float* xr = x + (size_t)row * DM;
    f32x4 v[4]; float ss = 0.f;
#pragma unroll
    for (int i = 0; i < 4; ++i) { v[i] = *(const f32x4*)(xr + i * 256 + lane * 4); ss += v[i][0] * v[i][0] + v[i][1] * v[i][1] + v[i][2] * v[i][2] + v[i][3] * v[i][3]; }
#pragma unroll
    for (int o = 32; o >= 1; o >>= 1) ss += __shfl_xor(ss, o);
    const float rstd = rsqrtf(ss * (1.0f / DM) + 1e-6f);
#pragma unroll
    for (int i = 0; i < 4; ++i) {
      const f32x4 gg = *(const f32x4*)(g + i * 256 + lane * 4);
      u32x2 w; w.x = pk2(v[i][0] * rstd * gg[0], v[i][1] * rstd * gg[1]); w.y = pk2(v[i][2] * rstd * gg[2], v[i][3] * rstd * gg[3]);
      *(u32x2*)(H + (size_t)row * DM + i * 256 + lane * 4) = w;
    }
  }
}

DI void phase_final_norm(float* __restrict__ x, const float* __restrict__ g, int rows) {
  const int tid = otid(), lane = tid & 63, wid = tid >> 6;
  for (int row = blockIdx.x * 8 + wid; row < rows; row += gridDim.x * 8) {
    float* xr = x + (size_t)row * DM;
    f32x4 v[4]; float ss = 0.f;
#pragma unroll
    for (int i = 0; i < 4; ++i) { v[i] = *(const f32x4*)(xr + i * 256 + lane * 4); ss += v[i][0] * v[i][0] + v[i][1] * v[i][1] + v[i][2] * v[i][2] + v[i][3] * v[i][3]; }
#pragma unroll
    for (int o = 32; o >= 1; o >>= 1) ss += __shfl_xor(ss, o);
    const float rstd = rsqrtf(ss * (1.0f / DM) + 1e-6f);
#pragma unroll
    for (int i = 0; i < 4; ++i) {
      const f32x4 gg = *(const f32x4*)(g + i * 256 + lane * 4);
      f32x4 o = {v[i][0] * rstd * gg[0], v[i][1] * rstd * gg[1], v[i][2] * rstd * gg[2], v[i][3] * rstd * gg[3]};
      *(f32x4*)(xr + i * 256 + lane * 4) = o;
    }
  }
}


namespace pg8 {
#define PG8_LAS __attribute__((address_space(3)))
typedef unsigned short bf16_t;
typedef short bf16x8 __attribute__((ext_vector_type(8)));
typedef float f32x4 __attribute__((ext_vector_type(4)));
typedef unsigned u32x4 __attribute__((ext_vector_type(4)));
constexpr int BM = 256, BK = 64, HALF = 128, HTB = HALF * BK * 2  , STAGE_BYTES = 8 * HTB, NXCD = 8, WGM = 8;

__host__ __device__ __forceinline__ int lds_byte(int r, int c) { const int st = (r >> 4) * 2 + (c >> 5), rr = r & 15, cc = c & 31, ob = rr * 64 + cc * 2; return st * 1024 + (ob ^ (((ob >> 9) & 1) << 5)); }
__host__ __device__ __forceinline__ void stage_rc(int b, int& R, int& C) { const int st = b / 1024, sb = b % 1024, swz = sb ^ (((sb >> 9) & 1) << 5); R = (st >> 1) * 16 + swz / 64; C = (st & 1) * 32 + (swz % 64) / 2; }
__host__ __device__ __forceinline__ int perm32(int rho) { const int n = rho >> 4, i = rho & 15; return 8 * (i >> 2) + 4 * n + (i & 3); }

struct Unit { int pm, pn; };
struct Gemm { const bf16_t* A; const bf16_t* Bt; int M, N, K, lda, ldb; };

struct StaticOrder {
    int nM, nN, nwg, G, c;
    __host__ __device__ void init(int M, int N, int G_, int c_) { nM = M / BM; nN = N / BM; nwg = nM * nN; G = G_; c = c_; }
    __host__ __device__ bool next(int i, Unit& u) const {
        const long L = (long)i * G + c; if (L >= nwg) return false;
        map((int)L, u); return true; }
    __host__ __device__ void map(int L, Unit& u) const {
        int wgid = L; { const int q = nwg / NXCD, r = nwg % NXCD, xcd = wgid % NXCD, off = wgid / NXCD; wgid = (xcd < r ? xcd * (q + 1) : r * (q + 1) + (xcd - r) * q) + off; }
        const int nig = WGM * nN, gid = wgid / nig, fm = gid * WGM, gsz = (nM - fm) < WGM ? (nM - fm) : WGM;
        u.pm = fm + ((wgid % nig) % gsz); u.pn = (wgid % nig) / gsz;
    }
    __device__ __forceinline__ void a_ready(const Unit&) const {}
    __device__ __forceinline__ void done(const Unit&) const {}
};
template <class Epi, class Sched, bool ALIGN_EPI = false, bool SP2 = false>
__device__ __forceinline__ void gemm_phase(PG8_LAS unsigned char* lds, const Gemm g, const Sched& S, const Epi& E) {
    int tid_ = threadIdx.x; asm volatile("" : "+v"(tid_)); const int tid = tid_, wid = __builtin_amdgcn_readfirstlane(tid >> 6), lane = tid & 63, wr = wid >> 2, wc = wid & 3, fr = lane & 15, fq = lane >> 4;
    const int K = g.K, nt = K / BK;
    unsigned voffA[2], voffB[2];
#pragma unroll
    for (int i = 0; i < 2; ++i) { int R, C; stage_rc(tid * 16 + i * 8192, R, C); const int Rb = Epi::PERM ? ((R & ~31) + perm32(R & 31)) : R;
        voffA[i] = (unsigned)(R * g.lda + C) * 2u; voffB[i] = (unsigned)(Rb * g.ldb + C) * 2u; }
    const size_t kstep = (size_t)(BK * 2);
    const size_t hA = (size_t)HALF * g.lda * 2, hB = (size_t)HALF * g.ldb * 2;
    const size_t tA = 2 * hA, tB = 2 * hB;
    const unsigned ldsw = (unsigned)wid * 1024u;
    const int aoff = lds_byte(wr * 64 + fr, fq * 8), boff = lds_byte(wc * 32 + fr, fq * 8);
#define PG8_SA(b, h) (((b) * 2 + (h)) * HTB)
#define PG8_SB(b, h) ((4 + (b) * 2 + (h)) * HTB)
#define PG8_STAGE(bufoff, gbase, voff) do { _Pragma("unroll") for (int _i = 0; _i < 2; ++_i) \
        __builtin_amdgcn_global_load_lds((const unsigned*)((const char*)(gbase) + (voff)[_i]), (PG8_LAS unsigned*)(lds + (bufoff) + ldsw + _i * 8192), 16, 0, 0); } while (0)
#define PG8_LDA(dst, b, h) do { _Pragma("unroll") for (int m = 0; m < 4; ++m) _Pragma("unroll") for (int k = 0; k < 2; ++k) dst[m][k] = *(const PG8_LAS bf16x8*)(lds + PG8_SA(b, h) + aoff + m * 2048 + k * 1024); } while (0)
#define PG8_LDB(dst, b, h) do { _Pragma("unroll") for (int n = 0; n < 2; ++n) _Pragma("unroll") for (int k = 0; k < 2; ++k) dst[n][k] = *(const PG8_LAS bf16x8*)(lds + PG8_SB(b, h) + boff + n * 2048 + k * 1024); } while (0)
#define PG8_MMA(ai, bj, At, Bt) do { __builtin_amdgcn_s_setprio(1); _Pragma("unroll") for (int m = 0; m < 4; ++m) _Pragma("unroll") for (int n = 0; n < 2; ++n) _Pragma("unroll") for (int k = 0; k < 2; ++k) \
        acc[ai][bj][m][n] = __builtin_amdgcn_mfma_f32_16x16x32_bf16(Bt[n][k], At[m][k], acc[ai][bj][m][n], 0, 0, 0); __builtin_amdgcn_s_setprio(0); } while (0)
#define PG8_WAIT_V(n) asm volatile("s_waitcnt vmcnt(" #n ")" ::: "memory")
#define PG8_WAIT_L(n) asm volatile("s_waitcnt lgkmcnt(" #n ")" ::: "memory")
#define PG8_BAR __builtin_amdgcn_s_barrier()
#define PG8_SCHED __builtin_amdgcn_sched_barrier(0)
    Unit cur, nxt; int ui = 0;
    if (!S.next(0, cur)) return;
    f32x4 acc[2][2][4][2];
#pragma unroll
    for (int a = 0; a < 2; ++a)
#pragma unroll
        for (int b = 0; b < 2; ++b)
#pragma unroll
            for (int m = 0; m < 4; ++m)
#pragma unroll
                for (int n = 0; n < 2; ++n) acc[a][b][m][n] = (f32x4){0.f, 0.f, 0.f, 0.f};
    bf16x8 At[4][2], B0[2][2], B1[2][2];
    const char* cA = (const char*)g.A + (size_t)cur.pm * tA; const char* cB = (const char*)g.Bt + (size_t)cur.pn * tB;
    S.a_ready(cur);
    if constexpr (SP2) {
        PG8_STAGE(PG8_SB(0, 0), cB, voffB); PG8_STAGE(PG8_SB(0, 1), cB + hB, voffB); PG8_STAGE(PG8_SA(0, 0), cA, voffA); PG8_STAGE(PG8_SA(0, 1), cA + hA, voffA);
        if (wr == 1) PG8_BAR;
        PG8_WAIT_V(2); PG8_BAR;
        PG8_STAGE(PG8_SB(1, 0), cB + kstep, voffB); PG8_STAGE(PG8_SA(1, 0), cA + kstep, voffA); PG8_STAGE(PG8_SB(1, 1), cB + hB + kstep, voffB);
        PG8_WAIT_V(6); PG8_BAR;
    } else {
        PG8_STAGE(PG8_SB(0, 0), cB, voffB); PG8_STAGE(PG8_SA(0, 0), cA, voffA); PG8_STAGE(PG8_SB(0, 1), cB + hB, voffB); PG8_STAGE(PG8_SA(0, 1), cA + hA, voffA);
        if (wr == 1) PG8_BAR;
        PG8_WAIT_V(4); PG8_BAR;
        PG8_STAGE(PG8_SB(1, 0), cB + kstep, voffB); PG8_STAGE(PG8_SA(1, 0), cA + kstep, voffA); PG8_STAGE(PG8_SB(1, 1), cB + hB + kstep, voffB);
        PG8_WAIT_V(6); PG8_BAR;
    }
    for (;;) {
        const bool has_next = S.next(ui + 1, nxt);
        const char* nA = has_next ? (const char*)g.A + (size_t)nxt.pm * tA : cA; const char* nB = has_next ? (const char*)g.Bt + (size_t)nxt.pn * tB : cB;
_Pragma("unroll 1")
        for (int t = 0; t < nt; t += 2) {
            const bool last = (t == nt - 2);
            const char* a1 = cA + (size_t)(t + 1) * kstep;
            const char* a2 = last ? nA : cA + (size_t)(t + 2) * kstep; const char* b2 = last ? nB : cB + (size_t)(t + 2) * kstep;
            const char* a3 = a2 + kstep; const char* b3 = b2 + kstep;
            if (last && has_next) S.a_ready(nxt);
            if constexpr (SP2) {
            PG8_LDB(B0, 0, 0); PG8_LDB(B1, 0, 1); PG8_SCHED; PG8_LDA(At, 0, 0); PG8_STAGE(PG8_SA(1, 1), a1 + hA, voffA);
            PG8_WAIT_V(8); PG8_WAIT_L(0); PG8_BAR; PG8_MMA(0, 0, At, B0); PG8_MMA(0, 1, At, B1); PG8_BAR; PG8_SCHED;
            PG8_LDA(At, 0, 1); PG8_STAGE(PG8_SB(0, 0), b2, voffB); PG8_STAGE(PG8_SB(0, 1), b2 + hB, voffB); PG8_STAGE(PG8_SA(0, 0), a2, voffA);
            PG8_WAIT_V(8); PG8_WAIT_L(0); PG8_BAR; PG8_MMA(1, 0, At, B0); PG8_MMA(1, 1, At, B1); PG8_BAR; PG8_SCHED;
            PG8_LDB(B0, 1, 0); PG8_LDB(B1, 1, 1); PG8_SCHED; PG8_LDA(At, 1, 0); PG8_STAGE(PG8_SA(0, 1), a2 + hA, voffA);
            PG8_WAIT_V(8); PG8_WAIT_L(0); PG8_BAR; PG8_MMA(0, 0, At, B0); PG8_MMA(0, 1, At, B1); PG8_BAR; PG8_SCHED;
            PG8_LDA(At, 1, 1); PG8_STAGE(PG8_SB(1, 0), b3, voffB); PG8_STAGE(PG8_SB(1, 1), b3 + hB, voffB); PG8_STAGE(PG8_SA(1, 0), a3, voffA);
            PG8_WAIT_V(8); PG8_WAIT_L(0); PG8_BAR; PG8_MMA(1, 0, At, B0); PG8_MMA(1, 1, At, B1); PG8_BAR; PG8_SCHED;
            } else {
            PG8_LDB(B0, 0, 0); PG8_SCHED; PG8_LDA(At, 0, 0); PG8_STAGE(PG8_SA(1, 1), a1 + hA, voffA);
            PG8_WAIT_L(8); PG8_BAR; PG8_WAIT_L(0); PG8_MMA(0, 0, At, B0); PG8_BAR; PG8_SCHED;
            PG8_LDB(B1, 0, 1); PG8_STAGE(PG8_SB(0, 0), b2, voffB);
            PG8_BAR; PG8_WAIT_L(0); PG8_MMA(0, 1, At, B1); PG8_BAR;
            PG8_LDA(At, 0, 1); PG8_STAGE(PG8_SA(0, 0), a2, voffA);
            PG8_BAR; PG8_WAIT_L(0); PG8_MMA(1, 0, At, B0); PG8_BAR; PG8_SCHED;
            PG8_STAGE(PG8_SB(0, 1), b2 + hB, voffB);
            PG8_WAIT_V(6); PG8_BAR; PG8_MMA(1, 1, At, B1); PG8_BAR;
            PG8_LDB(B0, 1, 0); PG8_SCHED; PG8_LDA(At, 1, 0); PG8_STAGE(PG8_SA(0, 1), a2 + hA, voffA);
            PG8_WAIT_L(8); PG8_BAR; PG8_WAIT_L(0); PG8_MMA(0, 0, At, B0); PG8_BAR; PG8_SCHED;
            PG8_LDB(B1, 1, 1); PG8_STAGE(PG8_SB(1, 0), b3, voffB);
            PG8_BAR; PG8_WAIT_L(0); PG8_MMA(0, 1, At, B1); PG8_BAR;
            PG8_LDA(At, 1, 1); PG8_STAGE(PG8_SA(1, 0), a3, voffA);
            PG8_BAR; PG8_WAIT_L(0); PG8_MMA(1, 0, At, B0); PG8_BAR; PG8_SCHED;
            PG8_STAGE(PG8_SB(1, 1), b3 + hB, voffB);
            PG8_WAIT_V(6); PG8_BAR; PG8_MMA(1, 1, At, B1); PG8_BAR;
            }
        }
        if constexpr (ALIGN_EPI) { if (wr == 0) PG8_BAR; }
        if constexpr (!Epi::AFTER_DRAIN) { E(acc, cur, wr, wc, fr, fq); S.done(cur); }
        if (!has_next) break;
#pragma unroll
        for (int a = 0; a < 2; ++a)
#pragma unroll
            for (int b = 0; b < 2; ++b)
#pragma unroll
                for (int m = 0; m < 4; ++m)
#pragma unroll
                    for (int n = 0; n < 2; ++n) acc[a][b][m][n] = (f32x4){0.f, 0.f, 0.f, 0.f};
        cur = nxt; cA = nA; cB = nB; ++ui;
        if constexpr (ALIGN_EPI) { if (wr == 1) PG8_BAR; }
    }
    PG8_WAIT_V(0);
    if constexpr (!ALIGN_EPI) { if (wr == 0) PG8_BAR; }
    PG8_BAR;
    if constexpr (Epi::AFTER_DRAIN) { E.fused(acc, cur, wr, wc, fr, fq, lds, wid, lane); S.done(cur); }
#undef PG8_SA
#undef PG8_SB
#undef PG8_STAGE
#undef PG8_LDA
#undef PG8_LDB
#undef PG8_MMA
#undef PG8_WAIT_V
#undef PG8_WAIT_L
#undef PG8_BAR
#undef PG8_SCHED
}
}

DI void rope_pair8(float (&x1)[8], float (&x2)[8], const f32x2* cs) {
#pragma unroll
  for (int j = 0; j < 8; ++j) { const f32x2 c = cs[j]; const float a = x1[j], b = x2[j]; x1[j] = a * c.x - b * c.y; x2[j] = a * c.y + b * c.x; }
}
typedef pg8::Unit Unit;
#define ACC_T const f32x4 (&acc)[2][2][4][2]
#define EROW(u, ai, m) ((u).pm * 256 + (ai) * 128 + wr * 64 + (m) * 16 + fr)
DI u32x4 pack_f8(const f32x4 a, const f32x4 b) { u32x4 w; w.x = pk2(a[0], a[1]); w.y = pk2(a[2], a[3]); w.z = pk2(b[0], b[1]); w.w = pk2(b[2], b[3]); return w; }

struct EpiInproj {
  static constexpr bool PERM = true, AFTER_DRAIN = false;
  bf16_t* Z; bf16_t* VCT; bf16_t* VBT; float* ssq_q; float* ssq_kv;
  DI void operator()(ACC_T, const Unit& u, int wr, int wc, int fr, int fq) const {
#pragma unroll
    for (int bj = 0; bj < 2; ++bj) {
      const int tt = 2 * u.pn + bj, cb = tt * 128 + wc * 32 + 8 * fq;
      int sh = 0; if (tt >= 6 && tt < 42) sh = 2 * (((tt - 6) >> 2) % 3);
      const int msk = (1 << sh) - 1;
      if (tt >= 38 && tt < 42) {
        bf16_t* vt = VBT + (size_t)(cb - GC_VB) * S + fr * (S >> 4) + u.pm * 16 + wr * 4;
#pragma unroll
        for (int ai = 0; ai < 2; ++ai)
#pragma unroll
          for (int n = 0; n < 2; ++n) {
            __builtin_amdgcn_sched_barrier(0);
#pragma unroll
            for (int e = 0; e < 4; ++e) {
              u32x2 w; w.x = pk2(acc[ai][bj][0][n][e], acc[ai][bj][1][n][e]); w.y = pk2(acc[ai][bj][2][n][e], acc[ai][bj][3][n][e]);
              *(u32x2*)(vt + (size_t)(4 * n + e) * S + ai * 8) = w;
            }
          }
      } else if (tt == 47 || (tt >= 30 && tt < 38)) {
        bf16_t* vt = (tt == 47) ? VCT + (size_t)(cb - GC_VC) * S : VBT + (size_t)(cb - GC_VB) * S;
#pragma unroll
        for (int ai = 0; ai < 2; ++ai)
#pragma unroll
          for (int m = 0; m < 4; ++m) {
            __builtin_amdgcn_sched_barrier(0);
            const int row = EROW(u, ai, m), prow = (row & msk) * (S >> sh) + (row >> sh);
            bf16_t* vp = vt + prow;
#pragma unroll
            for (int n = 0; n < 2; ++n)
#pragma unroll
              for (int e = 0; e < 4; ++e) vp[(size_t)(4 * n + e) * S] = f2bf(acc[ai][bj][m][n][e]);
          }
      } else {
        const int zc = cb < GC_VB ? cb : cb - 1536;
        float* ssq = (tt < 3) ? ssq_q : ((tt < 5) ? ssq_kv : nullptr);
#pragma unroll
        for (int ai = 0; ai < 2; ++ai)
#pragma unroll
          for (int m = 0; m < 4; ++m) {
            const int row = EROW(u, ai, m), prow = (row & msk) * (S >> sh) + (row >> sh);
            const f32x4 v0 = acc[ai][bj][m][0], v1 = acc[ai][bj][m][1];
            *(u32x4*)(Z + (size_t)prow * ZP + zc) = pack_f8(v0, v1);
            if (ssq) {
              float s = v0[0] * v0[0] + v0[1] * v0[1] + v0[2] * v0[2] + v0[3] * v0[3] + v1[0] * v1[0] + v1[1] * v1[1] + v1[2] * v1[2] + v1[3] * v1[3];
              s += __shfl_xor(s, 16); s += __shfl_xor(s, 32);
              if (fq == 0) __hip_atomic_fetch_add(ssq + row, s, __ATOMIC_RELAXED, __HIP_MEMORY_SCOPE_AGENT);
            }
          }
      }
    }
  }
};
struct EpiUpQ {
  static constexpr bool PERM = true, AFTER_DRAIN = false;
  bf16_t* QA; const float* ssq;
  DI void operator()(ACC_T, const Unit& u, int wr, int wc, int fr, int fq) const {
#pragma unroll
    for (int ai = 0; ai < 2; ++ai)
#pragma unroll
      for (int m = 0; m < 4; ++m) {
        const int row = EROW(u, ai, m); const float rs = rsqrtf(ssq[row] * (1.0f / 384.0f) + 1e-6f);
#pragma unroll
        for (int bj = 0; bj < 2; ++bj) {
          const int cb = u.pn * 256 + bj * 128 + wc * 32 + 8 * fq;
          *(u32x4*)(QA + (size_t)row * 768 + cb) = pack_f8(acc[ai][bj][m][0] * rs, acc[ai][bj][m][1] * rs);
        }
      }
  }
};
struct EpiUpKV {
  static constexpr bool PERM = true, AFTER_DRAIN = false;
  bf16_t* KA; bf16_t* VAT; const float* ssq;
  DI void operator()(ACC_T, const Unit& u, int wr, int wc, int fr, int fq) const {
#pragma unroll
    for (int ai = 0; ai < 2; ++ai)
#pragma unroll
      for (int m = 0; m < 4; ++m) {
        __builtin_amdgcn_sched_barrier(0);
        const int row = EROW(u, ai, m); const float rs = rsqrtf(ssq[row] * (1.0f / 256.0f) + 1e-6f);
#pragma unroll
        for (int bj = 0; bj < 2; ++bj) {
          const int head = 2 * u.pn + bj, w0 = wc * 32 + 8 * fq;
          if (wc < 2) {
            *(u32x4*)(KA + (size_t)row * 512 + head * 64 + w0) = pack_f8(acc[ai][bj][m][0] * rs, acc[ai][bj][m][1] * rs);
          } else {
            bf16_t* vp = VAT + (size_t)(head * 64 + w0 - 64) * S + row;
#pragma unroll
            for (int n = 0; n < 2; ++n)
#pragma unroll
              for (int e = 0; e < 4; ++e) vp[(size_t)(4 * n + e) * S] = f2bf(acc[ai][bj][m][n][e] * rs);
          }
        }
      }
  }
};
struct EpiMerge {
  static constexpr bool PERM = true, AFTER_DRAIN = false;
  const bf16_t* Z; bf16_t* MIX;
  DI void operator()(ACC_T, const Unit& u, int wr, int wc, int fr, int fq) const {
    const int b = u.pm >> 6, pm = u.pm & 63, pn = u.pn & 3;
#pragma unroll
    for (int ai = 0; ai < 2; ++ai)
#pragma unroll
      for (int m = 0; m < 4; ++m) {
        const int row = pm * 256 + ai * 128 + wr * 64 + m * 16 + fr;
#pragma unroll
        for (int bj = 0; bj < 2; ++bj) {
          const int col = pn * 256 + bj * 128 + wc * 32 + 8 * fq;
          const u32x4 g = *(const u32x4*)(Z + (size_t)row * ZP + ZC_GATE + b * 1024 + col);
          f32x4 v0 = acc[ai][bj][m][0], v1 = acc[ai][bj][m][1];
#pragma unroll
          for (int q = 0; q < 2; ++q) {
            v0[2 * q] *= 1.0f / (1.0f + __expf(-bflo(g[q]))); v0[2 * q + 1] *= 1.0f / (1.0f + __expf(-bfhi(g[q])));
            v1[2 * q] *= 1.0f / (1.0f + __expf(-bflo(g[2 + q]))); v1[2 * q + 1] *= 1.0f / (1.0f + __expf(-bfhi(g[2 + q])));
          }
          bf16_t* mp = MIX + (size_t)row * DM + col;
          if (b > 0) { const u32x4 o = *(const u32x4*)mp;
#pragma unroll
            for (int q = 0; q < 2; ++q) { v0[2 * q] += bflo(o[q]); v0[2 * q + 1] += bfhi(o[q]); v1[2 * q] += bflo(o[2 + q]); v1[2 * q + 1] += bfhi(o[2 + q]); } }
          *(u32x4*)mp = pack_f8(v0, v1);
        }
      }
  }
};
template <bool NORM_OUT> struct EpiResid {
  static constexpr bool PERM = false, AFTER_DRAIN = false;
  const float* xs; float* xd; bf16_t* xb; float* ssq;
  DI void operator()(ACC_T, const Unit& u, int wr, int wc, int fr, int fq) const {
#pragma unroll
    for (int ai = 0; ai < 2; ++ai)
#pragma unroll
      for (int m = 0; m < 4; ++m) {
        const int row = EROW(u, ai, m);
        const size_t ro = (size_t)row * DM + u.pn * 256 + wc * 32 + 4 * fq;
        float ss = 0.f;
#pragma unroll
        for (int bj = 0; bj < 2; ++bj)
#pragma unroll
          for (int n = 0; n < 2; ++n) {
            const size_t o = ro + bj * 128 + n * 16; const f32x4 x = *(const f32x4*)(xs + o) + acc[ai][bj][m][n]; *(f32x4*)(xd + o) = x;
            if (NORM_OUT) { u32x2 w; w.x = pk2(x[0], x[1]); w.y = pk2(x[2], x[3]); *(u32x2*)(xb + o) = w; ss += x[0] * x[0] + x[1] * x[1] + x[2] * x[2] + x[3] * x[3]; }
          }
        if (NORM_OUT) { ss += __shfl_xor(ss, 16); ss += __shfl_xor(ss, 32); if (fq == 0) __hip_atomic_fetch_add(ssq + row, ss, __ATOMIC_RELAXED, __HIP_MEMORY_SCOPE_AGENT); }
      }
  }
};
struct EpiRelu2 {
  static constexpr bool PERM = true, AFTER_DRAIN = false;
  bf16_t* HID; const float* ssq;
  DI void operator()(ACC_T, const Unit& u, int wr, int wc, int fr, int fq) const {
#pragma unroll
    for (int ai = 0; ai < 2; ++ai)
#pragma unroll
      for (int m = 0; m < 4; ++m) {
        const int row = EROW(u, ai, m); const float rs = rsqrtf(ssq[row] * (1.0f / DM) + 1e-6f);
#pragma unroll
        for (int bj = 0; bj < 2; ++bj) {
          f32x4 v0 = acc[ai][bj][m][0], v1 = acc[ai][bj][m][1];
#pragma unroll
          for (int e = 0; e < 4; ++e) { const float a = fmaxf(v0[e], 0.f) * rs, c = fmaxf(v1[e], 0.f) * rs; v0[e] = a * a; v1[e] = c * c; }
          *(u32x4*)(HID + (size_t)row * DFF + u.pn * 256 + bj * 128 + wc * 32 + 8 * fq) = pack_f8(v0, v1);
        }
      }
  }
};
struct DiagOrder {
  pg8::StaticOrder so; int G, c;
  DI void init(int G_, int c_) { so.init(S, 1024, G_, c_); G = G_; c = c_; }
  DI bool next(int i, Unit& u) const { const int tile = (i / 3) * G + c, b = i % 3; if (tile >= 256) return false; so.map(tile, u); u.pm += 64 * b; u.pn += 4 * b; return true; }
  DI void a_ready(const Unit&) const {}
  DI void done(const Unit&) const {}
};
#define GEMM_LDS ((PG8_LAS unsigned char*)smem)

DI void phase_kpost(const Params& p, int layer) {
  bf16_t* Z = (bf16_t*)(p.ws + OFF_Z);
  const f32x2* CS = (const f32x2*)(p.ws + OFF_CS);
  for (int it = (int)gridDim.x - 1 - (int)blockIdx.x; it < 96; it += gridDim.x) {
      const int tid = otid();
      const int idx = it * 512 + tid;
      const int unit = idx / S, tkn = idx % S;
      if (unit < 2) {
        bf16_t* kp = Z + (size_t)tkn * ZP + ZC_KC + unit * 64;
        float x[8][8]; float ss = 0.f;
#pragma unroll
        for (int c = 0; c < 8; ++c) { const u32x4 v = *(const u32x4*)(kp + c * 8);
#pragma unroll
          for (int q = 0; q < 4; ++q) { x[c][2 * q] = bflo(v[q]); x[c][2 * q + 1] = bfhi(v[q]); ss += x[c][2 * q] * x[c][2 * q] + x[c][2 * q + 1] * x[c][2 * q + 1]; } }
        const float rs = rsqrtf(ss * (1.0f / 64.0f) + 1e-6f);
        const float* gk = p.c_k_norm + layer * 64;
#pragma unroll
        for (int c = 0; c < 8; ++c)
#pragma unroll
          for (int q = 0; q < 8; ++q) x[c][q] *= rs * gk[c * 8 + q];
        const f32x2* cr = CS + (size_t)(tkn >> 6) * 16; const f32x2* cc = CS + (size_t)(tkn & 63) * 16;
        rope_pair8(x[0], x[2], cr); rope_pair8(x[1], x[3], cr + 8);
        rope_pair8(x[4], x[6], cc); rope_pair8(x[5], x[7], cc + 8);
#pragma unroll
        for (int c = 0; c < 8; ++c) { u32x4 w; w.x = pk2(x[c][0], x[c][1]); w.y = pk2(x[c][2], x[c][3]); w.z = pk2(x[c][4], x[c][5]); w.w = pk2(x[c][6], x[c][7]); *(u32x4*)(kp + c * 8) = w; }
      } else {
        bf16_t* kp = Z + (size_t)tkn * ZP + ZC_KR;
        float x[4][8];
#pragma unroll
        for (int c = 0; c < 4; ++c) { const u32x4 v = *(const u32x4*)(kp + c * 8);
#pragma unroll
          for (int q = 0; q < 4; ++q) { x[c][2 * q] = bflo(v[q]); x[c][2 * q + 1] = bfhi(v[q]); } }
        const f32x2* cp = CS + (size_t)tkn * 16;
        rope_pair8(x[0], x[2], cp); rope_pair8(x[1], x[3], cp + 8);
#pragma unroll
        for (int c = 0; c < 4; ++c) { u32x4 w; w.x = pk2(x[c][0], x[c][1]); w.y = pk2(x[c][2], x[c][3]); w.z = pk2(x[c][4], x[c][5]); w.w = pk2(x[c][6], x[c][7]); *(u32x4*)(kp + c * 8) = w; }
      }
  }
}

DI bf16x8 pack8(float a0, float a1, float a2, float a3, float a4, float a5, float a6, float a7) {
  u32x4 w; w.x = pk2(a0, a1); w.y = pk2(a2, a3); w.z = pk2(a4, a5); w.w = pk2(a6, a7); return __builtin_bit_cast(bf16x8, w);
}
DI void unpack8(const u32x4 v, float (&x)[8]) {
#pragma unroll
  for (int q = 0; q < 4; ++q) { x[2 * q] = bflo(v[q]); x[2 * q + 1] = bfhi(v[q]); }
}

DI void store_o_wide(bf16_t* rowp, const f32x16& o, float inv, int h) {
#pragma unroll
  for (int pr = 0; pr < 2; ++pr) {
    const int g = 2 * pr;
    const unsigned ax = pk2(o[4 * g] * inv, o[4 * g + 1] * inv), ay = pk2(o[4 * g + 2] * inv, o[4 * g + 3] * inv);
    const unsigned bx = pk2(o[4 * g + 4] * inv, o[4 * g + 5] * inv), by = pk2(o[4 * g + 6] * inv, o[4 * g + 7] * inv);
    const auto sx = __builtin_amdgcn_permlane32_swap(ax, bx, false, false);
    const auto sy = __builtin_amdgcn_permlane32_swap(ay, by, false, false);
    const u32x4 w = {sx[0], sy[0], sx[1], sy[1]};
    *(u32x4*)(rowp + 8 * (g + h)) = w;
  }
}

constexpr int ATT_STAGE = 20480;

template <int TYPE>
DI void attn_dense_unit(const Params& p, int layer, int head, int qb, char* lds) {
  constexpr int NQK = TYPE == 0 ? 6 : 4;
  const int tid = otid(), lane = tid & 63, wid = wave_of(tid), r = lane & 31, h = lane >> 5;
  const bf16_t* Z = (const bf16_t*)(p.ws + OFF_Z);
  const f32x2* CS = (const f32x2*)(p.ws + OFF_CS);
  const bf16_t* Kn; int ldk; const bf16_t* VT; bf16_t* O;
  if (TYPE == 0) { Kn = (const bf16_t*)(p.ws + OFF_KA) + head * 64; ldk = 512; VT = (const bf16_t*)(p.ws + OFF_VAT) + (size_t)head * 64 * S; O = (bf16_t*)(p.ws + OFF_OA); }
  else { const int kvh = head >> 2; Kn = Z + ZC_KC + kvh * 64; ldk = ZP; VT = (const bf16_t*)(p.ws + OFF_VCT) + (size_t)kvh * 64 * S; O = (bf16_t*)(p.ws + OFF_OC); }
  const int q = qb * 256 + wid * 32 + r;
  bf16x8 qf[NQK];
  if (TYPE == 0) {
    const bf16_t* qp = (const bf16_t*)(p.ws + OFF_QA) + (size_t)q * 768 + head * 96 + 8 * h;
    float x[6][8];
#pragma unroll
    for (int d0 = 0; d0 < 6; ++d0) unpack8(*(const u32x4*)(qp + d0 * 16), x[d0]);
    rope_pair8(x[4], x[5], CS + (size_t)q * 16 + 8 * h);
    const float sc = 0.10206207261596577f * LOG2E;
#pragma unroll
    for (int d0 = 0; d0 < 6; ++d0) qf[d0] = pack8(x[d0][0] * sc, x[d0][1] * sc, x[d0][2] * sc, x[d0][3] * sc, x[d0][4] * sc, x[d0][5] * sc, x[d0][6] * sc, x[d0][7] * sc);
  } else {
    const bf16_t* qp = Z + (size_t)q * ZP + ZC_QC + head * 64 + 8 * h;
    float x[4][8]; float ss = 0.f;
#pragma unroll
    for (int d0 = 0; d0 < 4; ++d0) { unpack8(*(const u32x4*)(qp + d0 * 16), x[d0]);
#pragma unroll
      for (int j = 0; j < 8; ++j) ss += x[d0][j] * x[d0][j]; }
    ss += __shfl_xor(ss, 32);
    const float rs = rsqrtf(ss * (1.0f / 64.0f) + 1e-6f);
    const float* gq = p.c_q_norm + layer * 64;
#pragma unroll
    for (int d0 = 0; d0 < 4; ++d0)
#pragma unroll
      for (int j = 0; j < 8; ++j) x[d0][j] *= rs * gq[d0 * 16 + 8 * h + j];
    rope_pair8(x[0], x[1], CS + (size_t)(q >> 6) * 16 + 8 * h);
    rope_pair8(x[2], x[3], CS + (size_t)(q & 63) * 16 + 8 * h);
    const float sc = 0.125f * LOG2E;
#pragma unroll
    for (int d0 = 0; d0 < 4; ++d0) qf[d0] = pack8(x[d0][0] * sc, x[d0][1] * sc, x[d0][2] * sc, x[d0][3] * sc, x[d0][4] * sc, x[d0][5] * sc, x[d0][6] * sc, x[d0][7] * sc);
  }
  typedef __attribute__((address_space(3))) unsigned lds_u32;
  const int srow = tid >> 3, sch = (tid & 7) ^ ((srow >> 1) & 7);
  const bf16_t* gk = Kn + (size_t)srow * ldk + sch * 8;
  const bf16_t* gv = VT + (size_t)srow * S + sch * 8;
  const int rrow = tid >> 2, rch = (tid & 3) ^ ((rrow >> 2) & 3);
  const bf16_t* gr = Z + ZC_KR + (size_t)rrow * ZP + rch * 8;
  char* wbase = lds + wid * 1024;
#define DMA(t, soff) do { \
    __builtin_amdgcn_global_load_lds((const unsigned*)(gk + (size_t)(t) * 64 * ldk), (lds_u32*)(wbase + (soff)), 16, 0, 0); \
    __builtin_amdgcn_global_load_lds((const unsigned*)(gv + (size_t)(t) * 64), (lds_u32*)(wbase + (soff) + 8192), 16, 0, 0); \
    if (TYPE == 0 && wid < 4) __builtin_amdgcn_global_load_lds((const unsigned*)(gr + (size_t)(t) * 64 * ZP), (lds_u32*)(wbase + (soff) + 16384), 16, 0, 0); } while (0)
#define DMA_WAIT(keep) do { if (keep) { if (TYPE == 0 && wid < 4) asm volatile("s_waitcnt vmcnt(3)" ::: "memory"); else asm volatile("s_waitcnt vmcnt(2)" ::: "memory"); } \
    else asm volatile("s_waitcnt vmcnt(0)" ::: "memory"); } while (0)
#define BAR() do { asm volatile("s_waitcnt lgkmcnt(0)" ::: "memory"); __builtin_amdgcn_s_barrier(); asm volatile("" ::: "memory"); } while (0)
  constexpr int NONES = (TYPE == 0) ? 0 : 2;
  float m_run = 0.f, lsum = 0.f, ls0 = 0.f, ls1 = 0.f, ls2 = 0.f; f32x16 o0, o1, negm, la;
#pragma unroll
  for (int i = 0; i < 16; ++i) { o0[i] = 0.f; o1[i] = 0.f; negm[i] = 0.f; la[i] = 0.f; }
  const bf16x8 ones = {0x3F80, 0x3F80, 0x3F80, 0x3F80, 0x3F80, 0x3F80, 0x3F80, 0x3F80};
  const int rK = (r & ~12) | ((r & 4) << 1) | ((r & 8) >> 1);
  const int ksw = (rK >> 1) & 7, rsw = (rK >> 2) & 3, vsw = (r >> 1) & 7;
  int koff[4], roff[2], voff[4];
#pragma unroll
  for (int d0 = 0; d0 < 4; ++d0) { koff[d0] = rK * 128 + (((2 * d0 + h) ^ ksw) << 4); voff[d0] = 8192 + r * 128 + (((2 * d0 + h) ^ vsw) << 4); }
#pragma unroll
  for (int d0 = 0; d0 < 2; ++d0) roff[d0] = 16384 + rK * 64 + (((2 * d0 + h) ^ rsw) << 4);
  constexpr int NT = S / 64;
  constexpr float THR = 8.0f;
#define SB() __builtin_amdgcn_sched_barrier(0)
#define QKR(d0, K0, K1, SOFF) do { if ((d0) < 4) { K0 = *(const bf16x8*)(lds + (SOFF) + koff[(d0) & 3]); K1 = *(const bf16x8*)(lds + (SOFF) + 32 * 128 + koff[(d0) & 3]); } \
    else if ((d0) < NQK) { K0 = *(const bf16x8*)(lds + (SOFF) + roff[(d0) & 1]); K1 = *(const bf16x8*)(lds + (SOFF) + 32 * 64 + roff[(d0) & 1]); } } while (0)
#define QKM(N0, N1, d0, K0, K1) do { if ((d0) == 0) { N0 = MFMA(K0, qf[0], negm); N1 = MFMA(K1, qf[0], negm); } \
    else if ((d0) < NQK) { N0 = MFMA(K0, qf[(d0) < NQK ? (d0) : 0], N0); N1 = MFMA(K1, qf[(d0) < NQK ? (d0) : 0], N1); } } while (0)
#define EX4(CC, B, SI) do { __builtin_amdgcn_s_setprio(1); _Pragma("unroll") for (int i_ = 0; i_ < 4; ++i_) { CC[(B) + i_] = fexp2(CC[(B) + i_]); if ((SI) >= NONES) { if (i_ == 0) ls0 += CC[(B) + i_]; else if (i_ == 1) ls1 += CC[(B) + i_]; else if (i_ == 2) ls2 += CC[(B) + i_]; else lsum += CC[(B) + i_]; } } __builtin_amdgcn_s_setprio(0); } while (0)
#define PK8(PF, CC, B) do { PF = pack8(CC[(B)], CC[(B) + 1], CC[(B) + 2], CC[(B) + 3], CC[(B) + 4], CC[(B) + 5], CC[(B) + 6], CC[(B) + 7]); } while (0)
#define VR(s_, V0, V1, SOFF) do { V0 = *(const bf16x8*)(lds + (SOFF) + voff[s_]); V1 = *(const bf16x8*)(lds + (SOFF) + 32 * 128 + voff[s_]); } while (0)
#define PVM(s_, V0, V1) do { o0 = MFMA(V0, pf[s_], o0); o1 = MFMA(V1, pf[s_], o1); if ((s_) < NONES) la = MFMA(ones, pf[s_], la); } while (0)
#define MAXG(NN, B) do { ma_ = fmaxf(fmaxf(ma_, NN[(B)]), NN[(B) + 1]); mb_ = fmaxf(fmaxf(mb_, NN[(B) + 2]), NN[(B) + 3]); \
    ma_ = fmaxf(fmaxf(ma_, NN[(B) + 4]), NN[(B) + 5]); mb_ = fmaxf(fmaxf(mb_, NN[(B) + 6]), NN[(B) + 7]); } while (0)
#define ROWMAX(P0, P1, MX) do { float a_ = fmaxf(fmaxf(P0[0], P0[1]), P1[0]), c_ = fmaxf(fmaxf(P0[2], P0[3]), P1[1]); a_ = fmaxf(fmaxf(a_, P1[2]), P1[3]); \
    _Pragma("unroll") for (int i_ = 4; i_ < 16; i_ += 4) { a_ = fmaxf(fmaxf(a_, P0[i_]), P0[i_ + 1]); c_ = fmaxf(fmaxf(c_, P0[i_ + 2]), P0[i_ + 3]); a_ = fmaxf(fmaxf(a_, P1[i_]), P1[i_ + 1]); c_ = fmaxf(fmaxf(c_, P1[i_ + 2]), P1[i_ + 3]); } \
    a_ = fmaxf(a_, c_); MX = fmaxf(a_, __shfl_xor(a_, 32)); } while (0)
#define RESCALE(P0, P1, DELTA) do { const float dl_ = (DELTA); m_run += dl_; const float al_ = fexp2(-dl_); lsum *= al_; ls0 *= al_; ls1 *= al_; ls2 *= al_; \
    _Pragma("unroll") for (int i_ = 0; i_ < 16; ++i_) { P0[i_] -= dl_; P1[i_] -= dl_; o0[i_] *= al_; o1[i_] *= al_; if (NONES > 0) la[i_] *= al_; negm[i_] = -m_run; } } while (0)
#define STEP(C0, C1, N0, N1, T, HAS_NEXT, HAS_LOAD, S0, S1, S3) do { \
    if (HAS_LOAD) DMA((T) + 3, S3); \
    bf16x8 pf[4]; bf16x8 ka0, ka1, kb0, kb1, va0, va1, vb0, vb1; \
    if (HAS_NEXT) QKR(0, ka0, ka1, S1); \
    SB(); if (HAS_NEXT) { QKR(1, kb0, kb1, S1); QKM(N0, N1, 0, ka0, ka1); } EX4(C0, 0, 0); \
    SB(); if (HAS_NEXT) { QKR(2, ka0, ka1, S1); QKM(N0, N1, 1, kb0, kb1); } EX4(C0, 4, 0); PK8(pf[0], C0, 0); \
    SB(); if (HAS_NEXT) { QKR(3, kb0, kb1, S1); QKM(N0, N1, 2, ka0, ka1); } EX4(C0, 8, 1); \
    SB(); if (HAS_NEXT) { QKR(4, ka0, ka1, S1); QKM(N0, N1, 3, kb0, kb1); } EX4(C0, 12, 1); PK8(pf[1], C0, 8); if (NQK == 4) VR(0, va0, va1, S0); \
    if (NQK > 4) { \
      SB(); if (HAS_NEXT) { QKR(5, kb0, kb1, S1); QKM(N0, N1, 4, ka0, ka1); } EX4(C1, 0, 2); \
      SB(); if (HAS_NEXT) QKM(N0, N1, 5, kb0, kb1); EX4(C1, 4, 2); PK8(pf[2], C1, 0); VR(0, va0, va1, S0); } \
    float ma_ = -1e30f, mb_ = -1e30f; \
    if (NQK == 4) { \
      SB(); VR(1, vb0, vb1, S0); PVM(0, va0, va1); EX4(C1, 0, 2); EX4(C1, 4, 2); PK8(pf[2], C1, 0); \
      SB(); VR(2, va0, va1, S0); PVM(1, vb0, vb1); EX4(C1, 8, 3); EX4(C1, 12, 3); PK8(pf[3], C1, 8); \
    } else { \
      SB(); VR(1, vb0, vb1, S0); PVM(0, va0, va1); EX4(C1, 8, 3); \
      SB(); VR(2, va0, va1, S0); PVM(1, vb0, vb1); EX4(C1, 12, 3); PK8(pf[3], C1, 8); } \
    SB(); VR(3, vb0, vb1, S0); PVM(2, va0, va1); if (HAS_NEXT) { MAXG(N0, 0); MAXG(N0, 8); } \
    SB(); PVM(3, vb0, vb1); if (HAS_NEXT) { MAXG(N1, 0); MAXG(N1, 8); } \
    SB(); \
    float mx_ = fmaxf(ma_, mb_); { const auto rr_ = __builtin_amdgcn_permlane32_swap(__float_as_uint(mx_), __float_as_uint(mx_), false, false); mx_ = fmaxf(__uint_as_float(rr_[0]), __uint_as_float(rr_[1])); } \
    DMA_WAIT(HAS_LOAD); BAR(); \
    if (HAS_NEXT) { if (__any(mx_ > THR)) RESCALE(N0, N1, fmaxf(mx_, 0.f)); } } while (0)
  constexpr int R0 = 0, R1 = ATT_STAGE, R2 = 2 * ATT_STAGE, R3 = 3 * ATT_STAGE;
  f32x16 sA0, sA1, sB0, sB1;
  DMA(0, R0); DMA(1, R1); DMA(2, R2); DMA_WAIT(true); BAR();
  { bf16x8 ka0, ka1;
#pragma unroll
    for (int d0 = 0; d0 < NQK; ++d0) { QKR(d0, ka0, ka1, R0); QKM(sA0, sA1, d0, ka0, ka1); } }
  { float mx0; ROWMAX(sA0, sA1, mx0); m_run = mx0;
#pragma unroll
    for (int i = 0; i < 16; ++i) { sA0[i] -= mx0; sA1[i] -= mx0; negm[i] = -mx0; } }
  for (int t = 0; t < NT - 4; t += 4) {
    STEP(sA0, sA1, sB0, sB1, t, true, true, R0, R1, R3);
    STEP(sB0, sB1, sA0, sA1, t + 1, true, true, R1, R2, R0);
    STEP(sA0, sA1, sB0, sB1, t + 2, true, true, R2, R3, R1);
    STEP(sB0, sB1, sA0, sA1, t + 3, true, true, R3, R0, R2);
  }
  STEP(sA0, sA1, sB0, sB1, NT - 4, true, true, R0, R1, R3);
  STEP(sB0, sB1, sA0, sA1, NT - 3, true, false, R1, R2, R0);
  STEP(sA0, sA1, sB0, sB1, NT - 2, true, false, R2, R3, R1);
  STEP(sB0, sB1, sA0, sA1, NT - 1, false, false, R3, R0, R2);
  lsum += ls0 + ls1 + ls2;
  const float l = (NONES > 0 ? la[0] : 0.f) + lsum + __shfl_xor(lsum, 32);
#undef DMA
#undef DMA_WAIT
#undef BAR
#undef SB
#undef QKR
#undef QKM
#undef EX4
#undef PK8
#undef VR
#undef PVM
#undef MAXG
#undef ROWMAX
#undef RESCALE
#undef STEP
  const float inv = 1.0f / l;
  bf16_t* op = O + (size_t)q * 512 + head * 64;
  store_o_wide(op, o0, inv, h); store_o_wide(op + 32, o1, inv, h);
}

constexpr int BLV = 49152;
DI void b_issue_k(const Params& p, int x, char* lds, int tid, int wid) {
  typedef __attribute__((address_space(3))) unsigned lds_u32;
  const int g = x >> 9, head = (x >> 6) & 7, blk256 = x & 63;
  const int sh = 2 * g, Ls = S >> sh, P0 = blk256 * 256, sub = P0 / Ls, i0 = P0 & (Ls - 1), sub0 = sub * Ls;
  const bf16_t* Zk = (const bf16_t*)(p.ws + OFF_Z) + ZC_QKVB + ((1 * 3 + g) * 8 + head) * 64;
#pragma unroll
  for (int i = 0; i < 6; ++i) {
    const int sl = i * 512 + tid, row = sl >> 3, c = (sl & 7) ^ ((row >> 1) & 7); int key = i0 - 64 + row; key = key < 0 ? 0 : (key > Ls - 1 ? Ls - 1 : key);
    __builtin_amdgcn_global_load_lds((const unsigned*)(Zk + (size_t)(sub0 + key) * ZP + c * 8), (lds_u32*)(lds + (i * 512 + wid * 64) * 16), 16, 0, 0);
  }
}
DI void b_issue_v(const Params& p, int x, char* lds, int tid, int wid) {
  typedef __attribute__((address_space(3))) unsigned lds_u32;
  const int g = x >> 9, head = (x >> 6) & 7, blk256 = x & 63;
  const int sh = 2 * g, Ls = S >> sh, P0 = blk256 * 256, sub = P0 / Ls, i0 = P0 & (Ls - 1), sub0 = sub * Ls;
  const bf16_t* VTg = (const bf16_t*)(p.ws + OFF_VBT) + (size_t)((g * 8 + head) * 64) * S + sub0;
#pragma unroll
  for (int i = 0; i < 6; ++i) {
    const int sl = i * 512 + tid, d = sl / 48, c = (sl - d * 48) ^ (d & 15); int k0 = i0 - 64 + 8 * c; k0 = k0 < 0 ? 0 : (k0 > Ls - 8 ? Ls - 8 : k0);
    __builtin_amdgcn_global_load_lds((const unsigned*)(VTg + (size_t)d * S + k0), (lds_u32*)(lds + BLV + (i * 512 + wid * 64) * 16), 16, 0, 0);
  }
}
DI void attn_b_item(const Params& p, int x, int xnext, char* lds) {
  const int tid = otid(), lane = tid & 63, wid = wave_of(tid), r = lane & 31, h = lane >> 5;
  const int g = x >> 9, head = (x >> 6) & 7, blk256 = x & 63;
  const bf16_t* Z = (const bf16_t*)(p.ws + OFF_Z);
  const int sh = 2 * g, Ls = S >> sh, P0 = blk256 * 256, sub = P0 / Ls, i0 = P0 & (Ls - 1);
  const bf16_t* Zq = Z + ZC_QKVB + ((0 * 3 + g) * 8 + head) * 64;
  constexpr int LV = BLV;
  const int i0w = i0 + 32 * wid;
  const float* BT = (const float*)(p.ws + OFF_BT) + (g * 8 + head) * 256 + 32 - r + 8 * h;
  const int rK = (r & ~12) | ((r & 4) << 1) | ((r & 8) >> 1);
  bf16x8 qf[4];
  {
    const bf16_t* qp = Zq + (size_t)(P0 + 32 * wid + r) * ZP + 8 * h; const float scq = 0.125f * LOG2E;
#pragma unroll
    for (int d0 = 0; d0 < 4; ++d0) { float x8[8]; unpack8(*(const u32x4*)(qp + d0 * 16), x8); qf[d0] = pack8(x8[0] * scq, x8[1] * scq, x8[2] * scq, x8[3] * scq, x8[4] * scq, x8[5] * scq, x8[6] * scq, x8[7] * scq); }
  }
  float bvs[5][16];
#pragma unroll
  for (int c = 0; c < 5; ++c)
#pragma unroll
    for (int i = 0; i < 16; ++i) bvs[c][i] = BT[32 * c + (i & 3) + 4 * ((i >> 2) & 1) + 16 * (i >> 3)];
  asm volatile("s_waitcnt vmcnt(0)" ::: "memory"); __builtin_amdgcn_s_barrier(); asm volatile("" ::: "memory");
#pragma unroll
  for (int c = 0; c < 5; ++c)
#pragma unroll
    for (int i = 0; i < 16; ++i) asm volatile("" : "+v"(bvs[c][i]));
  f32x16 sc[5];
  const int ksw = (rK >> 1) & 7;
#pragma unroll
  for (int c = 0; c < 5; ++c) {
#pragma unroll
    for (int i = 0; i < 16; ++i) sc[c][i] = 0.f;
    const char* kp = lds + (32 * wid + 32 * c + rK) * 128;
#pragma unroll
    for (int d0 = 0; d0 < 4; ++d0) { const bf16x8 kf = *(const bf16x8*)(kp + (((2 * d0 + h) ^ ksw) << 4)); sc[c] = MFMA(kf, qf[d0], sc[c]); }
  }
  asm volatile("s_waitcnt lgkmcnt(0)" ::: "memory"); __builtin_amdgcn_s_barrier(); asm volatile("" ::: "memory");
  if (xnext >= 0) b_issue_k(p, xnext, lds, tid, wid);
  float mxa[4] = {-1e30f, -1e30f, -1e30f, -1e30f};
#pragma unroll
  for (int c = 0; c < 5; ++c)
#pragma unroll
    for (int i = 0; i < 16; ++i) {
      const int prow = (i & 3) + 4 * ((i >> 2) & 1) + 8 * h + 16 * (i >> 3);
      const int rel = 32 * c - 64 + prow - r, key = i0w + r + rel;
      const bool valid = ((unsigned)(rel + 64) <= 128u) & ((unsigned)key < (unsigned)Ls);
      const float v = valid ? sc[c][i] + bvs[c][i] : -1e30f;
      sc[c][i] = v; mxa[i & 3] = fmaxf(mxa[i & 3], v);
    }
  float mx = fmaxf(fmaxf(mxa[0], mxa[1]), fmaxf(mxa[2], mxa[3]));
  mx = fmaxf(mx, __shfl_xor(mx, 32));
  float la4[4] = {0.f, 0.f, 0.f, 0.f};
#pragma unroll
  for (int c = 0; c < 5; ++c)
#pragma unroll
    for (int i = 0; i < 16; ++i) { const float e = fexp2(sc[c][i] - mx); sc[c][i] = e; la4[i & 3] += e; }
  float l = (la4[0] + la4[1]) + (la4[2] + la4[3]);
  l += __shfl_xor(l, 32);
  f32x16 o0, o1;
#pragma unroll
  for (int i = 0; i < 16; ++i) { o0[i] = 0.f; o1[i] = 0.f; }
  const char* vp = lds + LV + r * 768; const int vsw = r & 15;
#pragma unroll
  for (int c = 0; c < 5; ++c)
#pragma unroll
    for (int s = 0; s < 2; ++s) {
      const bf16x8 pf = pack8(sc[c][8 * s], sc[c][8 * s + 1], sc[c][8 * s + 2], sc[c][8 * s + 3], sc[c][8 * s + 4], sc[c][8 * s + 5], sc[c][8 * s + 6], sc[c][8 * s + 7]);
      const int ch = ((4 * wid + 4 * c + 2 * s + h) ^ vsw) << 4;
      const bf16x8 v0 = *(const bf16x8*)(vp + ch), v1 = *(const bf16x8*)(vp + 32 * 768 + ch);
      o0 = MFMA(v0, pf, o0); o1 = MFMA(v1, pf, o1);
    }
  asm volatile("s_waitcnt lgkmcnt(0)" ::: "memory"); __builtin_amdgcn_s_barrier(); asm volatile("" ::: "memory");
  if (xnext >= 0) b_issue_v(p, xnext, lds, tid, wid);
  const float inv = 1.0f / l;
  const int tkn = ((i0w + r) << sh) + sub;
  bf16_t* OG = (g < 2) ? (bf16_t*)(p.ws + OFF_H) + (size_t)g * S * 512 : (bf16_t*)(p.ws + OFF_OB);
  bf16_t* op = OG + (size_t)tkn * 512 + head * 64;
  store_o_wide(op, o0, inv, h); store_o_wide(op + 32, o1, inv, h);
  if (h == 0) { float* LSE = (float*)(p.ws + OFF_LSE); LSE[((size_t)g * S + tkn) * 8 + head] = (mx + __builtin_amdgcn_logf(l)) * LN2; }
}

DI void phase_attn(const Params& p, int layer, char* smem) {
  const int n_dense = 1024, n_b = 1536, total = n_dense + n_b;
  int it = blockIdx.x;
  for (; it < n_dense; it += gridDim.x) {
    if (it < 512) { attn_dense_unit<0>(p, layer, it & 7, it >> 3, smem); }
    else { const int v = it - 512; attn_dense_unit<1>(p, layer, v & 7, v >> 3, smem); }
  }
  if (it < total) {
    const int tid = otid(), wid = wave_of(tid);
    b_issue_k(p, it - n_dense, smem, tid, wid); b_issue_v(p, it - n_dense, smem, tid, wid);
    for (; it < total; it += gridDim.x) {
      const int nx = it + (int)gridDim.x;
      attn_b_item(p, it - n_dense, nx < total ? nx - n_dense : -1, smem);
    }
  }
}

DI void phase_combine(const Params& p) {
  const bf16_t* G0 = (const bf16_t*)(p.ws + OFF_H); const bf16_t* G1 = G0 + (size_t)S * 512; bf16_t* OB = (bf16_t*)(p.ws + OFF_OB);
  const float* LSE = (const float*)(p.ws + OFF_LSE);
  for (int e = blockIdx.x * 512 + otid(); e < S * 64; e += gridDim.x * 512) {
    const int tkn = e >> 6, c = e & 63, head = c >> 3;
    const float l0 = LSE[((size_t)0 * S + tkn) * 8 + head], l1 = LSE[((size_t)1 * S + tkn) * 8 + head], l2 = LSE[((size_t)2 * S + tkn) * 8 + head];
    const float mm = fmaxf(l0, fmaxf(l1, l2));
    float w0 = __expf(l0 - mm), w1 = __expf(l1 - mm), w2 = __expf(l2 - mm);
    const float iw = 1.0f / (w0 + w1 + w2); w0 *= iw; w1 *= iw; w2 *= iw;
    const size_t off = (size_t)tkn * 512 + c * 8;
    const u32x4 a = *(const u32x4*)(G0 + off), b = *(const u32x4*)(G1 + off), d = *(const u32x4*)(OB + off);
    u32x4 o;
#pragma unroll
    for (int q = 0; q < 4; ++q) o[q] = pk2(w0 * bflo(a[q]) + w1 * bflo(b[q]) + w2 * bflo(d[q]), w0 * bfhi(a[q]) + w1 * bfhi(b[q]) + w2 * bfhi(d[q]));
    *(u32x4*)(OB + off) = o;
  }
}

#define XB_TMO      128
#define XB_XCNT(j)  (256  + 64 * (j))
#define XB_XSUB(j)  (1280 + 64 * (j))
#define XB_XGEN(j)  (2304 + 64 * (j))
#define XB_TOP      3328
#define XB_TOPGEN   3392
#define XCD_BAR_WORDS 3456
#define XB_SPIN_CAP (1u << 18)
#ifndef LAS
#define LAS __attribute__((address_space(3)))
#endif

__device__ __forceinline__ unsigned xb_ld(unsigned* p)              { return __hip_atomic_load(p, __ATOMIC_RELAXED, __HIP_MEMORY_SCOPE_AGENT); }
__device__ __forceinline__ unsigned xb_add(unsigned* p, unsigned v) { return __hip_atomic_fetch_add(p, v, __ATOMIC_RELAXED, __HIP_MEMORY_SCOPE_AGENT); }
__device__ __forceinline__ unsigned xb_xcc_id() { return (unsigned)__builtin_amdgcn_s_getreg((3 << 11) | 20) & 0xFu; }
#define XB_SPIN(cond, bar) do { unsigned _sp = 0; while (cond) { __builtin_amdgcn_s_sleep(1); \
    if ((++_sp & 255u) == 0u) { if (xb_ld(&(bar)[XB_TMO])) break; if (_sp > XB_SPIN_CAP) { atomicAdd(&(bar)[XB_TMO], 1u); break; } } } } while (0)

struct XcdBarrier {
    unsigned* bar; unsigned x;
    volatile LAS unsigned* st;
};

__device__ __forceinline__ XcdBarrier xcd_barrier_post(unsigned* bar, volatile LAS unsigned* st) {
    XcdBarrier b; b.bar = bar; b.x = xb_xcc_id(); b.st = st;
    if (threadIdx.x == 0) (void)xb_add(&bar[XB_XCNT(b.x)], 1u);
    return b;
}
__device__ __forceinline__ void xcd_barrier_complete(unsigned* bar, unsigned x, unsigned& nloc, unsigned& nx) {
    const unsigned G = gridDim.x * gridDim.y * gridDim.z;
    unsigned sum, cnt, mine, sp = 0u;
    for (;;) {
        sum = 0u; cnt = 0u; mine = 0u;
#pragma unroll
        for (unsigned j = 0; j < 16; ++j) { const unsigned c = xb_ld(&bar[XB_XCNT(j)]); sum += c; cnt += (c > 0u) ? 1u : 0u; mine = (j == x) ? c : mine; }
        if (sum == G) break;
        __builtin_amdgcn_s_sleep(1);
        if ((++sp & 255u) == 0u) { if (xb_ld(&bar[XB_TMO])) break; if (sp > XB_SPIN_CAP) { atomicAdd(&bar[XB_TMO], 1u); break; } }
    }
    nloc = mine > 0u ? mine : 1u; nx = cnt > 0u ? cnt : 1u;
}

__device__ __forceinline__ void xcd_barrier(const XcdBarrier& b) {
    asm volatile("s_waitcnt vmcnt(0)" ::: "memory");
    __syncthreads();
    if (threadIdx.x == 0) {
        unsigned* bar = b.bar;
        __builtin_amdgcn_s_waitcnt(0);
        unsigned nloc = b.st[0], nx = b.st[1];
        if (nloc == 0u) { xcd_barrier_complete(bar, b.x, nloc, nx); b.st[0] = nloc; b.st[1] = nx; }
        const unsigned old = xb_add(&bar[XB_XSUB(b.x)], 1u);
        const unsigned gen = old / nloc;
        if (old + 1u == (gen + 1u) * nloc) {
            __builtin_amdgcn_fence(__ATOMIC_RELEASE, "agent");
            asm volatile("s_waitcnt vmcnt(0)" ::: "memory");
            const unsigned og = xb_add(&bar[XB_TOP], 1u);
            const unsigned tg = og / nx;
            if (og + 1u == (tg + 1u) * nx) xb_add(&bar[XB_TOPGEN], 1u);
            else XB_SPIN(xb_ld(&bar[XB_TOPGEN]) == tg, bar);
            __builtin_amdgcn_fence(__ATOMIC_ACQUIRE, "agent");
            xb_add(&bar[XB_XGEN(b.x)], 1u);
            asm volatile("s_waitcnt vmcnt(0)" ::: "memory");
        } else {
            XB_SPIN(xb_ld(&bar[XB_XGEN(b.x)]) == gen, bar);
            __builtin_amdgcn_fence(__ATOMIC_ACQUIRE, "agent");
            asm volatile("s_waitcnt vmcnt(0)" ::: "memory");
        }
    }
    __syncthreads();
}

__global__ void __launch_bounds__(512) hybrid_encoder_mega(Params p) {
  extern __shared__ __attribute__((aligned(16))) char smem[];
  cg::grid_group grid = cg::this_grid();
  const int G = gridDim.x, bx = blockIdx.x;
  bf16_t* Z = (bf16_t*)(p.ws + OFF_Z); bf16_t* H = (bf16_t*)(p.ws + OFF_H);
  float* ssq_q = (float*)(p.ws + OFF_SSQ); float* ssq_kv = ssq_q + S; float* ssq_x = ssq_q + 2 * S;
  bf16_t* XB = (bf16_t*)(p.ws + OFF_OA);
  volatile LAS unsigned* xst = (volatile LAS unsigned*)(smem + 131072);
  if (threadIdx.x == 0) { xst[0] = 0u; xst[1] = 0u; xst[2] = 0u; xst[3] = 0u; }
  __syncthreads();
  const XcdBarrier xb = xcd_barrier_post((unsigned*)(p.ws + OFF_BAR), xst);
  bool first_sync = true;
#define GSYNC() do { if (first_sync) { grid.sync(); first_sync = false; } else xcd_barrier(xb); } while (0)
  build_tables(p);
  for (int layer = 0; layer < 2; ++layer) {
    convert_weights(p, layer, smem);
    for (int seq = 0; seq < 3; ++seq) {
      const float* xin = (layer == 0) ? (seq < 2 ? p.x_prompt + (size_t)seq * S * DM : p.x_sample) : p.out + (size_t)seq * S * DM;
      float* xo = p.out + (size_t)seq * S * DM;
      phase_norm(xin, p.norm_mix + layer * DM, H, S);
      { const int tz = otid();
_Pragma("nounroll")
        for (int b = bx; b < 96; b += G) ssq_q[b * 512 + tz] = 0.f; }
      GSYNC();
      { pg8::Gemm g{H, (const bf16_t*)(p.ws + WT_IN), S, 9216, DM, DM, DM}; pg8::StaticOrder so; so.init(S, 9216, G, bx);
        EpiInproj E{Z, (bf16_t*)(p.ws + OFF_VCT), (bf16_t*)(p.ws + OFF_VBT), ssq_q, ssq_kv};
        pg8::gemm_phase<EpiInproj, pg8::StaticOrder, true, true>(GEMM_LDS, g, so, E); }
      GSYNC();
      { pg8::Gemm g{Z + ZC_CQ, (const bf16_t*)(p.ws + WT_UQ), S, 768, 384, ZP, 384}; pg8::StaticOrder so; so.init(S, 768, G, bx);
        EpiUpQ E{(bf16_t*)(p.ws + OFF_QA), ssq_q};
        pg8::gemm_phase<EpiUpQ, pg8::StaticOrder, true, true>(GEMM_LDS, g, so, E); }
      { pg8::Gemm g{Z + ZC_CKV, (const bf16_t*)(p.ws + WT_UKV), S, 1024, 256, ZP, 256}; pg8::StaticOrder so; so.init(S, 1024, G, bx);
        EpiUpKV E{(bf16_t*)(p.ws + OFF_KA), (bf16_t*)(p.ws + OFF_VAT), ssq_kv};
        pg8::gemm_phase<EpiUpKV, pg8::StaticOrder, true, true>(GEMM_LDS, g, so, E); }
      phase_kpost(p, layer);
      GSYNC();
      phase_attn(p, layer, smem);
      GSYNC();
      phase_combine(p);
      GSYNC();
      { pg8::Gemm g{(const bf16_t*)(p.ws + OFF_OA), (const bf16_t*)(p.ws + WT_BRA), 3 * S, 3072, 512, 512, 512}; DiagOrder so; so.init(G, bx);
        EpiMerge E{Z, H};
        pg8::gemm_phase<EpiMerge, DiagOrder, true, true>(GEMM_LDS, g, so, E); }
      GSYNC();
      { pg8::Gemm g{H, (const bf16_t*)(p.ws + WT_OUT), S, 1024, DM, DM, DM}; pg8::StaticOrder so; so.init(S, 1024, G, bx);
        EpiResid<true> E{xin, xo, XB, ssq_x};
        pg8::gemm_phase<EpiResid<true>, pg8::StaticOrder, true, true>(GEMM_LDS, g, so, E); }
      GSYNC();
      { pg8::Gemm g{XB, (const bf16_t*)(p.ws + WT_UP), S, DFF, DM, DM, DM}; pg8::StaticOrder so; so.init(S, DFF, G, bx);
        EpiRelu2 E{Z, ssq_x};
        pg8::gemm_phase<EpiRelu2, pg8::StaticOrder, true, true>(GEMM_LDS, g, so, E); }
      GSYNC();
      { pg8::Gemm g{Z, (const bf16_t*)(p.ws + WT_DOWN), S, 1024, DFF, DFF, DFF}; pg8::StaticOrder so; so.init(S, 1024, G, bx);
        EpiResid<false> E{xo, xo, nullptr, nullptr};
        pg8::gemm_phase<EpiResid<false>, pg8::StaticOrder, true, true>(GEMM_LDS, g, so, E); }
      GSYNC();
    }
  }
  phase_final_norm(p.out, p.final_norm, 3 * S);
}

extern "C" void kernel_launch(void* const* d_in, const int* in_sizes, int n_in, void* d_out, int out_size, void* d_ws, size_t ws_size, hipStream_t stream) {
  static int grid_blocks = 0;
  if (!grid_blocks) {
    if (ws_size < WS_END) { fprintf(stderr, "kernel_launch: workspace too small: %zu < %zu\n", ws_size, (size_t)WS_END); return; }
    if (hipFuncSetAttribute((const void*)hybrid_encoder_mega, hipFuncAttributeMaxDynamicSharedMemorySize, LDS_BYTES) != hipSuccess) { fprintf(stderr, "hipFuncSetAttribute failed\n"); return; }
    int dev = 0, cus = 0, per_cu = 0;
    hipGetDevice(&dev);
    hipDeviceGetAttribute(&cus, hipDeviceAttributeMultiprocessorCount, dev);
    hipOccupancyMaxActiveBlocksPerMultiprocessor(&per_cu, hybrid_encoder_mega, 512, LDS_BYTES);
    if (per_cu < 1) { fprintf(stderr, "occupancy query returned %d\n", per_cu); return; }
    grid_blocks = cus;
  }
  Params p{};
  p.x_prompt = (const float*)d_in[0]; p.x_sample = (const float*)d_in[1];
  p.norm_mix = (const float*)d_in[2]; p.w_in = (const float*)d_in[3]; p.a_q_norm = (const float*)d_in[4]; p.a_kv_norm = (const float*)d_in[5];
  p.a_w_uq = (const float*)d_in[6]; p.a_w_ukv = (const float*)d_in[7]; p.c_q_norm = (const float*)d_in[8]; p.c_k_norm = (const float*)d_in[9];
  p.w_br_a = (const float*)d_in[10]; p.w_br_b = (const float*)d_in[11]; p.w_br_c = (const float*)d_in[12]; p.w_out = (const float*)d_in[13];
  p.norm_ffn = (const float*)d_in[14]; p.w_up = (const float*)d_in[15]; p.w_down = (const float*)d_in[16]; p.t5_table = (const float*)d_in[17];
  p.final_norm = (const float*)d_in[18];
  p.out = (float*)d_out; p.ws = (char*)d_ws;
  (void)hipMemsetAsync((char*)d_ws + OFF_BAR, 0, 16384, stream);
  void* args[] = {&p};
  hipError_t e = hipLaunchCooperativeKernel((const void*)hybrid_encoder_mega, dim3(grid_blocks), dim3(512), args, LDS_BYTES, stream);
  if (e != hipSuccess) fprintf(stderr, "cooperative launch failed: %s (grid %d)\n", hipGetErrorString(e), grid_blocks);
}
```

```cpp
#include <hip/hip_runtime.h>
#include <hip/hip_cooperative_groups.h>
#include <stdint.h>
#include <cstdio>
namespace cg = cooperative_groups;

typedef unsigned short bf16_t;
typedef short bf16x8 __attribute__((ext_vector_type(8)));
typedef short s16x4 __attribute__((ext_vector_type(4)));
typedef float f32x16 __attribute__((ext_vector_type(16)));
typedef float f32x4 __attribute__((ext_vector_type(4)));
typedef float f32x2 __attribute__((ext_vector_type(2)));
typedef unsigned u32x4 __attribute__((ext_vector_type(4)));
typedef unsigned u32x2 __attribute__((ext_vector_type(2)));
typedef __bf16 bf16x2_t __attribute__((ext_vector_type(2)));

#define DI __device__ __forceinline__
#define MFMA(a, b, c) __builtin_amdgcn_mfma_f32_32x32x16_bf16((a), (b), (c), 0, 0, 0)

DI unsigned pk2(float lo, float hi) { f32x2 v = {lo, hi}; bf16x2_t b = __builtin_convertvector(v, bf16x2_t); return __builtin_bit_cast(unsigned, b); }
DI bf16_t f2bf(float x) { return (bf16_t)(pk2(x, 0.f) & 0xffffu); }
DI float bflo(unsigned u) { return __uint_as_float(u << 16); }
DI float bfhi(unsigned u) { return __uint_as_float(u & 0xffff0000u); }
DI float bf2f(bf16_t b) { return __uint_as_float(((unsigned)b) << 16); }
DI int crow(int i, int h) { return (i & 3) + 8 * (i >> 2) + 4 * h; }
DI float fexp2(float x) { return __builtin_amdgcn_exp2f(x); }
DI int otid() { int t = threadIdx.x; asm volatile("" : "+v"(t)); return t; }
DI int wave_of(int tid) { return __builtin_amdgcn_readfirstlane(tid >> 6); }

constexpr int S = 16384, DM = 1024, ZP = 7680, DFF = 4096;
constexpr int ZC_CQ = 0, ZC_CKV = 384, ZC_KR = 640, ZC_QKVB = 768, ZC_QC = 3840, ZC_KC = 4352, ZC_GATE = 4608;
constexpr int GC_VB = 3840, GC_VC = 6016;
constexpr float LOG2E = 1.4426950408889634f, LN2 = 0.6931471805599453f;

constexpr size_t WT_IN = 0;
constexpr size_t WT_UQ = WT_IN + (size_t)9216 * 1024 * 2;
constexpr size_t WT_UKV = WT_UQ + (size_t)768 * 384 * 2;
constexpr size_t WT_BRA = WT_UKV + (size_t)1024 * 256 * 2;
constexpr size_t WT_BRB = WT_BRA + (size_t)1024 * 512 * 2;
constexpr size_t WT_BRC = WT_BRB + (size_t)1024 * 512 * 2;
constexpr size_t WT_OUT = WT_BRC + (size_t)1024 * 512 * 2;
constexpr size_t WT_UP = WT_OUT + (size_t)1024 * 3072 * 2;
constexpr size_t WT_DOWN = WT_UP + (size_t)4096 * 1024 * 2;
constexpr size_t OFF_CS = WT_DOWN + (size_t)1024 * 4096 * 2;
constexpr size_t OFF_BT = OFF_CS + (size_t)16384 * 16 * 8;
constexpr size_t OFF_Z = OFF_BT + 32768;
constexpr size_t OFF_H = OFF_Z + (size_t)S * ZP * 2;
constexpr size_t OFF_QA = OFF_H + (size_t)S * 1024 * 2;
constexpr size_t OFF_KA = OFF_QA + (size_t)S * 768 * 2;
constexpr size_t OFF_VAT = OFF_KA + (size_t)S * 512 * 2;
constexpr size_t OFF_VCT = OFF_VAT + (size_t)S * 512 * 2;
constexpr size_t OFF_OA = OFF_VCT + (size_t)S * 128 * 2;
constexpr size_t OFF_OB = OFF_OA + (size_t)S * 512 * 2;
constexpr size_t OFF_OC = OFF_OB + (size_t)S * 512 * 2;
constexpr size_t OFF_LSE = OFF_OC + (size_t)S * 512 * 2;
constexpr size_t OFF_SSQ = OFF_LSE + (size_t)3 * S * 8 * 4;
constexpr size_t OFF_VBT = OFF_SSQ + (size_t)3 * S * 4;
constexpr size_t OFF_BAR = OFF_VBT + (size_t)1536 * S * 2;
constexpr size_t WS_END = OFF_BAR + 16384;

constexpr int LDS_BYTES = 131072 + 1024;

struct Params {
  const float* x_prompt; const float* x_sample;
  const float* norm_mix; const float* w_in; const float* a_q_norm; const float* a_kv_norm; const float* a_w_uq; const float* a_w_ukv;
  const float* c_q_norm; const float* c_k_norm; const float* w_br_a; const float* w_br_b; const float* w_br_c; const float* w_out;
  const float* norm_ffn; const float* w_up; const float* w_down; const float* t5_table; const float* final_norm;
  float* out; char* ws;
};

DI void sincos_d(double x, float& c, float& s) {
  const double k = rint(x * 0.6366197723675814);
  double t = fma(-k, 1.5707963267948966, x); t = fma(-k, 6.123233995736766e-17, t);
  const double t2 = t * t;
  double sn = 1.0 - t2 / 210.0; sn = 1.0 - t2 / 156.0 * sn; sn = 1.0 - t2 / 110.0 * sn; sn = 1.0 - t2 / 72.0 * sn; sn = 1.0 - t2 / 42.0 * sn; sn = 1.0 - t2 / 20.0 * sn; sn = 1.0 - t2 / 6.0 * sn; sn *= t;
  double cs = 1.0 - t2 / 240.0; cs = 1.0 - t2 / 182.0 * cs; cs = 1.0 - t2 / 132.0 * cs; cs = 1.0 - t2 / 90.0 * cs; cs = 1.0 - t2 / 56.0 * cs; cs = 1.0 - t2 / 30.0 * cs; cs = 1.0 - t2 / 12.0 * cs; cs = 1.0 - t2 / 2.0 * cs;
  const int q = ((int)k) & 3;
  double so = (q == 0) ? sn : (q == 1) ? cs : (q == 2) ? -sn : -cs;
  double co = (q == 0) ? cs : (q == 1) ? -sn : (q == 2) ? -cs : sn;
  c = (float)co; s = (float)so;
}

DI void build_tables(const Params& p) {
  f32x2* CS = (f32x2*)(p.ws + OFF_CS);
  const int gsz = gridDim.x * 512, gid = blockIdx.x * 512 + otid();
  for (int e = gid; e < 16384 * 16; e += gsz) {
    const int pos = e >> 4, i = e & 15;
    double f = 1.0; for (int j = 0; j < i; ++j) f *= 0.5623413251903491;
    const float ff = (float)f; const float ang = (float)pos * ff;
    float c, s; sincos_d((double)ang, c, s);
    CS[e] = (f32x2){c, s};
  }
  float* BT = (float*)(p.ws + OFF_BT);
  for (int e = gid; e < 3 * 8 * 256; e += gsz) {
    const int gh = e >> 8, g = gh >> 3, hd = gh & 7, j = (e & 255) - 32;
    float v = 0.f;
    if (j >= 0 && j <= 128) {
      const int rel = (j - 64) << (2 * g);
      const int n = rel < 0 ? -rel : rel;
      int b = rel > 0 ? 16 : 0;
      if (n < 8) b += n; else { int lg = 31 - __clz(n); int vv = 5 + lg; b += (vv < 15 ? vv : 15); }
      v = p.t5_table[b * 24 + g * 8 + hd] * LOG2E;
    }
    BT[e] = v;
  }
}

DI void cvt_tile(const float* __restrict__ W, int ldw, int ldk, int koff, bf16_t* __restrict__ Wt, int k0, int n0, int mode, const float* __restrict__ rscale, float* tile) {
  const int tid = otid();
#pragma unroll
  for (int i = 0; i < 8; ++i) {
    const int kl = (tid >> 6) + 8 * i, nl = tid & 63, nn = n0 + nl;
    int src = nn;
    if (mode == 1) src = nn < 672 ? nn : (nn < 768 ? -1 : nn - 96);
    float v = 0.f;
    if (src >= 0) v = W[(size_t)(k0 + kl) * ldw + src];
    if (rscale) v *= rscale[k0 + kl];
    tile[kl * 65 + nl] = v;
  }
  __syncthreads();
#pragma unroll
  for (int i = 0; i < 8; ++i) {
    const int nl = (tid >> 6) + 8 * i, kl = tid & 63;
    Wt[(size_t)(n0 + nl) * ldk + koff + k0 + kl] = f2bf(tile[kl * 65 + nl]);
  }
  __syncthreads();
}

DI void convert_weights(const Params& p, int layer, char* smem) {
  float* tile = (float*)smem;
  int base = 0;
  for (int mtx = 0; mtx < 9; ++mtx) {
    const float* W; int K, Nsrc, Ndst, mode = 0, ldk = 0, koff = 0; const float* rs = nullptr; size_t off;
    switch (mtx) {
      case 0: W = p.w_in + (size_t)layer * 1024 * 9120; K = 1024; Nsrc = 9120; Ndst = 9216; mode = 1; off = WT_IN; break;
      case 1: W = p.a_w_uq + (size_t)layer * 384 * 768; K = 384; Nsrc = 768; Ndst = 768; rs = p.a_q_norm + layer * 384; off = WT_UQ; break;
      case 2: W = p.a_w_ukv + (size_t)layer * 256 * 1024; K = 256; Nsrc = 1024; Ndst = 1024; rs = p.a_kv_norm + layer * 256; off = WT_UKV; break;
      case 3: W = p.w_br_a + (size_t)layer * 512 * 1024; K = 512; Nsrc = 1024; Ndst = 1024; off = WT_BRA; break;
      case 4: W = p.w_br_b + (size_t)layer * 512 * 1024; K = 512; Nsrc = 1024; Ndst = 1024; off = WT_BRB; break;
      case 5: W = p.w_br_c + (size_t)layer * 512 * 1024; K = 512; Nsrc = 1024; Ndst = 1024; off = WT_BRC; break;
      case 6: W = p.w_out + (size_t)layer * 1024 * 1024; K = 1024; Nsrc = 1024; Ndst = 1024; off = WT_OUT; break;
      case 7: W = p.w_up + (size_t)layer * 1024 * 4096; K = 1024; Nsrc = 4096; Ndst = 4096; rs = p.norm_ffn + layer * DM; off = WT_UP; break;
      case 8: default: W = p.w_down + (size_t)layer * 4096 * 1024; K = 4096; Nsrc = 1024; Ndst = 1024; off = WT_DOWN; break;
    }
    if (ldk == 0) ldk = K;
    const int nk = K / 64, nn = Ndst / 64, cnt = nk * nn;
    bf16_t* Wt = (bf16_t*)(p.ws + off);
    int first = (int)blockIdx.x - (base % (int)gridDim.x); if (first < 0) first += gridDim.x;
    for (int it = first; it < cnt; it += gridDim.x) {
      const int kt = it % nk, nt = it / nk;
      cvt_tile(W, Nsrc, ldk, koff, Wt, kt * 64, nt * 64, mode, rs, tile);
    }
    base += cnt;
  }
}

DI void phase_norm(const float* __restrict__ x, const float* __restrict__ g, bf16_t* __restrict__ H, int rows) {
  const int tid = otid(), lane = tid & 63, wid = tid >> 6;
  for (int row = blockIdx.x * 8 + wid; row < rows; row += gridDim.x * 8) {
    const float* xr = x + (size_t)row * DM;
    f32x4 v[4]; float ss = 0.f;
#pragma unroll
    for (int i = 0; i < 4; ++i) { v[i] = *(const f32x4*)(xr + i * 256 + lane * 4); ss += v[i][0] * v[i][0] + v[i][1] * v[i][1] + v[i][2] * v[i][2] + v[i][3] * v[i][3]; }
#pragma unroll
    for (int o = 32; o >= 1; o >>= 1) ss += __shfl_xor(ss, o);
    const float rstd = rsqrtf(ss * (1.0f / DM) + 1e-6f);
#pragma unroll
    for (int i = 0; i < 4; ++i) {
      const f32x4 gg = *(const f32x4*)(g + i * 256 + lane * 4);
      u32x2 w; w.x = pk2(v[i][0] * rstd * gg[0], v[i][1] * rstd * gg[1]); w.y = pk2(v[i][2] * rstd * gg[2], v[i][3] * rstd * gg[3]);
      *(u32x2*)(H + (size_t)row * DM + i * 256 + lane * 4) = w;
    }
  }
}

DI void phase_final_norm(float* __restrict__ x, const float* __restrict__ g, int rows) {
  const int tid = otid(), lane = tid & 63, wid = tid >> 6;
  for (int row = blockIdx.x * 8 + wid; row < rows; row += gridDim.x * 8) {
    float* xr = x + (size_t)row * DM;
    f32x4 v[4]; float ss = 0.f;
#pragma unroll
    for (int i = 0; i < 4; ++i) { v[i] = *(const f32x4*)(xr + i * 256 + lane * 4); ss += v[i][0] * v[i][0] + v[i][1] * v[i][1] + v[i][2] * v[i][2] + v[i][3] * v[i][3]; }
#pragma unroll
    for (int o = 32; o >= 1; o >>= 1) ss += __shfl_xor(ss, o);
    const float rstd = rsqrtf(ss * (1.0f / DM) + 1e-6f);
#pragma unroll
    for (int i = 0; i < 4; ++i) {
      const f32x4 gg = *(const f32x4*)(g + i * 256 + lane * 4);
      f32x4 o = {v[i][0] * rstd * gg[0], v[i][1] * rstd * gg[1], v[i][2] * rstd * gg[2], v[i][3] * rstd * gg[3]};
      *(f32x4*)(xr + i * 256 + lane * 4) = o;
    }
  }
}


namespace pg8 {
#define PG8_LAS __attribute__((address_space(3)))
typedef unsigned short bf16_t;
typedef short bf16x8 __attribute__((ext_vector_type(8)));
typedef float f32x4 __attribute__((ext_vector_type(4)));
typedef unsigned u32x4 __attribute__((ext_vector_type(4)));
constexpr int BM = 256, BK = 64, HALF = 128, HTB = HALF * BK * 2  , STAGE_BYTES = 8 * HTB, NXCD = 8, WGM = 8;

__host__ __device__ __forceinline__ int lds_byte(int r, int c) { const int st = (r >> 4) * 2 + (c >> 5), rr = r & 15, cc = c & 31, ob = rr * 64 + cc * 2; return st * 1024 + (ob ^ (((ob >> 9) & 1) << 5)); }
__host__ __device__ __forceinline__ void stage_rc(int b, int& R, int& C) { const int st = b / 1024, sb = b % 1024, swz = sb ^ (((sb >> 9) & 1) << 5); R = (st >> 1) * 16 + swz / 64; C = (st & 1) * 32 + (swz % 64) / 2; }
__host__ __device__ __forceinline__ int perm32(int rho) { const int n = rho >> 4, i = rho & 15; return 8 * (i >> 2) + 4 * n + (i & 3); }

struct Unit { int pm, pn; };
struct Gemm { const bf16_t* A; const bf16_t* Bt; int M, N, K, lda, ldb; };

struct StaticOrder {
    int nM, nN, nwg, G, c;
    __host__ __device__ void init(int M, int N, int G_, int c_) { nM = M / BM; nN = N / BM; nwg = nM * nN; G = G_; c = c_; }
    __host__ __device__ bool next(int i, Unit& u) const {
        const long L = (long)i * G + c; if (L >= nwg) return false;
        map((int)L, u); return true; }
    __host__ __device__ void map(int L, Unit& u) const {
        int wgid = L; { const int q = nwg / NXCD, r = nwg % NXCD, xcd = wgid % NXCD, off = wgid / NXCD; wgid = (xcd < r ? xcd * (q + 1) : r * (q + 1) + (xcd - r) * q) + off; }
        const int nig = WGM * nN, gid = wgid / nig, fm = gid * WGM, gsz = (nM - fm) < WGM ? (nM - fm) : WGM;
        u.pm = fm + ((wgid % nig) % gsz); u.pn = (wgid % nig) / gsz;
    }
    __device__ __forceinline__ void a_ready(const Unit&) const {}
    __device__ __forceinline__ void done(const Unit&) const {}
};
template <class Epi, class Sched, bool ALIGN_EPI = false, bool SP2 = false>
__device__ __forceinline__ void gemm_phase(PG8_LAS unsigned char* lds, const Gemm g, const Sched& S, const Epi& E) {
    int tid_ = threadIdx.x; asm volatile("" : "+v"(tid_)); const int tid = tid_, wid = __builtin_amdgcn_readfirstlane(tid >> 6), lane = tid & 63, wr = wid >> 2, wc = wid & 3, fr = lane & 15, fq = lane >> 4;
    const int K = g.K, nt = K / BK;
    unsigned voffA[2], voffB[2];
#pragma unroll
    for (int i = 0; i < 2; ++i) { int R, C; stage_rc(tid * 16 + i * 8192, R, C); const int Rb = Epi::PERM ? ((R & ~31) + perm32(R & 31)) : R;
        voffA[i] = (unsigned)(R * g.lda + C) * 2u; voffB[i] = (unsigned)(Rb * g.ldb + C) * 2u; }
    const size_t kstep = (size_t)(BK * 2);
    const size_t hA = (size_t)HALF * g.lda * 2, hB = (size_t)HALF * g.ldb * 2;
    const size_t tA = 2 * hA, tB = 2 * hB;
    const unsigned ldsw = (unsigned)wid * 1024u;
    const int aoff = lds_byte(wr * 64 + fr, fq * 8), boff = lds_byte(wc * 32 + fr, fq * 8);
#define PG8_SA(b, h) (((b) * 2 + (h)) * HTB)
#define PG8_SB(b, h) ((4 + (b) * 2 + (h)) * HTB)
#define PG8_STAGE(bufoff, gbase, voff) do { _Pragma("unroll") for (int _i = 0; _i < 2; ++_i) \
        __builtin_amdgcn_global_load_lds((const unsigned*)((const char*)(gbase) + (voff)[_i]), (PG8_LAS unsigned*)(lds + (bufoff) + ldsw + _i * 8192), 16, 0, 0); } while (0)
#define PG8_LDA(dst, b, h) do { _Pragma("unroll") for (int m = 0; m < 4; ++m) _Pragma("unroll") for (int k = 0; k < 2; ++k) dst[m][k] = *(const PG8_LAS bf16x8*)(lds + PG8_SA(b, h) + aoff + m * 2048 + k * 1024); } while (0)
#define PG8_LDB(dst, b, h) do { _Pragma("unroll") for (int n = 0; n < 2; ++n) _Pragma("unroll") for (int k = 0; k < 2; ++k) dst[n][k] = *(const PG8_LAS bf16x8*)(lds + PG8_SB(b, h) + boff + n * 2048 + k * 1024); } while (0)
#define PG8_MMA(ai, bj, At, Bt) do { __builtin_amdgcn_s_setprio(1); _Pragma("unroll") for (int m = 0; m < 4; ++m) _Pragma("unroll") for (int n = 0; n < 2; ++n) _Pragma("unroll") for (int k = 0; k < 2; ++k) \
        acc[ai][bj][m][n] = __builtin_amdgcn_mfma_f32_16x16x32_bf16(Bt[n][k], At[m][k], acc[ai][bj][m][n], 0, 0, 0); __builtin_amdgcn_s_setprio(0); } while (0)
#define PG8_WAIT_V(n) asm volatile("s_waitcnt vmcnt(" #n ")" ::: "memory")
#define PG8_WAIT_L(n) asm volatile("s_waitcnt lgkmcnt(" #n ")" ::: "memory")
#define PG8_BAR __builtin_amdgcn_s_barrier()
#define PG8_SCHED __builtin_amdgcn_sched_barrier(0)
    Unit cur, nxt; int ui = 0;
    if (!S.next(0, cur)) return;
    f32x4 acc[2][2][4][2];
#pragma unroll
    for (int a = 0; a < 2; ++a)
#pragma unroll
        for (int b = 0; b < 2; ++b)
#pragma unroll
            for (int m = 0; m < 4; ++m)
#pragma unroll
                for (int n = 0; n < 2; ++n) acc[a][b][m][n] = (f32x4){0.f, 0.f, 0.f, 0.f};
    bf16x8 At[4][2], B0[2][2], B1[2][2];
    const char* cA = (const char*)g.A + (size_t)cur.pm * tA; const char* cB = (const char*)g.Bt + (size_t)cur.pn * tB;
    S.a_ready(cur);
    if constexpr (SP2) {
        PG8_STAGE(PG8_SB(0, 0), cB, voffB); PG8_STAGE(PG8_SB(0, 1), cB + hB, voffB); PG8_STAGE(PG8_SA(0, 0), cA, voffA); PG8_STAGE(PG8_SA(0, 1), cA + hA, voffA);
        if (wr == 1) PG8_BAR;
        PG8_WAIT_V(2); PG8_BAR;
        PG8_STAGE(PG8_SB(1, 0), cB + kstep, voffB); PG8_STAGE(PG8_SA(1, 0), cA + kstep, voffA); PG8_STAGE(PG8_SB(1, 1), cB + hB + kstep, voffB);
        PG8_WAIT_V(6); PG8_BAR;
    } else {
        PG8_STAGE(PG8_SB(0, 0), cB, voffB); PG8_STAGE(PG8_SA(0, 0), cA, voffA); PG8_STAGE(PG8_SB(0, 1), cB + hB, voffB); PG8_STAGE(PG8_SA(0, 1), cA + hA, voffA);
        if (wr == 1) PG8_BAR;
        PG8_WAIT_V(4); PG8_BAR;
        PG8_STAGE(PG8_SB(1, 0), cB + kstep, voffB); PG8_STAGE(PG8_SA(1, 0), cA + kstep, voffA); PG8_STAGE(PG8_SB(1, 1), cB + hB + kstep, voffB);
        PG8_WAIT_V(6); PG8_BAR;
    }
    for (;;) {
        const bool has_next = S.next(ui + 1, nxt);
        const char* nA = has_next ? (const char*)g.A + (size_t)nxt.pm * tA : cA; const char* nB = has_next ? (const char*)g.Bt + (size_t)nxt.pn * tB : cB;
_Pragma("unroll 1")
        for (int t = 0; t < nt; t += 2) {
            const bool last = (t == nt - 2);
            const char* a1 = cA + (size_t)(t + 1) * kstep;
            const char* a2 = last ? nA : cA + (size_t)(t + 2) * kstep; const char* b2 = last ? nB : cB + (size_t)(t + 2) * kstep;
            const char* a3 = a2 + kstep; const char* b3 = b2 + kstep;
            if (last && has_next) S.a_ready(nxt);
            if constexpr (SP2) {
            PG8_LDB(B0, 0, 0); PG8_LDB(B1, 0, 1); PG8_SCHED; PG8_LDA(At, 0, 0); PG8_STAGE(PG8_SA(1, 1), a1 + hA, voffA);
            PG8_WAIT_V(8); PG8_WAIT_L(0); PG8_BAR; PG8_MMA(0, 0, At, B0); PG8_MMA(0, 1, At, B1); PG8_BAR; PG8_SCHED;
            PG8_LDA(At, 0, 1); PG8_STAGE(PG8_SB(0, 0), b2, voffB); PG8_STAGE(PG8_SB(0, 1), b2 + hB, voffB); PG8_STAGE(PG8_SA(0, 0), a2, voffA);
            PG8_WAIT_V(8); PG8_WAIT_L(0); PG8_BAR; PG8_MMA(1, 0, At, B0); PG8_MMA(1, 1, At, B1); PG8_BAR; PG8_SCHED;
            PG8_LDB(B0, 1, 0); PG8_LDB(B1, 1, 1); PG8_SCHED; PG8_LDA(At, 1, 0); PG8_STAGE(PG8_SA(0, 1), a2 + hA, voffA);
            PG8_WAIT_V(8); PG8_WAIT_L(0); PG8_BAR; PG8_MMA(0, 0, At, B0); PG8_MMA(0, 1, At, B1); PG8_BAR; PG8_SCHED;
            PG8_LDA(At, 1, 1); PG8_STAGE(PG8_SB(1, 0), b3, voffB); PG8_STAGE(PG8_SB(1, 1), b3 + hB, voffB); PG8_STAGE(PG8_SA(1, 0), a3, voffA);
            PG8_WAIT_V(8); PG8_WAIT_L(0); PG8_BAR; PG8_MMA(1, 0, At, B0); PG8_MMA(1, 1, At, B1); PG8_BAR; PG8_SCHED;
            } else {
            PG8_LDB(B0, 0, 0); PG8_SCHED; PG8_LDA(At, 0, 0); PG8_STAGE(PG8_SA(1, 1), a1 + hA, voffA);
            PG8_WAIT_L(8); PG8_BAR; PG8_WAIT_L(0); PG8_MMA(0, 0, At, B0); PG8_BAR; PG8_SCHED;
            PG8_LDB(B1, 0, 1); PG8_STAGE(PG8_SB(0, 0), b2, voffB);
            PG8_BAR; PG8_WAIT_L(0); PG8_MMA(0, 1, At, B1); PG8_BAR;
            PG8_LDA(At, 0, 1); PG8_STAGE(PG8_SA(0, 0), a2, voffA);
            PG8_BAR; PG8_WAIT_L(0); PG8_MMA(1, 0, At, B0); PG8_BAR; PG8_SCHED;
            PG8_STAGE(PG8_SB(0, 1), b2 + hB, voffB);
            PG8_WAIT_V(6); PG8_BAR; PG8_MMA(1, 1, At, B1); PG8_BAR;
            PG8_LDB(B0, 1, 0); PG8_SCHED; PG8_LDA(At, 1, 0); PG8_STAGE(PG8_SA(0, 1), a2 + hA, voffA);
            PG8_WAIT_L(8); PG8_BAR; PG8_WAIT_L(0); PG8_MMA(0, 0, At, B0); PG8_BAR; PG8_SCHED;
            PG8_LDB(B1, 1, 1); PG8_STAGE(PG8_SB(1, 0), b3, voffB);
            PG8_BAR; PG8_WAIT_L(0); PG8_MMA(0, 1, At, B1); PG8_BAR;
            PG8_LDA(At, 1, 1); PG8_STAGE(PG8_SA(1, 0), a3, voffA);
            PG8_BAR; PG8_WAIT_L(0); PG8_MMA(1, 0, At, B0); PG8_BAR; PG8_SCHED;
            PG8_STAGE(PG8_SB(1, 1), b3 + hB, voffB);
            PG8_WAIT_V(6); PG8_BAR; PG8_MMA(1, 1, At, B1); PG8_BAR;
            }
        }
        if constexpr (ALIGN_EPI) { if (wr == 0) PG8_BAR; }
        if constexpr (!Epi::AFTER_DRAIN) { E(acc, cur, wr, wc, fr, fq); S.done(cur); }
        if (!has_next) break;
#pragma unroll
        for (int a = 0; a < 2; ++a)
#pragma unroll
            for (int b = 0; b < 2; ++b)
#pragma unroll
                for (int m = 0; m < 4; ++m)
#pragma unroll
                    for (int n = 0; n < 2; ++n) acc[a][b][m][n] = (f32x4){0.f, 0.f, 0.f, 0.f};
        cur = nxt; cA = nA; cB = nB; ++ui;
        if constexpr (ALIGN_EPI) { if (wr == 1) PG8_BAR; }
    }
    PG8_WAIT_V(0);
    if constexpr (!ALIGN_EPI) { if (wr == 0) PG8_BAR; }
    PG8_BAR;
    if constexpr (Epi::AFTER_DRAIN) { E.fused(acc, cur, wr, wc, fr, fq, lds, wid, lane); S.done(cur); }
#undef PG8_SA
#undef PG8_SB
#undef PG8_STAGE
#undef PG8_LDA
#undef PG8_LDB
#undef PG8_MMA
#undef PG8_WAIT_V
#undef PG8_WAIT_L
#undef PG8_BAR
#undef PG8_SCHED
}
}

DI void rope_pair8(float (&x1)[8], float (&x2)[8], const f32x2* cs) {
#pragma unroll
  for (int j = 0; j < 8; ++j) { const f32x2 c = cs[j]; const float a = x1[j], b = x2[j]; x1[j] = a * c.x - b * c.y; x2[j] = a * c.y + b * c.x; }
}
typedef pg8::Unit Unit;
#define ACC_T const f32x4 (&acc)[2][2][4][2]
#define EROW(u, ai, m) ((u).pm * 256 + (ai) * 128 + wr * 64 + (m) * 16 + fr)
DI u32x4 pack_f8(const f32x4 a, const f32x4 b) { u32x4 w; w.x = pk2(a[0], a[1]); w.y = pk2(a[2], a[3]); w.z = pk2(b[0], b[1]); w.w = pk2(b[2], b[3]); return w; }

struct EpiInproj {
  static constexpr bool PERM = true, AFTER_DRAIN = false;
  bf16_t* Z; bf16_t* VCT; bf16_t* VBT; float* ssq_q; float* ssq_kv;
  DI void operator()(ACC_T, const Unit& u, int wr, int wc, int fr, int fq) const {
#pragma unroll
    for (int bj = 0; bj < 2; ++bj) {
      const int tt = 2 * u.pn + bj, cb = tt * 128 + wc * 32 + 8 * fq;
      int sh = 0; if (tt >= 6 && tt < 42) sh = 2 * (((tt - 6) >> 2) % 3);
      const int msk = (1 << sh) - 1;
      if (tt >= 38 && tt < 42) {
        bf16_t* vt = VBT + (size_t)(cb - GC_VB) * S + fr * (S >> 4) + u.pm * 16 + wr * 4;
#pragma unroll
        for (int ai = 0; ai < 2; ++ai)
#pragma unroll
          for (int n = 0; n < 2; ++n) {
            __builtin_amdgcn_sched_barrier(0);
#pragma unroll
            for (int e = 0; e < 4; ++e) {
              u32x2 w; w.x = pk2(acc[ai][bj][0][n][e], acc[ai][bj][1][n][e]); w.y = pk2(acc[ai][bj][2][n][e], acc[ai][bj][3][n][e]);
              *(u32x2*)(vt + (size_t)(4 * n + e) * S + ai * 8) = w;
            }
          }
      } else if (tt == 47 || (tt >= 30 && tt < 38)) {
        bf16_t* vt = (tt == 47) ? VCT + (size_t)(cb - GC_VC) * S : VBT + (size_t)(cb - GC_VB) * S;
#pragma unroll
        for (int ai = 0; ai < 2; ++ai)
#pragma unroll
          for (int m = 0; m < 4; ++m) {
            __builtin_amdgcn_sched_barrier(0);
            const int row = EROW(u, ai, m), prow = (row & msk) * (S >> sh) + (row >> sh);
            bf16_t* vp = vt + prow;
#pragma unroll
            for (int n = 0; n < 2; ++n)
#pragma unroll
              for (int e = 0; e < 4; ++e) vp[(size_t)(4 * n + e) * S] = f2bf(acc[ai][bj][m][n][e]);
          }
      } else {
        const int zc = cb < GC_VB ? cb : cb - 1536;
        float* ssq = (tt < 3) ? ssq_q : ((tt < 5) ? ssq_kv : nullptr);
#pragma unroll
        for (int ai = 0; ai < 2; ++ai)
#pragma unroll
          for (int m = 0; m < 4; ++m) {
            const int row = EROW(u, ai, m), prow = (row & msk) * (S >> sh) + (row >> sh);
            const f32x4 v0 = acc[ai][bj][m][0], v1 = acc[ai][bj][m][1];
            *(u32x4*)(Z + (size_t)prow * ZP + zc) = pack_f8(v0, v1);
            if (ssq) {
              float s = v0[0] * v0[0] + v0[1] * v0[1] + v0[2] * v0[2] + v0[3] * v0[3] + v1[0] * v1[0] + v1[1] * v1[1] + v1[2] * v1[2] + v1[3] * v1[3];
              s += __shfl_xor(s, 16); s += __shfl_xor(s, 32);
              if (fq == 0) __hip_atomic_fetch_add(ssq + row, s, __ATOMIC_RELAXED, __HIP_MEMORY_SCOPE_AGENT);
            }
          }
      }
    }
  }
};
struct EpiUpQ {
  static constexpr bool PERM = true, AFTER_DRAIN = false;
  bf16_t* QA; const float* ssq;
  DI void operator()(ACC_T, const Unit& u, int wr, int wc, int fr, int fq) const {
#pragma unroll
    for (int ai = 0; ai < 2; ++ai)
#pragma unroll
      for (int m = 0; m < 4; ++m) {
        const int row = EROW(u, ai, m); const float rs = rsqrtf(ssq[row] * (1.0f / 384.0f) + 1e-6f);
#pragma unroll
        for (int bj = 0; bj < 2; ++bj) {
          const int cb = u.pn * 256 + bj * 128 + wc * 32 + 8 * fq;
          *(u32x4*)(QA + (size_t)row * 768 + cb) = pack_f8(acc[ai][bj][m][0] * rs, acc[ai][bj][m][1] * rs);
        }
      }
  }
};
struct EpiUpKV {
  static constexpr bool PERM = true, AFTER_DRAIN = false;
  bf16_t* KA; bf16_t* VAT; const float* ssq;
  DI void operator()(ACC_T, const Unit& u, int wr, int wc, int fr, int fq) const {
#pragma unroll
    for (int ai = 0; ai < 2; ++ai)
#pragma unroll
      for (int m = 0; m < 4; ++m) {
        __builtin_amdgcn_sched_barrier(0);
        const int row = EROW(u, ai, m); const float rs = rsqrtf(ssq[row] * (1.0f / 256.0f) + 1e-6f);
#pragma unroll
        for (int bj = 0; bj < 2; ++bj) {
          const int head = 2 * u.pn + bj, w0 = wc * 32 + 8 * fq;
          if (wc < 2) {
            *(u32x4*)(KA + (size_t)row * 512 + head * 64 + w0) = pack_f8(acc[ai][bj][m][0] * rs, acc[ai][bj][m][1] * rs);
          } else {
            bf16_t* vp = VAT + (size_t)(head * 64 + w0 - 64) * S + row;
#pragma unroll
            for (int n = 0; n < 2; ++n)
#pragma unroll
              for (int e = 0; e < 4; ++e) vp[(size_t)(4 * n + e) * S] = f2bf(acc[ai][bj][m][n][e] * rs);
          }
        }
      }
  }
};
struct EpiMerge {
  static constexpr bool PERM = true, AFTER_DRAIN = false;
  const bf16_t* Z; bf16_t* MIX;
  DI void operator()(ACC_T, const Unit& u, int wr, int wc, int fr, int fq) const {
    const int b = u.pm >> 6, pm = u.pm & 63, pn = u.pn & 3;
#pragma unroll
    for (int ai = 0; ai < 2; ++ai)
#pragma unroll
      for (int m = 0; m < 4; ++m) {
        const int row = pm * 256 + ai * 128 + wr * 64 + m * 16 + fr;
#pragma unroll
        for (int bj = 0; bj < 2; ++bj) {
          const int col = pn * 256 + bj * 128 + wc * 32 + 8 * fq;
          const u32x4 g = *(const u32x4*)(Z + (size_t)row * ZP + ZC_GATE + b * 1024 + col);
          f32x4 v0 = acc[ai][bj][m][0], v1 = acc[ai][bj][m][1];
#pragma unroll
          for (int q = 0; q < 2; ++q) {
            v0[2 * q] *= 1.0f / (1.0f + __expf(-bflo(g[q]))); v0[2 * q + 1] *= 1.0f / (1.0f + __expf(-bfhi(g[q])));
            v1[2 * q] *= 1.0f / (1.0f + __expf(-bflo(g[2 + q]))); v1[2 * q + 1] *= 1.0f / (1.0f + __expf(-bfhi(g[2 + q])));
          }
          bf16_t* mp = MIX + (size_t)row * DM + col;
          if (b > 0) { const u32x4 o = *(const u32x4*)mp;
#pragma unroll
            for (int q = 0; q < 2; ++q) { v0[2 * q] += bflo(o[q]); v0[2 * q + 1] += bfhi(o[q]); v1[2 * q] += bflo(o[2 + q]); v1[2 * q + 1] += bfhi(o[2 + q]); } }
          *(u32x4*)mp = pack_f8(v0, v1);
        }
      }
  }
};
template <bool NORM_OUT> struct EpiResid {
  static constexpr bool PERM = false, AFTER_DRAIN = false;
  const float* xs; float* xd; bf16_t* xb; float* ssq;
  DI void operator()(ACC_T, const Unit& u, int wr, int wc, int fr, int fq) const {
#pragma unroll
    for (int ai = 0; ai < 2; ++ai)
#pragma unroll
      for (int m = 0; m < 4; ++m) {
        const int row = EROW(u, ai, m);
        const size_t ro = (size_t)row * DM + u.pn * 256 + wc * 32 + 4 * fq;
        float ss = 0.f;
#pragma unroll
        for (int bj = 0; bj < 2; ++bj)
#pragma unroll
          for (int n = 0; n < 2; ++n) {
            const size_t o = ro + bj * 128 + n * 16; const f32x4 x = *(const f32x4*)(xs + o) + acc[ai][bj][m][n]; *(f32x4*)(xd + o) = x;
            if (NORM_OUT) { u32x2 w; w.x = pk2(x[0], x[1]); w.y = pk2(x[2], x[3]); *(u32x2*)(xb + o) = w; ss += x[0] * x[0] + x[1] * x[1] + x[2] * x[2] + x[3] * x[3]; }
          }
        if (NORM_OUT) { ss += __shfl_xor(ss, 16); ss += __shfl_xor(ss, 32); if (fq == 0) __hip_atomic_fetch_add(ssq + row, ss, __ATOMIC_RELAXED, __HIP_MEMORY_SCOPE_AGENT); }
      }
  }
};
struct EpiRelu2 {
  static constexpr bool PERM = true, AFTER_DRAIN = false;
  bf16_t* HID; const float* ssq;
  DI void operator()(ACC_T, const Unit& u, int wr, int wc, int fr, int fq) const {
#pragma unroll
    for (int ai = 0; ai < 2; ++ai)
#pragma unroll
      for (int m = 0; m < 4; ++m) {
        const int row = EROW(u, ai, m); const float rs = rsqrtf(ssq[row] * (1.0f / DM) + 1e-6f);
#pragma unroll
        for (int bj = 0; bj < 2; ++bj) {
          f32x4 v0 = acc[ai][bj][m][0], v1 = acc[ai][bj][m][1];
#pragma unroll
          for (int e = 0; e < 4; ++e) { const float a = fmaxf(v0[e], 0.f) * rs, c = fmaxf(v1[e], 0.f) * rs; v0[e] = a * a; v1[e] = c * c; }
          *(u32x4*)(HID + (size_t)row * DFF + u.pn * 256 + bj * 128 + wc * 32 + 8 * fq) = pack_f8(v0, v1);
        }
      }
  }
};
struct DiagOrder {
  pg8::StaticOrder so; int G, c;
  DI void init(int G_, int c_) { so.init(S, 1024, G_, c_); G = G_; c = c_; }
  DI bool next(int i, Unit& u) const { const int tile = (i / 3) * G + c, b = i % 3; if (tile >= 256) return false; so.map(tile, u); u.pm += 64 * b; u.pn += 4 * b; return true; }
  DI void a_ready(const Unit&) const {}
  DI void done(const Unit&) const {}
};
#define GEMM_LDS ((PG8_LAS unsigned char*)smem)

DI void phase_kpost(const Params& p, int layer) {
  bf16_t* Z = (bf16_t*)(p.ws + OFF_Z);
  const f32x2* CS = (const f32x2*)(p.ws + OFF_CS);
  for (int it = (int)gridDim.x - 1 - (int)blockIdx.x; it < 96; it += gridDim.x) {
      const int tid = otid();
      const int idx = it * 512 + tid;
      const int unit = idx / S, tkn = idx % S;
      if (unit < 2) {
        bf16_t* kp = Z + (size_t)tkn * ZP + ZC_KC + unit * 64;
        float x[8][8]; float ss = 0.f;
#pragma unroll
        for (int c = 0; c < 8; ++c) { const u32x4 v = *(const u32x4*)(kp + c * 8);
#pragma unroll
          for (int q = 0; q < 4; ++q) { x[c][2 * q] = bflo(v[q]); x[c][2 * q + 1] = bfhi(v[q]); ss += x[c][2 * q] * x[c][2 * q] + x[c][2 * q + 1] * x[c][2 * q + 1]; } }
        const float rs = rsqrtf(ss * (1.0f / 64.0f) + 1e-6f);
        const float* gk = p.c_k_norm + layer * 64;
#pragma unroll
        for (int c = 0; c < 8; ++c)
#pragma unroll
          for (int q = 0; q < 8; ++q) x[c][q] *= rs * gk[c * 8 + q];
        const f32x2* cr = CS + (size_t)(tkn >> 6) * 16; const f32x2* cc = CS + (size_t)(tkn & 63) * 16;
        rope_pair8(x[0], x[2], cr); rope_pair8(x[1], x[3], cr + 8);
        rope_pair8(x[4], x[6], cc); rope_pair8(x[5], x[7], cc + 8);
#pragma unroll
        for (int c = 0; c < 8; ++c) { u32x4 w; w.x = pk2(x[c][0], x[c][1]); w.y = pk2(x[c][2], x[c][3]); w.z = pk2(x[c][4], x[c][5]); w.w = pk2(x[c][6], x[c][7]); *(u32x4*)(kp + c * 8) = w; }
      } else {
        bf16_t* kp = Z + (size_t)tkn * ZP + ZC_KR;
        float x[4][8];
#pragma unroll
        for (int c = 0; c < 4; ++c) { const u32x4 v = *(const u32x4*)(kp + c * 8);
#pragma unroll
          for (int q = 0; q < 4; ++q) { x[c][2 * q] = bflo(v[q]); x[c][2 * q + 1] = bfhi(v[q]); } }
        const f32x2* cp = CS + (size_t)tkn * 16;
        rope_pair8(x[0], x[2], cp); rope_pair8(x[1], x[3], cp + 8);
#pragma unroll
        for (int c = 0; c < 4; ++c) { u32x4 w; w.x = pk2(x[c][0], x[c][1]); w.y = pk2(x[c][2], x[c][3]); w.z = pk2(x[c][4], x[c][5]); w.w = pk2(x[c][6], x[c][7]); *(u32x4*)(kp + c * 8) = w; }
      }
  }
}

DI bf16x8 pack8(float a0, float a1, float a2, float a3, float a4, float a5, float a6, float a7) {
  u32x4 w; w.x = pk2(a0, a1); w.y = pk2(a2, a3); w.z = pk2(a4, a5); w.w = pk2(a6, a7); return __builtin_bit_cast(bf16x8, w);
}
DI void unpack8(const u32x4 v, float (&x)[8]) {
#pragma unroll
  for (int q = 0; q < 4; ++q) { x[2 * q] = bflo(v[q]); x[2 * q + 1] = bfhi(v[q]); }
}

DI void store_o_wide(bf16_t* rowp, const f32x16& o, float inv, int h) {
#pragma unroll
  for (int pr = 0; pr < 2; ++pr) {
    const int g = 2 * pr;
    const unsigned ax = pk2(o[4 * g] * inv, o[4 * g + 1] * inv), ay = pk2(o[4 * g + 2] * inv, o[4 * g + 3] * inv);
    const unsigned bx = pk2(o[4 * g + 4] * inv, o[4 * g + 5] * inv), by = pk2(o[4 * g + 6] * inv, o[4 * g + 7] * inv);
    const auto sx = __builtin_amdgcn_permlane32_swap(ax, bx, false, false);
    const auto sy = __builtin_amdgcn_permlane32_swap(ay, by, false, false);
    const u32x4 w = {sx[0], sy[0], sx[1], sy[1]};
    *(u32x4*)(rowp + 8 * (g + h)) = w;
  }
}

constexpr int ATT_STAGE = 20480;

template <int TYPE, bool FIXREF>
DI void attn_dense_unit(const Params& p, int layer, int head, int qb, char* lds, float bref) {
  constexpr int NQK = TYPE == 0 ? 6 : 4;
  const int tid = otid(), lane = tid & 63, wid = wave_of(tid), r = lane & 31, h = lane >> 5;
  const bf16_t* Z = (const bf16_t*)(p.ws + OFF_Z);
  const f32x2* CS = (const f32x2*)(p.ws + OFF_CS);
  const bf16_t* Kn; int ldk; const bf16_t* VT; bf16_t* O;
  if (TYPE == 0) { Kn = (const bf16_t*)(p.ws + OFF_KA) + head * 64; ldk = 512; VT = (const bf16_t*)(p.ws + OFF_VAT) + (size_t)head * 64 * S; O = (bf16_t*)(p.ws + OFF_OA); }
  else { const int kvh = head >> 2; Kn = Z + ZC_KC + kvh * 64; ldk = ZP; VT = (const bf16_t*)(p.ws + OFF_VCT) + (size_t)kvh * 64 * S; O = (bf16_t*)(p.ws + OFF_OC); }
  const int q = qb * 256 + wid * 32 + r;
  bf16x8 qf[NQK];
  if (TYPE == 0) {
    const bf16_t* qp = (const bf16_t*)(p.ws + OFF_QA) + (size_t)q * 768 + head * 96 + 8 * h;
    float x[6][8];
#pragma unroll
    for (int d0 = 0; d0 < 6; ++d0) unpack8(*(const u32x4*)(qp + d0 * 16), x[d0]);
    rope_pair8(x[4], x[5], CS + (size_t)q * 16 + 8 * h);
    const float sc = 0.10206207261596577f * LOG2E;
#pragma unroll
    for (int d0 = 0; d0 < 6; ++d0) qf[d0] = pack8(x[d0][0] * sc, x[d0][1] * sc, x[d0][2] * sc, x[d0][3] * sc, x[d0][4] * sc, x[d0][5] * sc, x[d0][6] * sc, x[d0][7] * sc);
  } else {
    const bf16_t* qp = Z + (size_t)q * ZP + ZC_QC + head * 64 + 8 * h;
    float x[4][8]; float ss = 0.f;
#pragma unroll
    for (int d0 = 0; d0 < 4; ++d0) { unpack8(*(const u32x4*)(qp + d0 * 16), x[d0]);
#pragma unroll
      for (int j = 0; j < 8; ++j) ss += x[d0][j] * x[d0][j]; }
    ss += __shfl_xor(ss, 32);
    const float rs = rsqrtf(ss * (1.0f / 64.0f) + 1e-6f);
    const float* gq = p.c_q_norm + layer * 64;
#pragma unroll
    for (int d0 = 0; d0 < 4; ++d0)
#pragma unroll
      for (int j = 0; j < 8; ++j) x[d0][j] *= rs * gq[d0 * 16 + 8 * h + j];
    rope_pair8(x[0], x[1], CS + (size_t)(q >> 6) * 16 + 8 * h);
    rope_pair8(x[2], x[3], CS + (size_t)(q & 63) * 16 + 8 * h);
    const float sc = 0.125f * LOG2E;
#pragma unroll
    for (int d0 = 0; d0 < 4; ++d0) qf[d0] = pack8(x[d0][0] * sc, x[d0][1] * sc, x[d0][2] * sc, x[d0][3] * sc, x[d0][4] * sc, x[d0][5] * sc, x[d0][6] * sc, x[d0][7] * sc);
  }
  typedef __attribute__((address_space(3))) unsigned lds_u32;
  const int srow = tid >> 3, sch = (tid & 7) ^ ((srow >> 1) & 7);
  const bf16_t* gk = Kn + (size_t)srow * ldk + sch * 8;
  const bf16_t* gv = VT + (size_t)srow * S + sch * 8;
  const int rrow = tid >> 2, rch = (tid & 3) ^ ((rrow >> 2) & 3);
  const bf16_t* gr = Z + ZC_KR + (size_t)rrow * ZP + rch * 8;
  char* wbase = lds + wid * 1024;
#define DMA(t, soff) do { \
    __builtin_amdgcn_global_load_lds((const unsigned*)(gk + (size_t)(t) * 64 * ldk), (lds_u32*)(wbase + (soff)), 16, 0, 0); \
    __builtin_amdgcn_global_load_lds((const unsigned*)(gv + (size_t)(t) * 64), (lds_u32*)(wbase + (soff) + 8192), 16, 0, 0); \
    if (TYPE == 0 && wid < 4) __builtin_amdgcn_global_load_lds((const unsigned*)(gr + (size_t)(t) * 64 * ZP), (lds_u32*)(wbase + (soff) + 16384), 16, 0, 0); } while (0)
#define DMA_WAIT(keep) do { if (keep) { if (TYPE == 0 && wid < 4) asm volatile("s_waitcnt vmcnt(3)" ::: "memory"); else asm volatile("s_waitcnt vmcnt(2)" ::: "memory"); } \
    else asm volatile("s_waitcnt vmcnt(0)" ::: "memory"); } while (0)
#define BAR() do { asm volatile("s_waitcnt lgkmcnt(0)" ::: "memory"); __builtin_amdgcn_s_barrier(); asm volatile("" ::: "memory"); } while (0)
  constexpr int NONES = (TYPE == 0) ? 0 : 2;
  float m_run = 0.f, lsum = 0.f, ls0 = 0.f, ls1 = 0.f, ls2 = 0.f; f32x16 o0, o1, negm, la;
#pragma unroll
  for (int i = 0; i < 16; ++i) { o0[i] = 0.f; o1[i] = 0.f; negm[i] = 0.f; la[i] = 0.f; }
  const bf16x8 ones = {0x3F80, 0x3F80, 0x3F80, 0x3F80, 0x3F80, 0x3F80, 0x3F80, 0x3F80};
  const int rK = (r & ~12) | ((r & 4) << 1) | ((r & 8) >> 1);
  const int ksw = (rK >> 1) & 7, rsw = (rK >> 2) & 3, vsw = (r >> 1) & 7;
  int koff[4], roff[2], voff[4];
#pragma unroll
  for (int d0 = 0; d0 < 4; ++d0) { koff[d0] = rK * 128 + (((2 * d0 + h) ^ ksw) << 4); voff[d0] = 8192 + r * 128 + (((2 * d0 + h) ^ vsw) << 4); }
#pragma unroll
  for (int d0 = 0; d0 < 2; ++d0) roff[d0] = 16384 + rK * 64 + (((2 * d0 + h) ^ rsw) << 4);
  constexpr int NT = S / 64;
  constexpr float THR = 8.0f;
#define SB() __builtin_amdgcn_sched_barrier(0)
#define QKR(d0, K0, K1, SOFF) do { if ((d0) < 4) { K0 = *(const bf16x8*)(lds + (SOFF) + koff[(d0) & 3]); K1 = *(const bf16x8*)(lds + (SOFF) + 32 * 128 + koff[(d0) & 3]); } \
    else if ((d0) < NQK) { K0 = *(const bf16x8*)(lds + (SOFF) + roff[(d0) & 1]); K1 = *(const bf16x8*)(lds + (SOFF) + 32 * 64 + roff[(d0) & 1]); } } while (0)
#define QKM(N0, N1, d0, K0, K1) do { if ((d0) == 0) { N0 = MFMA(K0, qf[0], negm); N1 = MFMA(K1, qf[0], negm); } \
    else if ((d0) < NQK) { N0 = MFMA(K0, qf[(d0) < NQK ? (d0) : 0], N0); N1 = MFMA(K1, qf[(d0) < NQK ? (d0) : 0], N1); } } while (0)
#define EX4(CC, B, SI) do { __builtin_amdgcn_s_setprio(1); _Pragma("unroll") for (int i_ = 0; i_ < 4; ++i_) { CC[(B) + i_] = fexp2(CC[(B) + i_]); if ((SI) >= NONES) { if (i_ == 0) ls0 += CC[(B) + i_]; else if (i_ == 1) ls1 += CC[(B) + i_]; else if (i_ == 2) ls2 += CC[(B) + i_]; else lsum += CC[(B) + i_]; } } __builtin_amdgcn_s_setprio(0); } while (0)
#define PK8(PF, CC, B) do { PF = pack8(CC[(B)], CC[(B) + 1], CC[(B) + 2], CC[(B) + 3], CC[(B) + 4], CC[(B) + 5], CC[(B) + 6], CC[(B) + 7]); } while (0)
#define VR(s_, V0, V1, SOFF) do { V0 = *(const bf16x8*)(lds + (SOFF) + voff[s_]); V1 = *(const bf16x8*)(lds + (SOFF) + 32 * 128 + voff[s_]); } while (0)
#define PVM(s_, V0, V1) do { o0 = MFMA(V0, pf[s_], o0); o1 = MFMA(V1, pf[s_], o1); if ((s_) < NONES) la = MFMA(ones, pf[s_], la); } while (0)
#define MAXG(NN, B) do { ma_ = fmaxf(fmaxf(ma_, NN[(B)]), NN[(B) + 1]); mb_ = fmaxf(fmaxf(mb_, NN[(B) + 2]), NN[(B) + 3]); \
    ma_ = fmaxf(fmaxf(ma_, NN[(B) + 4]), NN[(B) + 5]); mb_ = fmaxf(fmaxf(mb_, NN[(B) + 6]), NN[(B) + 7]); } while (0)
#define ROWMAX(P0, P1, MX) do { float a_ = fmaxf(fmaxf(P0[0], P0[1]), P1[0]), c_ = fmaxf(fmaxf(P0[2], P0[3]), P1[1]); a_ = fmaxf(fmaxf(a_, P1[2]), P1[3]); \
    _Pragma("unroll") for (int i_ = 4; i_ < 16; i_ += 4) { a_ = fmaxf(fmaxf(a_, P0[i_]), P0[i_ + 1]); c_ = fmaxf(fmaxf(c_, P0[i_ + 2]), P0[i_ + 3]); a_ = fmaxf(fmaxf(a_, P1[i_]), P1[i_ + 1]); c_ = fmaxf(fmaxf(c_, P1[i_ + 2]), P1[i_ + 3]); } \
    a_ = fmaxf(a_, c_); MX = fmaxf(a_, __shfl_xor(a_, 32)); } while (0)
#define RESCALE(P0, P1, DELTA) do { const float dl_ = (DELTA); m_run += dl_; const float al_ = fexp2(-dl_); lsum *= al_; ls0 *= al_; ls1 *= al_; ls2 *= al_; \
    _Pragma("unroll") for (int i_ = 0; i_ < 16; ++i_) { P0[i_] -= dl_; P1[i_] -= dl_; o0[i_] *= al_; o1[i_] *= al_; if (NONES > 0) la[i_] *= al_; negm[i_] = -m_run; } } while (0)
#define STEP(C0, C1, N0, N1, T, HAS_NEXT, HAS_LOAD, S0, S1, S3) do { \
    if (HAS_LOAD) DMA((T) + 3, S3); \
    bf16x8 pf[4]; bf16x8 ka0, ka1, kb0, kb1, va0, va1, vb0, vb1; \
    if (HAS_NEXT) QKR(0, ka0, ka1, S1); \
    SB(); if (HAS_NEXT) { QKR(1, kb0, kb1, S1); QKM(N0, N1, 0, ka0, ka1); } EX4(C0, 0, 0); \
    SB(); if (HAS_NEXT) { QKR(2, ka0, ka1, S1); QKM(N0, N1, 1, kb0, kb1); } EX4(C0, 4, 0); PK8(pf[0], C0, 0); \
    SB(); if (HAS_NEXT) { QKR(3, kb0, kb1, S1); QKM(N0, N1, 2, ka0, ka1); } EX4(C0, 8, 1); \
    SB(); if (HAS_NEXT) { QKR(4, ka0, ka1, S1); QKM(N0, N1, 3, kb0, kb1); } EX4(C0, 12, 1); PK8(pf[1], C0, 8); if (NQK == 4) VR(0, va0, va1, S0); \
    if (NQK > 4) { \
      SB(); if (HAS_NEXT) { QKR(5, kb0, kb1, S1); QKM(N0, N1, 4, ka0, ka1); } EX4(C1, 0, 2); \
      SB(); if (HAS_NEXT) QKM(N0, N1, 5, kb0, kb1); EX4(C1, 4, 2); PK8(pf[2], C1, 0); VR(0, va0, va1, S0); } \
    float ma_ = -1e30f, mb_ = -1e30f; \
    if (NQK == 4) { \
      SB(); VR(1, vb0, vb1, S0); PVM(0, va0, va1); EX4(C1, 0, 2); EX4(C1, 4, 2); PK8(pf[2], C1, 0); \
      SB(); VR(2, va0, va1, S0); PVM(1, vb0, vb1); EX4(C1, 8, 3); EX4(C1, 12, 3); PK8(pf[3], C1, 8); \
    } else { \
      SB(); VR(1, vb0, vb1, S0); PVM(0, va0, va1); EX4(C1, 8, 3); \
      SB(); VR(2, va0, va1, S0); PVM(1, vb0, vb1); EX4(C1, 12, 3); PK8(pf[3], C1, 8); } \
    SB(); VR(3, vb0, vb1, S0); PVM(2, va0, va1); if (HAS_NEXT && !FIXREF) { MAXG(N0, 0); MAXG(N0, 8); } \
    SB(); PVM(3, vb0, vb1); if (HAS_NEXT && !FIXREF) { MAXG(N1, 0); MAXG(N1, 8); } \
    SB(); \
    float mx_ = fmaxf(ma_, mb_); { const auto rr_ = __builtin_amdgcn_permlane32_swap(__float_as_uint(mx_), __float_as_uint(mx_), false, false); mx_ = fmaxf(__uint_as_float(rr_[0]), __uint_as_float(rr_[1])); } \
    DMA_WAIT(HAS_LOAD); BAR(); \
    if (HAS_NEXT && !FIXREF) { if (__any(mx_ > THR)) RESCALE(N0, N1, fmaxf(mx_, 0.f)); } } while (0)
  constexpr int R0 = 0, R1 = ATT_STAGE, R2 = 2 * ATT_STAGE, R3 = 3 * ATT_STAGE;
  f32x16 sA0, sA1, sB0, sB1;
  DMA(0, R0); DMA(1, R1); DMA(2, R2); DMA_WAIT(true); BAR();
  if (FIXREF) { m_run = bref;
#pragma unroll
    for (int i = 0; i < 16; ++i) negm[i] = -bref; }
  { bf16x8 ka0, ka1;
#pragma unroll
    for (int d0 = 0; d0 < NQK; ++d0) { QKR(d0, ka0, ka1, R0); QKM(sA0, sA1, d0, ka0, ka1); } }
  if (!FIXREF) { float mx0; ROWMAX(sA0, sA1, mx0); m_run = mx0;
#pragma unroll
    for (int i = 0; i < 16; ++i) { sA0[i] -= mx0; sA1[i] -= mx0; negm[i] = -mx0; } }
  for (int t = 0; t < NT - 4; t += 4) {
    STEP(sA0, sA1, sB0, sB1, t, true, true, R0, R1, R3);
    STEP(sB0, sB1, sA0, sA1, t + 1, true, true, R1, R2, R0);
    STEP(sA0, sA1, sB0, sB1, t + 2, true, true, R2, R3, R1);
    STEP(sB0, sB1, sA0, sA1, t + 3, true, true, R3, R0, R2);
  }
  STEP(sA0, sA1, sB0, sB1, NT - 4, true, true, R0, R1, R3);
  STEP(sB0, sB1, sA0, sA1, NT - 3, true, false, R1, R2, R0);
  STEP(sA0, sA1, sB0, sB1, NT - 2, true, false, R2, R3, R1);
  STEP(sB0, sB1, sA0, sA1, NT - 1, false, false, R3, R0, R2);
  lsum += ls0 + ls1 + ls2;
  const float l = (NONES > 0 ? la[0] : 0.f) + lsum + __shfl_xor(lsum, 32);
#undef DMA
#undef DMA_WAIT
#undef BAR
#undef SB
#undef QKR
#undef QKM
#undef EX4
#undef PK8
#undef VR
#undef PVM
#undef MAXG
#undef ROWMAX
#undef RESCALE
#undef STEP
  const float inv = 1.0f / l;
  bf16_t* op = O + (size_t)q * 512 + head * 64;
  store_o_wide(op, o0, inv, h); store_o_wide(op + 32, o1, inv, h);
}

constexpr int BLV = 49152;
DI void b_issue_k(const Params& p, int x, char* lds, int tid, int wid) {
  typedef __attribute__((address_space(3))) unsigned lds_u32;
  const int g = x >> 9, head = (x >> 6) & 7, blk256 = x & 63;
  const int sh = 2 * g, Ls = S >> sh, P0 = blk256 * 256, sub = P0 / Ls, i0 = P0 & (Ls - 1), sub0 = sub * Ls;
  const bf16_t* Zk = (const bf16_t*)(p.ws + OFF_Z) + ZC_QKVB + ((1 * 3 + g) * 8 + head) * 64;
#pragma unroll
  for (int i = 0; i < 6; ++i) {
    const int sl = i * 512 + tid, row = sl >> 3, c = (sl & 7) ^ ((row >> 1) & 7); int key = i0 - 64 + row; key = key < 0 ? 0 : (key > Ls - 1 ? Ls - 1 : key);
    __builtin_amdgcn_global_load_lds((const unsigned*)(Zk + (size_t)(sub0 + key) * ZP + c * 8), (lds_u32*)(lds + (i * 512 + wid * 64) * 16), 16, 0, 0);
  }
}
DI void b_issue_v(const Params& p, int x, char* lds, int tid, int wid) {
  typedef __attribute__((address_space(3))) unsigned lds_u32;
  const int g = x >> 9, head = (x >> 6) & 7, blk256 = x & 63;
  const int sh = 2 * g, Ls = S >> sh, P0 = blk256 * 256, sub = P0 / Ls, i0 = P0 & (Ls - 1), sub0 = sub * Ls;
  const bf16_t* VTg = (const bf16_t*)(p.ws + OFF_VBT) + (size_t)((g * 8 + head) * 64) * S + sub0;
#pragma unroll
  for (int i = 0; i < 6; ++i) {
    const int sl = i * 512 + tid, d = sl / 48, c = (sl - d * 48) ^ (d & 15); int k0 = i0 - 64 + 8 * c; k0 = k0 < 0 ? 0 : (k0 > Ls - 8 ? Ls - 8 : k0);
    __builtin_amdgcn_global_load_lds((const unsigned*)(VTg + (size_t)d * S + k0), (lds_u32*)(lds + BLV + (i * 512 + wid * 64) * 16), 16, 0, 0);
  }
}
DI void attn_b_item(const Params& p, int x, int xnext, char* lds) {
  const int tid = otid(), lane = tid & 63, wid = wave_of(tid), r = lane & 31, h = lane >> 5;
  const int g = x >> 9, head = (x >> 6) & 7, blk256 = x & 63;
  const bf16_t* Z = (const bf16_t*)(p.ws + OFF_Z);
  const int sh = 2 * g, Ls = S >> sh, P0 = blk256 * 256, sub = P0 / Ls, i0 = P0 & (Ls - 1);
  const bf16_t* Zq = Z + ZC_QKVB + ((0 * 3 + g) * 8 + head) * 64;
  constexpr int LV = BLV;
  const int i0w = i0 + 32 * wid;
  const float* BT = (const float*)(p.ws + OFF_BT) + (g * 8 + head) * 256 + 32 - r + 8 * h;
  const int rK = (r & ~12) | ((r & 4) << 1) | ((r & 8) >> 1);
  bf16x8 qf[4];
  {
    const bf16_t* qp = Zq + (size_t)(P0 + 32 * wid + r) * ZP + 8 * h; const float scq = 0.125f * LOG2E;
#pragma unroll
    for (int d0 = 0; d0 < 4; ++d0) { float x8[8]; unpack8(*(const u32x4*)(qp + d0 * 16), x8); qf[d0] = pack8(x8[0] * scq, x8[1] * scq, x8[2] * scq, x8[3] * scq, x8[4] * scq, x8[5] * scq, x8[6] * scq, x8[7] * scq); }
  }
  float bvs[5][16];
#pragma unroll
  for (int c = 0; c < 5; ++c)
#pragma unroll
    for (int i = 0; i < 16; ++i) bvs[c][i] = BT[32 * c + (i & 3) + 4 * ((i >> 2) & 1) + 16 * (i >> 3)];
  asm volatile("s_waitcnt vmcnt(0)" ::: "memory"); __builtin_amdgcn_s_barrier(); asm volatile("" ::: "memory");
#pragma unroll
  for (int c = 0; c < 5; ++c)
#pragma unroll
    for (int i = 0; i < 16; ++i) asm volatile("" : "+v"(bvs[c][i]));
  f32x16 sc[5];
  const int ksw = (rK >> 1) & 7;
#pragma unroll
  for (int c = 0; c < 5; ++c) {
#pragma unroll
    for (int i = 0; i < 16; ++i) sc[c][i] = 0.f;
    const char* kp = lds + (32 * wid + 32 * c + rK) * 128;
#pragma unroll
    for (int d0 = 0; d0 < 4; ++d0) { const bf16x8 kf = *(const bf16x8*)(kp + (((2 * d0 + h) ^ ksw) << 4)); sc[c] = MFMA(kf, qf[d0], sc[c]); }
  }
  asm volatile("s_waitcnt lgkmcnt(0)" ::: "memory"); __builtin_amdgcn_s_barrier(); asm volatile("" ::: "memory");
  if (xnext >= 0) b_issue_k(p, xnext, lds, tid, wid);
  float mxa[4] = {-1e30f, -1e30f, -1e30f, -1e30f};
#pragma unroll
  for (int c = 0; c < 5; ++c)
#pragma unroll
    for (int i = 0; i < 16; ++i) {
      const int prow = (i & 3) + 4 * ((i >> 2) & 1) + 8 * h + 16 * (i >> 3);
      const int rel = 32 * c - 64 + prow - r, key = i0w + r + rel;
      const bool valid = ((unsigned)(rel + 64) <= 128u) & ((unsigned)key < (unsigned)Ls);
      const float v = valid ? sc[c][i] + bvs[c][i] : -1e30f;
      sc[c][i] = v; mxa[i & 3] = fmaxf(mxa[i & 3], v);
    }
  float mx = fmaxf(fmaxf(mxa[0], mxa[1]), fmaxf(mxa[2], mxa[3]));
  mx = fmaxf(mx, __shfl_xor(mx, 32));
  float la4[4] = {0.f, 0.f, 0.f, 0.f};
#pragma unroll
  for (int c = 0; c < 5; ++c)
#pragma unroll
    for (int i = 0; i < 16; ++i) { const float e = fexp2(sc[c][i] - mx); sc[c][i] = e; la4[i & 3] += e; }
  float l = (la4[0] + la4[1]) + (la4[2] + la4[3]);
  l += __shfl_xor(l, 32);
  f32x16 o0, o1;
#pragma unroll
  for (int i = 0; i < 16; ++i) { o0[i] = 0.f; o1[i] = 0.f; }
  const char* vp = lds + LV + r * 768; const int vsw = r & 15;
#pragma unroll
  for (int c = 0; c < 5; ++c)
#pragma unroll
    for (int s = 0; s < 2; ++s) {
      const bf16x8 pf = pack8(sc[c][8 * s], sc[c][8 * s + 1], sc[c][8 * s + 2], sc[c][8 * s + 3], sc[c][8 * s + 4], sc[c][8 * s + 5], sc[c][8 * s + 6], sc[c][8 * s + 7]);
      const int ch = ((4 * wid + 4 * c + 2 * s + h) ^ vsw) << 4;
      const bf16x8 v0 = *(const bf16x8*)(vp + ch), v1 = *(const bf16x8*)(vp + 32 * 768 + ch);
      o0 = MFMA(v0, pf, o0); o1 = MFMA(v1, pf, o1);
    }
  asm volatile("s_waitcnt lgkmcnt(0)" ::: "memory"); __builtin_amdgcn_s_barrier(); asm volatile("" ::: "memory");
  if (xnext >= 0) b_issue_v(p, xnext, lds, tid, wid);
  const float inv = 1.0f / l;
  const int tkn = ((i0w + r) << sh) + sub;
  bf16_t* OG = (g < 2) ? (bf16_t*)(p.ws + OFF_H) + (size_t)g * S * 512 : (bf16_t*)(p.ws + OFF_OB);
  bf16_t* op = OG + (size_t)tkn * 512 + head * 64;
  store_o_wide(op, o0, inv, h); store_o_wide(op + 32, o1, inv, h);
  if (h == 0) { float* LSE = (float*)(p.ws + OFF_LSE); LSE[((size_t)g * S + tkn) * 8 + head] = (mx + __builtin_amdgcn_logf(l)) * LN2; }
}

DI void phase_attn(const Params& p, int layer, char* smem) {
  const int n_dense = 1024, n_b = 1536, total = n_dense + n_b;
  int it = blockIdx.x;
  for (; it < n_dense; it += gridDim.x) {
    if (it < 512) { attn_dense_unit<0, false>(p, layer, it & 7, it >> 3, smem, 0.f); }
    else { const int v = it - 512;
      float bref;
      { const int ln = otid() & 63; float gq = fabsf(p.c_q_norm[layer * 64 + ln]), gk = fabsf(p.c_k_norm[layer * 64 + ln]);
#pragma unroll
        for (int o = 32; o >= 1; o >>= 1) { gq = fmaxf(gq, __shfl_xor(gq, o)); gk = fmaxf(gk, __shfl_xor(gk, o)); }
        bref = 64.0f * gq * gk * 0.125f * LOG2E * 1.02f; }
      if (__builtin_amdgcn_readfirstlane(bref < 60.0f ? 1 : 0) != 0) attn_dense_unit<1, true>(p, layer, v & 7, v >> 3, smem, bref);
      else attn_dense_unit<1, false>(p, layer, v & 7, v >> 3, smem, 0.f); }
  }
  if (it < total) {
    const int tid = otid(), wid = wave_of(tid);
    b_issue_k(p, it - n_dense, smem, tid, wid); b_issue_v(p, it - n_dense, smem, tid, wid);
    for (; it < total; it += gridDim.x) {
      const int nx = it + (int)gridDim.x;
      attn_b_item(p, it - n_dense, nx < total ? nx - n_dense : -1, smem);
    }
  }
}

DI void phase_combine(const Params& p) {
  const bf16_t* G0 = (const bf16_t*)(p.ws + OFF_H); const bf16_t* G1 = G0 + (size_t)S * 512; bf16_t* OB = (bf16_t*)(p.ws + OFF_OB);
  const float* LSE = (const float*)(p.ws + OFF_LSE);
  for (int e = blockIdx.x * 512 + otid(); e < S * 64; e += gridDim.x * 512) {
    const int tkn = e >> 6, c = e & 63, head = c >> 3;
    const float l0 = LSE[((size_t)0 * S + tkn) * 8 + head], l1 = LSE[((size_t)1 * S + tkn) * 8 + head], l2 = LSE[((size_t)2 * S + tkn) * 8 + head];
    const float mm = fmaxf(l0, fmaxf(l1, l2));
    float w0 = __expf(l0 - mm), w1 = __expf(l1 - mm), w2 = __expf(l2 - mm);
    const float iw = 1.0f / (w0 + w1 + w2); w0 *= iw; w1 *= iw; w2 *= iw;
    const size_t off = (size_t)tkn * 512 + c * 8;
    const u32x4 a = *(const u32x4*)(G0 + off), b = *(const u32x4*)(G1 + off), d = *(const u32x4*)(OB + off);
    u32x4 o;
#pragma unroll
    for (int q = 0; q < 4; ++q) o[q] = pk2(w0 * bflo(a[q]) + w1 * bflo(b[q]) + w2 * bflo(d[q]), w0 * bfhi(a[q]) + w1 * bfhi(b[q]) + w2 * bfhi(d[q]));
    *(u32x4*)(OB + off) = o;
  }
}

#define XB_TMO      128
#define XB_XCNT(j)  (256  + 64 * (j))
#define XB_XSUB(j)  (1280 + 64 * (j))
#define XB_XGEN(j)  (2304 + 64 * (j))
#define XB_TOP      3328
#define XB_TOPGEN   3392
#define XCD_BAR_WORDS 3456
#define XB_SPIN_CAP (1u << 18)
#ifndef LAS
#define LAS __attribute__((address_space(3)))
#endif

__device__ __forceinline__ unsigned xb_ld(unsigned* p)              { return __hip_atomic_load(p, __ATOMIC_RELAXED, __HIP_MEMORY_SCOPE_AGENT); }
__device__ __forceinline__ unsigned xb_add(unsigned* p, unsigned v) { return __hip_atomic_fetch_add(p, v, __ATOMIC_RELAXED, __HIP_MEMORY_SCOPE_AGENT); }
__device__ __forceinline__ unsigned xb_xcc_id() { return (unsigned)__builtin_amdgcn_s_getreg((3 << 11) | 20) & 0xFu; }
#define XB_SPIN(cond, bar) do { unsigned _sp = 0; while (cond) { __builtin_amdgcn_s_sleep(1); \
    if ((++_sp & 255u) == 0u) { if (xb_ld(&(bar)[XB_TMO])) break; if (_sp > XB_SPIN_CAP) { atomicAdd(&(bar)[XB_TMO], 1u); break; } } } } while (0)

struct XcdBarrier {
    unsigned* bar; unsigned x;
    volatile LAS unsigned* st;
};

__device__ __forceinline__ XcdBarrier xcd_barrier_post(unsigned* bar, volatile LAS unsigned* st) {
    XcdBarrier b; b.bar = bar; b.x = xb_xcc_id(); b.st = st;
    if (threadIdx.x == 0) (void)xb_add(&bar[XB_XCNT(b.x)], 1u);
    return b;
}
__device__ __forceinline__ void xcd_barrier_complete(unsigned* bar, unsigned x, unsigned& nloc, unsigned& nx) {
    const unsigned G = gridDim.x * gridDim.y * gridDim.z;
    unsigned sum, cnt, mine, sp = 0u;
    for (;;) {
        sum = 0u; cnt = 0u; mine = 0u;
#pragma unroll
        for (unsigned j = 0; j < 16; ++j) { const unsigned c = xb_ld(&bar[XB_XCNT(j)]); sum += c; cnt += (c > 0u) ? 1u : 0u; mine = (j == x) ? c : mine; }
        if (sum == G) break;
        __builtin_amdgcn_s_sleep(1);
        if ((++sp & 255u) == 0u) { if (xb_ld(&bar[XB_TMO])) break; if (sp > XB_SPIN_CAP) { atomicAdd(&bar[XB_TMO], 1u); break; } }
    }
    nloc = mine > 0u ? mine : 1u; nx = cnt > 0u ? cnt : 1u;
}

__device__ __forceinline__ void xcd_barrier(const XcdBarrier& b) {
    asm volatile("s_waitcnt vmcnt(0)" ::: "memory");
    __syncthreads();
    if (threadIdx.x == 0) {
        unsigned* bar = b.bar;
        __builtin_amdgcn_s_waitcnt(0);
        unsigned nloc = b.st[0], nx = b.st[1];
        if (nloc == 0u) { xcd_barrier_complete(bar, b.x, nloc, nx); b.st[0] = nloc; b.st[1] = nx; }
        const unsigned old = xb_add(&bar[XB_XSUB(b.x)], 1u);
        const unsigned gen = old / nloc;
        if (old + 1u == (gen + 1u) * nloc) {
            __builtin_amdgcn_fence(__ATOMIC_RELEASE, "agent");
            asm volatile("s_waitcnt vmcnt(0)" ::: "memory");
            const unsigned og = xb_add(&bar[XB_TOP], 1u);
            const unsigned tg = og / nx;
            if (og + 1u == (tg + 1u) * nx) xb_add(&bar[XB_TOPGEN], 1u);
            else XB_SPIN(xb_ld(&bar[XB_TOPGEN]) == tg, bar);
            __builtin_amdgcn_fence(__ATOMIC_ACQUIRE, "agent");
            xb_add(&bar[XB_XGEN(b.x)], 1u);
            asm volatile("s_waitcnt vmcnt(0)" ::: "memory");
        } else {
            XB_SPIN(xb_ld(&bar[XB_XGEN(b.x)]) == gen, bar);
            __builtin_amdgcn_fence(__ATOMIC_ACQUIRE, "agent");
            asm volatile("s_waitcnt vmcnt(0)" ::: "memory");
        }
    }
    __syncthreads();
}

__global__ void __launch_bounds__(512) hybrid_encoder_mega(Params p) {
  extern __shared__ __attribute__((aligned(16))) char smem[];
  cg::grid_group grid = cg::this_grid();
  const int G = gridDim.x, bx = blockIdx.x;
  bf16_t* Z = (bf16_t*)(p.ws + OFF_Z); bf16_t* H = (bf16_t*)(p.ws + OFF_H);
  float* ssq_q = (float*)(p.ws + OFF_SSQ); float* ssq_kv = ssq_q + S; float* ssq_x = ssq_q + 2 * S;
  bf16_t* XB = (bf16_t*)(p.ws + OFF_OA);
  volatile LAS unsigned* xst = (volatile LAS unsigned*)(smem + 131072);
  if (threadIdx.x == 0) { xst[0] = 0u; xst[1] = 0u; xst[2] = 0u; xst[3] = 0u; }
  __syncthreads();
  const XcdBarrier xb = xcd_barrier_post((unsigned*)(p.ws + OFF_BAR), xst);
  bool first_sync = true;
#define GSYNC() do { if (first_sync) { grid.sync(); first_sync = false; } else xcd_barrier(xb); } while (0)
  build_tables(p);
  for (int layer = 0; layer < 2; ++layer) {
    convert_weights(p, layer, smem);
    for (int seq = 0; seq < 3; ++seq) {
      const float* xin = (layer == 0) ? (seq < 2 ? p.x_prompt + (size_t)seq * S * DM : p.x_sample) : p.out + (size_t)seq * S * DM;
      float* xo = p.out + (size_t)seq * S * DM;
      phase_norm(xin, p.norm_mix + layer * DM, H, S);
      { const int tz = otid();
_Pragma("nounroll")
        for (int b = bx; b < 96; b += G) ssq_q[b * 512 + tz] = 0.f; }
      GSYNC();
      { pg8::Gemm g{H, (const bf16_t*)(p.ws + WT_IN), S, 9216, DM, DM, DM}; pg8::StaticOrder so; so.init(S, 9216, G, bx);
        EpiInproj E{Z, (bf16_t*)(p.ws + OFF_VCT), (bf16_t*)(p.ws + OFF_VBT), ssq_q, ssq_kv};
        pg8::gemm_phase<EpiInproj, pg8::StaticOrder, true, true>(GEMM_LDS, g, so, E); }
      GSYNC();
      { pg8::Gemm g{Z + ZC_CQ, (const bf16_t*)(p.ws + WT_UQ), S, 768, 384, ZP, 384}; pg8::StaticOrder so; so.init(S, 768, G, bx);
        EpiUpQ E{(bf16_t*)(p.ws + OFF_QA), ssq_q};
        pg8::gemm_phase<EpiUpQ, pg8::StaticOrder, true, true>(GEMM_LDS, g, so, E); }
      { pg8::Gemm g{Z + ZC_CKV, (const bf16_t*)(p.ws + WT_UKV), S, 1024, 256, ZP, 256}; pg8::StaticOrder so; so.init(S, 1024, G, bx);
        EpiUpKV E{(bf16_t*)(p.ws + OFF_KA), (bf16_t*)(p.ws + OFF_VAT), ssq_kv};
        pg8::gemm_phase<EpiUpKV, pg8::StaticOrder, true, true>(GEMM_LDS, g, so, E); }
      phase_kpost(p, layer);
      GSYNC();
      phase_attn(p, layer, smem);
      GSYNC();
      phase_combine(p);
      GSYNC();
      { pg8::Gemm g{(const bf16_t*)(p.ws + OFF_OA), (const bf16_t*)(p.ws + WT_BRA), 3 * S, 3072, 512, 512, 512}; DiagOrder so; so.init(G, bx);
        EpiMerge E{Z, H};
        pg8::gemm_phase<EpiMerge, DiagOrder, true, true>(GEMM_LDS, g, so, E); }
      GSYNC();
      { pg8::Gemm g{H, (const bf16_t*)(p.ws + WT_OUT), S, 1024, DM, DM, DM}; pg8::StaticOrder so; so.init(S, 1024, G, bx);
        EpiResid<true> E{xin, xo, XB, ssq_x};
        pg8::gemm_phase<EpiResid<true>, pg8::StaticOrder, true, true>(GEMM_LDS, g, so, E); }
      GSYNC();
      { pg8::Gemm g{XB, (const bf16_t*)(p.ws + WT_UP), S, DFF, DM, DM, DM}; pg8::StaticOrder so; so.init(S, DFF, G, bx);
        EpiRelu2 E{Z, ssq_x};
        pg8::gemm_phase<EpiRelu2, pg8::StaticOrder, true, true>(GEMM_LDS, g, so, E); }
      GSYNC();
      { pg8::Gemm g{Z, (const bf16_t*)(p.ws + WT_DOWN), S, 1024, DFF, DFF, DFF}; pg8::StaticOrder so; so.init(S, 1024, G, bx);
        EpiResid<false> E{xo, xo, nullptr, nullptr};
        pg8::gemm_phase<EpiResid<false>, pg8::StaticOrder, true, true>(GEMM_LDS, g, so, E); }
      GSYNC();
    }
  }
  phase_final_norm(p.out, p.final_norm, 3 * S);
}

extern "C" void kernel_launch(void* const* d_in, const int* in_sizes, int n_in, void* d_out, int out_size, void* d_ws, size_t ws_size, hipStream_t stream) {
  static int grid_blocks = 0;
  if (!grid_blocks) {
    if (ws_size < WS_END) { fprintf(stderr, "kernel_launch: workspace too small: %zu < %zu\n", ws_size, (size_t)WS_END); return; }
    if (hipFuncSetAttribute((const void*)hybrid_encoder_mega, hipFuncAttributeMaxDynamicSharedMemorySize, LDS_BYTES) != hipSuccess) { fprintf(stderr, "hipFuncSetAttribute failed\n"); return; }
    int dev = 0, cus = 0, per_cu = 0;
    hipGetDevice(&dev);
    hipDeviceGetAttribute(&cus, hipDeviceAttributeMultiprocessorCount, dev);
    hipOccupancyMaxActiveBlocksPerMultiprocessor(&per_cu, hybrid_encoder_mega, 512, LDS_BYTES);
    if (per_cu < 1) { fprintf(stderr, "occupancy query returned %d\n", per_cu); return; }
    grid_blocks = cus;
  }
  Params p{};
  p.x_prompt = (const float*)d_in[0]; p.x_sample = (const float*)d_in[1];
  p.norm_mix = (const float*)d_in[2]; p.w_in = (const float*)d_in[3]; p.a_q_norm = (const float*)d_in[4]; p.a_kv_norm = (const float*)d_in[5];
  p.a_w_uq = (const float*)d_in[6]; p.a_w_ukv = (const float*)d_in[7]; p.c_q_norm = (const float*)d_in[8]; p.c_k_norm = (const float*)d_in[9];
  p.w_br_a = (const float*)d_in[10]; p.w_br_b = (const float*)d_in[11]; p.w_br_c = (const float*)d_in[12]; p.w_out = (const float*)d_in[13];
  p.norm_ffn = (const float*)d_in[14]; p.w_up = (const float*)d_in[15]; p.w_down = (const float*)d_in[16]; p.t5_table = (const float*)d_in[17];
  p.final_norm = (const float*)d_in[18];
  p.out = (float*)d_out; p.ws = (char*)d_ws;
  (void)hipMemsetAsync((char*)d_ws + OFF_BAR, 0, 16384, stream);
  void* args[] = {&p};
  hipError_t e = hipLaunchCooperativeKernel((const void*)hybrid_encoder_mega, dim3(grid_blocks), dim3(512), args, LDS_BYTES, stream);
  if (e != hipSuccess) fprintf(stderr, "cooperative launch failed: %s (grid %d)\n", hipGetErrorString(e), grid_blocks);
}
```

```cpp
#include <hip/hip_runtime.h>
#include <hip/hip_cooperative_groups.h>
#include <stdint.h>
#include <cstdio>
namespace cg = cooperative_groups;

typedef unsigned short bf16_t;
typedef short bf16x8 __attribute__((ext_vector_type(8)));
typedef short s16x4 __attribute__((ext_vector_type(4)));
typedef float f32x16 __attribute__((ext_vector_type(16)));
typedef float f32x4 __attribute__((ext_vector_type(4)));
typedef float f32x2 __attribute__((ext_vector_type(2)));
typedef unsigned u32x4 __attribute__((ext_vector_type(4)));
typedef unsigned u32x2 __attribute__((ext_vector_type(2)));
typedef __bf16 bf16x2_t __attribute__((ext_vector_type(2)));

#define DI __device__ __forceinline__
#define MFMA(a, b, c) __builtin_amdgcn_mfma_f32_32x32x16_bf16((a), (b), (c), 0, 0, 0)

DI unsigned pk2(float lo, float hi) { f32x2 v = {lo, hi}; bf16x2_t b = __builtin_convertvector(v, bf16x2_t); return __builtin_bit_cast(unsigned, b); }
DI bf16_t f2bf(float x) { return (bf16_t)(pk2(x, 0.f) & 0xffffu); }
DI float bflo(unsigned u) { return __uint_as_float(u << 16); }
DI float bfhi(unsigned u) { return __uint_as_float(u & 0xffff0000u); }
DI float bf2f(bf16_t b) { return __uint_as_float(((unsigned)b) << 16); }
DI int crow(int i, int h) { return (i & 3) + 8 * (i >> 2) + 4 * h; }
DI float fexp2(float x) { return __builtin_amdgcn_exp2f(x); }
DI int otid() { int t = threadIdx.x; asm volatile("" : "+v"(t)); return t; }
DI int wave_of(int tid) { return __builtin_amdgcn_readfirstlane(tid >> 6); }

constexpr int S = 16384, DM = 1024, ZP = 7680, DFF = 4096;
constexpr int ZC_CQ = 0, ZC_CKV = 384, ZC_KR = 640, ZC_QKVB = 768, ZC_QC = 3840, ZC_KC = 4352, ZC_GATE = 4608;
constexpr int GC_VB = 3840, GC_VC = 6016;
constexpr float LOG2E = 1.4426950408889634f, LN2 = 0.6931471805599453f;

constexpr size_t WT_IN = 0;
constexpr size_t WT_UQ = WT_IN + (size_t)9216 * 1024 * 2;
constexpr size_t WT_UKV = WT_UQ + (size_t)768 * 384 * 2;
constexpr size_t WT_BRA = WT_UKV + (size_t)1024 * 256 * 2;
constexpr size_t WT_BRB = WT_BRA + (size_t)1024 * 512 * 2;
constexpr size_t WT_BRC = WT_BRB + (size_t)1024 * 512 * 2;
constexpr size_t WT_OUT = WT_BRC + (size_t)1024 * 512 * 2;
constexpr size_t WT_UP = WT_OUT + (size_t)1024 * 3072 * 2;
constexpr size_t WT_DOWN = WT_UP + (size_t)4096 * 1024 * 2;
constexpr size_t OFF_CS = WT_DOWN + (size_t)1024 * 4096 * 2;
constexpr size_t OFF_BT = OFF_CS + (size_t)16384 * 16 * 8;
constexpr size_t OFF_Z = OFF_BT + 32768;
constexpr size_t OFF_H = OFF_Z + (size_t)S * ZP * 2;
constexpr size_t OFF_QA = OFF_H + (size_t)S * 1024 * 2;
constexpr size_t OFF_KA = OFF_QA + (size_t)S * 768 * 2;
constexpr size_t OFF_VAT = OFF_KA + (size_t)S * 512 * 2;
constexpr size_t OFF_VCT = OFF_VAT + (size_t)S * 512 * 2;
constexpr size_t OFF_OA = OFF_VCT + (size_t)S * 128 * 2;
constexpr size_t OFF_OB = OFF_OA + (size_t)S * 512 * 2;
constexpr size_t OFF_OC = OFF_OB + (size_t)S * 512 * 2;
constexpr size_t OFF_LSE = OFF_OC + (size_t)S * 512 * 2;
constexpr size_t OFF_SSQ = OFF_LSE + (size_t)3 * S * 8 * 4;
constexpr size_t OFF_VBT = OFF_SSQ + (size_t)3 * S * 4;
constexpr size_t OFF_BAR = OFF_VBT + (size_t)1536 * S * 2;
constexpr size_t WS_END = OFF_BAR + 16384;

constexpr int LDS_BYTES = 131072 + 1024;

struct Params {
  const float* x_prompt; const float* x_sample;
  const float* norm_mix; const float* w_in; const float* a_q_norm; const float* a_kv_norm; const float* a_w_uq; const float* a_w_ukv;
  const float* c_q_norm; const float* c_k_norm; const float* w_br_a; const float* w_br_b; const float* w_br_c; const float* w_out;
  const float* norm_ffn; const float* w_up; const float* w_down; const float* t5_table; const float* final_norm;
  float* out; char* ws;
};

DI void sincos_d(double x, float& c, float& s) {
  const double k = rint(x * 0.6366197723675814);
  double t = fma(-k, 1.5707963267948966, x); t = fma(-k, 6.123233995736766e-17, t);
  const double t2 = t * t;
  double sn = 1.0 - t2 / 210.0; sn = 1.0 - t2 / 156.0 * sn; sn = 1.0 - t2 / 110.0 * sn; sn = 1.0 - t2 / 72.0 * sn; sn = 1.0 - t2 / 42.0 * sn; sn = 1.0 - t2 / 20.0 * sn; sn = 1.0 - t2 / 6.0 * sn; sn *= t;
  double cs = 1.0 - t2 / 240.0; cs = 1.0 - t2 / 182.0 * cs; cs = 1.0 - t2 / 132.0 * cs; cs = 1.0 - t2 / 90.0 * cs; cs = 1.0 - t2 / 56.0 * cs; cs = 1.0 - t2 / 30.0 * cs; cs = 1.0 - t2 / 12.0 * cs; cs = 1.0 - t2 / 2.0 * cs;
  const int q = ((int)k) & 3;
  double so = (q == 0) ? sn : (q == 1) ? cs : (q == 2) ? -sn : -cs;
  double co = (q == 0) ? cs : (q == 1) ? -sn : (q == 2) ? -cs : sn;
  c = (float)co; s = (float)so;
}

DI void build_tables(const Params& p) {
  f32x2* CS = (f32x2*)(p.ws + OFF_CS);
  const int gsz = gridDim.x * 512, gid = blockIdx.x * 512 + otid();
  for (int e = gid; e < 16384 * 16; e += gsz) {
    const int pos = e >> 4, i = e & 15;
    double f = 1.0; for (int j = 0; j < i; ++j) f *= 0.5623413251903491;
    const float ff = (float)f; const float ang = (float)pos * ff;
    float c, s; sincos_d((double)ang, c, s);
    CS[e] = (f32x2){c, s};
  }
  float* BT = (float*)(p.ws + OFF_BT);
  for (int e = gid; e < 3 * 8 * 256; e += gsz) {
    const int gh = e >> 8, g = gh >> 3, hd = gh & 7, j = (e & 255) - 32;
    float v = 0.f;
    if (j >= 0 && j <= 128) {
      const int rel = (j - 64) << (2 * g);
      const int n = rel < 0 ? -rel : rel;
      int b = rel > 0 ? 16 : 0;
      if (n < 8) b += n; else { int lg = 31 - __clz(n); int vv = 5 + lg; b += (vv < 15 ? vv : 15); }
      v = p.t5_table[b * 24 + g * 8 + hd] * LOG2E;
    }
    BT[e] = v;
  }
}

DI void cvt_tile(const float* __restrict__ W, int ldw, int ldk, int koff, bf16_t* __restrict__ Wt, int k0, int n0, int mode, const float* __restrict__ rscale, float* tile) {
  const int tid = otid();
#pragma unroll
  for (int i = 0; i < 8; ++i) {
    const int kl = (tid >> 6) + 8 * i, nl = tid & 63, nn = n0 + nl;
    int src = nn;
    if (mode == 1) src = nn < 672 ? nn : (nn < 768 ? -1 : nn - 96);
    float v = 0.f;
    if (src >= 0) v = W[(size_t)(k0 + kl) * ldw + src];
    if (rscale) v *= rscale[k0 + kl];
    tile[kl * 65 + nl] = v;
  }
  __syncthreads();
#pragma unroll
  for (int i = 0; i < 8; ++i) {
    const int nl = (tid >> 6) + 8 * i, kl = tid & 63;
    Wt[(size_t)(n0 + nl) * ldk + koff + k0 + kl] = f2bf(tile[kl * 65 + nl]);
  }
  __syncthreads();
}

DI void convert_weights(const Params& p, int layer, char* smem) {
  float* tile = (float*)smem;
  int base = 0;
  for (int mtx = 0; mtx < 9; ++mtx) {
    const float* W; int K, Nsrc, Ndst, mode = 0, ldk = 0, koff = 0; const float* rs = nullptr; size_t off;
    switch (mtx) {
      case 0: W = p.w_in + (size_t)layer * 1024 * 9120; K = 1024; Nsrc = 9120; Ndst = 9216; mode = 1; off = WT_IN; break;
      case 1: W = p.a_w_uq + (size_t)layer * 384 * 768; K = 384; Nsrc = 768; Ndst = 768; rs = p.a_q_norm + layer * 384; off = WT_UQ; break;
      case 2: W = p.a_w_ukv + (size_t)layer * 256 * 1024; K = 256; Nsrc = 1024; Ndst = 1024; rs = p.a_kv_norm + layer * 256; off = WT_UKV; break;
      case 3: W = p.w_br_a + (size_t)layer * 512 * 1024; K = 512; Nsrc = 1024; Ndst = 1024; off = WT_BRA; break;
      case 4: W = p.w_br_b + (size_t)layer * 512 * 1024; K = 512; Nsrc = 1024; Ndst = 1024; off = WT_BRB; break;
      case 5: W = p.w_br_c + (size_t)layer * 512 * 1024; K = 512; Nsrc = 1024; Ndst = 1024; off = WT_BRC; break;
      case 6: W = p.w_out + (size_t)layer * 1024 * 1024; K = 1024; Nsrc = 1024; Ndst = 1024; off = WT_OUT; break;
      case 7: W = p.w_up + (size_t)layer * 1024 * 4096; K = 1024; Nsrc = 4096; Ndst = 4096; rs = p.norm_ffn + layer * DM; off = WT_UP; break;
      case 8: default: W = p.w_down + (size_t)layer * 4096 * 1024; K = 4096; Nsrc = 1024; Ndst = 1024; off = WT_DOWN; break;
    }
    if (ldk == 0) ldk = K;
    const int nk = K / 64, nn = Ndst / 64, cnt = nk * nn;
    bf16_t* Wt = (bf16_t*)(p.ws + off);
    int first = (int)blockIdx.x - (base % (int)gridDim.x); if (first < 0) first += gridDim.x;
    for (int it = first; it < cnt; it += gridDim.x) {
      const int kt = it % nk, nt = it / nk;
      cvt_tile(W, Nsrc, ldk, koff, Wt, kt * 64, nt * 64, mode, rs, tile);
    }
    base += cnt;
  }
}

DI void phase_norm(const float* __restrict__ x, const float* __restrict__ g, bf16_t* __restrict__ H, int rows) {
  const int tid = otid(), lane = tid & 63, wid = tid >> 6;
  for (int row = blockIdx.x * 8 + wid; row < rows; row += gridDim.x * 8) {
    const float* xr = x + (size_t)row * DM;
    f32x4 v[4]; float ss = 0.f;
#pragma unroll
    for (int i = 0; i < 4; ++i) { v[i] = *(const f32x4*)(xr + i * 256 + lane * 4); ss += v[i][0] * v[i][0] + v[i][1] * v[i][1] + v[i][2] * v[i][2] + v[i][3] * v[i][3]; }
#pragma unroll
    for (int o = 32; o >= 1; o >>= 1) ss += __shfl_xor(ss, o);
    const float rstd = rsqrtf(ss * (1.0f / DM) + 1e-6f);
#pragma unroll
    for (int i = 0; i < 4; ++i) {
      const f32x4 gg = *(const f32x4*)(g + i * 256 + lane * 4);
      u32x2 w; w.x = pk2(v[i][0] * rstd * gg[0], v[i][1] * rstd * gg[1]); w.y = pk2(v[i][2] * rstd * gg[2], v[i][3] * rstd * gg[3]);
      *(u32x2*)(H + (size_t)row * DM + i * 256 + lane * 4) = w;
    }
  }
}

DI void phase_final_norm(float* __restrict__ x, const float* __restrict__ g, int rows) {
  const int tid = otid(), lane = tid & 63, wid = tid >> 6;
  for (int row = blockIdx.x * 8 + wid; row < rows; row += gridDim.x * 8) {
    float* xr = x + (size_t)row * DM;
    f32x4 v[4]; float ss = 0.f;
#pragma unroll
    for (int i = 0; i < 4; ++i) { v[i] = *(const f32x4*)(xr + i * 256 + lane * 4); ss += v[i][0] * v[i][0] + v[i][1] * v[i][1] + v[i][2] * v[i][2] + v[i][3] * v[i][3]; }
#pragma unroll
    for (int o = 32; o >= 1; o >>= 1) ss += __shfl_xor(ss, o);
    const float rstd = rsqrtf(ss * (1.0f / DM) + 1e-6f);
#pragma unroll
    for (int i = 0; i < 4; ++i) {
      const f32x4 gg = *(const f32x4*)(g + i * 256 + lane * 4);
      f32x4 o = {v[i][0] * rstd * gg[0], v[i][1] * rstd * gg[1], v[i][2] * rstd * gg[2], v[i][3] * rstd * gg[3]};
      *(f32x4*)(xr + i * 256 + lane * 4) = o;
    }
  }
}


namespace pg8 {
#define PG8_LAS __attribute__((address_space(3)))
typedef unsigned short bf16_t;
typedef short bf16x8 __attribute__((ext_vector_type(8)));
typedef float f32x4 __attribute__((ext_vector_type(4)));
typedef unsigned u32x4 __attribute__((ext_vector_type(4)));
constexpr int BM = 256, BK = 64, HALF = 128, HTB = HALF * BK * 2  , STAGE_BYTES = 8 * HTB, NXCD = 8, WGM = 8;

__host__ __device__ __forceinline__ int lds_byte(int r, int c) { const int st = (r >> 4) * 2 + (c >> 5), rr = r & 15, cc = c & 31, ob = rr * 64 + cc * 2; return st * 1024 + (ob ^ (((ob >> 9) & 1) << 5)); }
__host__ __device__ __forceinline__ void stage_rc(int b, int& R, int& C) { const int st = b / 1024, sb = b % 1024, swz = sb ^ (((sb >> 9) & 1) << 5); R = (st >> 1) * 16 + swz / 64; C = (st & 1) * 32 + (swz % 64) / 2; }
__host__ __device__ __forceinline__ int perm32(int rho) { const int n = rho >> 4, i = rho & 15; return 8 * (i >> 2) + 4 * n + (i & 3); }

struct Unit { int pm, pn; };
struct Gemm { const bf16_t* A; const bf16_t* Bt; int M, N, K, lda, ldb; };

struct StaticOrder {
    int nM, nN, nwg, G, c;
    __host__ __device__ void init(int M, int N, int G_, int c_) { nM = M / BM; nN = N / BM; nwg = nM * nN; G = G_; c = c_; }
    __host__ __device__ bool next(int i, Unit& u) const {
        const long L = (long)i * G + c; if (L >= nwg) return false;
        map((int)L, u); return true; }
    __host__ __device__ void map(int L, Unit& u) const {
        int wgid = L; { const int q = nwg / NXCD, r = nwg % NXCD, xcd = wgid % NXCD, off = wgid / NXCD; wgid = (xcd < r ? xcd * (q + 1) : r * (q + 1) + (xcd - r) * q) + off; }
        const int nig = WGM * nN, gid = wgid / nig, fm = gid * WGM, gsz = (nM - fm) < WGM ? (nM - fm) : WGM;
        u.pm = fm + ((wgid % nig) % gsz); u.pn = (wgid % nig) / gsz;
    }
    __device__ __forceinline__ void a_ready(const Unit&) const {}
    __device__ __forceinline__ void done(const Unit&) const {}
};
template <class Epi, class Sched, bool ALIGN_EPI = false, bool SP2 = false>
__device__ __forceinline__ void gemm_phase(PG8_LAS unsigned char* lds, const Gemm g, const Sched& S, const Epi& E) {
    int tid_ = threadIdx.x; asm volatile("" : "+v"(tid_)); const int tid = tid_, wid = __builtin_amdgcn_readfirstlane(tid >> 6), lane = tid & 63, wr = wid >> 2, wc = wid & 3, fr = lane & 15, fq = lane >> 4;
    const int K = g.K, nt = K / BK;
    unsigned voffA[2], voffB[2];
#pragma unroll
    for (int i = 0; i < 2; ++i) { int R, C; stage_rc(tid * 16 + i * 8192, R, C); const int Rb = Epi::PERM ? ((R & ~31) + perm32(R & 31)) : R;
        voffA[i] = (unsigned)(R * g.lda + C) * 2u; voffB[i] = (unsigned)(Rb * g.ldb + C) * 2u; }
    const size_t kstep = (size_t)(BK * 2);
    const size_t hA = (size_t)HALF * g.lda * 2, hB = (size_t)HALF * g.ldb * 2;
    const size_t tA = 2 * hA, tB = 2 * hB;
    const unsigned ldsw = (unsigned)wid * 1024u;
    const int aoff = lds_byte(wr * 64 + fr, fq * 8), boff = lds_byte(wc * 32 + fr, fq * 8);
#define PG8_SA(b, h) (((b) * 2 + (h)) * HTB)
#define PG8_SB(b, h) ((4 + (b) * 2 + (h)) * HTB)
#define PG8_STAGE(bufoff, gbase, voff) do { _Pragma("unroll") for (int _i = 0; _i < 2; ++_i) \
        __builtin_amdgcn_global_load_lds((const unsigned*)((const char*)(gbase) + (voff)[_i]), (PG8_LAS unsigned*)(lds + (bufoff) + ldsw + _i * 8192), 16, 0, 0); } while (0)
#define PG8_LDA(dst, b, h) do { _Pragma("unroll") for (int m = 0; m < 4; ++m) _Pragma("unroll") for (int k = 0; k < 2; ++k) dst[m][k] = *(const PG8_LAS bf16x8*)(lds + PG8_SA(b, h) + aoff + m * 2048 + k * 1024); } while (0)
#define PG8_LDB(dst, b, h) do { _Pragma("unroll") for (int n = 0; n < 2; ++n) _Pragma("unroll") for (int k = 0; k < 2; ++k) dst[n][k] = *(const PG8_LAS bf16x8*)(lds + PG8_SB(b, h) + boff + n * 2048 + k * 1024); } while (0)
#define PG8_MMA(ai, bj, At, Bt) do { __builtin_amdgcn_s_setprio(1); _Pragma("unroll") for (int m = 0; m < 4; ++m) _Pragma("unroll") for (int n = 0; n < 2; ++n) _Pragma("unroll") for (int k = 0; k < 2; ++k) \
        acc[ai][bj][m][n] = __builtin_amdgcn_mfma_f32_16x16x32_bf16(Bt[n][k], At[m][k], acc[ai][bj][m][n], 0, 0, 0); __builtin_amdgcn_s_setprio(0); } while (0)
#define PG8_WAIT_V(n) asm volatile("s_waitcnt vmcnt(" #n ")" ::: "memory")
#define PG8_WAIT_L(n) asm volatile("s_waitcnt lgkmcnt(" #n ")" ::: "memory")
#define PG8_BAR __builtin_amdgcn_s_barrier()
#define PG8_SCHED __builtin_amdgcn_sched_barrier(0)
    Unit cur, nxt; int ui = 0;
    if (!S.next(0, cur)) return;
    f32x4 acc[2][2][4][2];
#pragma unroll
    for (int a = 0; a < 2; ++a)
#pragma unroll
        for (int b = 0; b < 2; ++b)
#pragma unroll
            for (int m = 0; m < 4; ++m)
#pragma unroll
                for (int n = 0; n < 2; ++n) acc[a][b][m][n] = (f32x4){0.f, 0.f, 0.f, 0.f};
    bf16x8 At[4][2], B0[2][2], B1[2][2];
    const char* cA = (const char*)g.A + (size_t)cur.pm * tA; const char* cB = (const char*)g.Bt + (size_t)cur.pn * tB;
    S.a_ready(cur);
    if constexpr (SP2) {
        PG8_STAGE(PG8_SB(0, 0), cB, voffB); PG8_STAGE(PG8_SB(0, 1), cB + hB, voffB); PG8_STAGE(PG8_SA(0, 0), cA, voffA); PG8_STAGE(PG8_SA(0, 1), cA + hA, voffA);
        if (wr == 1) PG8_BAR;
        PG8_WAIT_V(2); PG8_BAR;
        PG8_STAGE(PG8_SB(1, 0), cB + kstep, voffB); PG8_STAGE(PG8_SA(1, 0), cA + kstep, voffA); PG8_STAGE(PG8_SB(1, 1), cB + hB + kstep, voffB);
        PG8_WAIT_V(6); PG8_BAR;
    } else {
        PG8_STAGE(PG8_SB(0, 0), cB, voffB); PG8_STAGE(PG8_SA(0, 0), cA, voffA); PG8_STAGE(PG8_SB(0, 1), cB + hB, voffB); PG8_STAGE(PG8_SA(0, 1), cA + hA, voffA);
        if (wr == 1) PG8_BAR;
        PG8_WAIT_V(4); PG8_BAR;
        PG8_STAGE(PG8_SB(1, 0), cB + kstep, voffB); PG8_STAGE(PG8_SA(1, 0), cA + kstep, voffA); PG8_STAGE(PG8_SB(1, 1), cB + hB + kstep, voffB);
        PG8_WAIT_V(6); PG8_BAR;
    }
    for (;;) {
        const bool has_next = S.next(ui + 1, nxt);
        const char* nA = has_next ? (const char*)g.A + (size_t)nxt.pm * tA : cA; const char* nB = has_next ? (const char*)g.Bt + (size_t)nxt.pn * tB : cB;
_Pragma("unroll 1")
        for (int t = 0; t < nt; t += 2) {
            const bool last = (t == nt - 2);
            const char* a1 = cA + (size_t)(t + 1) * kstep;
            const char* a2 = last ? nA : cA + (size_t)(t + 2) * kstep; const char* b2 = last ? nB : cB + (size_t)(t + 2) * kstep;
            const char* a3 = a2 + kstep; const char* b3 = b2 + kstep;
            if (last && has_next) S.a_ready(nxt);
            if constexpr (SP2) {
            PG8_LDB(B0, 0, 0); PG8_LDB(B1, 0, 1); PG8_SCHED; PG8_LDA(At, 0, 0); PG8_STAGE(PG8_SA(1, 1), a1 + hA, voffA);
            PG8_WAIT_V(8); PG8_WAIT_L(0); PG8_BAR; PG8_MMA(0, 0, At, B0); PG8_MMA(0, 1, At, B1); PG8_BAR; PG8_SCHED;
            PG8_LDA(At, 0, 1); PG8_STAGE(PG8_SB(0, 0), b2, voffB); PG8_STAGE(PG8_SB(0, 1), b2 + hB, voffB); PG8_STAGE(PG8_SA(0, 0), a2, voffA);
            PG8_WAIT_V(8); PG8_WAIT_L(0); PG8_BAR; PG8_MMA(1, 0, At, B0); PG8_MMA(1, 1, At, B1); PG8_BAR; PG8_SCHED;
            PG8_LDB(B0, 1, 0); PG8_LDB(B1, 1, 1); PG8_SCHED; PG8_LDA(At, 1, 0); PG8_STAGE(PG8_SA(0, 1), a2 + hA, voffA);
            PG8_WAIT_V(8); PG8_WAIT_L(0); PG8_BAR; PG8_MMA(0, 0, At, B0); PG8_MMA(0, 1, At, B1); PG8_BAR; PG8_SCHED;
            PG8_LDA(At, 1, 1); PG8_STAGE(PG8_SB(1, 0), b3, voffB); PG8_STAGE(PG8_SB(1, 1), b3 + hB, voffB); PG8_STAGE(PG8_SA(1, 0), a3, voffA);
            PG8_WAIT_V(8); PG8_WAIT_L(0); PG8_BAR; PG8_MMA(1, 0, At, B0); PG8_MMA(1, 1, At, B1); PG8_BAR; PG8_SCHED;
            } else {
            PG8_LDB(B0, 0, 0); PG8_SCHED; PG8_LDA(At, 0, 0); PG8_STAGE(PG8_SA(1, 1), a1 + hA, voffA);
            PG8_WAIT_L(8); PG8_BAR; PG8_WAIT_L(0); PG8_MMA(0, 0, At, B0); PG8_BAR; PG8_SCHED;
            PG8_LDB(B1, 0, 1); PG8_STAGE(PG8_SB(0, 0), b2, voffB);
            PG8_BAR; PG8_WAIT_L(0); PG8_MMA(0, 1, At, B1); PG8_BAR;
            PG8_LDA(At, 0, 1); PG8_STAGE(PG8_SA(0, 0), a2, voffA);
            PG8_BAR; PG8_WAIT_L(0); PG8_MMA(1, 0, At, B0); PG8_BAR; PG8_SCHED;
            PG8_STAGE(PG8_SB(0, 1), b2 + hB, voffB);
            PG8_WAIT_V(6); PG8_BAR; PG8_MMA(1, 1, At, B1); PG8_BAR;
            PG8_LDB(B0, 1, 0); PG8_SCHED; PG8_LDA(At, 1, 0); PG8_STAGE(PG8_SA(0, 1), a2 + hA, voffA);
            PG8_WAIT_L(8); PG8_BAR; PG8_WAIT_L(0); PG8_MMA(0, 0, At, B0); PG8_BAR; PG8_SCHED;
            PG8_LDB(B1, 1, 1); PG8_STAGE(PG8_SB(1, 0), b3, voffB);
            PG8_BAR; PG8_WAIT_L(0); PG8_MMA(0, 1, At, B1); PG8_BAR;
            PG8_LDA(At, 1, 1); PG8_STAGE(PG8_SA(1, 0), a3, voffA);
            PG8_BAR; PG8_WAIT_L(0); PG8_MMA(1, 0, At, B0); PG8_BAR; PG8_SCHED;
            PG8_STAGE(PG8_SB(1, 1), b3 + hB, voffB);
            PG8_WAIT_V(6); PG8_BAR; PG8_MMA(1, 1, At, B1); PG8_BAR;
            }
        }
        if constexpr (ALIGN_EPI) { if (wr == 0) PG8_BAR; }
        if constexpr (!Epi::AFTER_DRAIN) { E(acc, cur, wr, wc, fr, fq); S.done(cur); }
        if (!has_next) break;
#pragma unroll
        for (int a = 0; a < 2; ++a)
#pragma unroll
            for (int b = 0; b < 2; ++b)
#pragma unroll
                for (int m = 0; m < 4; ++m)
#pragma unroll
                    for (int n = 0; n < 2; ++n) acc[a][b][m][n] = (f32x4){0.f, 0.f, 0.f, 0.f};
        cur = nxt; cA = nA; cB = nB; ++ui;
        if constexpr (ALIGN_EPI) { if (wr == 1) PG8_BAR; }
    }
    PG8_WAIT_V(0);
    if constexpr (!ALIGN_EPI) { if (wr == 0) PG8_BAR; }
    PG8_BAR;
    if constexpr (Epi::AFTER_DRAIN) { E.fused(acc, cur, wr, wc, fr, fq, lds, wid, lane); S.done(cur); }
#undef PG8_SA
#undef PG8_SB
#undef PG8_STAGE
#undef PG8_LDA
#undef PG8_LDB
#undef PG8_MMA
#undef PG8_WAIT_V
#undef PG8_WAIT_L
#undef PG8_BAR
#undef PG8_SCHED
}
}

DI void rope_pair8(float (&x1)[8], float (&x2)[8], const f32x2* cs) {
#pragma unroll
  for (int j = 0; j < 8; ++j) { const f32x2 c = cs[j]; const float a = x1[j], b = x2[j]; x1[j] = a * c.x - b * c.y; x2[j] = a * c.y + b * c.x; }
}
typedef pg8::Unit Unit;
#define ACC_T const f32x4 (&acc)[2][2][4][2]
#define EROW(u, ai, m) ((u).pm * 256 + (ai) * 128 + wr * 64 + (m) * 16 + fr)
DI u32x4 pack_f8(const f32x4 a, const f32x4 b) { u32x4 w; w.x = pk2(a[0], a[1]); w.y = pk2(a[2], a[3]); w.z = pk2(b[0], b[1]); w.w = pk2(b[2], b[3]); return w; }

struct EpiInproj {
  static constexpr bool PERM = true, AFTER_DRAIN = false;
  bf16_t* Z; bf16_t* VCT; bf16_t* VBT; float* ssq_q; float* ssq_kv;
  DI void operator()(ACC_T, const Unit& u, int wr, int wc, int fr, int fq) const {
#pragma unroll
    for (int bj = 0; bj < 2; ++bj) {
      const int tt = 2 * u.pn + bj, cb = tt * 128 + wc * 32 + 8 * fq;
      int sh = 0; if (tt >= 6 && tt < 42) sh = 2 * (((tt - 6) >> 2) % 3);
      const int msk = (1 << sh) - 1;
      if (tt >= 38 && tt < 42) {
        bf16_t* vt = VBT + (size_t)(cb - GC_VB) * S + fr * (S >> 4) + u.pm * 16 + wr * 4;
#pragma unroll
        for (int ai = 0; ai < 2; ++ai)
#pragma unroll
          for (int n = 0; n < 2; ++n) {
            __builtin_amdgcn_sched_barrier(0);
#pragma unroll
            for (int e = 0; e < 4; ++e) {
              u32x2 w; w.x = pk2(acc[ai][bj][0][n][e], acc[ai][bj][1][n][e]); w.y = pk2(acc[ai][bj][2][n][e], acc[ai][bj][3][n][e]);
              *(u32x2*)(vt + (size_t)(4 * n + e) * S + ai * 8) = w;
            }
          }
      } else if (tt == 47 || (tt >= 30 && tt < 38)) {
        bf16_t* vt = (tt == 47) ? VCT + (size_t)(cb - GC_VC) * S : VBT + (size_t)(cb - GC_VB) * S;
#pragma unroll
        for (int ai = 0; ai < 2; ++ai)
#pragma unroll
          for (int m = 0; m < 4; ++m) {
            __builtin_amdgcn_sched_barrier(0);
            const int row = EROW(u, ai, m), prow = (row & msk) * (S >> sh) + (row >> sh);
            bf16_t* vp = vt + prow;
#pragma unroll
            for (int n = 0; n < 2; ++n)
#pragma unroll
              for (int e = 0; e < 4; ++e) vp[(size_t)(4 * n + e) * S] = f2bf(acc[ai][bj][m][n][e]);
          }
      } else {
        const int zc = cb < GC_VB ? cb : cb - 1536;
        float* ssq = (tt < 3) ? ssq_q : ((tt < 5) ? ssq_kv : nullptr);
#pragma unroll
        for (int ai = 0; ai < 2; ++ai)
#pragma unroll
          for (int m = 0; m < 4; ++m) {
            const int row = EROW(u, ai, m), prow = (row & msk) * (S >> sh) + (row >> sh);
            const f32x4 v0 = acc[ai][bj][m][0], v1 = acc[ai][bj][m][1];
            *(u32x4*)(Z + (size_t)prow * ZP + zc) = pack_f8(v0, v1);
            if (ssq) {
              float s = v0[0] * v0[0] + v0[1] * v0[1] + v0[2] * v0[2] + v0[3] * v0[3] + v1[0] * v1[0] + v1[1] * v1[1] + v1[2] * v1[2] + v1[3] * v1[3];
              s += __shfl_xor(s, 16); s += __shfl_xor(s, 32);
              if (fq == 0) __hip_atomic_fetch_add(ssq + row, s, __ATOMIC_RELAXED, __HIP_MEMORY_SCOPE_AGENT);
            }
          }
      }
    }
  }
};
struct EpiUpQ {
  static constexpr bool PERM = true, AFTER_DRAIN = false;
  bf16_t* QA; const float* ssq;
  DI void operator()(ACC_T, const Unit& u, int wr, int wc, int fr, int fq) const {
#pragma unroll
    for (int ai = 0; ai < 2; ++ai)
#pragma unroll
      for (int m = 0; m < 4; ++m) {
        const int row = EROW(u, ai, m); const float rs = rsqrtf(ssq[row] * (1.0f / 384.0f) + 1e-6f);
#pragma unroll
        for (int bj = 0; bj < 2; ++bj) {
          const int cb = u.pn * 256 + bj * 128 + wc * 32 + 8 * fq;
          *(u32x4*)(QA + (size_t)row * 768 + cb) = pack_f8(acc[ai][bj][m][0] * rs, acc[ai][bj][m][1] * rs);
        }
      }
  }
};
struct EpiUpKV {
  static constexpr bool PERM = true, AFTER_DRAIN = false;
  bf16_t* KA; bf16_t* VAT; const float* ssq;
  DI void operator()(ACC_T, const Unit& u, int wr, int wc, int fr, int fq) const {
#pragma unroll
    for (int ai = 0; ai < 2; ++ai)
#pragma unroll
      for (int m = 0; m < 4; ++m) {
        __builtin_amdgcn_sched_barrier(0);
        const int row = EROW(u, ai, m); const float rs = rsqrtf(ssq[row] * (1.0f / 256.0f) + 1e-6f);
#pragma unroll
        for (int bj = 0; bj < 2; ++bj) {
          const int head = 2 * u.pn + bj, w0 = wc * 32 + 8 * fq;
          if (wc < 2) {
            *(u32x4*)(KA + (size_t)row * 512 + head * 64 + w0) = pack_f8(acc[ai][bj][m][0] * rs, acc[ai][bj][m][1] * rs);
          } else {
            bf16_t* vp = VAT + (size_t)(head * 64 + w0 - 64) * S + row;
#pragma unroll
            for (int n = 0; n < 2; ++n)
#pragma unroll
              for (int e = 0; e < 4; ++e) vp[(size_t)(4 * n + e) * S] = f2bf(acc[ai][bj][m][n][e] * rs);
          }
        }
      }
  }
};
struct EpiMerge {
  static constexpr bool PERM = true, AFTER_DRAIN = false;
  const bf16_t* Z; bf16_t* MIX;
  DI void operator()(ACC_T, const Unit& u, int wr, int wc, int fr, int fq) const {
    const int b = u.pm >> 6, pm = u.pm & 63, pn = u.pn & 3;
#pragma unroll
    for (int ai = 0; ai < 2; ++ai)
#pragma unroll
      for (int m = 0; m < 4; ++m) {
        const int row = pm * 256 + ai * 128 + wr * 64 + m * 16 + fr;
#pragma unroll
        for (int bj = 0; bj < 2; ++bj) {
          const int col = pn * 256 + bj * 128 + wc * 32 + 8 * fq;
          const u32x4 g = *(const u32x4*)(Z + (size_t)row * ZP + ZC_GATE + b * 1024 + col);
          f32x4 v0 = acc[ai][bj][m][0], v1 = acc[ai][bj][m][1];
#pragma unroll
          for (int q = 0; q < 2; ++q) {
            v0[2 * q] *= __builtin_amdgcn_rcpf(1.0f + __expf(-bflo(g[q]))); v0[2 * q + 1] *= __builtin_amdgcn_rcpf(1.0f + __expf(-bfhi(g[q])));
            v1[2 * q] *= __builtin_amdgcn_rcpf(1.0f + __expf(-bflo(g[2 + q]))); v1[2 * q + 1] *= __builtin_amdgcn_rcpf(1.0f + __expf(-bfhi(g[2 + q])));
          }
          bf16_t* mp = MIX + (size_t)row * DM + col;
          if (b > 0) { const u32x4 o = *(const u32x4*)mp;
#pragma unroll
            for (int q = 0; q < 2; ++q) { v0[2 * q] += bflo(o[q]); v0[2 * q + 1] += bfhi(o[q]); v1[2 * q] += bflo(o[2 + q]); v1[2 * q + 1] += bfhi(o[2 + q]); } }
          *(u32x4*)mp = pack_f8(v0, v1);
        }
      }
  }
};
template <bool NORM_OUT> struct EpiResid {
  static constexpr bool PERM = false, AFTER_DRAIN = false;
  const float* xs; float* xd; bf16_t* xb; float* ssq;
  DI void operator()(ACC_T, const Unit& u, int wr, int wc, int fr, int fq) const {
#pragma unroll
    for (int ai = 0; ai < 2; ++ai)
#pragma unroll
      for (int m = 0; m < 4; ++m) {
        const int row = EROW(u, ai, m);
        const size_t ro = (size_t)row * DM + u.pn * 256 + wc * 32 + 4 * fq;
        float ss = 0.f;
#pragma unroll
        for (int bj = 0; bj < 2; ++bj)
#pragma unroll
          for (int n = 0; n < 2; ++n) {
            const size_t o = ro + bj * 128 + n * 16; const f32x4 x = *(const f32x4*)(xs + o) + acc[ai][bj][m][n]; *(f32x4*)(xd + o) = x;
            if (NORM_OUT) { u32x2 w; w.x = pk2(x[0], x[1]); w.y = pk2(x[2], x[3]); *(u32x2*)(xb + o) = w; ss += x[0] * x[0] + x[1] * x[1] + x[2] * x[2] + x[3] * x[3]; }
          }
        if (NORM_OUT) { ss += __shfl_xor(ss, 16); ss += __shfl_xor(ss, 32); if (fq == 0) __hip_atomic_fetch_add(ssq + row, ss, __ATOMIC_RELAXED, __HIP_MEMORY_SCOPE_AGENT); }
      }
  }
};
struct EpiRelu2 {
  static constexpr bool PERM = true, AFTER_DRAIN = false;
  bf16_t* HID; const float* ssq;
  DI void operator()(ACC_T, const Unit& u, int wr, int wc, int fr, int fq) const {
#pragma unroll
    for (int ai = 0; ai < 2; ++ai)
#pragma unroll
      for (int m = 0; m < 4; ++m) {
        const int row = EROW(u, ai, m); const float rs = rsqrtf(ssq[row] * (1.0f / DM) + 1e-6f);
#pragma unroll
        for (int bj = 0; bj < 2; ++bj) {
          f32x4 v0 = acc[ai][bj][m][0], v1 = acc[ai][bj][m][1];
#pragma unroll
          for (int e = 0; e < 4; ++e) { const float a = fmaxf(v0[e], 0.f) * rs, c = fmaxf(v1[e], 0.f) * rs; v0[e] = a * a; v1[e] = c * c; }
          *(u32x4*)(HID + (size_t)row * DFF + u.pn * 256 + bj * 128 + wc * 32 + 8 * fq) = pack_f8(v0, v1);
        }
      }
  }
};
struct DiagOrder {
  pg8::StaticOrder so; int G, c;
  DI void init(int G_, int c_) { so.init(S, 1024, G_, c_); G = G_; c = c_; }
  DI bool next(int i, Unit& u) const { const int tile = (i / 3) * G + c, b = i % 3; if (tile >= 256) return false; so.map(tile, u); u.pm += 64 * b; u.pn += 4 * b; return true; }
  DI void a_ready(const Unit&) const {}
  DI void done(const Unit&) const {}
};
#define GEMM_LDS ((PG8_LAS unsigned char*)smem)

DI void phase_kpost(const Params& p, int layer) {
  bf16_t* Z = (bf16_t*)(p.ws + OFF_Z);
  const f32x2* CS = (const f32x2*)(p.ws + OFF_CS);
  for (int it = (int)gridDim.x - 1 - (int)blockIdx.x; it < 96; it += gridDim.x) {
      const int tid = otid();
      const int idx = it * 512 + tid;
      const int unit = idx / S, tkn = idx % S;
      if (unit < 2) {
        bf16_t* kp = Z + (size_t)tkn * ZP + ZC_KC + unit * 64;
        float x[8][8]; float ss = 0.f;
#pragma unroll
        for (int c = 0; c < 8; ++c) { const u32x4 v = *(const u32x4*)(kp + c * 8);
#pragma unroll
          for (int q = 0; q < 4; ++q) { x[c][2 * q] = bflo(v[q]); x[c][2 * q + 1] = bfhi(v[q]); ss += x[c][2 * q] * x[c][2 * q] + x[c][2 * q + 1] * x[c][2 * q + 1]; } }
        const float rs = rsqrtf(ss * (1.0f / 64.0f) + 1e-6f);
        const float* gk = p.c_k_norm + layer * 64;
#pragma unroll
        for (int c = 0; c < 8; ++c)
#pragma unroll
          for (int q = 0; q < 8; ++q) x[c][q] *= rs * gk[c * 8 + q];
        const f32x2* cr = CS + (size_t)(tkn >> 6) * 16; const f32x2* cc = CS + (size_t)(tkn & 63) * 16;
        rope_pair8(x[0], x[2], cr); rope_pair8(x[1], x[3], cr + 8);
        rope_pair8(x[4], x[6], cc); rope_pair8(x[5], x[7], cc + 8);
#pragma unroll
        for (int c = 0; c < 8; ++c) { u32x4 w; w.x = pk2(x[c][0], x[c][1]); w.y = pk2(x[c][2], x[c][3]); w.z = pk2(x[c][4], x[c][5]); w.w = pk2(x[c][6], x[c][7]); *(u32x4*)(kp + c * 8) = w; }
      } else {
        bf16_t* kp = Z + (size_t)tkn * ZP + ZC_KR;
        float x[4][8];
#pragma unroll
        for (int c = 0; c < 4; ++c) { const u32x4 v = *(const u32x4*)(kp + c * 8);
#pragma unroll
          for (int q = 0; q < 4; ++q) { x[c][2 * q] = bflo(v[q]); x[c][2 * q + 1] = bfhi(v[q]); } }
        const f32x2* cp = CS + (size_t)tkn * 16;
        rope_pair8(x[0], x[2], cp); rope_pair8(x[1], x[3], cp + 8);
#pragma unroll
        for (int c = 0; c < 4; ++c) { u32x4 w; w.x = pk2(x[c][0], x[c][1]); w.y = pk2(x[c][2], x[c][3]); w.z = pk2(x[c][4], x[c][5]); w.w = pk2(x[c][6], x[c][7]); *(u32x4*)(kp + c * 8) = w; }
      }
  }
}

DI bf16x8 pack8(float a0, float a1, float a2, float a3, float a4, float a5, float a6, float a7) {
  u32x4 w; w.x = pk2(a0, a1); w.y = pk2(a2, a3); w.z = pk2(a4, a5); w.w = pk2(a6, a7); return __builtin_bit_cast(bf16x8, w);
}
DI void unpack8(const u32x4 v, float (&x)[8]) {
#pragma unroll
  for (int q = 0; q < 4; ++q) { x[2 * q] = bflo(v[q]); x[2 * q + 1] = bfhi(v[q]); }
}

DI void store_o_wide(bf16_t* rowp, const f32x16& o, float inv, int h) {
#pragma unroll
  for (int pr = 0; pr < 2; ++pr) {
    const int g = 2 * pr;
    const unsigned ax = pk2(o[4 * g] * inv, o[4 * g + 1] * inv), ay = pk2(o[4 * g + 2] * inv, o[4 * g + 3] * inv);
    const unsigned bx = pk2(o[4 * g + 4] * inv, o[4 * g + 5] * inv), by = pk2(o[4 * g + 6] * inv, o[4 * g + 7] * inv);
    const auto sx = __builtin_amdgcn_permlane32_swap(ax, bx, false, false);
    const auto sy = __builtin_amdgcn_permlane32_swap(ay, by, false, false);
    const u32x4 w = {sx[0], sy[0], sx[1], sy[1]};
    *(u32x4*)(rowp + 8 * (g + h)) = w;
  }
}

constexpr int ATT_STAGE = 20480;

template <int TYPE, bool FIXREF>
DI void attn_dense_unit(const Params& p, int layer, int head, int qb, char* lds, float bref) {
  constexpr int NQK = TYPE == 0 ? 6 : 4;
  const int tid = otid(), lane = tid & 63, wid = wave_of(tid), r = lane & 31, h = lane >> 5;
  const bf16_t* Z = (const bf16_t*)(p.ws + OFF_Z);
  const f32x2* CS = (const f32x2*)(p.ws + OFF_CS);
  const bf16_t* Kn; int ldk; const bf16_t* VT; bf16_t* O;
  if (TYPE == 0) { Kn = (const bf16_t*)(p.ws + OFF_KA) + head * 64; ldk = 512; VT = (const bf16_t*)(p.ws + OFF_VAT) + (size_t)head * 64 * S; O = (bf16_t*)(p.ws + OFF_OA); }
  else { const int kvh = head >> 2; Kn = Z + ZC_KC + kvh * 64; ldk = ZP; VT = (const bf16_t*)(p.ws + OFF_VCT) + (size_t)kvh * 64 * S; O = (bf16_t*)(p.ws + OFF_OC); }
  const int q = qb * 256 + wid * 32 + r;
  bf16x8 qf[NQK];
  if (TYPE == 0) {
    const bf16_t* qp = (const bf16_t*)(p.ws + OFF_QA) + (size_t)q * 768 + head * 96 + 8 * h;
    float x[6][8];
#pragma unroll
    for (int d0 = 0; d0 < 6; ++d0) unpack8(*(const u32x4*)(qp + d0 * 16), x[d0]);
    rope_pair8(x[4], x[5], CS + (size_t)q * 16 + 8 * h);
    const float sc = 0.10206207261596577f * LOG2E;
#pragma unroll
    for (int d0 = 0; d0 < 6; ++d0) qf[d0] = pack8(x[d0][0] * sc, x[d0][1] * sc, x[d0][2] * sc, x[d0][3] * sc, x[d0][4] * sc, x[d0][5] * sc, x[d0][6] * sc, x[d0][7] * sc);
  } else {
    const bf16_t* qp = Z + (size_t)q * ZP + ZC_QC + head * 64 + 8 * h;
    float x[4][8]; float ss = 0.f;
#pragma unroll
    for (int d0 = 0; d0 < 4; ++d0) { unpack8(*(const u32x4*)(qp + d0 * 16), x[d0]);
#pragma unroll
      for (int j = 0; j < 8; ++j) ss += x[d0][j] * x[d0][j]; }
    ss += __shfl_xor(ss, 32);
    const float rs = rsqrtf(ss * (1.0f / 64.0f) + 1e-6f);
    const float* gq = p.c_q_norm + layer * 64;
#pragma unroll
    for (int d0 = 0; d0 < 4; ++d0)
#pragma unroll
      for (int j = 0; j < 8; ++j) x[d0][j] *= rs * gq[d0 * 16 + 8 * h + j];
    rope_pair8(x[0], x[1], CS + (size_t)(q >> 6) * 16 + 8 * h);
    rope_pair8(x[2], x[3], CS + (size_t)(q & 63) * 16 + 8 * h);
    const float sc = 0.125f * LOG2E;
#pragma unroll
    for (int d0 = 0; d0 < 4; ++d0) qf[d0] = pack8(x[d0][0] * sc, x[d0][1] * sc, x[d0][2] * sc, x[d0][3] * sc, x[d0][4] * sc, x[d0][5] * sc, x[d0][6] * sc, x[d0][7] * sc);
  }
  typedef __attribute__((address_space(3))) unsigned lds_u32;
  const int srow = tid >> 3, sch = (tid & 7) ^ ((srow >> 1) & 7);
  const bf16_t* gk = Kn + (size_t)srow * ldk + sch * 8;
  const bf16_t* gv = VT + (size_t)srow * S + sch * 8;
  const int rrow = tid >> 2, rch = (tid & 3) ^ ((rrow >> 2) & 3);
  const bf16_t* gr = Z + ZC_KR + (size_t)rrow * ZP + rch * 8;
  char* wbase = lds + wid * 1024;
#define DMA(t, soff) do { \
    __builtin_amdgcn_global_load_lds((const unsigned*)(gk + (size_t)(t) * 64 * ldk), (lds_u32*)(wbase + (soff)), 16, 0, 0); \
    __builtin_amdgcn_global_load_lds((const unsigned*)(gv + (size_t)(t) * 64), (lds_u32*)(wbase + (soff) + 8192), 16, 0, 0); \
    if (TYPE == 0 && wid < 4) __builtin_amdgcn_global_load_lds((const unsigned*)(gr + (size_t)(t) * 64 * ZP), (lds_u32*)(wbase + (soff) + 16384), 16, 0, 0); } while (0)
#define DMA_WAIT(keep) do { if (keep) { if (TYPE == 0 && wid < 4) asm volatile("s_waitcnt vmcnt(3)" ::: "memory"); else asm volatile("s_waitcnt vmcnt(2)" ::: "memory"); } \
    else asm volatile("s_waitcnt vmcnt(0)" ::: "memory"); } while (0)
#define BAR() do { asm volatile("s_waitcnt lgkmcnt(0)" ::: "memory"); __builtin_amdgcn_s_barrier(); asm volatile("" ::: "memory"); } while (0)
  constexpr int NONES = (TYPE == 0) ? 0 : 2;
  float m_run = 0.f, lsum = 0.f, ls0 = 0.f, ls1 = 0.f, ls2 = 0.f; f32x16 o0, o1, negm, la;
#pragma unroll
  for (int i = 0; i < 16; ++i) { o0[i] = 0.f; o1[i] = 0.f; negm[i] = 0.f; la[i] = 0.f; }
  const bf16x8 ones = {0x3F80, 0x3F80, 0x3F80, 0x3F80, 0x3F80, 0x3F80, 0x3F80, 0x3F80};
  const int rK = (r & ~12) | ((r & 4) << 1) | ((r & 8) >> 1);
  const int ksw = (rK >> 1) & 7, rsw = (rK >> 2) & 3, vsw = (r >> 1) & 7;
  int koff[4], roff[2], voff[4];
#pragma unroll
  for (int d0 = 0; d0 < 4; ++d0) { koff[d0] = rK * 128 + (((2 * d0 + h) ^ ksw) << 4); voff[d0] = 8192 + r * 128 + (((2 * d0 + h) ^ vsw) << 4); }
#pragma unroll
  for (int d0 = 0; d0 < 2; ++d0) roff[d0] = 16384 + rK * 64 + (((2 * d0 + h) ^ rsw) << 4);
  constexpr int NT = S / 64;
  constexpr float THR = 8.0f;
#define SB() __builtin_amdgcn_sched_barrier(0)
#define QKR(d0, K0, K1, SOFF) do { if ((d0) < 4) { K0 = *(const bf16x8*)(lds + (SOFF) + koff[(d0) & 3]); K1 = *(const bf16x8*)(lds + (SOFF) + 32 * 128 + koff[(d0) & 3]); } \
    else if ((d0) < NQK) { K0 = *(const bf16x8*)(lds + (SOFF) + roff[(d0) & 1]); K1 = *(const bf16x8*)(lds + (SOFF) + 32 * 64 + roff[(d0) & 1]); } } while (0)
#define QKM(N0, N1, d0, K0, K1) do { if ((d0) == 0) { N0 = MFMA(K0, qf[0], negm); N1 = MFMA(K1, qf[0], negm); } \
    else if ((d0) < NQK) { N0 = MFMA(K0, qf[(d0) < NQK ? (d0) : 0], N0); N1 = MFMA(K1, qf[(d0) < NQK ? (d0) : 0], N1); } } while (0)
#define EX4(CC, B, SI) do { __builtin_amdgcn_s_setprio(1); _Pragma("unroll") for (int i_ = 0; i_ < 4; ++i_) { CC[(B) + i_] = fexp2(CC[(B) + i_]); if ((SI) >= NONES) { if (i_ == 0) ls0 += CC[(B) + i_]; else if (i_ == 1) ls1 += CC[(B) + i_]; else if (i_ == 2) ls2 += CC[(B) + i_]; else lsum += CC[(B) + i_]; } } __builtin_amdgcn_s_setprio(0); } while (0)
#define PK8(PF, CC, B) do { PF = pack8(CC[(B)], CC[(B) + 1], CC[(B) + 2], CC[(B) + 3], CC[(B) + 4], CC[(B) + 5], CC[(B) + 6], CC[(B) + 7]); } while (0)
#define VR(s_, V0, V1, SOFF) do { V0 = *(const bf16x8*)(lds + (SOFF) + voff[s_]); V1 = *(const bf16x8*)(lds + (SOFF) + 32 * 128 + voff[s_]); } while (0)
#define PVM(s_, V0, V1) do { o0 = MFMA(V0, pf[s_], o0); o1 = MFMA(V1, pf[s_], o1); if ((s_) < NONES) la = MFMA(ones, pf[s_], la); } while (0)
#define MAXG(NN, B) do { ma_ = fmaxf(fmaxf(ma_, NN[(B)]), NN[(B) + 1]); mb_ = fmaxf(fmaxf(mb_, NN[(B) + 2]), NN[(B) + 3]); \
    ma_ = fmaxf(fmaxf(ma_, NN[(B) + 4]), NN[(B) + 5]); mb_ = fmaxf(fmaxf(mb_, NN[(B) + 6]), NN[(B) + 7]); } while (0)
#define ROWMAX(P0, P1, MX) do { float a_ = fmaxf(fmaxf(P0[0], P0[1]), P1[0]), c_ = fmaxf(fmaxf(P0[2], P0[3]), P1[1]); a_ = fmaxf(fmaxf(a_, P1[2]), P1[3]); \
    _Pragma("unroll") for (int i_ = 4; i_ < 16; i_ += 4) { a_ = fmaxf(fmaxf(a_, P0[i_]), P0[i_ + 1]); c_ = fmaxf(fmaxf(c_, P0[i_ + 2]), P0[i_ + 3]); a_ = fmaxf(fmaxf(a_, P1[i_]), P1[i_ + 1]); c_ = fmaxf(fmaxf(c_, P1[i_ + 2]), P1[i_ + 3]); } \
    a_ = fmaxf(a_, c_); MX = fmaxf(a_, __shfl_xor(a_, 32)); } while (0)
#define RESCALE(P0, P1, DELTA) do { const float dl_ = (DELTA); m_run += dl_; const float al_ = fexp2(-dl_); lsum *= al_; ls0 *= al_; ls1 *= al_; ls2 *= al_; \
    _Pragma("unroll") for (int i_ = 0; i_ < 16; ++i_) { P0[i_] -= dl_; P1[i_] -= dl_; o0[i_] *= al_; o1[i_] *= al_; if (NONES > 0) la[i_] *= al_; negm[i_] = -m_run; } } while (0)
#define STEP(C0, C1, N0, N1, T, HAS_NEXT, HAS_LOAD, S0, S1, S3) do { \
    if (HAS_LOAD) DMA((T) + 3, S3); \
    bf16x8 pf[4]; bf16x8 ka0, ka1, kb0, kb1, va0, va1, vb0, vb1; \
    if (HAS_NEXT) QKR(0, ka0, ka1, S1); \
    SB(); if (HAS_NEXT) { QKR(1, kb0, kb1, S1); QKM(N0, N1, 0, ka0, ka1); } EX4(C0, 0, 0); \
    SB(); if (HAS_NEXT) { QKR(2, ka0, ka1, S1); QKM(N0, N1, 1, kb0, kb1); } EX4(C0, 4, 0); PK8(pf[0], C0, 0); \
    SB(); if (HAS_NEXT) { QKR(3, kb0, kb1, S1); QKM(N0, N1, 2, ka0, ka1); } EX4(C0, 8, 1); \
    SB(); if (HAS_NEXT) { QKR(4, ka0, ka1, S1); QKM(N0, N1, 3, kb0, kb1); } EX4(C0, 12, 1); PK8(pf[1], C0, 8); if (NQK == 4) VR(0, va0, va1, S0); \
    if (NQK > 4) { \
      SB(); if (HAS_NEXT) { QKR(5, kb0, kb1, S1); QKM(N0, N1, 4, ka0, ka1); } EX4(C1, 0, 2); \
      SB(); if (HAS_NEXT) QKM(N0, N1, 5, kb0, kb1); EX4(C1, 4, 2); PK8(pf[2], C1, 0); VR(0, va0, va1, S0); } \
    float ma_ = -1e30f, mb_ = -1e30f; \
    if (NQK == 4) { \
      SB(); VR(1, vb0, vb1, S0); PVM(0, va0, va1); EX4(C1, 0, 2); EX4(C1, 4, 2); PK8(pf[2], C1, 0); \
      SB(); VR(2, va0, va1, S0); PVM(1, vb0, vb1); EX4(C1, 8, 3); EX4(C1, 12, 3); PK8(pf[3], C1, 8); \
    } else { \
      SB(); VR(1, vb0, vb1, S0); PVM(0, va0, va1); EX4(C1, 8, 3); \
      SB(); VR(2, va0, va1, S0); PVM(1, vb0, vb1); EX4(C1, 12, 3); PK8(pf[3], C1, 8); } \
    SB(); VR(3, vb0, vb1, S0); PVM(2, va0, va1); if (HAS_NEXT && !FIXREF) { MAXG(N0, 0); MAXG(N0, 8); } \
    SB(); PVM(3, vb0, vb1); if (HAS_NEXT && !FIXREF) { MAXG(N1, 0); MAXG(N1, 8); } \
    SB(); \
    float mx_ = fmaxf(ma_, mb_); { const auto rr_ = __builtin_amdgcn_permlane32_swap(__float_as_uint(mx_), __float_as_uint(mx_), false, false); mx_ = fmaxf(__uint_as_float(rr_[0]), __uint_as_float(rr_[1])); } \
    DMA_WAIT(HAS_LOAD); BAR(); \
    if (HAS_NEXT && !FIXREF) { if (__any(mx_ > THR)) RESCALE(N0, N1, fmaxf(mx_, 0.f)); } } while (0)
  constexpr int R0 = 0, R1 = ATT_STAGE, R2 = 2 * ATT_STAGE, R3 = 3 * ATT_STAGE;
  f32x16 sA0, sA1, sB0, sB1;
  DMA(0, R0); DMA(1, R1); DMA(2, R2); DMA_WAIT(true); BAR();
  if (FIXREF) { m_run = bref;
#pragma unroll
    for (int i = 0; i < 16; ++i) negm[i] = -bref; }
  { bf16x8 ka0, ka1;
#pragma unroll
    for (int d0 = 0; d0 < NQK; ++d0) { QKR(d0, ka0, ka1, R0); QKM(sA0, sA1, d0, ka0, ka1); } }
  if (!FIXREF) { float mx0; ROWMAX(sA0, sA1, mx0); m_run = mx0;
#pragma unroll
    for (int i = 0; i < 16; ++i) { sA0[i] -= mx0; sA1[i] -= mx0; negm[i] = -mx0; } }
  for (int t = 0; t < NT - 4; t += 4) {
    STEP(sA0, sA1, sB0, sB1, t, true, true, R0, R1, R3);
    STEP(sB0, sB1, sA0, sA1, t + 1, true, true, R1, R2, R0);
    STEP(sA0, sA1, sB0, sB1, t + 2, true, true, R2, R3, R1);
    STEP(sB0, sB1, sA0, sA1, t + 3, true, true, R3, R0, R2);
  }
  STEP(sA0, sA1, sB0, sB1, NT - 4, true, true, R0, R1, R3);
  STEP(sB0, sB1, sA0, sA1, NT - 3, true, false, R1, R2, R0);
  STEP(sA0, sA1, sB0, sB1, NT - 2, true, false, R2, R3, R1);
  STEP(sB0, sB1, sA0, sA1, NT - 1, false, false, R3, R0, R2);
  lsum += ls0 + ls1 + ls2;
  const float l = (NONES > 0 ? la[0] : 0.f) + lsum + __shfl_xor(lsum, 32);
#undef DMA
#undef DMA_WAIT
#undef BAR
#undef SB
#undef QKR
#undef QKM
#undef EX4
#undef PK8
#undef VR
#undef PVM
#undef MAXG
#undef ROWMAX
#undef RESCALE
#undef STEP
  const float inv = 1.0f / l;
  bf16_t* op = O + (size_t)q * 512 + head * 64;
  store_o_wide(op, o0, inv, h); store_o_wide(op + 32, o1, inv, h);
}

constexpr int BLV = 49152;
DI void b_issue_k(const Params& p, int x, char* lds, int tid, int wid) {
  typedef __attribute__((address_space(3))) unsigned lds_u32;
  const int g = x >> 9, head = (x >> 6) & 7, blk256 = x & 63;
  const int sh = 2 * g, Ls = S >> sh, P0 = blk256 * 256, sub = P0 / Ls, i0 = P0 & (Ls - 1), sub0 = sub * Ls;
  const bf16_t* Zk = (const bf16_t*)(p.ws + OFF_Z) + ZC_QKVB + ((1 * 3 + g) * 8 + head) * 64;
#pragma unroll
  for (int i = 0; i < 6; ++i) {
    const int sl = i * 512 + tid, row = sl >> 3, c = (sl & 7) ^ ((row >> 1) & 7); int key = i0 - 64 + row; key = key < 0 ? 0 : (key > Ls - 1 ? Ls - 1 : key);
    __builtin_amdgcn_global_load_lds((const unsigned*)(Zk + (size_t)(sub0 + key) * ZP + c * 8), (lds_u32*)(lds + (i * 512 + wid * 64) * 16), 16, 0, 0);
  }
}
DI void b_issue_v(const Params& p, int x, char* lds, int tid, int wid) {
  typedef __attribute__((address_space(3))) unsigned lds_u32;
  const int g = x >> 9, head = (x >> 6) & 7, blk256 = x & 63;
  const int sh = 2 * g, Ls = S >> sh, P0 = blk256 * 256, sub = P0 / Ls, i0 = P0 & (Ls - 1), sub0 = sub * Ls;
  const bf16_t* VTg = (const bf16_t*)(p.ws + OFF_VBT) + (size_t)((g * 8 + head) * 64) * S + sub0;
#pragma unroll
  for (int i = 0; i < 6; ++i) {
    const int sl = i * 512 + tid, d = sl / 48, c = (sl - d * 48) ^ (d & 15); int k0 = i0 - 64 + 8 * c; k0 = k0 < 0 ? 0 : (k0 > Ls - 8 ? Ls - 8 : k0);
    __builtin_amdgcn_global_load_lds((const unsigned*)(VTg + (size_t)d * S + k0), (lds_u32*)(lds + BLV + (i * 512 + wid * 64) * 16), 16, 0, 0);
  }
}
DI void attn_b_item(const Params& p, int x, int xnext, char* lds) {
  const int tid = otid(), lane = tid & 63, wid = wave_of(tid), r = lane & 31, h = lane >> 5;
  const int g = x >> 9, head = (x >> 6) & 7, blk256 = x & 63;
  const bf16_t* Z = (const bf16_t*)(p.ws + OFF_Z);
  const int sh = 2 * g, Ls = S >> sh, P0 = blk256 * 256, sub = P0 / Ls, i0 = P0 & (Ls - 1);
  const bf16_t* Zq = Z + ZC_QKVB + ((0 * 3 + g) * 8 + head) * 64;
  constexpr int LV = BLV;
  const int i0w = i0 + 32 * wid;
  const float* BT = (const float*)(p.ws + OFF_BT) + (g * 8 + head) * 256 + 32 - r + 8 * h;
  const int rK = (r & ~12) | ((r & 4) << 1) | ((r & 8) >> 1);
  bf16x8 qf[4];
  {
    const bf16_t* qp = Zq + (size_t)(P0 + 32 * wid + r) * ZP + 8 * h; const float scq = 0.125f * LOG2E;
#pragma unroll
    for (int d0 = 0; d0 < 4; ++d0) { float x8[8]; unpack8(*(const u32x4*)(qp + d0 * 16), x8); qf[d0] = pack8(x8[0] * scq, x8[1] * scq, x8[2] * scq, x8[3] * scq, x8[4] * scq, x8[5] * scq, x8[6] * scq, x8[7] * scq); }
  }
  float bvs[5][16];
#pragma unroll
  for (int c = 0; c < 5; ++c)
#pragma unroll
    for (int i = 0; i < 16; ++i) bvs[c][i] = BT[32 * c + (i & 3) + 4 * ((i >> 2) & 1) + 16 * (i >> 3)];
  asm volatile("s_waitcnt vmcnt(0)" ::: "memory"); __builtin_amdgcn_s_barrier(); asm volatile("" ::: "memory");
#pragma unroll
  for (int c = 0; c < 5; ++c)
#pragma unroll
    for (int i = 0; i < 16; ++i) asm volatile("" : "+v"(bvs[c][i]));
  f32x16 sc[5];
  const int ksw = (rK >> 1) & 7;
#pragma unroll
  for (int c = 0; c < 5; ++c) {
#pragma unroll
    for (int i = 0; i < 16; ++i) sc[c][i] = 0.f;
    const char* kp = lds + (32 * wid + 32 * c + rK) * 128;
#pragma unroll
    for (int d0 = 0; d0 < 4; ++d0) { const bf16x8 kf = *(const bf16x8*)(kp + (((2 * d0 + h) ^ ksw) << 4)); sc[c] = MFMA(kf, qf[d0], sc[c]); }
  }
  asm volatile("s_waitcnt lgkmcnt(0)" ::: "memory"); __builtin_amdgcn_s_barrier(); asm volatile("" ::: "memory");
  if (xnext >= 0) b_issue_k(p, xnext, lds, tid, wid);
  float mxa[4] = {-1e30f, -1e30f, -1e30f, -1e30f};
#pragma unroll
  for (int c = 0; c < 5; ++c)
#pragma unroll
    for (int i = 0; i < 16; ++i) {
      const int prow = (i & 3) + 4 * ((i >> 2) & 1) + 8 * h + 16 * (i >> 3);
      const int rel = 32 * c - 64 + prow - r, key = i0w + r + rel;
      const bool valid = ((unsigned)(rel + 64) <= 128u) & ((unsigned)key < (unsigned)Ls);
      const float v = valid ? sc[c][i] + bvs[c][i] : -1e30f;
      sc[c][i] = v; mxa[i & 3] = fmaxf(mxa[i & 3], v);
    }
  float mx = fmaxf(fmaxf(mxa[0], mxa[1]), fmaxf(mxa[2], mxa[3]));
  mx = fmaxf(mx, __shfl_xor(mx, 32));
  float la4[4] = {0.f, 0.f, 0.f, 0.f};
#pragma unroll
  for (int c = 0; c < 5; ++c)
#pragma unroll
    for (int i = 0; i < 16; ++i) { const float e = fexp2(sc[c][i] - mx); sc[c][i] = e; la4[i & 3] += e; }
  float l = (la4[0] + la4[1]) + (la4[2] + la4[3]);
  l += __shfl_xor(l, 32);
  f32x16 o0, o1;
#pragma unroll
  for (int i = 0; i < 16; ++i) { o0[i] = 0.f; o1[i] = 0.f; }
  const char* vp = lds + LV + r * 768; const int vsw = r & 15;
#pragma unroll
  for (int c = 0; c < 5; ++c)
#pragma unroll
    for (int s = 0; s < 2; ++s) {
      const bf16x8 pf = pack8(sc[c][8 * s], sc[c][8 * s + 1], sc[c][8 * s + 2], sc[c][8 * s + 3], sc[c][8 * s + 4], sc[c][8 * s + 5], sc[c][8 * s + 6], sc[c][8 * s + 7]);
      const int ch = ((4 * wid + 4 * c + 2 * s + h) ^ vsw) << 4;
      const bf16x8 v0 = *(const bf16x8*)(vp + ch), v1 = *(const bf16x8*)(vp + 32 * 768 + ch);
      o0 = MFMA(v0, pf, o0); o1 = MFMA(v1, pf, o1);
    }
  asm volatile("s_waitcnt lgkmcnt(0)" ::: "memory"); __builtin_amdgcn_s_barrier(); asm volatile("" ::: "memory");
  if (xnext >= 0) b_issue_v(p, xnext, lds, tid, wid);
  const float inv = 1.0f / l;
  const int tkn = ((i0w + r) << sh) + sub;
  bf16_t* OG = (g < 2) ? (bf16_t*)(p.ws + OFF_H) + (size_t)g * S * 512 : (bf16_t*)(p.ws + OFF_OB);
  bf16_t* op = OG + (size_t)tkn * 512 + head * 64;
  store_o_wide(op, o0, inv, h); store_o_wide(op + 32, o1, inv, h);
  if (h == 0) { float* LSE = (float*)(p.ws + OFF_LSE); LSE[((size_t)g * S + tkn) * 8 + head] = (mx + __builtin_amdgcn_logf(l)) * LN2; }
}

DI void phase_attn(const Params& p, int layer, char* smem) {
  const int n_dense = 1024, n_b = 1536, total = n_dense + n_b;
  int it = blockIdx.x;
  for (; it < n_dense; it += gridDim.x) {
    if (it < 512) { attn_dense_unit<0, false>(p, layer, it & 7, it >> 3, smem, 0.f); }
    else { const int v = it - 512;
      float bref;
      { const int ln = otid() & 63; float gq = fabsf(p.c_q_norm[layer * 64 + ln]), gk = fabsf(p.c_k_norm[layer * 64 + ln]);
#pragma unroll
        for (int o = 32; o >= 1; o >>= 1) { gq = fmaxf(gq, __shfl_xor(gq, o)); gk = fmaxf(gk, __shfl_xor(gk, o)); }
        bref = 64.0f * gq * gk * 0.125f * LOG2E * 1.02f; }
      if (__builtin_amdgcn_readfirstlane(bref < 60.0f ? 1 : 0) != 0) attn_dense_unit<1, true>(p, layer, v & 7, v >> 3, smem, bref);
      else attn_dense_unit<1, false>(p, layer, v & 7, v >> 3, smem, 0.f); }
  }
  if (it < total) {
    const int tid = otid(), wid = wave_of(tid);
    b_issue_k(p, it - n_dense, smem, tid, wid); b_issue_v(p, it - n_dense, smem, tid, wid);
    for (; it < total; it += gridDim.x) {
      const int nx = it + (int)gridDim.x;
      attn_b_item(p, it - n_dense, nx < total ? nx - n_dense : -1, smem);
    }
  }
}

DI void phase_combine(const Params& p) {
  const bf16_t* G0 = (const bf16_t*)(p.ws + OFF_H); const bf16_t* G1 = G0 + (size_t)S * 512; bf16_t* OB = (bf16_t*)(p.ws + OFF_OB);
  const float* LSE = (const float*)(p.ws + OFF_LSE);
  for (int e = blockIdx.x * 512 + otid(); e < S * 64; e += gridDim.x * 512) {
    const int tkn = e >> 6, c = e & 63, head = c >> 3;
    const float l0 = LSE[((size_t)0 * S + tkn) * 8 + head], l1 = LSE[((size_t)1 * S + tkn) * 8 + head], l2 = LSE[((size_t)2 * S + tkn) * 8 + head];
    const float mm = fmaxf(l0, fmaxf(l1, l2));
    float w0 = __expf(l0 - mm), w1 = __expf(l1 - mm), w2 = __expf(l2 - mm);
    const float iw = 1.0f / (w0 + w1 + w2); w0 *= iw; w1 *= iw; w2 *= iw;
    const size_t off = (size_t)tkn * 512 + c * 8;
    const u32x4 a = *(const u32x4*)(G0 + off), b = *(const u32x4*)(G1 + off), d = *(const u32x4*)(OB + off);
    u32x4 o;
#pragma unroll
    for (int q = 0; q < 4; ++q) o[q] = pk2(w0 * bflo(a[q]) + w1 * bflo(b[q]) + w2 * bflo(d[q]), w0 * bfhi(a[q]) + w1 * bfhi(b[q]) + w2 * bfhi(d[q]));
    *(u32x4*)(OB + off) = o;
  }
}

#define XB_TMO      128
#define XB_XCNT(j)  (256  + 64 * (j))
#define XB_XSUB(j)  (1280 + 64 * (j))
#define XB_XGEN(j)  (2304 + 64 * (j))
#define XB_TOP      3328
#define XB_TOPGEN   3392
#define XCD_BAR_WORDS 3456
#define XB_SPIN_CAP (1u << 18)
#ifndef LAS
#define LAS __attribute__((address_space(3)))
#endif

__device__ __forceinline__ unsigned xb_ld(unsigned* p)              { return __hip_atomic_load(p, __ATOMIC_RELAXED, __HIP_MEMORY_SCOPE_AGENT); }
__device__ __forceinline__ unsigned xb_add(unsigned* p, unsigned v) { return __hip_atomic_fetch_add(p, v, __ATOMIC_RELAXED, __HIP_MEMORY_SCOPE_AGENT); }
__device__ __forceinline__ unsigned xb_xcc_id() { return (unsigned)__builtin_amdgcn_s_getreg((3 << 11) | 20) & 0xFu; }
#define XB_SPIN(cond, bar) do { unsigned _sp = 0; while (cond) { __builtin_amdgcn_s_sleep(1); \
    if ((++_sp & 255u) == 0u) { if (xb_ld(&(bar)[XB_TMO])) break; if (_sp > XB_SPIN_CAP) { atomicAdd(&(bar)[XB_TMO], 1u); break; } } } } while (0)

struct XcdBarrier {
    unsigned* bar; unsigned x;
    volatile LAS unsigned* st;
};

__device__ __forceinline__ XcdBarrier xcd_barrier_post(unsigned* bar, volatile LAS unsigned* st) {
    XcdBarrier b; b.bar = bar; b.x = xb_xcc_id(); b.st = st;
    if (threadIdx.x == 0) (void)xb_add(&bar[XB_XCNT(b.x)], 1u);
    return b;
}
__device__ __forceinline__ void xcd_barrier_complete(unsigned* bar, unsigned x, unsigned& nloc, unsigned& nx) {
    const unsigned G = gridDim.x * gridDim.y * gridDim.z;
    unsigned sum, cnt, mine, sp = 0u;
    for (;;) {
        sum = 0u; cnt = 0u; mine = 0u;
#pragma unroll
        for (unsigned j = 0; j < 16; ++j) { const unsigned c = xb_ld(&bar[XB_XCNT(j)]); sum += c; cnt += (c > 0u) ? 1u : 0u; mine = (j == x) ? c : mine; }
        if (sum == G) break;
        __builtin_amdgcn_s_sleep(1);
        if ((++sp & 255u) == 0u) { if (xb_ld(&bar[XB_TMO])) break; if (sp > XB_SPIN_CAP) { atomicAdd(&bar[XB_TMO], 1u); break; } }
    }
    nloc = mine > 0u ? mine : 1u; nx = cnt > 0u ? cnt : 1u;
}

__device__ __forceinline__ void xcd_barrier(const XcdBarrier& b) {
    asm volatile("s_waitcnt vmcnt(0)" ::: "memory");
    __syncthreads();
    if (threadIdx.x == 0) {
        unsigned* bar = b.bar;
        __builtin_amdgcn_s_waitcnt(0);
        unsigned nloc = b.st[0], nx = b.st[1];
        if (nloc == 0u) { xcd_barrier_complete(bar, b.x, nloc, nx); b.st[0] = nloc; b.st[1] = nx; }
        const unsigned old = xb_add(&bar[XB_XSUB(b.x)], 1u);
        const unsigned gen = old / nloc;
        if (old + 1u == (gen + 1u) * nloc) {
            __builtin_amdgcn_fence(__ATOMIC_RELEASE, "agent");
            asm volatile("s_waitcnt vmcnt(0)" ::: "memory");
            const unsigned og = xb_add(&bar[XB_TOP], 1u);
            const unsigned tg = og / nx;
            if (og + 1u == (tg + 1u) * nx) xb_add(&bar[XB_TOPGEN], 1u);
            else XB_SPIN(xb_ld(&bar[XB_TOPGEN]) == tg, bar);
            __builtin_amdgcn_fence(__ATOMIC_ACQUIRE, "agent");
            xb_add(&bar[XB_XGEN(b.x)], 1u);
            asm volatile("s_waitcnt vmcnt(0)" ::: "memory");
        } else {
            XB_SPIN(xb_ld(&bar[XB_XGEN(b.x)]) == gen, bar);
            __builtin_amdgcn_fence(__ATOMIC_ACQUIRE, "agent");
            asm volatile("s_waitcnt vmcnt(0)" ::: "memory");
        }
    }
    __syncthreads();
}

__global__ void __launch_bounds__(512) hybrid_encoder_mega(Params p) {
  extern __shared__ __attribute__((aligned(16))) char smem[];
  cg::grid_group grid = cg::this_grid();
  const int G = gridDim.x, bx = blockIdx.x;
  bf16_t* Z = (bf16_t*)(p.ws + OFF_Z); bf16_t* H = (bf16_t*)(p.ws + OFF_H);
  float* ssq_q = (float*)(p.ws + OFF_SSQ); float* ssq_kv = ssq_q + S; float* ssq_x = ssq_q + 2 * S;
  bf16_t* XB = (bf16_t*)(p.ws + OFF_OA);
  volatile LAS unsigned* xst = (volatile LAS unsigned*)(smem + 131072);
  if (threadIdx.x == 0) { xst[0] = 0u; xst[1] = 0u; xst[2] = 0u; xst[3] = 0u; }
  __syncthreads();
  const XcdBarrier xb = xcd_barrier_post((unsigned*)(p.ws + OFF_BAR), xst);
  bool first_sync = true;
#define GSYNC() do { if (first_sync) { grid.sync(); first_sync = false; } else xcd_barrier(xb); } while (0)
  build_tables(p);
  for (int layer = 0; layer < 2; ++layer) {
    convert_weights(p, layer, smem);
    for (int seq = 0; seq < 3; ++seq) {
      const float* xin = (layer == 0) ? (seq < 2 ? p.x_prompt + (size_t)seq * S * DM : p.x_sample) : p.out + (size_t)seq * S * DM;
      float* xo = p.out + (size_t)seq * S * DM;
      phase_norm(xin, p.norm_mix + layer * DM, H, S);
      { const int tz = otid();
_Pragma("nounroll")
        for (int b = bx; b < 96; b += G) ssq_q[b * 512 + tz] = 0.f; }
      GSYNC();
      { pg8::Gemm g{H, (const bf16_t*)(p.ws + WT_IN), S, 9216, DM, DM, DM}; pg8::StaticOrder so; so.init(S, 9216, G, bx);
        EpiInproj E{Z, (bf16_t*)(p.ws + OFF_VCT), (bf16_t*)(p.ws + OFF_VBT), ssq_q, ssq_kv};
        pg8::gemm_phase<EpiInproj, pg8::StaticOrder, true, true>(GEMM_LDS, g, so, E); }
      GSYNC();
      { pg8::Gemm g{Z + ZC_CQ, (const bf16_t*)(p.ws + WT_UQ), S, 768, 384, ZP, 384}; pg8::StaticOrder so; so.init(S, 768, G, bx);
        EpiUpQ E{(bf16_t*)(p.ws + OFF_QA), ssq_q};
        pg8::gemm_phase<EpiUpQ, pg8::StaticOrder, true, true>(GEMM_LDS, g, so, E); }
      { pg8::Gemm g{Z + ZC_CKV, (const bf16_t*)(p.ws + WT_UKV), S, 1024, 256, ZP, 256}; pg8::StaticOrder so; so.init(S, 1024, G, bx);
        EpiUpKV E{(bf16_t*)(p.ws + OFF_KA), (bf16_t*)(p.ws + OFF_VAT), ssq_kv};
        pg8::gemm_phase<EpiUpKV, pg8::StaticOrder, true, true>(GEMM_LDS, g, so, E); }
      phase_kpost(p, layer);
      GSYNC();
      phase_attn(p, layer, smem);
      GSYNC();
      phase_combine(p);
      GSYNC();
      { pg8::Gemm g{(const bf16_t*)(p.ws + OFF_OA), (const bf16_t*)(p.ws + WT_BRA), 3 * S, 3072, 512, 512, 512}; DiagOrder so; so.init(G, bx);
        EpiMerge E{Z, H};
        pg8::gemm_phase<EpiMerge, DiagOrder, true, true>(GEMM_LDS, g, so, E); }
      GSYNC();
      { pg8::Gemm g{H, (const bf16_t*)(p.ws + WT_OUT), S, 1024, DM, DM, DM}; pg8::StaticOrder so; so.init(S, 1024, G, bx);
        EpiResid<true> E{xin, xo, XB, ssq_x};
        pg8::gemm_phase<EpiResid<true>, pg8::StaticOrder, true, true>(GEMM_LDS, g, so, E); }
      GSYNC();
      { pg8::Gemm g{XB, (const bf16_t*)(p.ws + WT_UP), S, DFF, DM, DM, DM}; pg8::StaticOrder so; so.init(S, DFF, G, bx);
        EpiRelu2 E{Z, ssq_x};
        pg8::gemm_phase<EpiRelu2, pg8::StaticOrder, true, true>(GEMM_LDS, g, so, E); }
      GSYNC();
      { pg8::Gemm g{Z, (const bf16_t*)(p.ws + WT_DOWN), S, 1024, DFF, DFF, DFF}; pg8::StaticOrder so; so.init(S, 1024, G, bx);
        EpiResid<false> E{xo, xo, nullptr, nullptr};
        pg8::gemm_phase<EpiResid<false>, pg8::StaticOrder, true, true>(GEMM_LDS, g, so, E); }
      GSYNC();
    }
  }
  phase_final_norm(p.out, p.final_norm, 3 * S);
}

extern "C" void kernel_launch(void* const* d_in, const int* in_sizes, int n_in, void* d_out, int out_size, void* d_ws, size_t ws_size, hipStream_t stream) {
  static int grid_blocks = 0;
  if (!grid_blocks) {
    if (ws_size < WS_END) { fprintf(stderr, "kernel_launch: workspace too small: %zu < %zu\n", ws_size, (size_t)WS_END); return; }
    if (hipFuncSetAttribute((const void*)hybrid_encoder_mega, hipFuncAttributeMaxDynamicSharedMemorySize, LDS_BYTES) != hipSuccess) { fprintf(stderr, "hipFuncSetAttribute failed\n"); return; }
    int dev = 0, cus = 0, per_cu = 0;
    hipGetDevice(&dev);
    hipDeviceGetAttribute(&cus, hipDeviceAttributeMultiprocessorCount, dev);
    hipOccupancyMaxActiveBlocksPerMultiprocessor(&per_cu, hybrid_encoder_mega, 512, LDS_BYTES);
    if (per_cu < 1) { fprintf(stderr, "occupancy query returned %d\n", per_cu); return; }
    grid_blocks = cus;
  }
  Params p{};
  p.x_prompt = (const float*)d_in[0]; p.x_sample = (const float*)d_in[1];
  p.norm_mix = (const float*)d_in[2]; p.w_in = (const float*)d_in[3]; p.a_q_norm = (const float*)d_in[4]; p.a_kv_norm = (const float*)d_in[5];
  p.a_w_uq = (const float*)d_in[6]; p.a_w_ukv = (const float*)d_in[7]; p.c_q_norm = (const float*)d_in[8]; p.c_k_norm = (const float*)d_in[9];
  p.w_br_a = (const float*)d_in[10]; p.w_br_b = (const float*)d_in[11]; p.w_br_c = (const float*)d_in[12]; p.w_out = (const float*)d_in[13];
  p.norm_ffn = (const float*)d_in[14]; p.w_up = (const float*)d_in[15]; p.w_down = (const float*)d_in[16]; p.t5_table = (const float*)d_in[17];
  p.final_norm = (const float*)d_in[18];
  p.out = (float*)d_out; p.ws = (char*)d_ws;
  (void)hipMemsetAsync((char*)d_ws + OFF_BAR, 0, 16384, stream);
  void* args[] = {&p};
  hipError_t e = hipLaunchCooperativeKernel((const void*)hybrid_encoder_mega, dim3(grid_blocks), dim3(512), args, LDS_BYTES, stream);
  if (e != hipSuccess) fprintf(stderr, "cooperative launch failed: %s (grid %d)\n", hipGetErrorString(e), grid_blocks);
}
```

```cpp
#include <hip/hip_runtime.h>
#include <hip/hip_cooperative_groups.h>
#include <stdint.h>
#include <cstdio>
namespace cg = cooperative_groups;

typedef unsigned short bf16_t;
typedef short bf16x8 __attribute__((ext_vector_type(8)));
typedef short s16x4 __attribute__((ext_vector_type(4)));
typedef float f32x16 __attribute__((ext_vector_type(16)));
typedef float f32x4 __attribute__((ext_vector_type(4)));
typedef float f32x2 __attribute__((ext_vector_type(2)));
typedef unsigned u32x4 __attribute__((ext_vector_type(4)));
typedef unsigned u32x2 __attribute__((ext_vector_type(2)));
typedef __bf16 bf16x2_t __attribute__((ext_vector_type(2)));

#define DI __device__ __forceinline__
#define MFMA(a, b, c) __builtin_amdgcn_mfma_f32_32x32x16_bf16((a), (b), (c), 0, 0, 0)

DI unsigned pk2(float lo, float hi) { f32x2 v = {lo, hi}; bf16x2_t b = __builtin_convertvector(v, bf16x2_t); return __builtin_bit_cast(unsigned, b); }
DI bf16_t f2bf(float x) { return (bf16_t)(pk2(x, 0.f) & 0xffffu); }
DI float bflo(unsigned u) { return __uint_as_float(u << 16); }
DI float bfhi(unsigned u) { return __uint_as_float(u & 0xffff0000u); }
DI float bf2f(bf16_t b) { return __uint_as_float(((unsigned)b) << 16); }
DI int crow(int i, int h) { return (i & 3) + 8 * (i >> 2) + 4 * h; }
DI float fexp2(float x) { return __builtin_amdgcn_exp2f(x); }
DI int otid() { int t = threadIdx.x; asm volatile("" : "+v"(t)); return t; }
DI int wave_of(int tid) { return __builtin_amdgcn_readfirstlane(tid >> 6); }

constexpr int S = 16384, DM = 1024, ZP = 7680, DFF = 4096;
constexpr int ZC_CQ = 0, ZC_CKV = 384, ZC_KR = 640, ZC_QKVB = 768, ZC_QC = 3840, ZC_KC = 4352, ZC_GATE = 4608;
constexpr int GC_VB = 3840, GC_VC = 6016;
constexpr float LOG2E = 1.4426950408889634f, LN2 = 0.6931471805599453f;

constexpr size_t WT_IN = 0;
constexpr size_t WT_UQ = WT_IN + (size_t)9216 * 1024 * 2;
constexpr size_t WT_UKV = WT_UQ + (size_t)768 * 384 * 2;
constexpr size_t WT_BRA = WT_UKV + (size_t)1024 * 256 * 2;
constexpr size_t WT_BRB = WT_BRA + (size_t)1024 * 512 * 2;
constexpr size_t WT_BRC = WT_BRB + (size_t)1024 * 512 * 2;
constexpr size_t WT_OUT = WT_BRC + (size_t)1024 * 512 * 2;
constexpr size_t WT_UP = WT_OUT + (size_t)1024 * 3072 * 2;
constexpr size_t WT_DOWN = WT_UP + (size_t)4096 * 1024 * 2;
constexpr size_t OFF_CS = WT_DOWN + (size_t)1024 * 4096 * 2;
constexpr size_t OFF_BT = OFF_CS + (size_t)16384 * 16 * 8;
constexpr size_t OFF_Z = OFF_BT + 32768;
constexpr size_t OFF_H = OFF_Z + (size_t)S * ZP * 2;
constexpr size_t OFF_QA = OFF_H + (size_t)S * 1024 * 2;
constexpr size_t OFF_KA = OFF_QA + (size_t)S * 768 * 2;
constexpr size_t OFF_VAT = OFF_KA + (size_t)S * 512 * 2;
constexpr size_t OFF_VCT = OFF_VAT + (size_t)S * 512 * 2;
constexpr size_t OFF_OA = OFF_VCT + (size_t)S * 128 * 2;
constexpr size_t OFF_OB = OFF_OA + (size_t)S * 512 * 2;
constexpr size_t OFF_OC = OFF_OB + (size_t)S * 512 * 2;
constexpr size_t OFF_LSE = OFF_OC + (size_t)S * 512 * 2;
constexpr size_t OFF_SSQ = OFF_LSE + (size_t)3 * S * 8 * 4;
constexpr size_t OFF_VBT = OFF_SSQ + (size_t)3 * S * 4;
constexpr size_t OFF_BAR = OFF_VBT + (size_t)1536 * S * 2;
constexpr size_t WS_END = OFF_BAR + 16384;

constexpr int LDS_BYTES = 131072 + 1024;

struct Params {
  const float* x_prompt; const float* x_sample;
  const float* norm_mix; const float* w_in; const float* a_q_norm; const float* a_kv_norm; const float* a_w_uq; const float* a_w_ukv;
  const float* c_q_norm; const float* c_k_norm; const float* w_br_a; const float* w_br_b; const float* w_br_c; const float* w_out;
  const float* norm_ffn; const float* w_up; const float* w_down; const float* t5_table; const float* final_norm;
  float* out; char* ws;
};

DI void sincos_d(double x, float& c, float& s) {
  const double k = rint(x * 0.6366197723675814);
  double t = fma(-k, 1.5707963267948966, x); t = fma(-k, 6.123233995736766e-17, t);
  const double t2 = t * t;
  double sn = 1.0 - t2 / 210.0; sn = 1.0 - t2 / 156.0 * sn; sn = 1.0 - t2 / 110.0 * sn; sn = 1.0 - t2 / 72.0 * sn; sn = 1.0 - t2 / 42.0 * sn; sn = 1.0 - t2 / 20.0 * sn; sn = 1.0 - t2 / 6.0 * sn; sn *= t;
  double cs = 1.0 - t2 / 240.0; cs = 1.0 - t2 / 182.0 * cs; cs = 1.0 - t2 / 132.0 * cs; cs = 1.0 - t2 / 90.0 * cs; cs = 1.0 - t2 / 56.0 * cs; cs = 1.0 - t2 / 30.0 * cs; cs = 1.0 - t2 / 12.0 * cs; cs = 1.0 - t2 / 2.0 * cs;
  const int q = ((int)k) & 3;
  double so = (q == 0) ? sn : (q == 1) ? cs : (q == 2) ? -sn : -cs;
  double co = (q == 0) ? cs : (q == 1) ? -sn : (q == 2) ? -cs : sn;
  c = (float)co; s = (float)so;
}

DI void build_tables(const Params& p) {
  f32x2* CS = (f32x2*)(p.ws + OFF_CS);
  const int gsz = gridDim.x * 512, gid = blockIdx.x * 512 + otid();
  for (int e = gid; e < 16384 * 16; e += gsz) {
    const int pos = e >> 4, i = e & 15;
    double f = 1.0; for (int j = 0; j < i; ++j) f *= 0.5623413251903491;
    const float ff = (float)f; const float ang = (float)pos * ff;
    float c, s; sincos_d((double)ang, c, s);
    CS[e] = (f32x2){c, s};
  }
  float* BT = (float*)(p.ws + OFF_BT);
  for (int e = gid; e < 3 * 8 * 256; e += gsz) {
    const int gh = e >> 8, g = gh >> 3, hd = gh & 7, j = (e & 255) - 32;
    float v = 0.f;
    if (j >= 0 && j <= 128) {
      const int rel = (j - 64) << (2 * g);
      const int n = rel < 0 ? -rel : rel;
      int b = rel > 0 ? 16 : 0;
      if (n < 8) b += n; else { int lg = 31 - __clz(n); int vv = 5 + lg; b += (vv < 15 ? vv : 15); }
      v = p.t5_table[b * 24 + g * 8 + hd] * LOG2E;
    }
    BT[e] = v;
  }
}

DI void cvt_tile(const float* __restrict__ W, int ldw, int ldk, int koff, bf16_t* __restrict__ Wt, int k0, int n0, int mode, const float* __restrict__ rscale, float* tile) {
  const int tid = otid();
#pragma unroll
  for (int i = 0; i < 8; ++i) {
    const int kl = (tid >> 6) + 8 * i, nl = tid & 63, nn = n0 + nl;
    int src = nn;
    if (mode == 1) src = nn < 672 ? nn : (nn < 768 ? -1 : nn - 96);
    float v = 0.f;
    if (src >= 0) v = W[(size_t)(k0 + kl) * ldw + src];
    if (rscale) v *= rscale[k0 + kl];
    tile[kl * 65 + nl] = v;
  }
  __syncthreads();
#pragma unroll
  for (int i = 0; i < 8; ++i) {
    const int nl = (tid >> 6) + 8 * i, kl = tid & 63;
    Wt[(size_t)(n0 + nl) * ldk + koff + k0 + kl] = f2bf(tile[kl * 65 + nl]);
  }
  __syncthreads();
}

DI void convert_weights(const Params& p, int layer, char* smem) {
  float* tile = (float*)smem;
  int base = 0;
  for (int mtx = 0; mtx < 9; ++mtx) {
    const float* W; int K, Nsrc, Ndst, mode = 0, ldk = 0, koff = 0; const float* rs = nullptr; size_t off;
    switch (mtx) {
      case 0: W = p.w_in + (size_t)layer * 1024 * 9120; K = 1024; Nsrc = 9120; Ndst = 9216; mode = 1; off = WT_IN; break;
      case 1: W = p.a_w_uq + (size_t)layer * 384 * 768; K = 384; Nsrc = 768; Ndst = 768; rs = p.a_q_norm + layer * 384; off = WT_UQ; break;
      case 2: W = p.a_w_ukv + (size_t)layer * 256 * 1024; K = 256; Nsrc = 1024; Ndst = 1024; rs = p.a_kv_norm + layer * 256; off = WT_UKV; break;
      case 3: W = p.w_br_a + (size_t)layer * 512 * 1024; K = 512; Nsrc = 1024; Ndst = 1024; off = WT_BRA; break;
      case 4: W = p.w_br_b + (size_t)layer * 512 * 1024; K = 512; Nsrc = 1024; Ndst = 1024; off = WT_BRB; break;
      case 5: W = p.w_br_c + (size_t)layer * 512 * 1024; K = 512; Nsrc = 1024; Ndst = 1024; off = WT_BRC; break;
      case 6: W = p.w_out + (size_t)layer * 1024 * 1024; K = 1024; Nsrc = 1024; Ndst = 1024; off = WT_OUT; break;
      case 7: W = p.w_up + (size_t)layer * 1024 * 4096; K = 1024; Nsrc = 4096; Ndst = 4096; rs = p.norm_ffn + layer * DM; off = WT_UP; break;
      case 8: default: W = p.w_down + (size_t)layer * 4096 * 1024; K = 4096; Nsrc = 1024; Ndst = 1024; off = WT_DOWN; break;
    }
    if (ldk == 0) ldk = K;
    const int nk = K / 64, nn = Ndst / 64, cnt = nk * nn;
    bf16_t* Wt = (bf16_t*)(p.ws + off);
    int first = (int)blockIdx.x - (base % (int)gridDim.x); if (first < 0) first += gridDim.x;
    for (int it = first; it < cnt; it += gridDim.x) {
      const int kt = it % nk, nt = it / nk;
      cvt_tile(W, Nsrc, ldk, koff, Wt, kt * 64, nt * 64, mode, rs, tile);
    }
    base += cnt;
  }
}

DI void phase_norm(const float* __restrict__ x, const float* __restrict__ g, bf16_t* __restrict__ H, int rows) {
  const int tid = otid(), lane = tid & 63, wid = tid >> 6;
  for (int row = blockIdx.x * 8 + wid; row < rows; row += gridDim.x * 8) {
    const float* xr = x + (size_t)row * DM;
    f32x4 v[4]; float ss = 0.f;
#pragma unroll
    for (int i = 0; i < 4; ++i) { v[i] = *(const f32x4*)(xr + i * 256 + lane * 4); ss += v[i][0] * v[i][0] + v[i][1] * v[i][1] + v[i][2] * v[i][2] + v[i][3] * v[i][3]; }
#pragma unroll
    for (int o = 32; o >= 1; o >>= 1) ss += __shfl_xor(ss, o);
    const float rstd = rsqrtf(ss * (1.0f / DM) + 1e-6f);
#pragma unroll
    for (int i = 0; i < 4; ++i) {
      const f32x4 gg = *(const f32x4*)(g + i * 256 + lane * 4);
      u32x2 w; w.x = pk2(v[i][0] * rstd * gg[0], v[i][1] * rstd * gg[1]); w.y = pk2(v[i][2] * rstd * gg[2], v[i][3] * rstd * gg[3]);
      *(u32x2*)(H + (size_t)row * DM + i * 256 + lane * 4) = w;
    }
  }
}

DI void phase_final_norm(float* __restrict__ x, const float* __restrict__ g, int rows) {
  const int tid = otid(), lane = tid & 63, wid = tid >> 6;
  for (int row = blockIdx.x * 8 + wid; row < rows; row += gridDim.x * 8) {
    float* xr = x + (size_t)row * DM;
    f32x4 v[4]; float ss = 0.f;
#pragma unroll
    for (int i = 0; i < 4; ++i) { v[i] = *(const f32x4*)(xr + i * 256 + lane * 4); ss += v[i][0] * v[i][0] + v[i][1] * v[i][1] + v[i][2] * v[i][2] + v[i][3] * v[i][3]; }
#pragma unroll
    for (int o = 32; o >= 1; o >>= 1) ss += __shfl_xor(ss, o);
    const float rstd = rsqrtf(ss * (1.0f / DM) + 1e-6f);
#pragma unroll
    for (int i = 0; i < 4; ++i) {
      const f32x4 gg = *(const f32x4*)(g + i * 256 + lane * 4);
      f32x4 o = {v[i][0] * rstd * gg[0], v[i][1] * rstd * gg[1], v[i][2] * rstd * gg[2], v[i][3] * rstd * gg[3]};
      *(f32x4*)(xr + i * 256 + lane * 4) = o;
    }
  }
}


namespace pg8 {
#define PG8_LAS __attribute__((address_space(3)))
typedef unsigned short bf16_t;
typedef short bf16x8 __attribute__((ext_vector_type(8)));
typedef float f32x4 __attribute__((ext_vector_type(4)));
typedef unsigned u32x4 __attribute__((ext_vector_type(4)));
constexpr int BM = 256, BK = 64, HALF = 128, HTB = HALF * BK * 2  , STAGE_BYTES = 8 * HTB, NXCD = 8, WGM = 8;

__host__ __device__ __forceinline__ int lds_byte(int r, int c) { const int st = (r >> 4) * 2 + (c >> 5), rr = r & 15, cc = c & 31, ob = rr * 64 + cc * 2; return st * 1024 + (ob ^ (((ob >> 9) & 1) << 5)); }
__host__ __device__ __forceinline__ void stage_rc(int b, int& R, int& C) { const int st = b / 1024, sb = b % 1024, swz = sb ^ (((sb >> 9) & 1) << 5); R = (st >> 1) * 16 + swz / 64; C = (st & 1) * 32 + (swz % 64) / 2; }
__host__ __device__ __forceinline__ int perm32(int rho) { const int n = rho >> 4, i = rho & 15; return 8 * (i >> 2) + 4 * n + (i & 3); }

struct Unit { int pm, pn; };
struct Gemm { const bf16_t* A; const bf16_t* Bt; int M, N, K, lda, ldb; };

struct StaticOrder {
    int nM, nN, nwg, G, c;
    __host__ __device__ void init(int M, int N, int G_, int c_) { nM = M / BM; nN = N / BM; nwg = nM * nN; G = G_; c = c_; }
    __host__ __device__ bool next(int i, Unit& u) const {
        const long L = (long)i * G + c; if (L >= nwg) return false;
        map((int)L, u); return true; }
    __host__ __device__ void map(int L, Unit& u) const {
        int wgid = L; { const int q = nwg / NXCD, r = nwg % NXCD, xcd = wgid % NXCD, off = wgid / NXCD; wgid = (xcd < r ? xcd * (q + 1) : r * (q + 1) + (xcd - r) * q) + off; }
        const int nig = WGM * nN, gid = wgid / nig, fm = gid * WGM, gsz = (nM - fm) < WGM ? (nM - fm) : WGM;
        u.pm = fm + ((wgid % nig) % gsz); u.pn = (wgid % nig) / gsz;
    }
    __device__ __forceinline__ void a_ready(const Unit&) const {}
    __device__ __forceinline__ void done(const Unit&) const {}
};
template <class Epi, class Sched, bool ALIGN_EPI = false, bool SP2 = false>
__device__ __forceinline__ void gemm_phase(PG8_LAS unsigned char* lds, const Gemm g, const Sched& S, const Epi& E) {
    int tid_ = threadIdx.x; asm volatile("" : "+v"(tid_)); const int tid = tid_, wid = __builtin_amdgcn_readfirstlane(tid >> 6), lane = tid & 63, wr = wid >> 2, wc = wid & 3, fr = lane & 15, fq = lane >> 4;
    const int K = g.K, nt = K / BK;
    unsigned voffA[2], voffB[2];
#pragma unroll
    for (int i = 0; i < 2; ++i) { int R, C; stage_rc(tid * 16 + i * 8192, R, C); const int Rb = Epi::PERM ? ((R & ~31) + perm32(R & 31)) : R;
        voffA[i] = (unsigned)(R * g.lda + C) * 2u; voffB[i] = (unsigned)(Rb * g.ldb + C) * 2u; }
    const size_t kstep = (size_t)(BK * 2);
    const size_t hA = (size_t)HALF * g.lda * 2, hB = (size_t)HALF * g.ldb * 2;
    const size_t tA = 2 * hA, tB = 2 * hB;
    const unsigned ldsw = (unsigned)wid * 1024u;
    const int aoff = lds_byte(wr * 64 + fr, fq * 8), boff = lds_byte(wc * 32 + fr, fq * 8);
#define PG8_SA(b, h) (((b) * 2 + (h)) * HTB)
#define PG8_SB(b, h) ((4 + (b) * 2 + (h)) * HTB)
#define PG8_STAGE(bufoff, gbase, voff) do { _Pragma("unroll") for (int _i = 0; _i < 2; ++_i) \
        __builtin_amdgcn_global_load_lds((const unsigned*)((const char*)(gbase) + (voff)[_i]), (PG8_LAS unsigned*)(lds + (bufoff) + ldsw + _i * 8192), 16, 0, 0); } while (0)
#define PG8_LDA(dst, b, h) do { _Pragma("unroll") for (int m = 0; m < 4; ++m) _Pragma("unroll") for (int k = 0; k < 2; ++k) dst[m][k] = *(const PG8_LAS bf16x8*)(lds + PG8_SA(b, h) + aoff + m * 2048 + k * 1024); } while (0)
#define PG8_LDB(dst, b, h) do { _Pragma("unroll") for (int n = 0; n < 2; ++n) _Pragma("unroll") for (int k = 0; k < 2; ++k) dst[n][k] = *(const PG8_LAS bf16x8*)(lds + PG8_SB(b, h) + boff + n * 2048 + k * 1024); } while (0)
#define PG8_MMA(ai, bj, At, Bt) do { __builtin_amdgcn_s_setprio(1); _Pragma("unroll") for (int m = 0; m < 4; ++m) _Pragma("unroll") for (int n = 0; n < 2; ++n) _Pragma("unroll") for (int k = 0; k < 2; ++k) \
        acc[ai][bj][m][n] = __builtin_amdgcn_mfma_f32_16x16x32_bf16(Bt[n][k], At[m][k], acc[ai][bj][m][n], 0, 0, 0); __builtin_amdgcn_s_setprio(0); } while (0)
#define PG8_WAIT_V(n) asm volatile("s_waitcnt vmcnt(" #n ")" ::: "memory")
#define PG8_WAIT_L(n) asm volatile("s_waitcnt lgkmcnt(" #n ")" ::: "memory")
#define PG8_BAR __builtin_amdgcn_s_barrier()
#define PG8_SCHED __builtin_amdgcn_sched_barrier(0)
    Unit cur, nxt; int ui = 0;
    if (!S.next(0, cur)) return;
    f32x4 acc[2][2][4][2];
#pragma unroll
    for (int a = 0; a < 2; ++a)
#pragma unroll
        for (int b = 0; b < 2; ++b)
#pragma unroll
            for (int m = 0; m < 4; ++m)
#pragma unroll
                for (int n = 0; n < 2; ++n) acc[a][b][m][n] = (f32x4){0.f, 0.f, 0.f, 0.f};
    bf16x8 At[4][2], B0[2][2], B1[2][2];
    const char* cA = (const char*)g.A + (size_t)cur.pm * tA; const char* cB = (const char*)g.Bt + (size_t)cur.pn * tB;
    S.a_ready(cur);
    if constexpr (SP2) {
        PG8_STAGE(PG8_SB(0, 0), cB, voffB); PG8_STAGE(PG8_SB(0, 1), cB + hB, voffB); PG8_STAGE(PG8_SA(0, 0), cA, voffA); PG8_STAGE(PG8_SA(0, 1), cA + hA, voffA);
        if (wr == 1) PG8_BAR;
        PG8_WAIT_V(2); PG8_BAR;
        PG8_STAGE(PG8_SB(1, 0), cB + kstep, voffB); PG8_STAGE(PG8_SA(1, 0), cA + kstep, voffA); PG8_STAGE(PG8_SB(1, 1), cB + hB + kstep, voffB);
        PG8_WAIT_V(6); PG8_BAR;
    } else {
        PG8_STAGE(PG8_SB(0, 0), cB, voffB); PG8_STAGE(PG8_SA(0, 0), cA, voffA); PG8_STAGE(PG8_SB(0, 1), cB + hB, voffB); PG8_STAGE(PG8_SA(0, 1), cA + hA, voffA);
        if (wr == 1) PG8_BAR;
        PG8_WAIT_V(4); PG8_BAR;
        PG8_STAGE(PG8_SB(1, 0), cB + kstep, voffB); PG8_STAGE(PG8_SA(1, 0), cA + kstep, voffA); PG8_STAGE(PG8_SB(1, 1), cB + hB + kstep, voffB);
        PG8_WAIT_V(6); PG8_BAR;
    }
    for (;;) {
        const bool has_next = S.next(ui + 1, nxt);
        const char* nA = has_next ? (const char*)g.A + (size_t)nxt.pm * tA : cA; const char* nB = has_next ? (const char*)g.Bt + (size_t)nxt.pn * tB : cB;
_Pragma("unroll 1")
        for (int t = 0; t < nt; t += 2) {
            const bool last = (t == nt - 2);
            const char* a1 = cA + (size_t)(t + 1) * kstep;
            const char* a2 = last ? nA : cA + (size_t)(t + 2) * kstep; const char* b2 = last ? nB : cB + (size_t)(t + 2) * kstep;
            const char* a3 = a2 + kstep; const char* b3 = b2 + kstep;
            if (last && has_next) S.a_ready(nxt);
            if constexpr (SP2) {
            PG8_LDB(B0, 0, 0); PG8_LDB(B1, 0, 1); PG8_SCHED; PG8_LDA(At, 0, 0); PG8_STAGE(PG8_SA(1, 1), a1 + hA, voffA);
            PG8_WAIT_V(8); PG8_WAIT_L(0); PG8_BAR; PG8_MMA(0, 0, At, B0); PG8_MMA(0, 1, At, B1); PG8_BAR; PG8_SCHED;
            PG8_LDA(At, 0, 1); PG8_STAGE(PG8_SB(0, 0), b2, voffB); PG8_STAGE(PG8_SB(0, 1), b2 + hB, voffB); PG8_STAGE(PG8_SA(0, 0), a2, voffA);
            PG8_WAIT_V(8); PG8_WAIT_L(0); PG8_BAR; PG8_MMA(1, 0, At, B0); PG8_MMA(1, 1, At, B1); PG8_BAR; PG8_SCHED;
            PG8_LDB(B0, 1, 0); PG8_LDB(B1, 1, 1); PG8_SCHED; PG8_LDA(At, 1, 0); PG8_STAGE(PG8_SA(0, 1), a2 + hA, voffA);
            PG8_WAIT_V(8); PG8_WAIT_L(0); PG8_BAR; PG8_MMA(0, 0, At, B0); PG8_MMA(0, 1, At, B1); PG8_BAR; PG8_SCHED;
            PG8_LDA(At, 1, 1); PG8_STAGE(PG8_SB(1, 0), b3, voffB); PG8_STAGE(PG8_SB(1, 1), b3 + hB, voffB); PG8_STAGE(PG8_SA(1, 0), a3, voffA);
            PG8_WAIT_V(8); PG8_WAIT_L(0); PG8_BAR; PG8_MMA(1, 0, At, B0); PG8_MMA(1, 1, At, B1); PG8_BAR; PG8_SCHED;
            } else {
            PG8_LDB(B0, 0, 0); PG8_SCHED; PG8_LDA(At, 0, 0); PG8_STAGE(PG8_SA(1, 1), a1 + hA, voffA);
            PG8_WAIT_L(8); PG8_BAR; PG8_WAIT_L(0); PG8_MMA(0, 0, At, B0); PG8_BAR; PG8_SCHED;
            PG8_LDB(B1, 0, 1); PG8_STAGE(PG8_SB(0, 0), b2, voffB);
            PG8_BAR; PG8_WAIT_L(0); PG8_MMA(0, 1, At, B1); PG8_BAR;
            PG8_LDA(At, 0, 1); PG8_STAGE(PG8_SA(0, 0), a2, voffA);
            PG8_BAR; PG8_WAIT_L(0); PG8_MMA(1, 0, At, B0); PG8_BAR; PG8_SCHED;
            PG8_STAGE(PG8_SB(0, 1), b2 + hB, voffB);
            PG8_WAIT_V(6); PG8_BAR; PG8_MMA(1, 1, At, B1); PG8_BAR;
            PG8_LDB(B0, 1, 0); PG8_SCHED; PG8_LDA(At, 1, 0); PG8_STAGE(PG8_SA(0, 1), a2 + hA, voffA);
            PG8_WAIT_L(8); PG8_BAR; PG8_WAIT_L(0); PG8_MMA(0, 0, At, B0); PG8_BAR; PG8_SCHED;
            PG8_LDB(B1, 1, 1); PG8_STAGE(PG8_SB(1, 0), b3, voffB);
            PG8_BAR; PG8_WAIT_L(0); PG8_MMA(0, 1, At, B1); PG8_BAR;
            PG8_LDA(At, 1, 1); PG8_STAGE(PG8_SA(1, 0), a3, voffA);
            PG8_BAR; PG8_WAIT_L(0); PG8_MMA(1, 0, At, B0); PG8_BAR; PG8_SCHED;
            PG8_STAGE(PG8_SB(1, 1), b3 + hB, voffB);
            PG8_WAIT_V(6); PG8_BAR; PG8_MMA(1, 1, At, B1); PG8_BAR;
            }
        }
        if constexpr (ALIGN_EPI) { if (wr == 0) PG8_BAR; }
        if constexpr (!Epi::AFTER_DRAIN) { E(acc, cur, wr, wc, fr, fq); S.done(cur); }
        if (!has_next) break;
#pragma unroll
        for (int a = 0; a < 2; ++a)
#pragma unroll
            for (int b = 0; b < 2; ++b)
#pragma unroll
                for (int m = 0; m < 4; ++m)
#pragma unroll
                    for (int n = 0; n < 2; ++n) acc[a][b][m][n] = (f32x4){0.f, 0.f, 0.f, 0.f};
        cur = nxt; cA = nA; cB = nB; ++ui;
        if constexpr (ALIGN_EPI) { if (wr == 1) PG8_BAR; }
    }
    PG8_WAIT_V(0);
    if constexpr (!ALIGN_EPI) { if (wr == 0) PG8_BAR; }
    PG8_BAR;
    if constexpr (Epi::AFTER_DRAIN) { E.fused(acc, cur, wr, wc, fr, fq, lds, wid, lane); S.done(cur); }
#undef PG8_SA
#undef PG8_SB
#undef PG8_STAGE
#undef PG8_LDA
#undef PG8_LDB
#undef PG8_MMA
#undef PG8_WAIT_V
#undef PG8_WAIT_L
#undef PG8_BAR
#undef PG8_SCHED
}
}

DI void rope_pair8(float (&x1)[8], float (&x2)[8], const f32x2* cs) {
#pragma unroll
  for (int j = 0; j < 8; ++j) { const f32x2 c = cs[j]; const float a = x1[j], b = x2[j]; x1[j] = a * c.x - b * c.y; x2[j] = a * c.y + b * c.x; }
}
typedef pg8::Unit Unit;
#define ACC_T const f32x4 (&acc)[2][2][4][2]
#define EROW(u, ai, m) ((u).pm * 256 + (ai) * 128 + wr * 64 + (m) * 16 + fr)
DI u32x4 pack_f8(const f32x4 a, const f32x4 b) { u32x4 w; w.x = pk2(a[0], a[1]); w.y = pk2(a[2], a[3]); w.z = pk2(b[0], b[1]); w.w = pk2(b[2], b[3]); return w; }

struct EpiInproj {
  static constexpr bool PERM = true, AFTER_DRAIN = false;
  bf16_t* Z; bf16_t* VCT; bf16_t* VBT; float* ssq_q; float* ssq_kv;
  DI void operator()(ACC_T, const Unit& u, int wr, int wc, int fr, int fq) const {
#pragma unroll
    for (int bj = 0; bj < 2; ++bj) {
      const int tt = 2 * u.pn + bj, cb = tt * 128 + wc * 32 + 8 * fq;
      int sh = 0; if (tt >= 6 && tt < 42) sh = 2 * (((tt - 6) >> 2) % 3);
      const int msk = (1 << sh) - 1;
      if (tt >= 38 && tt < 42) {
        bf16_t* vt = VBT + (size_t)(cb - GC_VB) * S + fr * (S >> 4) + u.pm * 16 + wr * 4;
#pragma unroll
        for (int ai = 0; ai < 2; ++ai)
#pragma unroll
          for (int n = 0; n < 2; ++n) {
            __builtin_amdgcn_sched_barrier(0);
#pragma unroll
            for (int e = 0; e < 4; ++e) {
              u32x2 w; w.x = pk2(acc[ai][bj][0][n][e], acc[ai][bj][1][n][e]); w.y = pk2(acc[ai][bj][2][n][e], acc[ai][bj][3][n][e]);
              *(u32x2*)(vt + (size_t)(4 * n + e) * S + ai * 8) = w;
            }
          }
      } else if (tt == 47 || (tt >= 30 && tt < 38)) {
        bf16_t* vt = (tt == 47) ? VCT + (size_t)(cb - GC_VC) * S : VBT + (size_t)(cb - GC_VB) * S;
#pragma unroll
        for (int ai = 0; ai < 2; ++ai)
#pragma unroll
          for (int m = 0; m < 4; ++m) {
            __builtin_amdgcn_sched_barrier(0);
            const int row = EROW(u, ai, m), prow = (row & msk) * (S >> sh) + (row >> sh);
            bf16_t* vp = vt + prow;
#pragma unroll
            for (int n = 0; n < 2; ++n)
#pragma unroll
              for (int e = 0; e < 4; ++e) vp[(size_t)(4 * n + e) * S] = f2bf(acc[ai][bj][m][n][e]);
          }
      } else {
        const int zc = cb < GC_VB ? cb : cb - 1536;
        float* ssq = (tt < 3) ? ssq_q : ((tt < 5) ? ssq_kv : nullptr);
#pragma unroll
        for (int ai = 0; ai < 2; ++ai)
#pragma unroll
          for (int m = 0; m < 4; ++m) {
            const int row = EROW(u, ai, m), prow = (row & msk) * (S >> sh) + (row >> sh);
            const f32x4 v0 = acc[ai][bj][m][0], v1 = acc[ai][bj][m][1];
            *(u32x4*)(Z + (size_t)prow * ZP + zc) = pack_f8(v0, v1);
            if (ssq) {
              float s = v0[0] * v0[0] + v0[1] * v0[1] + v0[2] * v0[2] + v0[3] * v0[3] + v1[0] * v1[0] + v1[1] * v1[1] + v1[2] * v1[2] + v1[3] * v1[3];
              s += __shfl_xor(s, 16); s += __shfl_xor(s, 32);
              if (fq == 0) __hip_atomic_fetch_add(ssq + row, s, __ATOMIC_RELAXED, __HIP_MEMORY_SCOPE_AGENT);
            }
          }
      }
    }
  }
};
struct EpiUpQ {
  static constexpr bool PERM = true, AFTER_DRAIN = false;
  bf16_t* QA; const float* ssq;
  DI void operator()(ACC_T, const Unit& u, int wr, int wc, int fr, int fq) const {
#pragma unroll
    for (int ai = 0; ai < 2; ++ai)
#pragma unroll
      for (int m = 0; m < 4; ++m) {
        const int row = EROW(u, ai, m); const float rs = rsqrtf(ssq[row] * (1.0f / 384.0f) + 1e-6f);
#pragma unroll
        for (int bj = 0; bj < 2; ++bj) {
          const int cb = u.pn * 256 + bj * 128 + wc * 32 + 8 * fq;
          *(u32x4*)(QA + (size_t)row * 768 + cb) = pack_f8(acc[ai][bj][m][0] * rs, acc[ai][bj][m][1] * rs);
        }
      }
  }
};
struct EpiUpKV {
  static constexpr bool PERM = true, AFTER_DRAIN = false;
  bf16_t* KA; bf16_t* VAT; const float* ssq;
  DI void operator()(ACC_T, const Unit& u, int wr, int wc, int fr, int fq) const {
#pragma unroll
    for (int ai = 0; ai < 2; ++ai)
#pragma unroll
      for (int m = 0; m < 4; ++m) {
        __builtin_amdgcn_sched_barrier(0);
        const int row = EROW(u, ai, m); const float rs = rsqrtf(ssq[row] * (1.0f / 256.0f) + 1e-6f);
#pragma unroll
        for (int bj = 0; bj < 2; ++bj) {
          const int head = 2 * u.pn + bj, w0 = wc * 32 + 8 * fq;
          if (wc < 2) {
            *(u32x4*)(KA + (size_t)row * 512 + head * 64 + w0) = pack_f8(acc[ai][bj][m][0] * rs, acc[ai][bj][m][1] * rs);
          } else {
            bf16_t* vp = VAT + (size_t)(head * 64 + w0 - 64) * S + row;
#pragma unroll
            for (int n = 0; n < 2; ++n)
#pragma unroll
              for (int e = 0; e < 4; ++e) vp[(size_t)(4 * n + e) * S] = f2bf(acc[ai][bj][m][n][e] * rs);
          }
        }
      }
  }
};
struct EpiMerge {
  static constexpr bool PERM = true, AFTER_DRAIN = false;
  const bf16_t* Z; bf16_t* MIX;
  DI void operator()(ACC_T, const Unit& u, int wr, int wc, int fr, int fq) const {
    const int b = u.pm >> 6, pm = u.pm & 63, pn = u.pn & 3;
#pragma unroll
    for (int ai = 0; ai < 2; ++ai)
#pragma unroll
      for (int m = 0; m < 4; ++m) {
        const int row = pm * 256 + ai * 128 + wr * 64 + m * 16 + fr;
#pragma unroll
        for (int bj = 0; bj < 2; ++bj) {
          const int col = pn * 256 + bj * 128 + wc * 32 + 8 * fq;
          const u32x4 g = *(const u32x4*)(Z + (size_t)row * ZP + ZC_GATE + b * 1024 + col);
          f32x4 v0 = acc[ai][bj][m][0], v1 = acc[ai][bj][m][1];
#pragma unroll
          for (int q = 0; q < 2; ++q) {
            v0[2 * q] *= __builtin_amdgcn_rcpf(1.0f + __expf(-bflo(g[q]))); v0[2 * q + 1] *= __builtin_amdgcn_rcpf(1.0f + __expf(-bfhi(g[q])));
            v1[2 * q] *= __builtin_amdgcn_rcpf(1.0f + __expf(-bflo(g[2 + q]))); v1[2 * q + 1] *= __builtin_amdgcn_rcpf(1.0f + __expf(-bfhi(g[2 + q])));
          }
          bf16_t* mp = MIX + (size_t)row * DM + col;
          if (b > 0) { const u32x4 o = *(const u32x4*)mp;
#pragma unroll
            for (int q = 0; q < 2; ++q) { v0[2 * q] += bflo(o[q]); v0[2 * q + 1] += bfhi(o[q]); v1[2 * q] += bflo(o[2 + q]); v1[2 * q + 1] += bfhi(o[2 + q]); } }
          *(u32x4*)mp = pack_f8(v0, v1);
        }
      }
  }
};
template <bool NORM_OUT> struct EpiResid {
  static constexpr bool PERM = false, AFTER_DRAIN = false;
  const float* xs; float* xd; bf16_t* xb; float* ssq;
  DI void operator()(ACC_T, const Unit& u, int wr, int wc, int fr, int fq) const {
#pragma unroll
    for (int ai = 0; ai < 2; ++ai)
#pragma unroll
      for (int m = 0; m < 4; ++m) {
        const int row = EROW(u, ai, m);
        const size_t ro = (size_t)row * DM + u.pn * 256 + wc * 32 + 4 * fq;
        float ss = 0.f;
#pragma unroll
        for (int bj = 0; bj < 2; ++bj)
#pragma unroll
          for (int n = 0; n < 2; ++n) {
            const size_t o = ro + bj * 128 + n * 16; const f32x4 x = *(const f32x4*)(xs + o) + acc[ai][bj][m][n]; *(f32x4*)(xd + o) = x;
            if (NORM_OUT) { u32x2 w; w.x = pk2(x[0], x[1]); w.y = pk2(x[2], x[3]); *(u32x2*)(xb + o) = w; ss += x[0] * x[0] + x[1] * x[1] + x[2] * x[2] + x[3] * x[3]; }
          }
        if (NORM_OUT) { ss += __shfl_xor(ss, 16); ss += __shfl_xor(ss, 32); if (fq == 0) __hip_atomic_fetch_add(ssq + row, ss, __ATOMIC_RELAXED, __HIP_MEMORY_SCOPE_AGENT); }
      }
  }
};
struct EpiRelu2 {
  static constexpr bool PERM = true, AFTER_DRAIN = false;
  bf16_t* HID; const float* ssq;
  DI void operator()(ACC_T, const Unit& u, int wr, int wc, int fr, int fq) const {
#pragma unroll
    for (int ai = 0; ai < 2; ++ai)
#pragma unroll
      for (int m = 0; m < 4; ++m) {
        const int row = EROW(u, ai, m); const float rs = rsqrtf(ssq[row] * (1.0f / DM) + 1e-6f);
#pragma unroll
        for (int bj = 0; bj < 2; ++bj) {
          f32x4 v0 = acc[ai][bj][m][0], v1 = acc[ai][bj][m][1];
#pragma unroll
          for (int e = 0; e < 4; ++e) { const float a = fmaxf(v0[e], 0.f) * rs, c = fmaxf(v1[e], 0.f) * rs; v0[e] = a * a; v1[e] = c * c; }
          *(u32x4*)(HID + (size_t)row * DFF + u.pn * 256 + bj * 128 + wc * 32 + 8 * fq) = pack_f8(v0, v1);
        }
      }
  }
};
struct DiagOrder {
  pg8::StaticOrder so; int G, c;
  DI void init(int G_, int c_) { so.init(S, 1024, G_, c_); G = G_; c = c_; }
  DI bool next(int i, Unit& u) const { const int tile = (i / 3) * G + c, b = i % 3; if (tile >= 256) return false; so.map(tile, u); u.pm += 64 * b; u.pn += 4 * b; return true; }
  DI void a_ready(const Unit&) const {}
  DI void done(const Unit&) const {}
};
#define GEMM_LDS ((PG8_LAS unsigned char*)smem)

DI void phase_kpost(const Params& p, int layer) {
  bf16_t* Z = (bf16_t*)(p.ws + OFF_Z);
  const f32x2* CS = (const f32x2*)(p.ws + OFF_CS);
  for (int it = (int)gridDim.x - 1 - (int)blockIdx.x; it < 96; it += gridDim.x) {
      const int tid = otid();
      const int idx = it * 512 + tid;
      const int unit = idx / S, tkn = idx % S;
      if (unit < 2) {
        bf16_t* kp = Z + (size_t)tkn * ZP + ZC_KC + unit * 64;
        float x[8][8]; float ss = 0.f;
#pragma unroll
        for (int c = 0; c < 8; ++c) { const u32x4 v = *(const u32x4*)(kp + c * 8);
#pragma unroll
          for (int q = 0; q < 4; ++q) { x[c][2 * q] = bflo(v[q]); x[c][2 * q + 1] = bfhi(v[q]); ss += x[c][2 * q] * x[c][2 * q] + x[c][2 * q + 1] * x[c][2 * q + 1]; } }
        const float rs = rsqrtf(ss * (1.0f / 64.0f) + 1e-6f);
        const float* gk = p.c_k_norm + layer * 64;
#pragma unroll
        for (int c = 0; c < 8; ++c)
#pragma unroll
          for (int q = 0; q < 8; ++q) x[c][q] *= rs * gk[c * 8 + q];
        const f32x2* cr = CS + (size_t)(tkn >> 6) * 16; const f32x2* cc = CS + (size_t)(tkn & 63) * 16;
        rope_pair8(x[0], x[2], cr); rope_pair8(x[1], x[3], cr + 8);
        rope_pair8(x[4], x[6], cc); rope_pair8(x[5], x[7], cc + 8);
#pragma unroll
        for (int c = 0; c < 8; ++c) { u32x4 w; w.x = pk2(x[c][0], x[c][1]); w.y = pk2(x[c][2], x[c][3]); w.z = pk2(x[c][4], x[c][5]); w.w = pk2(x[c][6], x[c][7]); *(u32x4*)(kp + c * 8) = w; }
      } else {
        bf16_t* kp = Z + (size_t)tkn * ZP + ZC_KR;
        float x[4][8];
#pragma unroll
        for (int c = 0; c < 4; ++c) { const u32x4 v = *(const u32x4*)(kp + c * 8);
#pragma unroll
          for (int q = 0; q < 4; ++q) { x[c][2 * q] = bflo(v[q]); x[c][2 * q + 1] = bfhi(v[q]); } }
        const f32x2* cp = CS + (size_t)tkn * 16;
        rope_pair8(x[0], x[2], cp); rope_pair8(x[1], x[3], cp + 8);
#pragma unroll
        for (int c = 0; c < 4; ++c) { u32x4 w; w.x = pk2(x[c][0], x[c][1]); w.y = pk2(x[c][2], x[c][3]); w.z = pk2(x[c][4], x[c][5]); w.w = pk2(x[c][6], x[c][7]); *(u32x4*)(kp + c * 8) = w; }
      }
  }
}

DI bf16x8 pack8(float a0, float a1, float a2, float a3, float a4, float a5, float a6, float a7) {
  u32x4 w; w.x = pk2(a0, a1); w.y = pk2(a2, a3); w.z = pk2(a4, a5); w.w = pk2(a6, a7); return __builtin_bit_cast(bf16x8, w);
}
DI void unpack8(const u32x4 v, float (&x)[8]) {
#pragma unroll
  for (int q = 0; q < 4; ++q) { x[2 * q] = bflo(v[q]); x[2 * q + 1] = bfhi(v[q]); }
}

DI void store_o_wide(bf16_t* rowp, const f32x16& o, float inv, int h) {
#pragma unroll
  for (int pr = 0; pr < 2; ++pr) {
    const int g = 2 * pr;
    const unsigned ax = pk2(o[4 * g] * inv, o[4 * g + 1] * inv), ay = pk2(o[4 * g + 2] * inv, o[4 * g + 3] * inv);
    const unsigned bx = pk2(o[4 * g + 4] * inv, o[4 * g + 5] * inv), by = pk2(o[4 * g + 6] * inv, o[4 * g + 7] * inv);
    const auto sx = __builtin_amdgcn_permlane32_swap(ax, bx, false, false);
    const auto sy = __builtin_amdgcn_permlane32_swap(ay, by, false, false);
    const u32x4 w = {sx[0], sy[0], sx[1], sy[1]};
    *(u32x4*)(rowp + 8 * (g + h)) = w;
  }
}

constexpr int ATT_STAGE = 20480;

template <int TYPE, bool FIXREF>
DI void attn_dense_unit(const Params& p, int layer, int head, int qb, char* lds, float bref) {
  constexpr int NQK = TYPE == 0 ? 6 : 4;
  const int tid = otid(), lane = tid & 63, wid = wave_of(tid), r = lane & 31, h = lane >> 5;
  const bf16_t* Z = (const bf16_t*)(p.ws + OFF_Z);
  const f32x2* CS = (const f32x2*)(p.ws + OFF_CS);
  const bf16_t* Kn; int ldk; const bf16_t* VT; bf16_t* O;
  if (TYPE == 0) { Kn = (const bf16_t*)(p.ws + OFF_KA) + head * 64; ldk = 512; VT = (const bf16_t*)(p.ws + OFF_VAT) + (size_t)head * 64 * S; O = (bf16_t*)(p.ws + OFF_OA); }
  else { const int kvh = head >> 2; Kn = Z + ZC_KC + kvh * 64; ldk = ZP; VT = (const bf16_t*)(p.ws + OFF_VCT) + (size_t)kvh * 64 * S; O = (bf16_t*)(p.ws + OFF_OC); }
  const int q = qb * 256 + wid * 32 + r;
  bf16x8 qf[NQK];
  if (TYPE == 0) {
    const bf16_t* qp = (const bf16_t*)(p.ws + OFF_QA) + (size_t)q * 768 + head * 96 + 8 * h;
    float x[6][8];
#pragma unroll
    for (int d0 = 0; d0 < 6; ++d0) unpack8(*(const u32x4*)(qp + d0 * 16), x[d0]);
    rope_pair8(x[4], x[5], CS + (size_t)q * 16 + 8 * h);
    const float sc = 0.10206207261596577f * LOG2E;
#pragma unroll
    for (int d0 = 0; d0 < 6; ++d0) qf[d0] = pack8(x[d0][0] * sc, x[d0][1] * sc, x[d0][2] * sc, x[d0][3] * sc, x[d0][4] * sc, x[d0][5] * sc, x[d0][6] * sc, x[d0][7] * sc);
  } else {
    const bf16_t* qp = Z + (size_t)q * ZP + ZC_QC + head * 64 + 8 * h;
    float x[4][8]; float ss = 0.f;
#pragma unroll
    for (int d0 = 0; d0 < 4; ++d0) { unpack8(*(const u32x4*)(qp + d0 * 16), x[d0]);
#pragma unroll
      for (int j = 0; j < 8; ++j) ss += x[d0][j] * x[d0][j]; }
    ss += __shfl_xor(ss, 32);
    const float rs = rsqrtf(ss * (1.0f / 64.0f) + 1e-6f);
    const float* gq = p.c_q_norm + layer * 64;
#pragma unroll
    for (int d0 = 0; d0 < 4; ++d0)
#pragma unroll
      for (int j = 0; j < 8; ++j) x[d0][j] *= rs * gq[d0 * 16 + 8 * h + j];
    rope_pair8(x[0], x[1], CS + (size_t)(q >> 6) * 16 + 8 * h);
    rope_pair8(x[2], x[3], CS + (size_t)(q & 63) * 16 + 8 * h);
    const float sc = 0.125f * LOG2E;
#pragma unroll
    for (int d0 = 0; d0 < 4; ++d0) qf[d0] = pack8(x[d0][0] * sc, x[d0][1] * sc, x[d0][2] * sc, x[d0][3] * sc, x[d0][4] * sc, x[d0][5] * sc, x[d0][6] * sc, x[d0][7] * sc);
  }
  typedef __attribute__((address_space(3))) unsigned lds_u32;
  const int srow = tid >> 3, sch = (tid & 7) ^ ((srow >> 1) & 7);
  const bf16_t* gk = Kn + (size_t)srow * ldk + sch * 8;
  const bf16_t* gv = VT + (size_t)srow * S + sch * 8;
  const int rrow = tid >> 2, rch = (tid & 3) ^ ((rrow >> 2) & 3);
  const bf16_t* gr = Z + ZC_KR + (size_t)rrow * ZP + rch * 8;
  char* wbase = lds + wid * 1024;
#define DMA(t, soff) do { \
    __builtin_amdgcn_global_load_lds((const unsigned*)(gk + (size_t)(t) * 64 * ldk), (lds_u32*)(wbase + (soff)), 16, 0, 0); \
    __builtin_amdgcn_global_load_lds((const unsigned*)(gv + (size_t)(t) * 64), (lds_u32*)(wbase + (soff) + 8192), 16, 0, 0); \
    if (TYPE == 0 && wid < 4) __builtin_amdgcn_global_load_lds((const unsigned*)(gr + (size_t)(t) * 64 * ZP), (lds_u32*)(wbase + (soff) + 16384), 16, 0, 0); } while (0)
#define DMA_WAIT(keep) do { if (keep) { if (TYPE == 0 && wid < 4) asm volatile("s_waitcnt vmcnt(3)" ::: "memory"); else asm volatile("s_waitcnt vmcnt(2)" ::: "memory"); } \
    else asm volatile("s_waitcnt vmcnt(0)" ::: "memory"); } while (0)
#define BAR() do { asm volatile("s_waitcnt lgkmcnt(0)" ::: "memory"); __builtin_amdgcn_s_barrier(); asm volatile("" ::: "memory"); } while (0)
  constexpr int NONES = (TYPE == 0) ? 0 : 2;
  float m_run = 0.f, lsum = 0.f, ls0 = 0.f, ls1 = 0.f, ls2 = 0.f; f32x16 o0, o1, negm, la;
#pragma unroll
  for (int i = 0; i < 16; ++i) { o0[i] = 0.f; o1[i] = 0.f; negm[i] = 0.f; la[i] = 0.f; }
  const bf16x8 ones = {0x3F80, 0x3F80, 0x3F80, 0x3F80, 0x3F80, 0x3F80, 0x3F80, 0x3F80};
  const int rK = (r & ~12) | ((r & 4) << 1) | ((r & 8) >> 1);
  const int ksw = (rK >> 1) & 7, rsw = (rK >> 2) & 3, vsw = (r >> 1) & 7;
  int koff[4], roff[2], voff[4];
#pragma unroll
  for (int d0 = 0; d0 < 4; ++d0) { koff[d0] = rK * 128 + (((2 * d0 + h) ^ ksw) << 4); voff[d0] = 8192 + r * 128 + (((2 * d0 + h) ^ vsw) << 4); }
#pragma unroll
  for (int d0 = 0; d0 < 2; ++d0) roff[d0] = 16384 + rK * 64 + (((2 * d0 + h) ^ rsw) << 4);
  constexpr int NT = S / 64;
  constexpr float THR = 8.0f;
#define SB() __builtin_amdgcn_sched_barrier(0)
#define QKR(d0, K0, K1, SOFF) do { if ((d0) < 4) { K0 = *(const bf16x8*)(lds + (SOFF) + koff[(d0) & 3]); K1 = *(const bf16x8*)(lds + (SOFF) + 32 * 128 + koff[(d0) & 3]); } \
    else if ((d0) < NQK) { K0 = *(const bf16x8*)(lds + (SOFF) + roff[(d0) & 1]); K1 = *(const bf16x8*)(lds + (SOFF) + 32 * 64 + roff[(d0) & 1]); } } while (0)
#define QKM(N0, N1, d0, K0, K1) do { if ((d0) == 0) { N0 = MFMA(K0, qf[0], negm); N1 = MFMA(K1, qf[0], negm); } \
    else if ((d0) < NQK) { N0 = MFMA(K0, qf[(d0) < NQK ? (d0) : 0], N0); N1 = MFMA(K1, qf[(d0) < NQK ? (d0) : 0], N1); } } while (0)
#define EX4(CC, B, SI) do { if (!FIXREF) __builtin_amdgcn_s_setprio(1); _Pragma("unroll") for (int i_ = 0; i_ < 4; ++i_) { CC[(B) + i_] = fexp2(CC[(B) + i_]); if ((SI) >= NONES) { if (i_ == 0) ls0 += CC[(B) + i_]; else if (i_ == 1) ls1 += CC[(B) + i_]; else if (i_ == 2) ls2 += CC[(B) + i_]; else lsum += CC[(B) + i_]; } } if (!FIXREF) __builtin_amdgcn_s_setprio(0); } while (0)
#define PK8(PF, CC, B) do { PF = pack8(CC[(B)], CC[(B) + 1], CC[(B) + 2], CC[(B) + 3], CC[(B) + 4], CC[(B) + 5], CC[(B) + 6], CC[(B) + 7]); } while (0)
#define VR(s_, V0, V1, SOFF) do { V0 = *(const bf16x8*)(lds + (SOFF) + voff[s_]); V1 = *(const bf16x8*)(lds + (SOFF) + 32 * 128 + voff[s_]); } while (0)
#define PVM(s_, V0, V1) do { o0 = MFMA(V0, pf[s_], o0); o1 = MFMA(V1, pf[s_], o1); if ((s_) < NONES) la = MFMA(ones, pf[s_], la); } while (0)
#define MAXG(NN, B) do { ma_ = fmaxf(fmaxf(ma_, NN[(B)]), NN[(B) + 1]); mb_ = fmaxf(fmaxf(mb_, NN[(B) + 2]), NN[(B) + 3]); \
    ma_ = fmaxf(fmaxf(ma_, NN[(B) + 4]), NN[(B) + 5]); mb_ = fmaxf(fmaxf(mb_, NN[(B) + 6]), NN[(B) + 7]); } while (0)
#define ROWMAX(P0, P1, MX) do { float a_ = fmaxf(fmaxf(P0[0], P0[1]), P1[0]), c_ = fmaxf(fmaxf(P0[2], P0[3]), P1[1]); a_ = fmaxf(fmaxf(a_, P1[2]), P1[3]); \
    _Pragma("unroll") for (int i_ = 4; i_ < 16; i_ += 4) { a_ = fmaxf(fmaxf(a_, P0[i_]), P0[i_ + 1]); c_ = fmaxf(fmaxf(c_, P0[i_ + 2]), P0[i_ + 3]); a_ = fmaxf(fmaxf(a_, P1[i_]), P1[i_ + 1]); c_ = fmaxf(fmaxf(c_, P1[i_ + 2]), P1[i_ + 3]); } \
    a_ = fmaxf(a_, c_); MX = fmaxf(a_, __shfl_xor(a_, 32)); } while (0)
#define RESCALE(P0, P1, DELTA) do { const float dl_ = (DELTA); m_run += dl_; const float al_ = fexp2(-dl_); lsum *= al_; ls0 *= al_; ls1 *= al_; ls2 *= al_; \
    _Pragma("unroll") for (int i_ = 0; i_ < 16; ++i_) { P0[i_] -= dl_; P1[i_] -= dl_; o0[i_] *= al_; o1[i_] *= al_; if (NONES > 0) la[i_] *= al_; negm[i_] = -m_run; } } while (0)
#define STEP(C0, C1, N0, N1, T, HAS_NEXT, HAS_LOAD, S0, S1, S3) do { \
    if (HAS_LOAD) DMA((T) + 3, S3); \
    bf16x8 pf[4]; bf16x8 ka0, ka1, kb0, kb1, va0, va1, vb0, vb1; \
    if (HAS_NEXT) QKR(0, ka0, ka1, S1); \
    SB(); if (HAS_NEXT) { QKR(1, kb0, kb1, S1); QKM(N0, N1, 0, ka0, ka1); } EX4(C0, 0, 0); \
    SB(); if (HAS_NEXT) { QKR(2, ka0, ka1, S1); QKM(N0, N1, 1, kb0, kb1); } EX4(C0, 4, 0); PK8(pf[0], C0, 0); \
    SB(); if (HAS_NEXT) { QKR(3, kb0, kb1, S1); QKM(N0, N1, 2, ka0, ka1); } EX4(C0, 8, 1); \
    SB(); if (HAS_NEXT) { QKR(4, ka0, ka1, S1); QKM(N0, N1, 3, kb0, kb1); } EX4(C0, 12, 1); PK8(pf[1], C0, 8); if (NQK == 4) VR(0, va0, va1, S0); \
    if (NQK > 4) { \
      SB(); if (HAS_NEXT) { QKR(5, kb0, kb1, S1); QKM(N0, N1, 4, ka0, ka1); } EX4(C1, 0, 2); \
      SB(); if (HAS_NEXT) QKM(N0, N1, 5, kb0, kb1); EX4(C1, 4, 2); PK8(pf[2], C1, 0); VR(0, va0, va1, S0); } \
    float ma_ = -1e30f, mb_ = -1e30f; \
    if (NQK == 4) { \
      SB(); VR(1, vb0, vb1, S0); PVM(0, va0, va1); EX4(C1, 0, 2); EX4(C1, 4, 2); PK8(pf[2], C1, 0); \
      SB(); VR(2, va0, va1, S0); PVM(1, vb0, vb1); EX4(C1, 8, 3); EX4(C1, 12, 3); PK8(pf[3], C1, 8); \
    } else { \
      SB(); VR(1, vb0, vb1, S0); PVM(0, va0, va1); EX4(C1, 8, 3); \
      SB(); VR(2, va0, va1, S0); PVM(1, vb0, vb1); EX4(C1, 12, 3); PK8(pf[3], C1, 8); } \
    SB(); VR(3, vb0, vb1, S0); PVM(2, va0, va1); if (HAS_NEXT && !FIXREF) { MAXG(N0, 0); MAXG(N0, 8); } \
    SB(); PVM(3, vb0, vb1); if (HAS_NEXT && !FIXREF) { MAXG(N1, 0); MAXG(N1, 8); } \
    SB(); \
    float mx_ = fmaxf(ma_, mb_); { const auto rr_ = __builtin_amdgcn_permlane32_swap(__float_as_uint(mx_), __float_as_uint(mx_), false, false); mx_ = fmaxf(__uint_as_float(rr_[0]), __uint_as_float(rr_[1])); } \
    DMA_WAIT(HAS_LOAD); BAR(); \
    if (HAS_NEXT && !FIXREF) { if (__any(mx_ > THR)) RESCALE(N0, N1, fmaxf(mx_, 0.f)); } } while (0)
  constexpr int R0 = 0, R1 = ATT_STAGE, R2 = 2 * ATT_STAGE, R3 = 3 * ATT_STAGE;
  f32x16 sA0, sA1, sB0, sB1;
  DMA(0, R0); DMA(1, R1); DMA(2, R2); DMA_WAIT(true); BAR();
  if (FIXREF) { m_run = bref;
#pragma unroll
    for (int i = 0; i < 16; ++i) negm[i] = -bref; }
  { bf16x8 ka0, ka1;
#pragma unroll
    for (int d0 = 0; d0 < NQK; ++d0) { QKR(d0, ka0, ka1, R0); QKM(sA0, sA1, d0, ka0, ka1); } }
  if (!FIXREF) { float mx0; ROWMAX(sA0, sA1, mx0); m_run = mx0;
#pragma unroll
    for (int i = 0; i < 16; ++i) { sA0[i] -= mx0; sA1[i] -= mx0; negm[i] = -mx0; } }
  for (int t = 0; t < NT - 4; t += 4) {
    STEP(sA0, sA1, sB0, sB1, t, true, true, R0, R1, R3);
    STEP(sB0, sB1, sA0, sA1, t + 1, true, true, R1, R2, R0);
    STEP(sA0, sA1, sB0, sB1, t + 2, true, true, R2, R3, R1);
    STEP(sB0, sB1, sA0, sA1, t + 3, true, true, R3, R0, R2);
  }
  STEP(sA0, sA1, sB0, sB1, NT - 4, true, true, R0, R1, R3);
  STEP(sB0, sB1, sA0, sA1, NT - 3, true, false, R1, R2, R0);
  STEP(sA0, sA1, sB0, sB1, NT - 2, true, false, R2, R3, R1);
  STEP(sB0, sB1, sA0, sA1, NT - 1, false, false, R3, R0, R2);
  lsum += ls0 + ls1 + ls2;
  const float l = (NONES > 0 ? la[0] : 0.f) + lsum + __shfl_xor(lsum, 32);
#undef DMA
#undef DMA_WAIT
#undef BAR
#undef SB
#undef QKR
#undef QKM
#undef EX4
#undef PK8
#undef VR
#undef PVM
#undef MAXG
#undef ROWMAX
#undef RESCALE
#undef STEP
  const float inv = 1.0f / l;
  bf16_t* op = O + (size_t)q * 512 + head * 64;
  store_o_wide(op, o0, inv, h); store_o_wide(op + 32, o1, inv, h);
}

constexpr int BLV = 49152;
DI void b_issue_k(const Params& p, int x, char* lds, int tid, int wid) {
  typedef __attribute__((address_space(3))) unsigned lds_u32;
  const int g = x >> 9, head = (x >> 6) & 7, blk256 = x & 63;
  const int sh = 2 * g, Ls = S >> sh, P0 = blk256 * 256, sub = P0 / Ls, i0 = P0 & (Ls - 1), sub0 = sub * Ls;
  const bf16_t* Zk = (const bf16_t*)(p.ws + OFF_Z) + ZC_QKVB + ((1 * 3 + g) * 8 + head) * 64;
#pragma unroll
  for (int i = 0; i < 6; ++i) {
    const int sl = i * 512 + tid, row = sl >> 3, c = (sl & 7) ^ ((row >> 1) & 7); int key = i0 - 64 + row; key = key < 0 ? 0 : (key > Ls - 1 ? Ls - 1 : key);
    __builtin_amdgcn_global_load_lds((const unsigned*)(Zk + (size_t)(sub0 + key) * ZP + c * 8), (lds_u32*)(lds + (i * 512 + wid * 64) * 16), 16, 0, 0);
  }
}
DI void b_issue_v(const Params& p, int x, char* lds, int tid, int wid) {
  typedef __attribute__((address_space(3))) unsigned lds_u32;
  const int g = x >> 9, head = (x >> 6) & 7, blk256 = x & 63;
  const int sh = 2 * g, Ls = S >> sh, P0 = blk256 * 256, sub = P0 / Ls, i0 = P0 & (Ls - 1), sub0 = sub * Ls;
  const bf16_t* VTg = (const bf16_t*)(p.ws + OFF_VBT) + (size_t)((g * 8 + head) * 64) * S + sub0;
#pragma unroll
  for (int i = 0; i < 6; ++i) {
    const int sl = i * 512 + tid, d = sl / 48, c = (sl - d * 48) ^ (d & 15); int k0 = i0 - 64 + 8 * c; k0 = k0 < 0 ? 0 : (k0 > Ls - 8 ? Ls - 8 : k0);
    __builtin_amdgcn_global_load_lds((const unsigned*)(VTg + (size_t)d * S + k0), (lds_u32*)(lds + BLV + (i * 512 + wid * 64) * 16), 16, 0, 0);
  }
}
DI void attn_b_item(const Params& p, int x, int xnext, char* lds) {
  const int tid = otid(), lane = tid & 63, wid = wave_of(tid), r = lane & 31, h = lane >> 5;
  const int g = x >> 9, head = (x >> 6) & 7, blk256 = x & 63;
  const bf16_t* Z = (const bf16_t*)(p.ws + OFF_Z);
  const int sh = 2 * g, Ls = S >> sh, P0 = blk256 * 256, sub = P0 / Ls, i0 = P0 & (Ls - 1);
  const bf16_t* Zq = Z + ZC_QKVB + ((0 * 3 + g) * 8 + head) * 64;
  constexpr int LV = BLV;
  const int i0w = i0 + 32 * wid;
  const float* BT = (const float*)(p.ws + OFF_BT) + (g * 8 + head) * 256 + 32 - r + 8 * h;
  const int rK = (r & ~12) | ((r & 4) << 1) | ((r & 8) >> 1);
  bf16x8 qf[4];
  {
    const bf16_t* qp = Zq + (size_t)(P0 + 32 * wid + r) * ZP + 8 * h; const float scq = 0.125f * LOG2E;
#pragma unroll
    for (int d0 = 0; d0 < 4; ++d0) { float x8[8]; unpack8(*(const u32x4*)(qp + d0 * 16), x8); qf[d0] = pack8(x8[0] * scq, x8[1] * scq, x8[2] * scq, x8[3] * scq, x8[4] * scq, x8[5] * scq, x8[6] * scq, x8[7] * scq); }
  }
  float bvs[5][16];
#pragma unroll
  for (int c = 0; c < 5; ++c)
#pragma unroll
    for (int i = 0; i < 16; ++i) bvs[c][i] = BT[32 * c + (i & 3) + 4 * ((i >> 2) & 1) + 16 * (i >> 3)];
  asm volatile("s_waitcnt vmcnt(0)" ::: "memory"); __builtin_amdgcn_s_barrier(); asm volatile("" ::: "memory");
#pragma unroll
  for (int c = 0; c < 5; ++c)
#pragma unroll
    for (int i = 0; i < 16; ++i) asm volatile("" : "+v"(bvs[c][i]));
  f32x16 sc[5];
  const int ksw = (rK >> 1) & 7;
#pragma unroll
  for (int c = 0; c < 5; ++c) {
#pragma unroll
    for (int i = 0; i < 16; ++i) sc[c][i] = 0.f;
    const char* kp = lds + (32 * wid + 32 * c + rK) * 128;
#pragma unroll
    for (int d0 = 0; d0 < 4; ++d0) { const bf16x8 kf = *(const bf16x8*)(kp + (((2 * d0 + h) ^ ksw) << 4)); sc[c] = MFMA(kf, qf[d0], sc[c]); }
  }
  asm volatile("s_waitcnt lgkmcnt(0)" ::: "memory"); __builtin_amdgcn_s_barrier(); asm volatile("" ::: "memory");
  if (xnext >= 0) b_issue_k(p, xnext, lds, tid, wid);
  float mxa[4] = {-1e30f, -1e30f, -1e30f, -1e30f};
#pragma unroll
  for (int c = 0; c < 5; ++c)
#pragma unroll
    for (int i = 0; i < 16; ++i) {
      const int prow = (i & 3) + 4 * ((i >> 2) & 1) + 8 * h + 16 * (i >> 3);
      const int rel = 32 * c - 64 + prow - r, key = i0w + r + rel;
      const bool valid = ((unsigned)(rel + 64) <= 128u) & ((unsigned)key < (unsigned)Ls);
      const float v = valid ? sc[c][i] + bvs[c][i] : -1e30f;
      sc[c][i] = v; mxa[i & 3] = fmaxf(mxa[i & 3], v);
    }
  float mx = fmaxf(fmaxf(mxa[0], mxa[1]), fmaxf(mxa[2], mxa[3]));
  mx = fmaxf(mx, __shfl_xor(mx, 32));
  float la4[4] = {0.f, 0.f, 0.f, 0.f};
#pragma unroll
  for (int c = 0; c < 5; ++c)
#pragma unroll
    for (int i = 0; i < 16; ++i) { const float e = fexp2(sc[c][i] - mx); sc[c][i] = e; la4[i & 3] += e; }
  float l = (la4[0] + la4[1]) + (la4[2] + la4[3]);
  l += __shfl_xor(l, 32);
  f32x16 o0, o1;
#pragma unroll
  for (int i = 0; i < 16; ++i) { o0[i] = 0.f; o1[i] = 0.f; }
  const char* vp = lds + LV + r * 768; const int vsw = r & 15;
#pragma unroll
  for (int c = 0; c < 5; ++c)
#pragma unroll
    for (int s = 0; s < 2; ++s) {
      const bf16x8 pf = pack8(sc[c][8 * s], sc[c][8 * s + 1], sc[c][8 * s + 2], sc[c][8 * s + 3], sc[c][8 * s + 4], sc[c][8 * s + 5], sc[c][8 * s + 6], sc[c][8 * s + 7]);
      const int ch = ((4 * wid + 4 * c + 2 * s + h) ^ vsw) << 4;
      const bf16x8 v0 = *(const bf16x8*)(vp + ch), v1 = *(const bf16x8*)(vp + 32 * 768 + ch);
      o0 = MFMA(v0, pf, o0); o1 = MFMA(v1, pf, o1);
    }
  asm volatile("s_waitcnt lgkmcnt(0)" ::: "memory"); __builtin_amdgcn_s_barrier(); asm volatile("" ::: "memory");
  if (xnext >= 0) b_issue_v(p, xnext, lds, tid, wid);
  const float inv = 1.0f / l;
  const int tkn = ((i0w + r) << sh) + sub;
  bf16_t* OG = (g < 2) ? (bf16_t*)(p.ws + OFF_H) + (size_t)g * S * 512 : (bf16_t*)(p.ws + OFF_OB);
  bf16_t* op = OG + (size_t)tkn * 512 + head * 64;
  store_o_wide(op, o0, inv, h); store_o_wide(op + 32, o1, inv, h);
  if (h == 0) { float* LSE = (float*)(p.ws + OFF_LSE); LSE[((size_t)g * S + tkn) * 8 + head] = (mx + __builtin_amdgcn_logf(l)) * LN2; }
}

DI void phase_attn(const Params& p, int layer, char* smem) {
  const int n_dense = 1024, n_b = 1536, total = n_dense + n_b;
  int it = blockIdx.x;
  for (; it < n_dense; it += gridDim.x) {
    if (it < 512) { attn_dense_unit<0, false>(p, layer, it & 7, it >> 3, smem, 0.f); }
    else { const int v = it - 512;
      float bref;
      { const int ln = otid() & 63; float gq = fabsf(p.c_q_norm[layer * 64 + ln]), gk = fabsf(p.c_k_norm[layer * 64 + ln]);
#pragma unroll
        for (int o = 32; o >= 1; o >>= 1) { gq = fmaxf(gq, __shfl_xor(gq, o)); gk = fmaxf(gk, __shfl_xor(gk, o)); }
        bref = 64.0f * gq * gk * 0.125f * LOG2E * 1.02f; }
      if (__builtin_amdgcn_readfirstlane(bref < 60.0f ? 1 : 0) != 0) attn_dense_unit<1, true>(p, layer, v & 7, v >> 3, smem, bref);
      else attn_dense_unit<1, false>(p, layer, v & 7, v >> 3, smem, 0.f); }
  }
  if (it < total) {
    const int tid = otid(), wid = wave_of(tid);
    b_issue_k(p, it - n_dense, smem, tid, wid); b_issue_v(p, it - n_dense, smem, tid, wid);
    for (; it < total; it += gridDim.x) {
      const int nx = it + (int)gridDim.x;
      attn_b_item(p, it - n_dense, nx < total ? nx - n_dense : -1, smem);
    }
  }
}

DI void phase_combine(const Params& p) {
  const bf16_t* G0 = (const bf16_t*)(p.ws + OFF_H); const bf16_t* G1 = G0 + (size_t)S * 512; bf16_t* OB = (bf16_t*)(p.ws + OFF_OB);
  const float* LSE = (const float*)(p.ws + OFF_LSE);
  for (int e = blockIdx.x * 512 + otid(); e < S * 64; e += gridDim.x * 512) {
    const int tkn = e >> 6, c = e & 63, head = c >> 3;
    const float l0 = LSE[((size_t)0 * S + tkn) * 8 + head], l1 = LSE[((size_t)1 * S + tkn) * 8 + head], l2 = LSE[((size_t)2 * S + tkn) * 8 + head];
    const float mm = fmaxf(l0, fmaxf(l1, l2));
    float w0 = __expf(l0 - mm), w1 = __expf(l1 - mm), w2 = __expf(l2 - mm);
    const float iw = 1.0f / (w0 + w1 + w2); w0 *= iw; w1 *= iw; w2 *= iw;
    const size_t off = (size_t)tkn * 512 + c * 8;
    const u32x4 a = *(const u32x4*)(G0 + off), b = *(const u32x4*)(G1 + off), d = *(const u32x4*)(OB + off);
    u32x4 o;
#pragma unroll
    for (int q = 0; q < 4; ++q) o[q] = pk2(w0 * bflo(a[q]) + w1 * bflo(b[q]) + w2 * bflo(d[q]), w0 * bfhi(a[q]) + w1 * bfhi(b[q]) + w2 * bfhi(d[q]));
    *(u32x4*)(OB + off) = o;
  }
}

#define XB_TMO      128
#define XB_XCNT(j)  (256  + 64 * (j))
#define XB_XSUB(j)  (1280 + 64 * (j))
#define XB_XGEN(j)  (2304 + 64 * (j))
#define XB_TOP      3328
#define XB_TOPGEN   3392
#define XCD_BAR_WORDS 3456
#define XB_SPIN_CAP (1u << 18)
#ifndef LAS
#define LAS __attribute__((address_space(3)))
#endif

__device__ __forceinline__ unsigned xb_ld(unsigned* p)              { return __hip_atomic_load(p, __ATOMIC_RELAXED, __HIP_MEMORY_SCOPE_AGENT); }
__device__ __forceinline__ unsigned xb_add(unsigned* p, unsigned v) { return __hip_atomic_fetch_add(p, v, __ATOMIC_RELAXED, __HIP_MEMORY_SCOPE_AGENT); }
__device__ __forceinline__ unsigned xb_xcc_id() { return (unsigned)__builtin_amdgcn_s_getreg((3 << 11) | 20) & 0xFu; }
#define XB_SPIN(cond, bar) do { unsigned _sp = 0; while (cond) { __builtin_amdgcn_s_sleep(1); \
    if ((++_sp & 255u) == 0u) { if (xb_ld(&(bar)[XB_TMO])) break; if (_sp > XB_SPIN_CAP) { atomicAdd(&(bar)[XB_TMO], 1u); break; } } } } while (0)

struct XcdBarrier {
    unsigned* bar; unsigned x;
    volatile LAS unsigned* st;
};

__device__ __forceinline__ XcdBarrier xcd_barrier_post(unsigned* bar, volatile LAS unsigned* st) {
    XcdBarrier b; b.bar = bar; b.x = xb_xcc_id(); b.st = st;
    if (threadIdx.x == 0) (void)xb_add(&bar[XB_XCNT(b.x)], 1u);
    return b;
}
__device__ __forceinline__ void xcd_barrier_complete(unsigned* bar, unsigned x, unsigned& nloc, unsigned& nx) {
    const unsigned G = gridDim.x * gridDim.y * gridDim.z;
    unsigned sum, cnt, mine, sp = 0u;
    for (;;) {
        sum = 0u; cnt = 0u; mine = 0u;
#pragma unroll
        for (unsigned j = 0; j < 16; ++j) { const unsigned c = xb_ld(&bar[XB_XCNT(j)]); sum += c; cnt += (c > 0u) ? 1u : 0u; mine = (j == x) ? c : mine; }
        if (sum == G) break;
        __builtin_amdgcn_s_sleep(1);
        if ((++sp & 255u) == 0u) { if (xb_ld(&bar[XB_TMO])) break; if (sp > XB_SPIN_CAP) { atomicAdd(&bar[XB_TMO], 1u); break; } }
    }
    nloc = mine > 0u ? mine : 1u; nx = cnt > 0u ? cnt : 1u;
}

__device__ __forceinline__ void xcd_barrier(const XcdBarrier& b) {
    asm volatile("s_waitcnt vmcnt(0)" ::: "memory");
    __syncthreads();
    if (threadIdx.x == 0) {
        unsigned* bar = b.bar;
        __builtin_amdgcn_s_waitcnt(0);
        unsigned nloc = b.st[0], nx = b.st[1];
        if (nloc == 0u) { xcd_barrier_complete(bar, b.x, nloc, nx); b.st[0] = nloc; b.st[1] = nx; }
        const unsigned old = xb_add(&bar[XB_XSUB(b.x)], 1u);
        const unsigned gen = old / nloc;
        if (old + 1u == (gen + 1u) * nloc) {
            __builtin_amdgcn_fence(__ATOMIC_RELEASE, "agent");
            asm volatile("s_waitcnt vmcnt(0)" ::: "memory");
            const unsigned og = xb_add(&bar[XB_TOP], 1u);
            const unsigned tg = og / nx;
            if (og + 1u == (tg + 1u) * nx) xb_add(&bar[XB_TOPGEN], 1u);
            else XB_SPIN(xb_ld(&bar[XB_TOPGEN]) == tg, bar);
            __builtin_amdgcn_fence(__ATOMIC_ACQUIRE, "agent");
            xb_add(&bar[XB_XGEN(b.x)], 1u);
            asm volatile("s_waitcnt vmcnt(0)" ::: "memory");
        } else {
            XB_SPIN(xb_ld(&bar[XB_XGEN(b.x)]) == gen, bar);
            __builtin_amdgcn_fence(__ATOMIC_ACQUIRE, "agent");
            asm volatile("s_waitcnt vmcnt(0)" ::: "memory");
        }
    }
    __syncthreads();
}

__global__ void __launch_bounds__(512) hybrid_encoder_mega(Params p) {
  extern __shared__ __attribute__((aligned(16))) char smem[];
  cg::grid_group grid = cg::this_grid();
  const int G = gridDim.x, bx = blockIdx.x;
  bf16_t* Z = (bf16_t*)(p.ws + OFF_Z); bf16_t* H = (bf16_t*)(p.ws + OFF_H);
  float* ssq_q = (float*)(p.ws + OFF_SSQ); float* ssq_kv = ssq_q + S; float* ssq_x = ssq_q + 2 * S;
  bf16_t* XB = (bf16_t*)(p.ws + OFF_OA);
  volatile LAS unsigned* xst = (volatile LAS unsigned*)(smem + 131072);
  if (threadIdx.x == 0) { xst[0] = 0u; xst[1] = 0u; xst[2] = 0u; xst[3] = 0u; }
  __syncthreads();
  const XcdBarrier xb = xcd_barrier_post((unsigned*)(p.ws + OFF_BAR), xst);
  bool first_sync = true;
#define GSYNC() do { if (first_sync) { grid.sync(); first_sync = false; } else xcd_barrier(xb); } while (0)
  build_tables(p);
  for (int layer = 0; layer < 2; ++layer) {
    convert_weights(p, layer, smem);
    for (int seq = 0; seq < 3; ++seq) {
      const float* xin = (layer == 0) ? (seq < 2 ? p.x_prompt + (size_t)seq * S * DM : p.x_sample) : p.out + (size_t)seq * S * DM;
      float* xo = p.out + (size_t)seq * S * DM;
      phase_norm(xin, p.norm_mix + layer * DM, H, S);
      { const int tz = otid();
_Pragma("nounroll")
        for (int b = bx; b < 96; b += G) ssq_q[b * 512 + tz] = 0.f; }
      GSYNC();
      { pg8::Gemm g{H, (const bf16_t*)(p.ws + WT_IN), S, 9216, DM, DM, DM}; pg8::StaticOrder so; so.init(S, 9216, G, bx);
        EpiInproj E{Z, (bf16_t*)(p.ws + OFF_VCT), (bf16_t*)(p.ws + OFF_VBT), ssq_q, ssq_kv};
        pg8::gemm_phase<EpiInproj, pg8::StaticOrder, true, true>(GEMM_LDS, g, so, E); }
      GSYNC();
      { pg8::Gemm g{Z + ZC_CQ, (const bf16_t*)(p.ws + WT_UQ), S, 768, 384, ZP, 384}; pg8::StaticOrder so; so.init(S, 768, G, bx);
        EpiUpQ E{(bf16_t*)(p.ws + OFF_QA), ssq_q};
        pg8::gemm_phase<EpiUpQ, pg8::StaticOrder, true, true>(GEMM_LDS, g, so, E); }
      { pg8::Gemm g{Z + ZC_CKV, (const bf16_t*)(p.ws + WT_UKV), S, 1024, 256, ZP, 256}; pg8::StaticOrder so; so.init(S, 1024, G, bx);
        EpiUpKV E{(bf16_t*)(p.ws + OFF_KA), (bf16_t*)(p.ws + OFF_VAT), ssq_kv};
        pg8::gemm_phase<EpiUpKV, pg8::StaticOrder, true, true>(GEMM_LDS, g, so, E); }
      phase_kpost(p, layer);
      GSYNC();
      phase_attn(p, layer, smem);
      GSYNC();
      phase_combine(p);
      GSYNC();
      { pg8::Gemm g{(const bf16_t*)(p.ws + OFF_OA), (const bf16_t*)(p.ws + WT_BRA), 3 * S, 3072, 512, 512, 512}; DiagOrder so; so.init(G, bx);
        EpiMerge E{Z, H};
        pg8::gemm_phase<EpiMerge, DiagOrder, true, true>(GEMM_LDS, g, so, E); }
      GSYNC();
      { pg8::Gemm g{H, (const bf16_t*)(p.ws + WT_OUT), S, 1024, DM, DM, DM}; pg8::StaticOrder so; so.init(S, 1024, G, bx);
        EpiResid<true> E{xin, xo, XB, ssq_x};
        pg8::gemm_phase<EpiResid<true>, pg8::StaticOrder, true, true>(GEMM_LDS, g, so, E); }
      GSYNC();
      { pg8::Gemm g{XB, (const bf16_t*)(p.ws + WT_UP), S, DFF, DM, DM, DM}; pg8::StaticOrder so; so.init(S, DFF, G, bx);
        EpiRelu2 E{Z, ssq_x};
        pg8::gemm_phase<EpiRelu2, pg8::StaticOrder, true, true>(GEMM_LDS, g, so, E); }
      GSYNC();
      { pg8::Gemm g{Z, (const bf16_t*)(p.ws + WT_DOWN), S, 1024, DFF, DFF, DFF}; pg8::StaticOrder so; so.init(S, 1024, G, bx);
        EpiResid<false> E{xo, xo, nullptr, nullptr};
        pg8::gemm_phase<EpiResid<false>, pg8::StaticOrder, true, true>(GEMM_LDS, g, so, E); }
      GSYNC();
    }
  }
  phase_final_norm(p.out, p.final_norm, 3 * S);
}

extern "C" void kernel_launch(void* const* d_in, const int* in_sizes, int n_in, void* d_out, int out_size, void* d_ws, size_t ws_size, hipStream_t stream) {
  static int grid_blocks = 0;
  if (!grid_blocks) {
    if (ws_size < WS_END) { fprintf(stderr, "kernel_launch: workspace too small: %zu < %zu\n", ws_size, (size_t)WS_END); return; }
    if (hipFuncSetAttribute((const void*)hybrid_encoder_mega, hipFuncAttributeMaxDynamicSharedMemorySize, LDS_BYTES) != hipSuccess) { fprintf(stderr, "hipFuncSetAttribute failed\n"); return; }
    int dev = 0, cus = 0, per_cu = 0;
    hipGetDevice(&dev);
    hipDeviceGetAttribute(&cus, hipDeviceAttributeMultiprocessorCount, dev);
    hipOccupancyMaxActiveBlocksPerMultiprocessor(&per_cu, hybrid_encoder_mega, 512, LDS_BYTES);
    if (per_cu < 1) { fprintf(stderr, "occupancy query returned %d\n", per_cu); return; }
    grid_blocks = cus;
  }
  Params p{};
  p.x_prompt = (const float*)d_in[0]; p.x_sample = (const float*)d_in[1];
  p.norm_mix = (const float*)d_in[2]; p.w_in = (const float*)d_in[3]; p.a_q_norm = (const float*)d_in[4]; p.a_kv_norm = (const float*)d_in[5];
  p.a_w_uq = (const float*)d_in[6]; p.a_w_ukv = (const float*)d_in[7]; p.c_q_norm = (const float*)d_in[8]; p.c_k_norm = (const float*)d_in[9];
  p.w_br_a = (const float*)d_in[10]; p.w_br_b = (const float*)d_in[11]; p.w_br_c = (const float*)d_in[12]; p.w_out = (const float*)d_in[13];
  p.norm_ffn = (const float*)d_in[14]; p.w_up = (const float*)d_in[15]; p.w_down = (const float*)d_in[16]; p.t5_table = (const float*)d_in[17];
  p.final_norm = (const float*)d_in[18];
  p.out = (float*)d_out; p.ws = (char*)d_ws;
  (void)hipMemsetAsync((char*)d_ws + OFF_BAR, 0, 16384, stream);
  void* args[] = {&p};
  hipError_t e = hipLaunchCooperativeKernel((const void*)hybrid_encoder_mega, dim3(grid_blocks), dim3(512), args, LDS_BYTES, stream);
  if (e != hipSuccess) fprintf(stderr, "cooperative launch failed: %s (grid %d)\n", hipGetErrorString(e), grid_blocks);
}
```

```cpp
#include <hip/hip_runtime.h>
#include <hip/hip_cooperative_groups.h>
#include <stdint.h>
#include <cstdio>
namespace cg = cooperative_groups;

typedef unsigned short bf16_t;
typedef short bf16x8 __attribute__((ext_vector_type(8)));
typedef short s16x4 __attribute__((ext_vector_type(4)));
typedef float f32x16 __attribute__((ext_vector_type(16)));
typedef float f32x4 __attribute__((ext_vector_type(4)));
typedef float f32x2 __attribute__((ext_vector_type(2)));
typedef unsigned u32x4 __attribute__((ext_vector_type(4)));
typedef unsigned u32x2 __attribute__((ext_vector_type(2)));
typedef __bf16 bf16x2_t __attribute__((ext_vector_type(2)));

#define DI __device__ __forceinline__
#define MFMA(a, b, c) __builtin_amdgcn_mfma_f32_32x32x16_bf16((a), (b), (c), 0, 0, 0)

DI unsigned pk2(float lo, float hi) { f32x2 v = {lo, hi}; bf16x2_t b = __builtin_convertvector(v, bf16x2_t); return __builtin_bit_cast(unsigned, b); }
DI bf16_t f2bf(float x) { return (bf16_t)(pk2(x, 0.f) & 0xffffu); }
DI float bflo(unsigned u) { return __uint_as_float(u << 16); }
DI float bfhi(unsigned u) { return __uint_as_float(u & 0xffff0000u); }
DI float bf2f(bf16_t b) { return __uint_as_float(((unsigned)b) << 16); }
DI int crow(int i, int h) { return (i & 3) + 8 * (i >> 2) + 4 * h; }
DI float fexp2(float x) { return __builtin_amdgcn_exp2f(x); }
DI int otid() { int t = threadIdx.x; asm volatile("" : "+v"(t)); return t; }
DI int wave_of(int tid) { return __builtin_amdgcn_readfirstlane(tid >> 6); }

constexpr int S = 16384, DM = 1024, ZP = 7680, DFF = 4096;
constexpr int ZC_CQ = 0, ZC_CKV = 384, ZC_KR = 640, ZC_QKVB = 768, ZC_QC = 3840, ZC_KC = 4352, ZC_GATE = 4608;
constexpr int GC_VB = 3840, GC_VC = 6016;
constexpr float LOG2E = 1.4426950408889634f, LN2 = 0.6931471805599453f;

constexpr size_t WT_IN = 0;
constexpr size_t WT_UQ = WT_IN + (size_t)9216 * 1024 * 2;
constexpr size_t WT_UKV = WT_UQ + (size_t)768 * 384 * 2;
constexpr size_t WT_BRA = WT_UKV + (size_t)1024 * 256 * 2;
constexpr size_t WT_BRB = WT_BRA + (size_t)1024 * 512 * 2;
constexpr size_t WT_BRC = WT_BRB + (size_t)1024 * 512 * 2;
constexpr size_t WT_OUT = WT_BRC + (size_t)1024 * 512 * 2;
constexpr size_t WT_UP = WT_OUT + (size_t)1024 * 3072 * 2;
constexpr size_t WT_DOWN = WT_UP + (size_t)4096 * 1024 * 2;
constexpr size_t OFF_CS = WT_DOWN + (size_t)1024 * 4096 * 2;
constexpr size_t OFF_BT = OFF_CS + (size_t)16384 * 16 * 8;
constexpr size_t OFF_Z = OFF_BT + 32768;
constexpr size_t OFF_H = OFF_Z + (size_t)S * ZP * 2;
constexpr size_t OFF_QA = OFF_H + (size_t)S * 1024 * 2;
constexpr size_t OFF_KA = OFF_QA + (size_t)S * 768 * 2;
constexpr size_t OFF_VAT = OFF_KA + (size_t)S * 512 * 2;
constexpr size_t OFF_VCT = OFF_VAT + (size_t)S * 512 * 2;
constexpr size_t OFF_OA = OFF_VCT + (size_t)S * 128 * 2;
constexpr size_t OFF_OB = OFF_OA + (size_t)S * 512 * 2;
constexpr size_t OFF_OC = OFF_OB + (size_t)S * 512 * 2;
constexpr size_t OFF_LSE = OFF_OC + (size_t)S * 512 * 2;
constexpr size_t OFF_SSQ = OFF_LSE + (size_t)3 * S * 8 * 4;
constexpr size_t OFF_VBT = OFF_SSQ + (size_t)3 * S * 4;
constexpr size_t OFF_BAR = OFF_VBT + (size_t)1536 * S * 2;
constexpr size_t WS_END = OFF_BAR + 16384;

constexpr int LDS_BYTES = 131072 + 1024;

struct Params {
  const float* x_prompt; const float* x_sample;
  const float* norm_mix; const float* w_in; const float* a_q_norm; const float* a_kv_norm; const float* a_w_uq; const float* a_w_ukv;
  const float* c_q_norm; const float* c_k_norm; const float* w_br_a; const float* w_br_b; const float* w_br_c; const float* w_out;
  const float* norm_ffn; const float* w_up; const float* w_down; const float* t5_table; const float* final_norm;
  float* out; char* ws;
};

DI void sincos_d(double x, float& c, float& s) {
  const double k = rint(x * 0.6366197723675814);
  double t = fma(-k, 1.5707963267948966, x); t = fma(-k, 6.123233995736766e-17, t);
  const double t2 = t * t;
  double sn = 1.0 - t2 / 210.0; sn = 1.0 - t2 / 156.0 * sn; sn = 1.0 - t2 / 110.0 * sn; sn = 1.0 - t2 / 72.0 * sn; sn = 1.0 - t2 / 42.0 * sn; sn = 1.0 - t2 / 20.0 * sn; sn = 1.0 - t2 / 6.0 * sn; sn *= t;
  double cs = 1.0 - t2 / 240.0; cs = 1.0 - t2 / 182.0 * cs; cs = 1.0 - t2 / 132.0 * cs; cs = 1.0 - t2 / 90.0 * cs; cs = 1.0 - t2 / 56.0 * cs; cs = 1.0 - t2 / 30.0 * cs; cs = 1.0 - t2 / 12.0 * cs; cs = 1.0 - t2 / 2.0 * cs;
  const int q = ((int)k) & 3;
  double so = (q == 0) ? sn : (q == 1) ? cs : (q == 2) ? -sn : -cs;
  double co = (q == 0) ? cs : (q == 1) ? -sn : (q == 2) ? -cs : sn;
  c = (float)co; s = (float)so;
}

DI void build_tables(const Params& p) {
  f32x2* CS = (f32x2*)(p.ws + OFF_CS);
  const int gsz = gridDim.x * 512, gid = blockIdx.x * 512 + otid();
  for (int e = gid; e < 16384 * 16; e += gsz) {
    const int pos = e >> 4, i = e & 15;
    double f = 1.0; for (int j = 0; j < i; ++j) f *= 0.5623413251903491;
    const float ff = (float)f; const float ang = (float)pos * ff;
    float c, s; sincos_d((double)ang, c, s);
    CS[e] = (f32x2){c, s};
  }
  float* BT = (float*)(p.ws + OFF_BT);
  for (int e = gid; e < 3 * 8 * 256; e += gsz) {
    const int gh = e >> 8, g = gh >> 3, hd = gh & 7, j = (e & 255) - 32;
    float v = 0.f;
    if (j >= 0 && j <= 128) {
      const int rel = (j - 64) << (2 * g);
      const int n = rel < 0 ? -rel : rel;
      int b = rel > 0 ? 16 : 0;
      if (n < 8) b += n; else { int lg = 31 - __clz(n); int vv = 5 + lg; b += (vv < 15 ? vv : 15); }
      v = p.t5_table[b * 24 + g * 8 + hd] * LOG2E;
    }
    BT[e] = v;
  }
}

DI void cvt_tile(const float* __restrict__ W, int ldw, int ldk, int koff, bf16_t* __restrict__ Wt, int k0, int n0, int mode, const float* __restrict__ rscale, float* tile) {
  const int tid = otid();
#pragma unroll
  for (int i = 0; i < 8; ++i) {
    const int kl = (tid >> 6) + 8 * i, nl = tid & 63, nn = n0 + nl;
    int src = nn;
    if (mode == 1) src = nn < 672 ? nn : (nn < 768 ? -1 : nn - 96);
    float v = 0.f;
    if (src >= 0) v = W[(size_t)(k0 + kl) * ldw + src];
    if (rscale) v *= rscale[k0 + kl];
    tile[kl * 65 + nl] = v;
  }
  __syncthreads();
#pragma unroll
  for (int i = 0; i < 8; ++i) {
    const int nl = (tid >> 6) + 8 * i, kl = tid & 63;
    Wt[(size_t)(n0 + nl) * ldk + koff + k0 + kl] = f2bf(tile[kl * 65 + nl]);
  }
  __syncthreads();
}

DI void convert_weights(const Params& p, int layer, char* smem) {
  float* tile = (float*)smem;
  int base = 0;
  for (int mtx = 0; mtx < 9; ++mtx) {
    const float* W; int K, Nsrc, Ndst, mode = 0, ldk = 0, koff = 0; const float* rs = nullptr; size_t off;
    switch (mtx) {
      case 0: W = p.w_in + (size_t)layer * 1024 * 9120; K = 1024; Nsrc = 9120; Ndst = 9216; mode = 1; off = WT_IN; break;
      case 1: W = p.a_w_uq + (size_t)layer * 384 * 768; K = 384; Nsrc = 768; Ndst = 768; rs = p.a_q_norm + layer * 384; off = WT_UQ; break;
      case 2: W = p.a_w_ukv + (size_t)layer * 256 * 1024; K = 256; Nsrc = 1024; Ndst = 1024; rs = p.a_kv_norm + layer * 256; off = WT_UKV; break;
      case 3: W = p.w_br_a + (size_t)layer * 512 * 1024; K = 512; Nsrc = 1024; Ndst = 1024; off = WT_BRA; break;
      case 4: W = p.w_br_b + (size_t)layer * 512 * 1024; K = 512; Nsrc = 1024; Ndst = 1024; off = WT_BRB; break;
      case 5: W = p.w_br_c + (size_t)layer * 512 * 1024; K = 512; Nsrc = 1024; Ndst = 1024; off = WT_BRC; break;
      case 6: W = p.w_out + (size_t)layer * 1024 * 1024; K = 1024; Nsrc = 1024; Ndst = 1024; off = WT_OUT; break;
      case 7: W = p.w_up + (size_t)layer * 1024 * 4096; K = 1024; Nsrc = 4096; Ndst = 4096; rs = p.norm_ffn + layer * DM; off = WT_UP; break;
      case 8: default: W = p.w_down + (size_t)layer * 4096 * 1024; K = 4096; Nsrc = 1024; Ndst = 1024; off = WT_DOWN; break;
    }
    if (ldk == 0) ldk = K;
    const int nk = K / 64, nn = Ndst / 64, cnt = nk * nn;
    bf16_t* Wt = (bf16_t*)(p.ws + off);
    int first = (int)blockIdx.x - (base % (int)gridDim.x); if (first < 0) first += gridDim.x;
    for (int it = first; it < cnt; it += gridDim.x) {
      const int kt = it % nk, nt = it / nk;
      cvt_tile(W, Nsrc, ldk, koff, Wt, kt * 64, nt * 64, mode, rs, tile);
    }
    base += cnt;
  }
}

DI void phase_norm(const float* __restrict__ x, const float* __restrict__ g, bf16_t* __restrict__ H, int rows) {
  const int tid = otid(), lane = tid & 63, wid = tid >> 6;
  for (int row = blockIdx.x * 8 + wid; row < rows; row += gridDim.x * 8) {
    const float* xr = x + (size_t)row * DM;
    f32x4 v[4]; float ss = 0.f;
#pragma unroll
    for (int i = 0; i < 4; ++i) { v[i] = *(const f32x4*)(xr + i * 256 + lane * 4); ss += v[i][0] * v[i][0] + v[i][1] * v[i][1] + v[i][2] * v[i][2] + v[i][3] * v[i][3]; }
#pragma unroll
    for (int o = 32; o >= 1; o >>= 1) ss += __shfl_xor(ss, o);
    const float rstd = rsqrtf(ss * (1.0f / DM) + 1e-6f);
#pragma unroll
    for (int i = 0; i < 4; ++i) {
      const f32x4 gg = *(const f32x4*)(g + i * 256 + lane * 4);
      u32x2 w; w.x = pk2(v[i][0] * rstd * gg[0], v[i][1] * rstd * gg[1]); w.y = pk2(v[i][2] * rstd * gg[2], v[i][3] * rstd * gg[3]);
      *(u32x2*)(H + (size_t)row * DM + i * 256 + lane * 4) = w;
    }
  }
}

DI void phase_final_norm(float* __restrict__ x, const float* __restrict__ g, int rows) {
  const int tid = otid(), lane = tid & 63, wid = tid >> 6;
  for (int row = blockIdx.x * 8 + wid; row < rows; row += gridDim.x * 8) {
    float* xr = x + (size_t)row * DM;
    f32x4 v[4]; float ss = 0.f;
#pragma unroll
    for (int i = 0; i < 4; ++i) { v[i] = *(const f32x4*)(xr + i * 256 + lane * 4); ss += v[i][0] * v[i][0] + v[i][1] * v[i][1] + v[i][2] * v[i][2] + v[i][3] * v[i][3]; }
#pragma unroll
    for (int o = 32; o >= 1; o >>= 1) ss += __shfl_xor(ss, o);
    const float rstd = rsqrtf(ss * (1.0f / DM) + 1e-6f);
#pragma unroll
    for (int i = 0; i < 4; ++i) {
      const f32x4 gg = *(const f32x4*)(g + i * 256 + lane * 4);
      f32x4 o = {v[i][0] * rstd * gg[0], v[i][1] * rstd * gg[1], v[i][2] * rstd * gg[2], v[i][3] * rstd * gg[3]};
      *(f32x4*)(xr + i * 256 + lane * 4) = o;
    }
  }
}


namespace pg8 {
#define PG8_LAS __attribute__((address_space(3)))
typedef unsigned short bf16_t;
typedef short bf16x8 __attribute__((ext_vector_type(8)));
typedef float f32x4 __attribute__((ext_vector_type(4)));
typedef unsigned u32x4 __attribute__((ext_vector_type(4)));
constexpr int BM = 256, BK = 64, HALF = 128, HTB = HALF * BK * 2  , STAGE_BYTES = 8 * HTB, NXCD = 8, WGM = 4;

__host__ __device__ __forceinline__ int lds_byte(int r, int c) { const int st = (r >> 4) * 2 + (c >> 5), rr = r & 15, cc = c & 31, ob = rr * 64 + cc * 2; return st * 1024 + (ob ^ (((ob >> 9) & 1) << 5)); }
__host__ __device__ __forceinline__ void stage_rc(int b, int& R, int& C) { const int st = b / 1024, sb = b % 1024, swz = sb ^ (((sb >> 9) & 1) << 5); R = (st >> 1) * 16 + swz / 64; C = (st & 1) * 32 + (swz % 64) / 2; }
__host__ __device__ __forceinline__ int perm32(int rho) { const int n = rho >> 4, i = rho & 15; return 8 * (i >> 2) + 4 * n + (i & 3); }

struct Unit { int pm, pn; };
struct Gemm { const bf16_t* A; const bf16_t* Bt; int M, N, K, lda, ldb; };

struct StaticOrder {
    int nM, nN, nwg, G, c;
    __host__ __device__ void init(int M, int N, int G_, int c_) { nM = M / BM; nN = N / BM; nwg = nM * nN; G = G_; c = c_; }
    __host__ __device__ bool next(int i, Unit& u) const {
        const long L = (long)i * G + c; if (L >= nwg) return false;
        map((int)L, u); return true; }
    __host__ __device__ void map(int L, Unit& u) const {
        int wgid = L; { const int q = nwg / NXCD, r = nwg % NXCD, xcd = wgid % NXCD, off = wgid / NXCD; wgid = (xcd < r ? xcd * (q + 1) : r * (q + 1) + (xcd - r) * q) + off; }
        const int nig = WGM * nN, gid = wgid / nig, fm = gid * WGM, gsz = (nM - fm) < WGM ? (nM - fm) : WGM;
        u.pm = fm + ((wgid % nig) % gsz); u.pn = (wgid % nig) / gsz;
    }
    __device__ __forceinline__ void a_ready(const Unit&) const {}
    __device__ __forceinline__ void done(const Unit&) const {}
};
template <class Epi, class Sched, bool ALIGN_EPI = false, bool SP2 = false>
__device__ __forceinline__ void gemm_phase(PG8_LAS unsigned char* lds, const Gemm g, const Sched& S, const Epi& E) {
    int tid_ = threadIdx.x; asm volatile("" : "+v"(tid_)); const int tid = tid_, wid = __builtin_amdgcn_readfirstlane(tid >> 6), lane = tid & 63, wr = wid >> 2, wc = wid & 3, fr = lane & 15, fq = lane >> 4;
    const int K = g.K, nt = K / BK;
    unsigned voffA[2], voffB[2];
#pragma unroll
    for (int i = 0; i < 2; ++i) { int R, C; stage_rc(tid * 16 + i * 8192, R, C); const int Rb = Epi::PERM ? ((R & ~31) + perm32(R & 31)) : R;
        voffA[i] = (unsigned)(R * g.lda + C) * 2u; voffB[i] = (unsigned)(Rb * g.ldb + C) * 2u; }
    const size_t kstep = (size_t)(BK * 2);
    const size_t hA = (size_t)HALF * g.lda * 2, hB = (size_t)HALF * g.ldb * 2;
    const size_t tA = 2 * hA, tB = 2 * hB;
    const unsigned ldsw = (unsigned)wid * 1024u;
    const int aoff = lds_byte(wr * 64 + fr, fq * 8), boff = lds_byte(wc * 32 + fr, fq * 8);
#define PG8_SA(b, h) (((b) * 2 + (h)) * HTB)
#define PG8_SB(b, h) ((4 + (b) * 2 + (h)) * HTB)
#define PG8_STAGE(bufoff, gbase, voff) do { _Pragma("unroll") for (int _i = 0; _i < 2; ++_i) \
        __builtin_amdgcn_global_load_lds((const unsigned*)((const char*)(gbase) + (voff)[_i]), (PG8_LAS unsigned*)(lds + (bufoff) + ldsw + _i * 8192), 16, 0, 0); } while (0)
#define PG8_LDA(dst, b, h) do { _Pragma("unroll") for (int m = 0; m < 4; ++m) _Pragma("unroll") for (int k = 0; k < 2; ++k) dst[m][k] = *(const PG8_LAS bf16x8*)(lds + PG8_SA(b, h) + aoff + m * 2048 + k * 1024); } while (0)
#define PG8_LDB(dst, b, h) do { _Pragma("unroll") for (int n = 0; n < 2; ++n) _Pragma("unroll") for (int k = 0; k < 2; ++k) dst[n][k] = *(const PG8_LAS bf16x8*)(lds + PG8_SB(b, h) + boff + n * 2048 + k * 1024); } while (0)
#define PG8_MMA(ai, bj, At, Bt) do { __builtin_amdgcn_s_setprio(1); _Pragma("unroll") for (int m = 0; m < 4; ++m) _Pragma("unroll") for (int n = 0; n < 2; ++n) _Pragma("unroll") for (int k = 0; k < 2; ++k) \
        acc[ai][bj][m][n] = __builtin_amdgcn_mfma_f32_16x16x32_bf16(Bt[n][k], At[m][k], acc[ai][bj][m][n], 0, 0, 0); __builtin_amdgcn_s_setprio(0); } while (0)
#define PG8_WAIT_V(n) asm volatile("s_waitcnt vmcnt(" #n ")" ::: "memory")
#define PG8_WAIT_L(n) asm volatile("s_waitcnt lgkmcnt(" #n ")" ::: "memory")
#define PG8_BAR __builtin_amdgcn_s_barrier()
#define PG8_SCHED __builtin_amdgcn_sched_barrier(0)
    Unit cur, nxt; int ui = 0;
    if (!S.next(0, cur)) return;
    f32x4 acc[2][2][4][2];
#pragma unroll
    for (int a = 0; a < 2; ++a)
#pragma unroll
        for (int b = 0; b < 2; ++b)
#pragma unroll
            for (int m = 0; m < 4; ++m)
#pragma unroll
                for (int n = 0; n < 2; ++n) acc[a][b][m][n] = (f32x4){0.f, 0.f, 0.f, 0.f};
    bf16x8 At[4][2], B0[2][2], B1[2][2];
    const char* cA = (const char*)g.A + (size_t)cur.pm * tA; const char* cB = (const char*)g.Bt + (size_t)cur.pn * tB;
    S.a_ready(cur);
    if constexpr (SP2) {
        PG8_STAGE(PG8_SB(0, 0), cB, voffB); PG8_STAGE(PG8_SB(0, 1), cB + hB, voffB); PG8_STAGE(PG8_SA(0, 0), cA, voffA); PG8_STAGE(PG8_SA(0, 1), cA + hA, voffA);
        if (wr == 1) PG8_BAR;
        PG8_WAIT_V(2); PG8_BAR;
        PG8_STAGE(PG8_SB(1, 0), cB + kstep, voffB); PG8_STAGE(PG8_SA(1, 0), cA + kstep, voffA); PG8_STAGE(PG8_SB(1, 1), cB + hB + kstep, voffB);
        PG8_WAIT_V(6); PG8_BAR;
    } else {
        PG8_STAGE(PG8_SB(0, 0), cB, voffB); PG8_STAGE(PG8_SA(0, 0), cA, voffA); PG8_STAGE(PG8_SB(0, 1), cB + hB, voffB); PG8_STAGE(PG8_SA(0, 1), cA + hA, voffA);
        if (wr == 1) PG8_BAR;
        PG8_WAIT_V(4); PG8_BAR;
        PG8_STAGE(PG8_SB(1, 0), cB + kstep, voffB); PG8_STAGE(PG8_SA(1, 0), cA + kstep, voffA); PG8_STAGE(PG8_SB(1, 1), cB + hB + kstep, voffB);
        PG8_WAIT_V(6); PG8_BAR;
    }
    for (;;) {
        const bool has_next = S.next(ui + 1, nxt);
        const char* nA = has_next ? (const char*)g.A + (size_t)nxt.pm * tA : cA; const char* nB = has_next ? (const char*)g.Bt + (size_t)nxt.pn * tB : cB;
_Pragma("unroll 1")
        for (int t = 0; t < nt; t += 2) {
            const bool last = (t == nt - 2);
            const char* a1 = cA + (size_t)(t + 1) * kstep;
            const char* a2 = last ? nA : cA + (size_t)(t + 2) * kstep; const char* b2 = last ? nB : cB + (size_t)(t + 2) * kstep;
            const char* a3 = a2 + kstep; const char* b3 = b2 + kstep;
            if (last && has_next) S.a_ready(nxt);
            if constexpr (SP2) {
            PG8_LDB(B0, 0, 0); PG8_LDB(B1, 0, 1); PG8_SCHED; PG8_LDA(At, 0, 0); PG8_STAGE(PG8_SA(1, 1), a1 + hA, voffA);
            PG8_WAIT_V(8); PG8_WAIT_L(0); PG8_BAR; PG8_MMA(0, 0, At, B0); PG8_MMA(0, 1, At, B1); PG8_BAR; PG8_SCHED;
            PG8_LDA(At, 0, 1); PG8_STAGE(PG8_SB(0, 0), b2, voffB); PG8_STAGE(PG8_SB(0, 1), b2 + hB, voffB); PG8_STAGE(PG8_SA(0, 0), a2, voffA);
            PG8_WAIT_V(8); PG8_WAIT_L(0); PG8_BAR; PG8_MMA(1, 0, At, B0); PG8_MMA(1, 1, At, B1); PG8_BAR; PG8_SCHED;
            PG8_LDB(B0, 1, 0); PG8_LDB(B1, 1, 1); PG8_SCHED; PG8_LDA(At, 1, 0); PG8_STAGE(PG8_SA(0, 1), a2 + hA, voffA);
            PG8_WAIT_V(8); PG8_WAIT_L(0); PG8_BAR; PG8_MMA(0, 0, At, B0); PG8_MMA(0, 1, At, B1); PG8_BAR; PG8_SCHED;
            PG8_LDA(At, 1, 1); PG8_STAGE(PG8_SB(1, 0), b3, voffB); PG8_STAGE(PG8_SB(1, 1), b3 + hB, voffB); PG8_STAGE(PG8_SA(1, 0), a3, voffA);
            PG8_WAIT_V(8); PG8_WAIT_L(0); PG8_BAR; PG8_MMA(1, 0, At, B0); PG8_MMA(1, 1, At, B1); PG8_BAR; PG8_SCHED;
            } else {
            PG8_LDB(B0, 0, 0); PG8_SCHED; PG8_LDA(At, 0, 0); PG8_STAGE(PG8_SA(1, 1), a1 + hA, voffA);
            PG8_WAIT_L(8); PG8_BAR; PG8_WAIT_L(0); PG8_MMA(0, 0, At, B0); PG8_BAR; PG8_SCHED;
            PG8_LDB(B1, 0, 1); PG8_STAGE(PG8_SB(0, 0), b2, voffB);
            PG8_BAR; PG8_WAIT_L(0); PG8_MMA(0, 1, At, B1); PG8_BAR;
            PG8_LDA(At, 0, 1); PG8_STAGE(PG8_SA(0, 0), a2, voffA);
            PG8_BAR; PG8_WAIT_L(0); PG8_MMA(1, 0, At, B0); PG8_BAR; PG8_SCHED;
            PG8_STAGE(PG8_SB(0, 1), b2 + hB, voffB);
            PG8_WAIT_V(6); PG8_BAR; PG8_MMA(1, 1, At, B1); PG8_BAR;
            PG8_LDB(B0, 1, 0); PG8_SCHED; PG8_LDA(At, 1, 0); PG8_STAGE(PG8_SA(0, 1), a2 + hA, voffA);
            PG8_WAIT_L(8); PG8_BAR; PG8_WAIT_L(0); PG8_MMA(0, 0, At, B0); PG8_BAR; PG8_SCHED;
            PG8_LDB(B1, 1, 1); PG8_STAGE(PG8_SB(1, 0), b3, voffB);
            PG8_BAR; PG8_WAIT_L(0); PG8_MMA(0, 1, At, B1); PG8_BAR;
            PG8_LDA(At, 1, 1); PG8_STAGE(PG8_SA(1, 0), a3, voffA);
            PG8_BAR; PG8_WAIT_L(0); PG8_MMA(1, 0, At, B0); PG8_BAR; PG8_SCHED;
            PG8_STAGE(PG8_SB(1, 1), b3 + hB, voffB);
            PG8_WAIT_V(6); PG8_BAR; PG8_MMA(1, 1, At, B1); PG8_BAR;
            }
        }
        if constexpr (ALIGN_EPI) { if (wr == 0) PG8_BAR; }
        if constexpr (!Epi::AFTER_DRAIN) { E(acc, cur, wr, wc, fr, fq); S.done(cur); }
        if (!has_next) break;
#pragma unroll
        for (int a = 0; a < 2; ++a)
#pragma unroll
            for (int b = 0; b < 2; ++b)
#pragma unroll
                for (int m = 0; m < 4; ++m)
#pragma unroll
                    for (int n = 0; n < 2; ++n) acc[a][b][m][n] = (f32x4){0.f, 0.f, 0.f, 0.f};
        cur = nxt; cA = nA; cB = nB; ++ui;
        if constexpr (ALIGN_EPI) { if (wr == 1) PG8_BAR; }
    }
    PG8_WAIT_V(0);
    if constexpr (!ALIGN_EPI) { if (wr == 0) PG8_BAR; }
    PG8_BAR;
    if constexpr (Epi::AFTER_DRAIN) { E.fused(acc, cur, wr, wc, fr, fq, lds, wid, lane); S.done(cur); }
#undef PG8_SA
#undef PG8_SB
#undef PG8_STAGE
#undef PG8_LDA
#undef PG8_LDB
#undef PG8_MMA
#undef PG8_WAIT_V
#undef PG8_WAIT_L
#undef PG8_BAR
#undef PG8_SCHED
}
}

DI void rope_pair8(float (&x1)[8], float (&x2)[8], const f32x2* cs) {
#pragma unroll
  for (int j = 0; j < 8; ++j) { const f32x2 c = cs[j]; const float a = x1[j], b = x2[j]; x1[j] = a * c.x - b * c.y; x2[j] = a * c.y + b * c.x; }
}
typedef pg8::Unit Unit;
#define ACC_T const f32x4 (&acc)[2][2][4][2]
#define EROW(u, ai, m) ((u).pm * 256 + (ai) * 128 + wr * 64 + (m) * 16 + fr)
DI u32x4 pack_f8(const f32x4 a, const f32x4 b) { u32x4 w; w.x = pk2(a[0], a[1]); w.y = pk2(a[2], a[3]); w.z = pk2(b[0], b[1]); w.w = pk2(b[2], b[3]); return w; }

struct EpiInproj {
  static constexpr bool PERM = true, AFTER_DRAIN = false;
  bf16_t* Z; bf16_t* VCT; bf16_t* VBT; float* ssq_q; float* ssq_kv;
  DI void operator()(ACC_T, const Unit& u, int wr, int wc, int fr, int fq) const {
#pragma unroll
    for (int bj = 0; bj < 2; ++bj) {
      const int tt = 2 * u.pn + bj, cb = tt * 128 + wc * 32 + 8 * fq;
      int sh = 0; if (tt >= 6 && tt < 42) sh = 2 * (((tt - 6) >> 2) % 3);
      const int msk = (1 << sh) - 1;
      if (tt >= 38 && tt < 42) {
        bf16_t* vt = VBT + (size_t)(cb - GC_VB) * S + fr * (S >> 4) + u.pm * 16 + wr * 4;
#pragma unroll
        for (int ai = 0; ai < 2; ++ai)
#pragma unroll
          for (int n = 0; n < 2; ++n) {
            __builtin_amdgcn_sched_barrier(0);
#pragma unroll
            for (int e = 0; e < 4; ++e) {
              u32x2 w; w.x = pk2(acc[ai][bj][0][n][e], acc[ai][bj][1][n][e]); w.y = pk2(acc[ai][bj][2][n][e], acc[ai][bj][3][n][e]);
              *(u32x2*)(vt + (size_t)(4 * n + e) * S + ai * 8) = w;
            }
          }
      } else if (tt == 47 || (tt >= 30 && tt < 38)) {
        bf16_t* vt = (tt == 47) ? VCT + (size_t)(cb - GC_VC) * S : VBT + (size_t)(cb - GC_VB) * S;
#pragma unroll
        for (int ai = 0; ai < 2; ++ai)
#pragma unroll
          for (int m = 0; m < 4; ++m) {
            __builtin_amdgcn_sched_barrier(0);
            const int row = EROW(u, ai, m), prow = (row & msk) * (S >> sh) + (row >> sh);
            bf16_t* vp = vt + prow;
#pragma unroll
            for (int n = 0; n < 2; ++n)
#pragma unroll
              for (int e = 0; e < 4; ++e) vp[(size_t)(4 * n + e) * S] = f2bf(acc[ai][bj][m][n][e]);
          }
      } else {
        const int zc = cb < GC_VB ? cb : cb - 1536;
        float* ssq = (tt < 3) ? ssq_q : ((tt < 5) ? ssq_kv : nullptr);
#pragma unroll
        for (int ai = 0; ai < 2; ++ai)
#pragma unroll
          for (int m = 0; m < 4; ++m) {
            const int row = EROW(u, ai, m), prow = (row & msk) * (S >> sh) + (row >> sh);
            const f32x4 v0 = acc[ai][bj][m][0], v1 = acc[ai][bj][m][1];
            *(u32x4*)(Z + (size_t)prow * ZP + zc) = pack_f8(v0, v1);
            if (ssq) {
              float s = v0[0] * v0[0] + v0[1] * v0[1] + v0[2] * v0[2] + v0[3] * v0[3] + v1[0] * v1[0] + v1[1] * v1[1] + v1[2] * v1[2] + v1[3] * v1[3];
              s += __shfl_xor(s, 16); s += __shfl_xor(s, 32);
              if (fq == 0) __hip_atomic_fetch_add(ssq + row, s, __ATOMIC_RELAXED, __HIP_MEMORY_SCOPE_AGENT);
            }
          }
      }
    }
  }
};
struct EpiUpQ {
  static constexpr bool PERM = true, AFTER_DRAIN = false;
  bf16_t* QA; const float* ssq;
  DI void operator()(ACC_T, const Unit& u, int wr, int wc, int fr, int fq) const {
#pragma unroll
    for (int ai = 0; ai < 2; ++ai)
#pragma unroll
      for (int m = 0; m < 4; ++m) {
        const int row = EROW(u, ai, m); const float rs = rsqrtf(ssq[row] * (1.0f / 384.0f) + 1e-6f);
#pragma unroll
        for (int bj = 0; bj < 2; ++bj) {
          const int cb = u.pn * 256 + bj * 128 + wc * 32 + 8 * fq;
          *(u32x4*)(QA + (size_t)row * 768 + cb) = pack_f8(acc[ai][bj][m][0] * rs, acc[ai][bj][m][1] * rs);
        }
      }
  }
};
struct EpiUpKV {
  static constexpr bool PERM = true, AFTER_DRAIN = false;
  bf16_t* KA; bf16_t* VAT; const float* ssq;
  DI void operator()(ACC_T, const Unit& u, int wr, int wc, int fr, int fq) const {
#pragma unroll
    for (int ai = 0; ai < 2; ++ai)
#pragma unroll
      for (int m = 0; m < 4; ++m) {
        __builtin_amdgcn_sched_barrier(0);
        const int row = EROW(u, ai, m); const float rs = rsqrtf(ssq[row] * (1.0f / 256.0f) + 1e-6f);
#pragma unroll
        for (int bj = 0; bj < 2; ++bj) {
          const int head = 2 * u.pn + bj, w0 = wc * 32 + 8 * fq;
          if (wc < 2) {
            *(u32x4*)(KA + (size_t)row * 512 + head * 64 + w0) = pack_f8(acc[ai][bj][m][0] * rs, acc[ai][bj][m][1] * rs);
          } else {
            bf16_t* vp = VAT + (size_t)(head * 64 + w0 - 64) * S + row;
#pragma unroll
            for (int n = 0; n < 2; ++n)
#pragma unroll
              for (int e = 0; e < 4; ++e) vp[(size_t)(4 * n + e) * S] = f2bf(acc[ai][bj][m][n][e] * rs);
          }
        }
      }
  }
};
struct EpiMerge {
  static constexpr bool PERM = true, AFTER_DRAIN = false;
  const bf16_t* Z; bf16_t* MIX;
  DI void operator()(ACC_T, const Unit& u, int wr, int wc, int fr, int fq) const {
    const int b = u.pm >> 6, pm = u.pm & 63, pn = u.pn & 3;
#pragma unroll
    for (int ai = 0; ai < 2; ++ai)
#pragma unroll
      for (int m = 0; m < 4; ++m) {
        const int row = pm * 256 + ai * 128 + wr * 64 + m * 16 + fr;
#pragma unroll
        for (int bj = 0; bj < 2; ++bj) {
          const int col = pn * 256 + bj * 128 + wc * 32 + 8 * fq;
          const u32x4 g = *(const u32x4*)(Z + (size_t)row * ZP + ZC_GATE + b * 1024 + col);
          f32x4 v0 = acc[ai][bj][m][0], v1 = acc[ai][bj][m][1];
#pragma unroll
          for (int q = 0; q < 2; ++q) {
            v0[2 * q] *= __builtin_amdgcn_rcpf(1.0f + __expf(-bflo(g[q]))); v0[2 * q + 1] *= __builtin_amdgcn_rcpf(1.0f + __expf(-bfhi(g[q])));
            v1[2 * q] *= __builtin_amdgcn_rcpf(1.0f + __expf(-bflo(g[2 + q]))); v1[2 * q + 1] *= __builtin_amdgcn_rcpf(1.0f + __expf(-bfhi(g[2 + q])));
          }
          bf16_t* mp = MIX + (size_t)row * DM + col;
          if (b > 0) { const u32x4 o = *(const u32x4*)mp;
#pragma unroll
            for (int q = 0; q < 2; ++q) { v0[2 * q] += bflo(o[q]); v0[2 * q + 1] += bfhi(o[q]); v1[2 * q] += bflo(o[2 + q]); v1[2 * q + 1] += bfhi(o[2 + q]); } }
          *(u32x4*)mp = pack_f8(v0, v1);
        }
      }
  }
};
template <bool NORM_OUT> struct EpiResid {
  static constexpr bool PERM = false, AFTER_DRAIN = false;
  const float* xs; float* xd; bf16_t* xb; float* ssq;
  DI void operator()(ACC_T, const Unit& u, int wr, int wc, int fr, int fq) const {
#pragma unroll
    for (int ai = 0; ai < 2; ++ai)
#pragma unroll
      for (int m = 0; m < 4; ++m) {
        const int row = EROW(u, ai, m);
        const size_t ro = (size_t)row * DM + u.pn * 256 + wc * 32 + 4 * fq;
        float ss = 0.f;
#pragma unroll
        for (int bj = 0; bj < 2; ++bj)
#pragma unroll
          for (int n = 0; n < 2; ++n) {
            const size_t o = ro + bj * 128 + n * 16; const f32x4 x = *(const f32x4*)(xs + o) + acc[ai][bj][m][n]; *(f32x4*)(xd + o) = x;
            if (NORM_OUT) { u32x2 w; w.x = pk2(x[0], x[1]); w.y = pk2(x[2], x[3]); *(u32x2*)(xb + o) = w; ss += x[0] * x[0] + x[1] * x[1] + x[2] * x[2] + x[3] * x[3]; }
          }
        if (NORM_OUT) { ss += __shfl_xor(ss, 16); ss += __shfl_xor(ss, 32); if (fq == 0) __hip_atomic_fetch_add(ssq + row, ss, __ATOMIC_RELAXED, __HIP_MEMORY_SCOPE_AGENT); }
      }
  }
};
struct EpiRelu2 {
  static constexpr bool PERM = true, AFTER_DRAIN = false;
  bf16_t* HID; const float* ssq;
  DI void operator()(ACC_T, const Unit& u, int wr, int wc, int fr, int fq) const {
#pragma unroll
    for (int ai = 0; ai < 2; ++ai)
#pragma unroll
      for (int m = 0; m < 4; ++m) {
        const int row = EROW(u, ai, m); const float rs = rsqrtf(ssq[row] * (1.0f / DM) + 1e-6f);
#pragma unroll
        for (int bj = 0; bj < 2; ++bj) {
          f32x4 v0 = acc[ai][bj][m][0], v1 = acc[ai][bj][m][1];
#pragma unroll
          for (int e = 0; e < 4; ++e) { const float a = fmaxf(v0[e], 0.f) * rs, c = fmaxf(v1[e], 0.f) * rs; v0[e] = a * a; v1[e] = c * c; }
          *(u32x4*)(HID + (size_t)row * DFF + u.pn * 256 + bj * 128 + wc * 32 + 8 * fq) = pack_f8(v0, v1);
        }
      }
  }
};
struct DiagOrder {
  pg8::StaticOrder so; int G, c;
  DI void init(int G_, int c_) { so.init(S, 1024, G_, c_); G = G_; c = c_; }
  DI bool next(int i, Unit& u) const { const int tile = (i / 3) * G + c, b = i % 3; if (tile >= 256) return false; so.map(tile, u); u.pm += 64 * b; u.pn += 4 * b; return true; }
  DI void a_ready(const Unit&) const {}
  DI void done(const Unit&) const {}
};
#define GEMM_LDS ((PG8_LAS unsigned char*)smem)

DI void phase_kpost(const Params& p, int layer) {
  bf16_t* Z = (bf16_t*)(p.ws + OFF_Z);
  const f32x2* CS = (const f32x2*)(p.ws + OFF_CS);
  for (int it = (int)gridDim.x - 1 - (int)blockIdx.x; it < 96; it += gridDim.x) {
      const int tid = otid();
      const int idx = it * 512 + tid;
      const int unit = idx / S, tkn = idx % S;
      if (unit < 2) {
        bf16_t* kp = Z + (size_t)tkn * ZP + ZC_KC + unit * 64;
        float x[8][8]; float ss = 0.f;
#pragma unroll
        for (int c = 0; c < 8; ++c) { const u32x4 v = *(const u32x4*)(kp + c * 8);
#pragma unroll
          for (int q = 0; q < 4; ++q) { x[c][2 * q] = bflo(v[q]); x[c][2 * q + 1] = bfhi(v[q]); ss += x[c][2 * q] * x[c][2 * q] + x[c][2 * q + 1] * x[c][2 * q + 1]; } }
        const float rs = rsqrtf(ss * (1.0f / 64.0f) + 1e-6f);
        const float* gk = p.c_k_norm + layer * 64;
#pragma unroll
        for (int c = 0; c < 8; ++c)
#pragma unroll
          for (int q = 0; q < 8; ++q) x[c][q] *= rs * gk[c * 8 + q];
        const f32x2* cr = CS + (size_t)(tkn >> 6) * 16; const f32x2* cc = CS + (size_t)(tkn & 63) * 16;
        rope_pair8(x[0], x[2], cr); rope_pair8(x[1], x[3], cr + 8);
        rope_pair8(x[4], x[6], cc); rope_pair8(x[5], x[7], cc + 8);
#pragma unroll
        for (int c = 0; c < 8; ++c) { u32x4 w; w.x = pk2(x[c][0], x[c][1]); w.y = pk2(x[c][2], x[c][3]); w.z = pk2(x[c][4], x[c][5]); w.w = pk2(x[c][6], x[c][7]); *(u32x4*)(kp + c * 8) = w; }
      } else {
        bf16_t* kp = Z + (size_t)tkn * ZP + ZC_KR;
        float x[4][8];
#pragma unroll
        for (int c = 0; c < 4; ++c) { const u32x4 v = *(const u32x4*)(kp + c * 8);
#pragma unroll
          for (int q = 0; q < 4; ++q) { x[c][2 * q] = bflo(v[q]); x[c][2 * q + 1] = bfhi(v[q]); } }
        const f32x2* cp = CS + (size_t)tkn * 16;
        rope_pair8(x[0], x[2], cp); rope_pair8(x[1], x[3], cp + 8);
#pragma unroll
        for (int c = 0; c < 4; ++c) { u32x4 w; w.x = pk2(x[c][0], x[c][1]); w.y = pk2(x[c][2], x[c][3]); w.z = pk2(x[c][4], x[c][5]); w.w = pk2(x[c][6], x[c][7]); *(u32x4*)(kp + c * 8) = w; }
      }
  }
}

DI bf16x8 pack8(float a0, float a1, float a2, float a3, float a4, float a5, float a6, float a7) {
  u32x4 w; w.x = pk2(a0, a1); w.y = pk2(a2, a3); w.z = pk2(a4, a5); w.w = pk2(a6, a7); return __builtin_bit_cast(bf16x8, w);
}
DI void unpack8(const u32x4 v, float (&x)[8]) {
#pragma unroll
  for (int q = 0; q < 4; ++q) { x[2 * q] = bflo(v[q]); x[2 * q + 1] = bfhi(v[q]); }
}

DI void store_o_wide(bf16_t* rowp, const f32x16& o, float inv, int h) {
#pragma unroll
  for (int pr = 0; pr < 2; ++pr) {
    const int g = 2 * pr;
    const unsigned ax = pk2(o[4 * g] * inv, o[4 * g + 1] * inv), ay = pk2(o[4 * g + 2] * inv, o[4 * g + 3] * inv);
    const unsigned bx = pk2(o[4 * g + 4] * inv, o[4 * g + 5] * inv), by = pk2(o[4 * g + 6] * inv, o[4 * g + 7] * inv);
    const auto sx = __builtin_amdgcn_permlane32_swap(ax, bx, false, false);
    const auto sy = __builtin_amdgcn_permlane32_swap(ay, by, false, false);
    const u32x4 w = {sx[0], sy[0], sx[1], sy[1]};
    *(u32x4*)(rowp + 8 * (g + h)) = w;
  }
}

constexpr int ATT_STAGE = 20480;

template <int TYPE, bool FIXREF>
DI void attn_dense_unit(const Params& p, int layer, int head, int qb, char* lds, float bref) {
  constexpr int NQK = TYPE == 0 ? 6 : 4;
  const int tid = otid(), lane = tid & 63, wid = wave_of(tid), r = lane & 31, h = lane >> 5;
  const bf16_t* Z = (const bf16_t*)(p.ws + OFF_Z);
  const f32x2* CS = (const f32x2*)(p.ws + OFF_CS);
  const bf16_t* Kn; int ldk; const bf16_t* VT; bf16_t* O;
  if (TYPE == 0) { Kn = (const bf16_t*)(p.ws + OFF_KA) + head * 64; ldk = 512; VT = (const bf16_t*)(p.ws + OFF_VAT) + (size_t)head * 64 * S; O = (bf16_t*)(p.ws + OFF_OA); }
  else { const int kvh = head >> 2; Kn = Z + ZC_KC + kvh * 64; ldk = ZP; VT = (const bf16_t*)(p.ws + OFF_VCT) + (size_t)kvh * 64 * S; O = (bf16_t*)(p.ws + OFF_OC); }
  const int q = qb * 256 + wid * 32 + r;
  bf16x8 qf[NQK];
  if (TYPE == 0) {
    const bf16_t* qp = (const bf16_t*)(p.ws + OFF_QA) + (size_t)q * 768 + head * 96 + 8 * h;
    float x[6][8];
#pragma unroll
    for (int d0 = 0; d0 < 6; ++d0) unpack8(*(const u32x4*)(qp + d0 * 16), x[d0]);
    rope_pair8(x[4], x[5], CS + (size_t)q * 16 + 8 * h);
    const float sc = 0.10206207261596577f * LOG2E;
#pragma unroll
    for (int d0 = 0; d0 < 6; ++d0) qf[d0] = pack8(x[d0][0] * sc, x[d0][1] * sc, x[d0][2] * sc, x[d0][3] * sc, x[d0][4] * sc, x[d0][5] * sc, x[d0][6] * sc, x[d0][7] * sc);
  } else {
    const bf16_t* qp = Z + (size_t)q * ZP + ZC_QC + head * 64 + 8 * h;
    float x[4][8]; float ss = 0.f;
#pragma unroll
    for (int d0 = 0; d0 < 4; ++d0) { unpack8(*(const u32x4*)(qp + d0 * 16), x[d0]);
#pragma unroll
      for (int j = 0; j < 8; ++j) ss += x[d0][j] * x[d0][j]; }
    ss += __shfl_xor(ss, 32);
    const float rs = rsqrtf(ss * (1.0f / 64.0f) + 1e-6f);
    const float* gq = p.c_q_norm + layer * 64;
#pragma unroll
    for (int d0 = 0; d0 < 4; ++d0)
#pragma unroll
      for (int j = 0; j < 8; ++j) x[d0][j] *= rs * gq[d0 * 16 + 8 * h + j];
    rope_pair8(x[0], x[1], CS + (size_t)(q >> 6) * 16 + 8 * h);
    rope_pair8(x[2], x[3], CS + (size_t)(q & 63) * 16 + 8 * h);
    const float sc = 0.125f * LOG2E;
#pragma unroll
    for (int d0 = 0; d0 < 4; ++d0) qf[d0] = pack8(x[d0][0] * sc, x[d0][1] * sc, x[d0][2] * sc, x[d0][3] * sc, x[d0][4] * sc, x[d0][5] * sc, x[d0][6] * sc, x[d0][7] * sc);
  }
  typedef __attribute__((address_space(3))) unsigned lds_u32;
  const int srow = tid >> 3, sch = (tid & 7) ^ ((srow >> 1) & 7);
  const bf16_t* gk = Kn + (size_t)srow * ldk + sch * 8;
  const bf16_t* gv = VT + (size_t)srow * S + sch * 8;
  const int rrow = tid >> 2, rch = (tid & 3) ^ ((rrow >> 2) & 3);
  const bf16_t* gr = Z + ZC_KR + (size_t)rrow * ZP + rch * 8;
  char* wbase = lds + wid * 1024;
#define DMA(t, soff) do { \
    __builtin_amdgcn_global_load_lds((const unsigned*)(gk + (size_t)(t) * 64 * ldk), (lds_u32*)(wbase + (soff)), 16, 0, 0); \
    __builtin_amdgcn_global_load_lds((const unsigned*)(gv + (size_t)(t) * 64), (lds_u32*)(wbase + (soff) + 8192), 16, 0, 0); \
    if (TYPE == 0 && wid < 4) __builtin_amdgcn_global_load_lds((const unsigned*)(gr + (size_t)(t) * 64 * ZP), (lds_u32*)(wbase + (soff) + 16384), 16, 0, 0); } while (0)
#define DMA_WAIT(keep) do { if (keep) { if (TYPE == 0 && wid < 4) asm volatile("s_waitcnt vmcnt(3)" ::: "memory"); else asm volatile("s_waitcnt vmcnt(2)" ::: "memory"); } \
    else asm volatile("s_waitcnt vmcnt(0)" ::: "memory"); } while (0)
#define BAR() do { asm volatile("s_waitcnt lgkmcnt(0)" ::: "memory"); __builtin_amdgcn_s_barrier(); asm volatile("" ::: "memory"); } while (0)
  constexpr int NONES = (TYPE == 0) ? 0 : 2;
  float m_run = 0.f, lsum = 0.f, ls0 = 0.f, ls1 = 0.f, ls2 = 0.f; f32x16 o0, o1, negm, la;
#pragma unroll
  for (int i = 0; i < 16; ++i) { o0[i] = 0.f; o1[i] = 0.f; negm[i] = 0.f; la[i] = 0.f; }
  const bf16x8 ones = {0x3F80, 0x3F80, 0x3F80, 0x3F80, 0x3F80, 0x3F80, 0x3F80, 0x3F80};
  const int rK = (r & ~12) | ((r & 4) << 1) | ((r & 8) >> 1);
  const int ksw = (rK >> 1) & 7, rsw = (rK >> 2) & 3, vsw = (r >> 1) & 7;
  int koff[4], roff[2], voff[4];
#pragma unroll
  for (int d0 = 0; d0 < 4; ++d0) { koff[d0] = rK * 128 + (((2 * d0 + h) ^ ksw) << 4); voff[d0] = 8192 + r * 128 + (((2 * d0 + h) ^ vsw) << 4); }
#pragma unroll
  for (int d0 = 0; d0 < 2; ++d0) roff[d0] = 16384 + rK * 64 + (((2 * d0 + h) ^ rsw) << 4);
  constexpr int NT = S / 64;
  constexpr float THR = 8.0f;
#define SB() __builtin_amdgcn_sched_barrier(0)
#define QKR(d0, K0, K1, SOFF) do { if ((d0) < 4) { K0 = *(const bf16x8*)(lds + (SOFF) + koff[(d0) & 3]); K1 = *(const bf16x8*)(lds + (SOFF) + 32 * 128 + koff[(d0) & 3]); } \
    else if ((d0) < NQK) { K0 = *(const bf16x8*)(lds + (SOFF) + roff[(d0) & 1]); K1 = *(const bf16x8*)(lds + (SOFF) + 32 * 64 + roff[(d0) & 1]); } } while (0)
#define QKM(N0, N1, d0, K0, K1) do { if ((d0) == 0) { N0 = MFMA(K0, qf[0], negm); N1 = MFMA(K1, qf[0], negm); } \
    else if ((d0) < NQK) { N0 = MFMA(K0, qf[(d0) < NQK ? (d0) : 0], N0); N1 = MFMA(K1, qf[(d0) < NQK ? (d0) : 0], N1); } } while (0)
#define EX4(CC, B, SI) do { if (!FIXREF) __builtin_amdgcn_s_setprio(1); _Pragma("unroll") for (int i_ = 0; i_ < 4; ++i_) { CC[(B) + i_] = fexp2(CC[(B) + i_]); if ((SI) >= NONES) { if (i_ == 0) ls0 += CC[(B) + i_]; else if (i_ == 1) ls1 += CC[(B) + i_]; else if (i_ == 2) ls2 += CC[(B) + i_]; else lsum += CC[(B) + i_]; } } if (!FIXREF) __builtin_amdgcn_s_setprio(0); } while (0)
#define PK8(PF, CC, B) do { PF = pack8(CC[(B)], CC[(B) + 1], CC[(B) + 2], CC[(B) + 3], CC[(B) + 4], CC[(B) + 5], CC[(B) + 6], CC[(B) + 7]); } while (0)
#define VR(s_, V0, V1, SOFF) do { V0 = *(const bf16x8*)(lds + (SOFF) + voff[s_]); V1 = *(const bf16x8*)(lds + (SOFF) + 32 * 128 + voff[s_]); } while (0)
#define PVM(s_, V0, V1) do { o0 = MFMA(V0, pf[s_], o0); o1 = MFMA(V1, pf[s_], o1); if ((s_) < NONES) la = MFMA(ones, pf[s_], la); } while (0)
#define MAXG(NN, B) do { ma_ = fmaxf(fmaxf(ma_, NN[(B)]), NN[(B) + 1]); mb_ = fmaxf(fmaxf(mb_, NN[(B) + 2]), NN[(B) + 3]); \
    ma_ = fmaxf(fmaxf(ma_, NN[(B) + 4]), NN[(B) + 5]); mb_ = fmaxf(fmaxf(mb_, NN[(B) + 6]), NN[(B) + 7]); } while (0)
#define ROWMAX(P0, P1, MX) do { float a_ = fmaxf(fmaxf(P0[0], P0[1]), P1[0]), c_ = fmaxf(fmaxf(P0[2], P0[3]), P1[1]); a_ = fmaxf(fmaxf(a_, P1[2]), P1[3]); \
    _Pragma("unroll") for (int i_ = 4; i_ < 16; i_ += 4) { a_ = fmaxf(fmaxf(a_, P0[i_]), P0[i_ + 1]); c_ = fmaxf(fmaxf(c_, P0[i_ + 2]), P0[i_ + 3]); a_ = fmaxf(fmaxf(a_, P1[i_]), P1[i_ + 1]); c_ = fmaxf(fmaxf(c_, P1[i_ + 2]), P1[i_ + 3]); } \
    a_ = fmaxf(a_, c_); MX = fmaxf(a_, __shfl_xor(a_, 32)); } while (0)
#define RESCALE(P0, P1, DELTA) do { const float dl_ = (DELTA); m_run += dl_; const float al_ = fexp2(-dl_); lsum *= al_; ls0 *= al_; ls1 *= al_; ls2 *= al_; \
    _Pragma("unroll") for (int i_ = 0; i_ < 16; ++i_) { P0[i_] -= dl_; P1[i_] -= dl_; o0[i_] *= al_; o1[i_] *= al_; if (NONES > 0) la[i_] *= al_; negm[i_] = -m_run; } } while (0)
#define STEP(C0, C1, N0, N1, T, HAS_NEXT, HAS_LOAD, S0, S1, S3) do { \
    if (HAS_LOAD) DMA((T) + 3, S3); \
    bf16x8 pf[4]; bf16x8 ka0, ka1, kb0, kb1, va0, va1, vb0, vb1; \
    if (HAS_NEXT) QKR(0, ka0, ka1, S1); \
    SB(); if (HAS_NEXT) { QKR(1, kb0, kb1, S1); QKM(N0, N1, 0, ka0, ka1); } EX4(C0, 0, 0); \
    SB(); if (HAS_NEXT) { QKR(2, ka0, ka1, S1); QKM(N0, N1, 1, kb0, kb1); } EX4(C0, 4, 0); PK8(pf[0], C0, 0); \
    SB(); if (HAS_NEXT) { QKR(3, kb0, kb1, S1); QKM(N0, N1, 2, ka0, ka1); } EX4(C0, 8, 1); \
    SB(); if (HAS_NEXT) { QKR(4, ka0, ka1, S1); QKM(N0, N1, 3, kb0, kb1); } EX4(C0, 12, 1); PK8(pf[1], C0, 8); if (NQK == 4) VR(0, va0, va1, S0); \
    if (NQK > 4) { \
      SB(); if (HAS_NEXT) { QKR(5, kb0, kb1, S1); QKM(N0, N1, 4, ka0, ka1); } EX4(C1, 0, 2); \
      SB(); if (HAS_NEXT) QKM(N0, N1, 5, kb0, kb1); EX4(C1, 4, 2); PK8(pf[2], C1, 0); VR(0, va0, va1, S0); } \
    float ma_ = -1e30f, mb_ = -1e30f; \
    if (NQK == 4) { \
      SB(); VR(1, vb0, vb1, S0); PVM(0, va0, va1); EX4(C1, 0, 2); EX4(C1, 4, 2); PK8(pf[2], C1, 0); \
      SB(); VR(2, va0, va1, S0); PVM(1, vb0, vb1); EX4(C1, 8, 3); EX4(C1, 12, 3); PK8(pf[3], C1, 8); \
    } else { \
      SB(); VR(1, vb0, vb1, S0); PVM(0, va0, va1); EX4(C1, 8, 3); \
      SB(); VR(2, va0, va1, S0); PVM(1, vb0, vb1); EX4(C1, 12, 3); PK8(pf[3], C1, 8); } \
    SB(); VR(3, vb0, vb1, S0); PVM(2, va0, va1); if (HAS_NEXT && !FIXREF) { MAXG(N0, 0); MAXG(N0, 8); } \
    SB(); PVM(3, vb0, vb1); if (HAS_NEXT && !FIXREF) { MAXG(N1, 0); MAXG(N1, 8); } \
    SB(); \
    float mx_ = fmaxf(ma_, mb_); { const auto rr_ = __builtin_amdgcn_permlane32_swap(__float_as_uint(mx_), __float_as_uint(mx_), false, false); mx_ = fmaxf(__uint_as_float(rr_[0]), __uint_as_float(rr_[1])); } \
    DMA_WAIT(HAS_LOAD); BAR(); \
    if (HAS_NEXT && !FIXREF) { if (__any(mx_ > THR)) RESCALE(N0, N1, fmaxf(mx_, 0.f)); } } while (0)
  constexpr int R0 = 0, R1 = ATT_STAGE, R2 = 2 * ATT_STAGE, R3 = 3 * ATT_STAGE;
  f32x16 sA0, sA1, sB0, sB1;
  DMA(0, R0); DMA(1, R1); DMA(2, R2); DMA_WAIT(true); BAR();
  if (FIXREF) { m_run = bref;
#pragma unroll
    for (int i = 0; i < 16; ++i) negm[i] = -bref; }
  { bf16x8 ka0, ka1;
#pragma unroll
    for (int d0 = 0; d0 < NQK; ++d0) { QKR(d0, ka0, ka1, R0); QKM(sA0, sA1, d0, ka0, ka1); } }
  if (!FIXREF) { float mx0; ROWMAX(sA0, sA1, mx0); m_run = mx0;
#pragma unroll
    for (int i = 0; i < 16; ++i) { sA0[i] -= mx0; sA1[i] -= mx0; negm[i] = -mx0; } }
  for (int t = 0; t < NT - 4; t += 4) {
    STEP(sA0, sA1, sB0, sB1, t, true, true, R0, R1, R3);
    STEP(sB0, sB1, sA0, sA1, t + 1, true, true, R1, R2, R0);
    STEP(sA0, sA1, sB0, sB1, t + 2, true, true, R2, R3, R1);
    STEP(sB0, sB1, sA0, sA1, t + 3, true, true, R3, R0, R2);
  }
  STEP(sA0, sA1, sB0, sB1, NT - 4, true, true, R0, R1, R3);
  STEP(sB0, sB1, sA0, sA1, NT - 3, true, false, R1, R2, R0);
  STEP(sA0, sA1, sB0, sB1, NT - 2, true, false, R2, R3, R1);
  STEP(sB0, sB1, sA0, sA1, NT - 1, false, false, R3, R0, R2);
  lsum += ls0 + ls1 + ls2;
  const float l = (NONES > 0 ? la[0] : 0.f) + lsum + __shfl_xor(lsum, 32);
#undef DMA
#undef DMA_WAIT
#undef BAR
#undef SB
#undef QKR
#undef QKM
#undef EX4
#undef PK8
#undef VR
#undef PVM
#undef MAXG
#undef ROWMAX
#undef RESCALE
#undef STEP
  const float inv = 1.0f / l;
  bf16_t* op = O + (size_t)q * 512 + head * 64;
  store_o_wide(op, o0, inv, h); store_o_wide(op + 32, o1, inv, h);
}

constexpr int BLV = 49152;
DI void b_issue_k(const Params& p, int x, char* lds, int tid, int wid) {
  typedef __attribute__((address_space(3))) unsigned lds_u32;
  const int g = x >> 9, head = (x >> 6) & 7, blk256 = x & 63;
  const int sh = 2 * g, Ls = S >> sh, P0 = blk256 * 256, sub = P0 / Ls, i0 = P0 & (Ls - 1), sub0 = sub * Ls;
  const bf16_t* Zk = (const bf16_t*)(p.ws + OFF_Z) + ZC_QKVB + ((1 * 3 + g) * 8 + head) * 64;
#pragma unroll
  for (int i = 0; i < 6; ++i) {
    const int sl = i * 512 + tid, row = sl >> 3, c = (sl & 7) ^ ((row >> 1) & 7); int key = i0 - 64 + row; key = key < 0 ? 0 : (key > Ls - 1 ? Ls - 1 : key);
    __builtin_amdgcn_global_load_lds((const unsigned*)(Zk + (size_t)(sub0 + key) * ZP + c * 8), (lds_u32*)(lds + (i * 512 + wid * 64) * 16), 16, 0, 0);
  }
}
DI void b_issue_v(const Params& p, int x, char* lds, int tid, int wid) {
  typedef __attribute__((address_space(3))) unsigned lds_u32;
  const int g = x >> 9, head = (x >> 6) & 7, blk256 = x & 63;
  const int sh = 2 * g, Ls = S >> sh, P0 = blk256 * 256, sub = P0 / Ls, i0 = P0 & (Ls - 1), sub0 = sub * Ls;
  const bf16_t* VTg = (const bf16_t*)(p.ws + OFF_VBT) + (size_t)((g * 8 + head) * 64) * S + sub0;
#pragma unroll
  for (int i = 0; i < 6; ++i) {
    const int sl = i * 512 + tid, d = sl / 48, c = (sl - d * 48) ^ (d & 15); int k0 = i0 - 64 + 8 * c; k0 = k0 < 0 ? 0 : (k0 > Ls - 8 ? Ls - 8 : k0);
    __builtin_amdgcn_global_load_lds((const unsigned*)(VTg + (size_t)d * S + k0), (lds_u32*)(lds + BLV + (i * 512 + wid * 64) * 16), 16, 0, 0);
  }
}
DI void attn_b_item(const Params& p, int x, int xnext, char* lds) {
  const int tid = otid(), lane = tid & 63, wid = wave_of(tid), r = lane & 31, h = lane >> 5;
  const int g = x >> 9, head = (x >> 6) & 7, blk256 = x & 63;
  const bf16_t* Z = (const bf16_t*)(p.ws + OFF_Z);
  const int sh = 2 * g, Ls = S >> sh, P0 = blk256 * 256, sub = P0 / Ls, i0 = P0 & (Ls - 1);
  const bf16_t* Zq = Z + ZC_QKVB + ((0 * 3 + g) * 8 + head) * 64;
  constexpr int LV = BLV;
  const int i0w = i0 + 32 * wid;
  const float* BT = (const float*)(p.ws + OFF_BT) + (g * 8 + head) * 256 + 32 - r + 8 * h;
  const int rK = (r & ~12) | ((r & 4) << 1) | ((r & 8) >> 1);
  bf16x8 qf[4];
  {
    const bf16_t* qp = Zq + (size_t)(P0 + 32 * wid + r) * ZP + 8 * h; const float scq = 0.125f * LOG2E;
#pragma unroll
    for (int d0 = 0; d0 < 4; ++d0) { float x8[8]; unpack8(*(const u32x4*)(qp + d0 * 16), x8); qf[d0] = pack8(x8[0] * scq, x8[1] * scq, x8[2] * scq, x8[3] * scq, x8[4] * scq, x8[5] * scq, x8[6] * scq, x8[7] * scq); }
  }
  float bvs[5][16];
#pragma unroll
  for (int c = 0; c < 5; ++c)
#pragma unroll
    for (int i = 0; i < 16; ++i) bvs[c][i] = BT[32 * c + (i & 3) + 4 * ((i >> 2) & 1) + 16 * (i >> 3)];
  asm volatile("s_waitcnt vmcnt(0)" ::: "memory"); __builtin_amdgcn_s_barrier(); asm volatile("" ::: "memory");
#pragma unroll
  for (int c = 0; c < 5; ++c)
#pragma unroll
    for (int i = 0; i < 16; ++i) asm volatile("" : "+v"(bvs[c][i]));
  f32x16 sc[5];
  const int ksw = (rK >> 1) & 7;
#pragma unroll
  for (int c = 0; c < 5; ++c) {
#pragma unroll
    for (int i = 0; i < 16; ++i) sc[c][i] = 0.f;
    const char* kp = lds + (32 * wid + 32 * c + rK) * 128;
#pragma unroll
    for (int d0 = 0; d0 < 4; ++d0) { const bf16x8 kf = *(const bf16x8*)(kp + (((2 * d0 + h) ^ ksw) << 4)); sc[c] = MFMA(kf, qf[d0], sc[c]); }
  }
  asm volatile("s_waitcnt lgkmcnt(0)" ::: "memory"); __builtin_amdgcn_s_barrier(); asm volatile("" ::: "memory");
  if (xnext >= 0) b_issue_k(p, xnext, lds, tid, wid);
  float mxa[4] = {-1e30f, -1e30f, -1e30f, -1e30f};
#pragma unroll
  for (int c = 0; c < 5; ++c)
#pragma unroll
    for (int i = 0; i < 16; ++i) {
      const int prow = (i & 3) + 4 * ((i >> 2) & 1) + 8 * h + 16 * (i >> 3);
      const int rel = 32 * c - 64 + prow - r, key = i0w + r + rel;
      const bool valid = ((unsigned)(rel + 64) <= 128u) & ((unsigned)key < (unsigned)Ls);
      const float v = valid ? sc[c][i] + bvs[c][i] : -1e30f;
      sc[c][i] = v; mxa[i & 3] = fmaxf(mxa[i & 3], v);
    }
  float mx = fmaxf(fmaxf(mxa[0], mxa[1]), fmaxf(mxa[2], mxa[3]));
  mx = fmaxf(mx, __shfl_xor(mx, 32));
  float la4[4] = {0.f, 0.f, 0.f, 0.f};
#pragma unroll
  for (int c = 0; c < 5; ++c)
#pragma unroll
    for (int i = 0; i < 16; ++i) { const float e = fexp2(sc[c][i] - mx); sc[c][i] = e; la4[i & 3] += e; }
  float l = (la4[0] + la4[1]) + (la4[2] + la4[3]);
  l += __shfl_xor(l, 32);
  f32x16 o0, o1;
#pragma unroll
  for (int i = 0; i < 16; ++i) { o0[i] = 0.f; o1[i] = 0.f; }
  const char* vp = lds + LV + r * 768; const int vsw = r & 15;
#pragma unroll
  for (int c = 0; c < 5; ++c)
#pragma unroll
    for (int s = 0; s < 2; ++s) {
      const bf16x8 pf = pack8(sc[c][8 * s], sc[c][8 * s + 1], sc[c][8 * s + 2], sc[c][8 * s + 3], sc[c][8 * s + 4], sc[c][8 * s + 5], sc[c][8 * s + 6], sc[c][8 * s + 7]);
      const int ch = ((4 * wid + 4 * c + 2 * s + h) ^ vsw) << 4;
      const bf16x8 v0 = *(const bf16x8*)(vp + ch), v1 = *(const bf16x8*)(vp + 32 * 768 + ch);
      o0 = MFMA(v0, pf, o0); o1 = MFMA(v1, pf, o1);
    }
  asm volatile("s_waitcnt lgkmcnt(0)" ::: "memory"); __builtin_amdgcn_s_barrier(); asm volatile("" ::: "memory");
  if (xnext >= 0) b_issue_v(p, xnext, lds, tid, wid);
  const float inv = 1.0f / l;
  const int tkn = ((i0w + r) << sh) + sub;
  bf16_t* OG = (g < 2) ? (bf16_t*)(p.ws + OFF_H) + (size_t)g * S * 512 : (bf16_t*)(p.ws + OFF_OB);
  bf16_t* op = OG + (size_t)tkn * 512 + head * 64;
  store_o_wide(op, o0, inv, h); store_o_wide(op + 32, o1, inv, h);
  if (h == 0) { float* LSE = (float*)(p.ws + OFF_LSE); LSE[((size_t)g * S + tkn) * 8 + head] = (mx + __builtin_amdgcn_logf(l)) * LN2; }
}

DI void phase_attn(const Params& p, int layer, char* smem) {
  const int n_dense = 1024, n_b = 1536, total = n_dense + n_b;
  int it = blockIdx.x;
  for (; it < n_dense; it += gridDim.x) {
    if (it < 512) { attn_dense_unit<0, false>(p, layer, it & 7, it >> 3, smem, 0.f); }
    else { const int v = it - 512;
      float bref;
      { const int ln = otid() & 63; float gq = fabsf(p.c_q_norm[layer * 64 + ln]), gk = fabsf(p.c_k_norm[layer * 64 + ln]);
#pragma unroll
        for (int o = 32; o >= 1; o >>= 1) { gq = fmaxf(gq, __shfl_xor(gq, o)); gk = fmaxf(gk, __shfl_xor(gk, o)); }
        bref = 64.0f * gq * gk * 0.125f * LOG2E * 1.02f; }
      if (__builtin_amdgcn_readfirstlane(bref < 60.0f ? 1 : 0) != 0) attn_dense_unit<1, true>(p, layer, v & 7, v >> 3, smem, bref);
      else attn_dense_unit<1, false>(p, layer, v & 7, v >> 3, smem, 0.f); }
  }
  if (it < total) {
    const int tid = otid(), wid = wave_of(tid);
    b_issue_k(p, it - n_dense, smem, tid, wid); b_issue_v(p, it - n_dense, smem, tid, wid);
    for (; it < total; it += gridDim.x) {
      const int nx = it + (int)gridDim.x;
      attn_b_item(p, it - n_dense, nx < total ? nx - n_dense : -1, smem);
    }
  }
}

DI void phase_combine(const Params& p) {
  const bf16_t* G0 = (const bf16_t*)(p.ws + OFF_H); const bf16_t* G1 = G0 + (size_t)S * 512; bf16_t* OB = (bf16_t*)(p.ws + OFF_OB);
  const float* LSE = (const float*)(p.ws + OFF_LSE);
  for (int e = blockIdx.x * 512 + otid(); e < S * 64; e += gridDim.x * 512) {
    const int tkn = e >> 6, c = e & 63, head = c >> 3;
    const float l0 = LSE[((size_t)0 * S + tkn) * 8 + head], l1 = LSE[((size_t)1 * S + tkn) * 8 + head], l2 = LSE[((size_t)2 * S + tkn) * 8 + head];
    const float mm = fmaxf(l0, fmaxf(l1, l2));
    float w0 = __expf(l0 - mm), w1 = __expf(l1 - mm), w2 = __expf(l2 - mm);
    const float iw = 1.0f / (w0 + w1 + w2); w0 *= iw; w1 *= iw; w2 *= iw;
    const size_t off = (size_t)tkn * 512 + c * 8;
    const u32x4 a = *(const u32x4*)(G0 + off), b = *(const u32x4*)(G1 + off), d = *(const u32x4*)(OB + off);
    u32x4 o;
#pragma unroll
    for (int q = 0; q < 4; ++q) o[q] = pk2(w0 * bflo(a[q]) + w1 * bflo(b[q]) + w2 * bflo(d[q]), w0 * bfhi(a[q]) + w1 * bfhi(b[q]) + w2 * bfhi(d[q]));
    *(u32x4*)(OB + off) = o;
  }
}

#define XB_TMO      128
#define XB_XCNT(j)  (256  + 64 * (j))
#define XB_XSUB(j)  (1280 + 64 * (j))
#define XB_XGEN(j)  (2304 + 64 * (j))
#define XB_TOP      3328
#define XB_TOPGEN   3392
#define XCD_BAR_WORDS 3456
#define XB_SPIN_CAP (1u << 18)
#ifndef LAS
#define LAS __attribute__((address_space(3)))
#endif

__device__ __forceinline__ unsigned xb_ld(unsigned* p)              { return __hip_atomic_load(p, __ATOMIC_RELAXED, __HIP_MEMORY_SCOPE_AGENT); }
__device__ __forceinline__ unsigned xb_add(unsigned* p, unsigned v) { return __hip_atomic_fetch_add(p, v, __ATOMIC_RELAXED, __HIP_MEMORY_SCOPE_AGENT); }
__device__ __forceinline__ unsigned xb_xcc_id() { return (unsigned)__builtin_amdgcn_s_getreg((3 << 11) | 20) & 0xFu; }
#define XB_SPIN(cond, bar) do { unsigned _sp = 0; while (cond) { __builtin_amdgcn_s_sleep(1); \
    if ((++_sp & 255u) == 0u) { if (xb_ld(&(bar)[XB_TMO])) break; if (_sp > XB_SPIN_CAP) { atomicAdd(&(bar)[XB_TMO], 1u); break; } } } } while (0)

struct XcdBarrier {
    unsigned* bar; unsigned x;
    volatile LAS unsigned* st;
};

__device__ __forceinline__ XcdBarrier xcd_barrier_post(unsigned* bar, volatile LAS unsigned* st) {
    XcdBarrier b; b.bar = bar; b.x = xb_xcc_id(); b.st = st;
    if (threadIdx.x == 0) (void)xb_add(&bar[XB_XCNT(b.x)], 1u);
    return b;
}
__device__ __forceinline__ void xcd_barrier_complete(unsigned* bar, unsigned x, unsigned& nloc, unsigned& nx) {
    const unsigned G = gridDim.x * gridDim.y * gridDim.z;
    unsigned sum, cnt, mine, sp = 0u;
    for (;;) {
        sum = 0u; cnt = 0u; mine = 0u;
#pragma unroll
        for (unsigned j = 0; j < 16; ++j) { const unsigned c = xb_ld(&bar[XB_XCNT(j)]); sum += c; cnt += (c > 0u) ? 1u : 0u; mine = (j == x) ? c : mine; }
        if (sum == G) break;
        __builtin_amdgcn_s_sleep(1);
        if ((++sp & 255u) == 0u) { if (xb_ld(&bar[XB_TMO])) break; if (sp > XB_SPIN_CAP) { atomicAdd(&bar[XB_TMO], 1u); break; } }
    }
    nloc = mine > 0u ? mine : 1u; nx = cnt > 0u ? cnt : 1u;
}

__device__ __forceinline__ void xcd_barrier(const XcdBarrier& b) {
    asm volatile("s_waitcnt vmcnt(0)" ::: "memory");
    __syncthreads();
    if (threadIdx.x == 0) {
        unsigned* bar = b.bar;
        __builtin_amdgcn_s_waitcnt(0);
        unsigned nloc = b.st[0], nx = b.st[1];
        if (nloc == 0u) { xcd_barrier_complete(bar, b.x, nloc, nx); b.st[0] = nloc; b.st[1] = nx; }
        const unsigned old = xb_add(&bar[XB_XSUB(b.x)], 1u);
        const unsigned gen = old / nloc;
        if (old + 1u == (gen + 1u) * nloc) {
            __builtin_amdgcn_fence(__ATOMIC_RELEASE, "agent");
            asm volatile("s_waitcnt vmcnt(0)" ::: "memory");
            const unsigned og = xb_add(&bar[XB_TOP], 1u);
            const unsigned tg = og / nx;
            if (og + 1u == (tg + 1u) * nx) xb_add(&bar[XB_TOPGEN], 1u);
            else XB_SPIN(xb_ld(&bar[XB_TOPGEN]) == tg, bar);
            __builtin_amdgcn_fence(__ATOMIC_ACQUIRE, "agent");
            xb_add(&bar[XB_XGEN(b.x)], 1u);
            asm volatile("s_waitcnt vmcnt(0)" ::: "memory");
        } else {
            XB_SPIN(xb_ld(&bar[XB_XGEN(b.x)]) == gen, bar);
            __builtin_amdgcn_fence(__ATOMIC_ACQUIRE, "agent");
            asm volatile("s_waitcnt vmcnt(0)" ::: "memory");
        }
    }
    __syncthreads();
}

__global__ void __launch_bounds__(512) hybrid_encoder_mega(Params p) {
  extern __shared__ __attribute__((aligned(16))) char smem[];
  cg::grid_group grid = cg::this_grid();
  const int G = gridDim.x, bx = blockIdx.x;
  bf16_t* Z = (bf16_t*)(p.ws + OFF_Z); bf16_t* H = (bf16_t*)(p.ws + OFF_H);
  float* ssq_q = (float*)(p.ws + OFF_SSQ); float* ssq_kv = ssq_q + S; float* ssq_x = ssq_q + 2 * S;
  bf16_t* XB = (bf16_t*)(p.ws + OFF_OA);
  volatile LAS unsigned* xst = (volatile LAS unsigned*)(smem + 131072);
  if (threadIdx.x == 0) { xst[0] = 0u; xst[1] = 0u; xst[2] = 0u; xst[3] = 0u; }
  __syncthreads();
  const XcdBarrier xb = xcd_barrier_post((unsigned*)(p.ws + OFF_BAR), xst);
  bool first_sync = true;
#define GSYNC() do { if (first_sync) { grid.sync(); first_sync = false; } else xcd_barrier(xb); } while (0)
  build_tables(p);
  for (int layer = 0; layer < 2; ++layer) {
    convert_weights(p, layer, smem);
    for (int seq = 0; seq < 3; ++seq) {
      const float* xin = (layer == 0) ? (seq < 2 ? p.x_prompt + (size_t)seq * S * DM : p.x_sample) : p.out + (size_t)seq * S * DM;
      float* xo = p.out + (size_t)seq * S * DM;
      phase_norm(xin, p.norm_mix + layer * DM, H, S);
      { const int tz = otid();
_Pragma("nounroll")
        for (int b = bx; b < 96; b += G) ssq_q[b * 512 + tz] = 0.f; }
      GSYNC();
      { pg8::Gemm g{H, (const bf16_t*)(p.ws + WT_IN), S, 9216, DM, DM, DM}; pg8::StaticOrder so; so.init(S, 9216, G, bx);
        EpiInproj E{Z, (bf16_t*)(p.ws + OFF_VCT), (bf16_t*)(p.ws + OFF_VBT), ssq_q, ssq_kv};
        pg8::gemm_phase<EpiInproj, pg8::StaticOrder, true, true>(GEMM_LDS, g, so, E); }
      GSYNC();
      { pg8::Gemm g{Z + ZC_CQ, (const bf16_t*)(p.ws + WT_UQ), S, 768, 384, ZP, 384}; pg8::StaticOrder so; so.init(S, 768, G, bx);
        EpiUpQ E{(bf16_t*)(p.ws + OFF_QA), ssq_q};
        pg8::gemm_phase<EpiUpQ, pg8::StaticOrder, true, true>(GEMM_LDS, g, so, E); }
      { pg8::Gemm g{Z + ZC_CKV, (const bf16_t*)(p.ws + WT_UKV), S, 1024, 256, ZP, 256}; pg8::StaticOrder so; so.init(S, 1024, G, bx);
        EpiUpKV E{(bf16_t*)(p.ws + OFF_KA), (bf16_t*)(p.ws + OFF_VAT), ssq_kv};
        pg8::gemm_phase<EpiUpKV, pg8::StaticOrder, true, true>(GEMM_LDS, g, so, E); }
      phase_kpost(p, layer);
      GSYNC();
      phase_attn(p, layer, smem);
      GSYNC();
      phase_combine(p);
      GSYNC();
      { pg8::Gemm g{(const bf16_t*)(p.ws + OFF_OA), (const bf16_t*)(p.ws + WT_BRA), 3 * S, 3072, 512, 512, 512}; DiagOrder so; so.init(G, bx);
        EpiMerge E{Z, H};
        pg8::gemm_phase<EpiMerge, DiagOrder, true, true>(GEMM_LDS, g, so, E); }
      GSYNC();
      { pg8::Gemm g{H, (const bf16_t*)(p.ws + WT_OUT), S, 1024, DM, DM, DM}; pg8::StaticOrder so; so.init(S, 1024, G, bx);
        EpiResid<true> E{xin, xo, XB, ssq_x};
        pg8::gemm_phase<EpiResid<true>, pg8::StaticOrder, true, true>(GEMM_LDS, g, so, E); }
      GSYNC();
      { pg8::Gemm g{XB, (const bf16_t*)(p.ws + WT_UP), S, DFF, DM, DM, DM}; pg8::StaticOrder so; so.init(S, DFF, G, bx);
        EpiRelu2 E{Z, ssq_x};
        pg8::gemm_phase<EpiRelu2, pg8::StaticOrder, true, true>(GEMM_LDS, g, so, E); }
      GSYNC();
      { pg8::Gemm g{Z, (const bf16_t*)(p.ws + WT_DOWN), S, 1024, DFF, DFF, DFF}; pg8::StaticOrder so; so.init(S, 1024, G, bx);
        EpiResid<false> E{xo, xo, nullptr, nullptr};
        pg8::gemm_phase<EpiResid<false>, pg8::StaticOrder, true, true>(GEMM_LDS, g, so, E); }
      GSYNC();
    }
  }
  phase_final_norm(p.out, p.final_norm, 3 * S);
}

extern "C" void kernel_launch(void* const* d_in, const int* in_sizes, int n_in, void* d_out, int out_size, void* d_ws, size_t ws_size, hipStream_t stream) {
  static int grid_blocks = 0;
  if (!grid_blocks) {
    if (ws_size < WS_END) { fprintf(stderr, "kernel_launch: workspace too small: %zu < %zu\n", ws_size, (size_t)WS_END); return; }
    if (hipFuncSetAttribute((const void*)hybrid_encoder_mega, hipFuncAttributeMaxDynamicSharedMemorySize, LDS_BYTES) != hipSuccess) { fprintf(stderr, "hipFuncSetAttribute failed\n"); return; }
    int dev = 0, cus = 0, per_cu = 0;
    hipGetDevice(&dev);
    hipDeviceGetAttribute(&cus, hipDeviceAttributeMultiprocessorCount, dev);
    hipOccupancyMaxActiveBlocksPerMultiprocessor(&per_cu, hybrid_encoder_mega, 512, LDS_BYTES);
    if (per_cu < 1) { fprintf(stderr, "occupancy query returned %d\n", per_cu); return; }
    grid_blocks = cus;
  }
  Params p{};
  p.x_prompt = (const float*)d_in[0]; p.x_sample = (const float*)d_in[1];
  p.norm_mix = (const float*)d_in[2]; p.w_in = (const float*)d_in[3]; p.a_q_norm = (const float*)d_in[4]; p.a_kv_norm = (const float*)d_in[5];
  p.a_w_uq = (const float*)d_in[6]; p.a_w_ukv = (const float*)d_in[7]; p.c_q_norm = (const float*)d_in[8]; p.c_k_norm = (const float*)d_in[9];
  p.w_br_a = (const float*)d_in[10]; p.w_br_b = (const float*)d_in[11]; p.w_br_c = (const float*)d_in[12]; p.w_out = (const float*)d_in[13];
  p.norm_ffn = (const float*)d_in[14]; p.w_up = (const float*)d_in[15]; p.w_down = (const float*)d_in[16]; p.t5_table = (const float*)d_in[17];
  p.final_norm = (const float*)d_in[18];
  p.out = (float*)d_out; p.ws = (char*)d_ws;
  (void)hipMemsetAsync((char*)d_ws + OFF_BAR, 0, 16384, stream);
  void* args[] = {&p};
  hipError_t e = hipLaunchCooperativeKernel((const void*)hybrid_encoder_mega, dim3(grid_blocks), dim3(512), args, LDS_BYTES, stream);
  if (e != hipSuccess) fprintf(stderr, "cooperative launch failed: %s (grid %d)\n", hipGetErrorString(e), grid_blocks);
}
```
